# Optimizing an MI355X kernel written in HIP

```python
import jax, jax.numpy as jnp
from jax import lax
import numpy as np

D_MODEL = 1024
BATCH = 4
SEQ = 8192
DEPTH = 1

SC_WIDTH = 512
SC_GROUPS = 4
SC_KERNEL = 3
DN_HEADS = 8
DN_DK = 64
DN_DV = 64
DN_KEY = DN_HEADS * DN_DK
DN_VAL = DN_HEADS * DN_DV
DN_CONV = 4
DN_CHUNK = 64
PEER_HEADS = 8
PEER_NKEYS = 128
PEER_EXPERTS = PEER_NKEYS * PEER_NKEYS
PEER_QDIM = 256
PEER_HALF = PEER_QDIM // 2
PEER_TOPK = 16
PEER_BLOCK = 128
NORM_EPS = 1e-6

IN_SIZES = (SC_WIDTH, SC_WIDTH, SC_WIDTH, DN_KEY, DN_KEY, DN_VAL, DN_VAL,
            DN_HEADS, DN_HEADS, D_MODEL, D_MODEL)
IN_COLS = 3 * SC_WIDTH + 2 * DN_KEY + 2 * DN_VAL + 2 * DN_HEADS + 2 * D_MODEL

kernel_name = "hybrid_conv_deltanet_peer_block"


def rmsnorm(x, w):
    xf = x.astype(jnp.float32)
    y = xf * lax.rsqrt(jnp.mean(xf * xf, axis=-1, keepdims=True) + NORM_EPS)
    return (y * w.astype(jnp.float32)).astype(x.dtype)


def l2norm(x):
    return x * lax.rsqrt(jnp.sum(x * x, axis=-1, keepdims=True) + NORM_EPS)


def split_cols(t, sizes):
    outs, start = [], 0
    for s in sizes:
        outs.append(t[..., start:start + s])
        start += s
    return outs


def causal_dwconv(x, w):
    K = w.shape[0]
    T = x.shape[1]
    xp = jnp.pad(x, ((0, 0), (K - 1, 0), (0, 0)))
    acc = xp[:, 0:T] * w[0]
    for k in range(1, K):
        acc = acc + xp[:, k:k + T] * w[k]
    return acc


def gated_delta_rule(q, k, v, g, beta):
    B, T, H, dk = q.shape
    dv = v.shape[-1]
    C = DN_CHUNK
    n = T // C

    def to_chunks(t):
        return jnp.moveaxis(t.reshape((B, n, C) + t.shape[2:]), 3, 1)

    qc, kc, vc, gc, bc = (to_chunks(t) for t in (q, k, v, g, beta))
    G = jnp.cumsum(gc, axis=-1)
    incl = jnp.tril(jnp.ones((C, C), dtype=bool))
    strict = jnp.tril(jnp.ones((C, C), dtype=bool), -1)
    diff = G[..., :, None] - G[..., None, :]
    decay = jnp.where(incl, jnp.exp(jnp.where(incl, diff, 0.0)), 0.0)
    kb = kc * bc[..., None]
    vb = vc * bc[..., None]
    L = jnp.einsum('bhnid,bhnjd->bhnij', kb, kc) * jnp.where(strict, decay, 0.0)
    eye = jnp.eye(C, dtype=L.dtype)
    rhs = jnp.concatenate([vb, kb * jnp.exp(G)[..., None]], axis=-1)
    sol = lax.linalg.triangular_solve(eye + L, rhs, left_side=True, lower=True,
                                      unit_diagonal=True)
    u, w = sol[..., :dv], sol[..., dv:]
    a_qk = jnp.einsum('bhnid,bhnjd->bhnij', qc, kc) * decay
    qg = qc * jnp.exp(G)[..., None]
    kdec = kc * jnp.exp(G[..., -1:] - G)[..., None]
    glast = jnp.exp(G[..., -1])

    xs = tuple(jnp.moveaxis(t, 2, 0) for t in (u, w, qg, a_qk, kdec, glast))

    def step(S, inp):
        u_n, w_n, qg_n, a_n, kd_n, gl_n = inp
        v_new = u_n - jnp.einsum('bhck,bhkv->bhcv', w_n, S)
        o = jnp.einsum('bhck,bhkv->bhcv', qg_n, S) + jnp.einsum('bhij,bhjv->bhiv', a_n, v_new)
        S = S * gl_n[..., None, None] + jnp.einsum('bhck,bhcv->bhkv', kd_n, v_new)
        return S, o

    S0 = jnp.zeros((B, H, dk, dv), dtype=q.dtype)
    _, o = lax.scan(step, S0, xs)
    return o.transpose(1, 0, 3, 2, 4).reshape(B, T, H, dv)


def token_mixer(h, w_in, sc_conv_w, dn_conv_w, dn_a_log, dn_dt_bias, dn_out_norm,
                w_sc_out, w_dn_out, w_mix_out):
    B, T, _ = h.shape
    proj = h @ w_in
    (sc_b, sc_c, sc_x, dn_q, dn_k, dn_v, dn_z, dn_a, dn_b,
     gate_sc, gate_dn) = split_cols(proj, IN_SIZES)

    br_sc = (sc_b * causal_dwconv(sc_c * sc_x, sc_conv_w)) @ w_sc_out

    qkv = jax.nn.silu(causal_dwconv(jnp.concatenate([dn_q, dn_k, dn_v], axis=-1), dn_conv_w))
    q, k, v = split_cols(qkv.astype(jnp.float32), (DN_KEY, DN_KEY, DN_VAL))
    q = l2norm(q.reshape(B, T, DN_HEADS, DN_DK)) * (DN_DK ** -0.5)
    k = l2norm(k.reshape(B, T, DN_HEADS, DN_DK))
    v = v.reshape(B, T, DN_HEADS, DN_DV)
    beta = jax.nn.sigmoid(dn_b.astype(jnp.float32))
    g = -jnp.exp(dn_a_log.astype(jnp.float32)) * jax.nn.softplus(
        dn_a.astype(jnp.float32) + dn_dt_bias.astype(jnp.float32))
    o = gated_delta_rule(q, k, v, g, beta)
    z = dn_z.astype(jnp.float32).reshape(B, T, DN_HEADS, DN_DV)
    o = (rmsnorm(o, dn_out_norm) * jax.nn.silu(z)).astype(h.dtype).reshape(B, T, DN_VAL)
    br_dn = o @ w_dn_out

    merged = jax.nn.sigmoid(gate_sc) * br_sc + jax.nn.sigmoid(gate_dn) * br_dn
    return merged @ w_mix_out


def peer(h, w_q, sub_keys, u_tab, v_tab):
    B, T, D = h.shape
    K = PEER_TOPK
    q = (h @ w_q).reshape(B, T, PEER_HEADS, 2, PEER_HALF)
    s = jnp.einsum('bthpd,hpnd->bthpn', q, sub_keys).astype(jnp.float32)
    v1, i1 = lax.top_k(s[..., 0, :], K)
    v2, i2 = lax.top_k(s[..., 1, :], K)
    cand = (v1[..., :, None] + v2[..., None, :]).reshape(B, T, PEER_HEADS, K * K)
    cidx = (i1[..., :, None] * PEER_NKEYS + i2[..., None, :]).reshape(B, T, PEER_HEADS, K * K)
    top_s, pos = lax.top_k(cand, K)
    eidx = jnp.take_along_axis(cidx, pos, axis=-1)
    gates = jax.nn.softmax(top_s, axis=-1)
    E = PEER_HEADS * K
    eidx = eidx.reshape(B, T, E)
    gates = gates.reshape(B, T, E).astype(h.dtype)
    nb = T // PEER_BLOCK

    def blk(t):
        return jnp.moveaxis(t.reshape((B, nb, PEER_BLOCK) + t.shape[2:]), 1, 0)

    def expert_block(args):
        hb, ib, gb = args
        u = jnp.take(u_tab, ib, axis=0)
        act = jax.nn.gelu(jnp.einsum('btd,bted->bte', hb, u), approximate=False)
        vv = jnp.take(v_tab, ib, axis=0)
        return jnp.einsum('bte,bted->btd', gb * act, vv)

    out = lax.map(expert_block, (blk(h), blk(eidx), blk(gates)))
    return jnp.moveaxis(out, 0, 1).reshape(B, T, D)


def setup_inputs(seed: int = 0) -> dict:
    key = jax.random.key(seed)
    ks = jax.random.split(key, 24)
    D = D_MODEL
    nrm = jax.random.normal
    f32 = jnp.float32
    dt = jnp.exp(jax.random.uniform(ks[9], (DEPTH, DN_HEADS), f32,
                                    np.log(1e-3).astype(np.float32), np.log(1e-1).astype(np.float32)))
    return {
        "x": nrm(ks[0], (BATCH, SEQ, D), f32),
        "c": nrm(ks[1], (BATCH, D), f32),
        "w_ada": nrm(ks[2], (DEPTH, D, 6 * D), f32) * (0.5 * D ** -0.5),
        "b_ada": nrm(ks[3], (DEPTH, 6 * D), f32) * 0.01,
        "norm_pre_mix": 1.0 + 0.05 * nrm(ks[4], (DEPTH, D), f32),
        "norm_post_mix": 1.0 + 0.05 * nrm(ks[5], (DEPTH, D), f32),
        "w_in_mix": nrm(ks[6], (DEPTH, D, IN_COLS), f32) * D ** -0.5,
        "sc_conv_w": nrm(ks[7], (DEPTH, SC_KERNEL, SC_WIDTH), f32) * SC_KERNEL ** -0.5,
        "dn_conv_w": nrm(ks[8], (DEPTH, DN_CONV, 2 * DN_KEY + DN_VAL), f32) * DN_CONV ** -0.5,
        "dn_a_log": jnp.log(jax.random.uniform(ks[10], (DEPTH, DN_HEADS), f32, 1.0, 16.0)),
        "dn_dt_bias": dt + jnp.log(-jnp.expm1(-dt)),
        "dn_out_norm": 1.0 + 0.05 * nrm(ks[11], (DEPTH, DN_DV), f32),
        "w_sc_out": nrm(ks[12], (DEPTH, SC_WIDTH, D), f32) * SC_WIDTH ** -0.5,
        "w_dn_out": nrm(ks[13], (DEPTH, DN_VAL, D), f32) * DN_VAL ** -0.5,
        "w_mix_out": nrm(ks[14], (DEPTH, D, D), f32) * D ** -0.5,
        "norm_pre_ffn": 1.0 + 0.05 * nrm(ks[15], (DEPTH, D), f32),
        "norm_post_ffn": 1.0 + 0.05 * nrm(ks[16], (DEPTH, D), f32),
        "peer_w_q": nrm(ks[17], (DEPTH, D, PEER_HEADS * PEER_QDIM), f32) * D ** -0.5,
        "peer_sub_keys": nrm(ks[18], (DEPTH, PEER_HEADS, 2, PEER_NKEYS, PEER_HALF), f32) * PEER_HALF ** -0.5,
        "peer_u": nrm(ks[19], (PEER_EXPERTS, D), f32) * D ** -0.5,
        "peer_v": nrm(ks[20], (PEER_EXPERTS, D), f32) * (PEER_HEADS * PEER_TOPK) ** -0.5,
    }


def reference(x, c, w_ada, b_ada, norm_pre_mix, norm_post_mix, w_in_mix, sc_conv_w,
              dn_conv_w, dn_a_log, dn_dt_bias, dn_out_norm, w_sc_out, w_dn_out, w_mix_out,
              norm_pre_ffn, norm_post_ffn, peer_w_q, peer_sub_keys, peer_u, peer_v):
    for l in range(DEPTH):
        mod = jax.nn.silu(c) @ w_ada[l] + b_ada[l]
        sh1, sc1, gt1, sh2, sc2, gt2 = jnp.split(mod[:, None, :], 6, axis=-1)
        h = rmsnorm(x, norm_pre_mix[l]) * (1.0 + sc1) + sh1
        y = token_mixer(h, w_in_mix[l], sc_conv_w[l], dn_conv_w[l], dn_a_log[l],
                        dn_dt_bias[l], dn_out_norm[l], w_sc_out[l], w_dn_out[l], w_mix_out[l])
        x = x + gt1 * rmsnorm(y, norm_post_mix[l])
        h = rmsnorm(x, norm_pre_ffn[l]) * (1.0 + sc2) + sh2
        y = peer(h, peer_w_q[l], peer_sub_keys[l], peer_u, peer_v)
        x = x + gt2 * rmsnorm(y, norm_post_ffn[l])
    return x
```

```cpp
#include <hip/hip_runtime.h>
#include <hip/hip_cooperative_groups.h>
#include <cstdio>
#include <cstdint>
namespace cg = cooperative_groups;
namespace pg8 {
#define PG8_LAS __attribute__((address_space(3)))
typedef unsigned short bf16_t;
typedef short bf16x8 __attribute__((ext_vector_type(8)));
typedef float f32x4 __attribute__((ext_vector_type(4)));
typedef unsigned u32x4 __attribute__((ext_vector_type(4)));
constexpr int BM = 256, BK = 64, HALF = 128, HTB = HALF * BK * 2  , STAGE_BYTES = 8 * HTB, NXCD = 8, WGM = 8;

__host__ __device__ __forceinline__ int lds_byte(int r, int c) { const int st = (r >> 4) * 2 + (c >> 5), rr = r & 15, cc = c & 31, ob = rr * 64 + cc * 2; return st * 1024 + (ob ^ (((ob >> 9) & 1) << 5)); }
__host__ __device__ __forceinline__ void stage_rc(int b, int& R, int& C) { const int st = b / 1024, sb = b % 1024, swz = sb ^ (((sb >> 9) & 1) << 5); R = (st >> 1) * 16 + swz / 64; C = (st & 1) * 32 + (swz % 64) / 2; }
__host__ __device__ __forceinline__ int perm32(int rho) { const int n = rho >> 4, i = rho & 15; return 8 * (i >> 2) + 4 * n + (i & 3); }

struct Unit { int pm, pn; };
struct Gemm { const bf16_t* A; const bf16_t* Bt; int M, N, K; };

struct StaticOrder {
    int nM, nN, nwg, G, c;
    __host__ __device__ void init(int M, int N, int G_, int c_) { nM = M / BM; nN = N / BM; nwg = nM * nN; G = G_; c = c_; }
    __host__ __device__ bool next(int i, Unit& u) const {
        const long L = (long)i * G + c; if (L >= nwg) return false;
        int wgid = (int)L; { const int q = nwg / NXCD, r = nwg % NXCD, xcd = wgid % NXCD, off = wgid / NXCD; wgid = (xcd < r ? xcd * (q + 1) : r * (q + 1) + (xcd - r) * q) + off; }
        const int nig = WGM * nN, gid = wgid / nig, fm = gid * WGM, gsz = (nM - fm) < WGM ? (nM - fm) : WGM;
        u.pm = fm + ((wgid % nig) % gsz); u.pn = (wgid % nig) / gsz; return true;
    }
    __device__ __forceinline__ void a_ready(const Unit&) const {}
    __device__ __forceinline__ void done(const Unit&) const {}
};

__device__ __forceinline__ unsigned cvt_pk_bf16(float lo, float hi) { unsigned r; asm volatile("v_cvt_pk_bf16_f32 %0, %1, %2" : "=v"(r) : "v"(lo), "v"(hi)); return r; }
typedef float f32x2 __attribute__((ext_vector_type(2)));
__device__ __forceinline__ f32x2 gelu_pk(f32x2 v) {
    const f32x2 av = __builtin_elementwise_abs(v), d = av * 0.2316418882f + 1.0f;
    f32x2 t; t.x = __builtin_amdgcn_rcpf(d.x); t.y = __builtin_amdgcn_rcpf(d.y);
    f32x2 q = t * 0.5307027145f + (-0.7265760135f); q = q * t + 0.7107068705f; q = q * t + (-0.142248368f); q = q * t + 0.127414796f; q = q * t;
    const f32x2 s = (v * v) * (-0.72134752044f);
    f32x2 e; e.x = __builtin_amdgcn_exp2f(s.x); e.y = __builtin_amdgcn_exp2f(s.y);
    const f32x2 m = v * (q * e), r = v - m;
    f32x2 o; o.x = v.x < 0.f ? m.x : r.x; o.y = v.y < 0.f ? m.y : r.y; return o;
}

template <int ACT  > struct EpiBf16 {
    static constexpr bool PERM = true, AFTER_DRAIN = false; static_assert(ACT == 0 || ACT == 1, "EpiBf16: ACT is 0 (none) or 1 (gelu_pk)");
    bf16_t* O; int ldc; const float* bias; int split_cols; size_t split_stride; float scale0;
    __device__ __forceinline__ void operator()(const f32x4 (&acc)[2][2][4][2], const Unit& u, int wr, int wc, int fr, int fq) const {
        const int row0 = u.pm * BM + wr * 64 + fr; int colt = u.pn * BM; bf16_t* base = O;
        float sc = 1.f; if (split_cols) { const int t = colt / split_cols; base += (size_t)t * split_stride; colt -= t * split_cols; if (t == 0) sc = scale0; }
        const int col0 = colt + wc * 32 + 8 * fq, bcol0 = u.pn * BM + wc * 32 + 8 * fq;
        f32x4 bv[2][2];
#pragma unroll
        for (int bj = 0; bj < 2; ++bj)
#pragma unroll
            for (int n = 0; n < 2; ++n) bv[bj][n] = bias ? *(const f32x4*)(bias + bcol0 + bj * HALF + 4 * n) : (f32x4){0.f, 0.f, 0.f, 0.f};
#pragma unroll
        for (int ai = 0; ai < 2; ++ai)
#pragma unroll
            for (int m = 0; m < 4; ++m) { bf16_t* rowp = base + (size_t)(row0 + ai * HALF + m * 16) * ldc + col0;
#pragma unroll
                for (int bj = 0; bj < 2; ++bj) { f32x4 v0 = acc[ai][bj][m][0] + bv[bj][0], v1 = acc[ai][bj][m][1] + bv[bj][1];
                    if (ACT == 1) { f32x2 a = gelu_pk((f32x2){v0[0], v0[1]}), b = gelu_pk((f32x2){v0[2], v0[3]}), c = gelu_pk((f32x2){v1[0], v1[1]}), d = gelu_pk((f32x2){v1[2], v1[3]});
                        v0 = (f32x4){a.x, a.y, b.x, b.y}; v1 = (f32x4){c.x, c.y, d.x, d.y}; }
                    v0 = v0 * sc; v1 = v1 * sc; u32x4 w; w.x = cvt_pk_bf16(v0[0], v0[1]); w.y = cvt_pk_bf16(v0[2], v0[3]); w.z = cvt_pk_bf16(v1[0], v1[1]); w.w = cvt_pk_bf16(v1[2], v1[3]);
                    *(u32x4*)(rowp + bj * HALF) = w; } }
    }
};
__device__ __forceinline__ float bf_lo(unsigned u) { return __uint_as_float(u << 16); }
__device__ __forceinline__ float bf_hi(unsigned u) { return __uint_as_float(u & 0xffff0000u); }
__device__ __forceinline__ float sigm(float x) { return __builtin_amdgcn_rcpf(1.0f + __builtin_amdgcn_exp2f(-1.4426950408889634f * x)); }
template <bool ADD> struct EpiGate {
    static constexpr bool PERM = true, AFTER_DRAIN = false;
    bf16_t* O; const bf16_t* gate; size_t seg_elems;
    __device__ __forceinline__ void operator()(const f32x4 (&acc)[2][2][4][2], const Unit& u, int wr, int wc, int fr, int fq) const {
        const int row0 = u.pm * BM + wr * 64 + fr, col0 = u.pn * BM + wc * 32 + 8 * fq;
#pragma unroll
        for (int ai = 0; ai < 2; ++ai)
#pragma unroll
            for (int m = 0; m < 4; ++m) { const int row = row0 + ai * HALF + m * 16;
#pragma unroll
                for (int bj = 0; bj < 2; ++bj) { const int col = col0 + bj * HALF;
                    const u32x4 gv = *(const u32x4*)(gate + (size_t)(col >> 9) * seg_elems + (size_t)row * 512 + (col & 511));
                    bf16_t* op = O + (size_t)row * 1024 + col;
                    f32x4 v0 = acc[ai][bj][m][0], v1 = acc[ai][bj][m][1];
                    v0[0] *= sigm(bf_lo(gv.x)); v0[1] *= sigm(bf_hi(gv.x)); v0[2] *= sigm(bf_lo(gv.y)); v0[3] *= sigm(bf_hi(gv.y));
                    v1[0] *= sigm(bf_lo(gv.z)); v1[1] *= sigm(bf_hi(gv.z)); v1[2] *= sigm(bf_lo(gv.w)); v1[3] *= sigm(bf_hi(gv.w));
                    if (ADD) { const u32x4 ov = *(const u32x4*)op;
                        v0[0] += bf_lo(ov.x); v0[1] += bf_hi(ov.x); v0[2] += bf_lo(ov.y); v0[3] += bf_hi(ov.y);
                        v1[0] += bf_lo(ov.z); v1[1] += bf_hi(ov.z); v1[2] += bf_lo(ov.w); v1[3] += bf_hi(ov.w); }
                    u32x4 w; w.x = cvt_pk_bf16(v0[0], v0[1]); w.y = cvt_pk_bf16(v0[2], v0[3]); w.z = cvt_pk_bf16(v1[0], v1[1]); w.w = cvt_pk_bf16(v1[2], v1[3]);
                    *(u32x4*)op = w; } }
    }
};
template <class Epi, class Sched, bool ALIGN_EPI = false, bool SP2 = false>
__device__ __forceinline__ void gemm_phase(PG8_LAS unsigned char* lds, const Gemm g, const Sched& S, const Epi& E) {
    int tid_ = threadIdx.x; asm volatile("" : "+v"(tid_));
    const int tid = tid_, wid = __builtin_amdgcn_readfirstlane(tid >> 6), lane = tid & 63, wr = wid >> 2, wc = wid & 3, fr = lane & 15, fq = lane >> 4;
    const int K = g.K, nt = K / BK;
    unsigned voffA[2], voffB[2];
#pragma unroll
    for (int i = 0; i < 2; ++i) { int R, C; stage_rc(tid * 16 + i * 8192, R, C); const int Rb = Epi::PERM ? ((R & ~31) + perm32(R & 31)) : R;
        voffA[i] = (unsigned)(R * K + C) * 2u; voffB[i] = (unsigned)(Rb * K + C) * 2u; }
    const size_t kstep = (size_t)(BK * 2);
    const size_t hstep = (size_t)HALF * K * 2;
    const size_t tstep = 2 * hstep;
    const unsigned ldsw = (unsigned)wid * 1024u;
    const int aoff = lds_byte(wr * 64 + fr, fq * 8), boff = lds_byte(wc * 32 + fr, fq * 8);
#define PG8_SA(b, h) (((b) * 2 + (h)) * HTB)
#define PG8_SB(b, h) ((4 + (b) * 2 + (h)) * HTB)
#define PG8_STAGE(bufoff, gbase, voff) do { _Pragma("unroll") for (int _i = 0; _i < 2; ++_i) \
        __builtin_amdgcn_global_load_lds((const unsigned*)((const char*)(gbase) + (voff)[_i]), (PG8_LAS unsigned*)(lds + (bufoff) + ldsw + _i * 8192), 16, 0, 0); } while (0)
#define PG8_LDA(dst, b, h) do { _Pragma("unroll") for (int m = 0; m < 4; ++m) _Pragma("unroll") for (int k = 0; k < 2; ++k) dst[m][k] = *(const PG8_LAS bf16x8*)(lds + PG8_SA(b, h) + aoff + m * 2048 + k * 1024); } while (0)
#define PG8_LDB(dst, b, h) do { _Pragma("unroll") for (int n = 0; n < 2; ++n) _Pragma("unroll") for (int k = 0; k < 2; ++k) dst[n][k] = *(const PG8_LAS bf16x8*)(lds + PG8_SB(b, h) + boff + n * 2048 + k * 1024); } while (0)
#define PG8_MMA(ai, bj, At, Bt) do { __builtin_amdgcn_s_setprio(1); _Pragma("unroll") for (int m = 0; m < 4; ++m) _Pragma("unroll") for (int n = 0; n < 2; ++n) _Pragma("unroll") for (int k = 0; k < 2; ++k) \
        acc[ai][bj][m][n] = __builtin_amdgcn_mfma_f32_16x16x32_bf16(Bt[n][k], At[m][k], acc[ai][bj][m][n], 0, 0, 0); __builtin_amdgcn_s_setprio(0); } while (0)
#define PG8_WAIT_V(n) asm volatile("s_waitcnt vmcnt(" #n ")" ::: "memory")
#define PG8_WAIT_L(n) asm volatile("s_waitcnt lgkmcnt(" #n ")" ::: "memory")
#define PG8_BAR __builtin_amdgcn_s_barrier()
#define PG8_SCHED __builtin_amdgcn_sched_barrier(0)
    Unit cur, nxt; int ui = 0;
    if (!S.next(0, cur)) return;
    f32x4 acc[2][2][4][2];
#pragma unroll
    for (int a = 0; a < 2; ++a)
#pragma unroll
        for (int b = 0; b < 2; ++b)
#pragma unroll
            for (int m = 0; m < 4; ++m)
#pragma unroll
                for (int n = 0; n < 2; ++n) acc[a][b][m][n] = (f32x4){0.f, 0.f, 0.f, 0.f};
    bf16x8 At[4][2], B0[2][2], B1[2][2];
    const char* cA = (const char*)g.A + (size_t)cur.pm * tstep; const char* cB = (const char*)g.Bt + (size_t)cur.pn * tstep;
    S.a_ready(cur);
    if constexpr (SP2) {
        PG8_STAGE(PG8_SB(0, 0), cB, voffB); PG8_STAGE(PG8_SB(0, 1), cB + hstep, voffB); PG8_STAGE(PG8_SA(0, 0), cA, voffA); PG8_STAGE(PG8_SA(0, 1), cA + hstep, voffA);
        if (wr == 1) PG8_BAR;
        PG8_WAIT_V(2); PG8_BAR;
        PG8_STAGE(PG8_SB(1, 0), cB + kstep, voffB); PG8_STAGE(PG8_SA(1, 0), cA + kstep, voffA); PG8_STAGE(PG8_SB(1, 1), cB + hstep + kstep, voffB);
        PG8_WAIT_V(6); PG8_BAR;
    } else {
        PG8_STAGE(PG8_SB(0, 0), cB, voffB); PG8_STAGE(PG8_SA(0, 0), cA, voffA); PG8_STAGE(PG8_SB(0, 1), cB + hstep, voffB); PG8_STAGE(PG8_SA(0, 1), cA + hstep, voffA);
        if (wr == 1) PG8_BAR;
        PG8_WAIT_V(4); PG8_BAR;
        PG8_STAGE(PG8_SB(1, 0), cB + kstep, voffB); PG8_STAGE(PG8_SA(1, 0), cA + kstep, voffA); PG8_STAGE(PG8_SB(1, 1), cB + hstep + kstep, voffB);
        PG8_WAIT_V(6); PG8_BAR;
    }
    for (;;) {
        const bool has_next = S.next(ui + 1, nxt);
        const char* nA = has_next ? (const char*)g.A + (size_t)nxt.pm * tstep : cA; const char* nB = has_next ? (const char*)g.Bt + (size_t)nxt.pn * tstep : cB;
        for (int t = 0; t < nt; t += 2) {
            const bool last = (t == nt - 2);
            const char* a1 = cA + (size_t)(t + 1) * kstep;
            const char* a2 = last ? nA : cA + (size_t)(t + 2) * kstep; const char* b2 = last ? nB : cB + (size_t)(t + 2) * kstep;
            const char* a3 = a2 + kstep; const char* b3 = b2 + kstep;
            if (last && has_next) S.a_ready(nxt);
            if constexpr (SP2) {
            PG8_LDB(B0, 0, 0); PG8_LDB(B1, 0, 1); PG8_SCHED; PG8_LDA(At, 0, 0); PG8_STAGE(PG8_SA(1, 1), a1 + hstep, voffA);
            PG8_WAIT_V(8); PG8_WAIT_L(0); PG8_BAR; PG8_MMA(0, 0, At, B0); PG8_MMA(0, 1, At, B1); PG8_BAR; PG8_SCHED;
            PG8_LDA(At, 0, 1); PG8_STAGE(PG8_SB(0, 0), b2, voffB); PG8_STAGE(PG8_SB(0, 1), b2 + hstep, voffB); PG8_STAGE(PG8_SA(0, 0), a2, voffA);
            PG8_WAIT_V(8); PG8_WAIT_L(0); PG8_BAR; PG8_MMA(1, 0, At, B0); PG8_MMA(1, 1, At, B1); PG8_BAR; PG8_SCHED;
            PG8_LDB(B0, 1, 0); PG8_LDB(B1, 1, 1); PG8_SCHED; PG8_LDA(At, 1, 0); PG8_STAGE(PG8_SA(0, 1), a2 + hstep, voffA);
            PG8_WAIT_V(8); PG8_WAIT_L(0); PG8_BAR; PG8_MMA(0, 0, At, B0); PG8_MMA(0, 1, At, B1); PG8_BAR; PG8_SCHED;
            PG8_LDA(At, 1, 1); PG8_STAGE(PG8_SB(1, 0), b3, voffB); PG8_STAGE(PG8_SB(1, 1), b3 + hstep, voffB); PG8_STAGE(PG8_SA(1, 0), a3, voffA);
            PG8_WAIT_V(8); PG8_WAIT_L(0); PG8_BAR; PG8_MMA(1, 0, At, B0); PG8_MMA(1, 1, At, B1); PG8_BAR; PG8_SCHED;
            } else {
            PG8_LDB(B0, 0, 0); PG8_SCHED; PG8_LDA(At, 0, 0); PG8_STAGE(PG8_SA(1, 1), a1 + hstep, voffA);
            PG8_WAIT_L(8); PG8_BAR; PG8_WAIT_L(0); PG8_MMA(0, 0, At, B0); PG8_BAR; PG8_SCHED;
            PG8_LDB(B1, 0, 1); PG8_STAGE(PG8_SB(0, 0), b2, voffB);
            PG8_BAR; PG8_WAIT_L(0); PG8_MMA(0, 1, At, B1); PG8_BAR;
            PG8_LDA(At, 0, 1); PG8_STAGE(PG8_SA(0, 0), a2, voffA);
            PG8_BAR; PG8_WAIT_L(0); PG8_MMA(1, 0, At, B0); PG8_BAR; PG8_SCHED;
            PG8_STAGE(PG8_SB(0, 1), b2 + hstep, voffB);
            PG8_WAIT_V(6); PG8_BAR; PG8_MMA(1, 1, At, B1); PG8_BAR;
            PG8_LDB(B0, 1, 0); PG8_SCHED; PG8_LDA(At, 1, 0); PG8_STAGE(PG8_SA(0, 1), a2 + hstep, voffA);
            PG8_WAIT_L(8); PG8_BAR; PG8_WAIT_L(0); PG8_MMA(0, 0, At, B0); PG8_BAR; PG8_SCHED;
            PG8_LDB(B1, 1, 1); PG8_STAGE(PG8_SB(1, 0), b3, voffB);
            PG8_BAR; PG8_WAIT_L(0); PG8_MMA(0, 1, At, B1); PG8_BAR;
            PG8_LDA(At, 1, 1); PG8_STAGE(PG8_SA(1, 0), a3, voffA);
            PG8_BAR; PG8_WAIT_L(0); PG8_MMA(1, 0, At, B0); PG8_BAR; PG8_SCHED;
            PG8_STAGE(PG8_SB(1, 1), b3 + hstep, voffB);
            PG8_WAIT_V(6); PG8_BAR; PG8_MMA(1, 1, At, B1); PG8_BAR;
            }
        }
        if constexpr (ALIGN_EPI) { if (wr == 0) PG8_BAR; }
        if constexpr (!Epi::AFTER_DRAIN) { E(acc, cur, wr, wc, fr, fq); S.done(cur); }
        if (!has_next) break;
#pragma unroll
        for (int a = 0; a < 2; ++a)
#pragma unroll
            for (int b = 0; b < 2; ++b)
#pragma unroll
                for (int m = 0; m < 4; ++m)
#pragma unroll
                    for (int n = 0; n < 2; ++n) acc[a][b][m][n] = (f32x4){0.f, 0.f, 0.f, 0.f};
        cur = nxt; cA = nA; cB = nB; ++ui;
        if constexpr (ALIGN_EPI) { if (wr == 1) PG8_BAR; }
    }
    PG8_WAIT_V(0);
    if constexpr (!ALIGN_EPI) { if (wr == 0) PG8_BAR; }
    PG8_BAR;
    if constexpr (Epi::AFTER_DRAIN) { E.fused(acc, cur, wr, wc, fr, fq, lds, wid, lane); S.done(cur); }
#undef PG8_SA
#undef PG8_SB
#undef PG8_STAGE
#undef PG8_LDA
#undef PG8_LDB
#undef PG8_MMA
#undef PG8_WAIT_V
#undef PG8_WAIT_L
#undef PG8_BAR
#undef PG8_SCHED
}
}
constexpr int NWAVES = 8, NTHR = 512;
constexpr int M = 32768, D = 1024, SEQ = 8192, NBATCH = 4;
constexpr int NIN = 5888;
constexpr int NCHUNK = 128, NITEM = 32 * NCHUNK;
constexpr float EPS = 1e-6f;
constexpr size_t MiB = 1u << 20;
constexpr size_t SEG_ELEMS = (size_t)M * 512;
constexpr size_t WS_CTL = 0, WS_MODP = 1 * MiB, WS_WIN = 2 * MiB, WS_WQ = 14 * MiB, WS_WSC = 18 * MiB, WS_WDN = 19 * MiB, WS_WMIX = 20 * MiB,
                 WS_SK = 22 * MiB, WS_GL = 23 * MiB, WS_TU = 24 * MiB, WS_TV = 56 * MiB, WS_P = 88 * MiB, WS_KD = 472 * MiB, WS_END = 504 * MiB;
constexpr int LDS_BYTES = 147456;

#define GAS __attribute__((address_space(1)))
#define LAS __attribute__((address_space(3)))
typedef unsigned short bf16;
typedef unsigned v4u __attribute__((ext_vector_type(4)));
typedef unsigned v2u __attribute__((ext_vector_type(2)));
typedef float f32x4 __attribute__((ext_vector_type(4)));
typedef float f32x16 __attribute__((ext_vector_type(16)));
typedef short bf16x8 __attribute__((ext_vector_type(8)));

__device__ __forceinline__ unsigned f2bf(float f) { unsigned u = __builtin_bit_cast(unsigned, f); return (u + 0x7fffu + ((u >> 16) & 1u)) >> 16; }
__device__ __forceinline__ unsigned pk2(float lo, float hi) { return f2bf(lo) | (f2bf(hi) << 16); }
__device__ __forceinline__ float bflo(unsigned u) { return __uint_as_float(u << 16); }
__device__ __forceinline__ float bfhi(unsigned u) { return __uint_as_float(u & 0xffff0000u); }
__device__ __forceinline__ float bf2f(bf16 h) { return __uint_as_float((unsigned)h << 16); }
__device__ __forceinline__ float sigmoidf_(float x) { return 1.0f / (1.0f + __expf(-x)); }
__device__ __forceinline__ float wave_sum(float v) {
#pragma unroll
    for (int o = 1; o < 64; o <<= 1) v += __shfl_xor(v, o);
    return v;
}

struct Frame { LAS unsigned char* lds; int tid, lane, wave, G; };
__device__ __forceinline__ const void* karg(int i) {
    const char __attribute__((address_space(4)))* kp = (const char __attribute__((address_space(4)))*)__builtin_amdgcn_kernarg_segment_ptr();
    asm volatile("" : "+s"(i));
    return *(const void* const __attribute__((address_space(4)))*)(kp + 8 * i);
}
__device__ __forceinline__ const float* IN(int i) { return (const float*)karg(i); }
__device__ __forceinline__ float* OUTP() { return (float*)karg(21); }
__device__ __forceinline__ unsigned char* WSP() { return (unsigned char*)karg(22); }
enum { I_X = 0, I_C, I_WADA, I_BADA, I_NPREMIX, I_NPOSTMIX, I_WIN, I_SCCONV, I_DNCONV, I_ALOG, I_DTBIAS, I_OUTNORM, I_WSC, I_WDN, I_WMIX, I_NPREFFN, I_NPOSTFFN, I_WQ, I_SUBK, I_PU, I_PV };
__device__ __forceinline__ bf16* segp(unsigned char* ws, int s) { return (bf16*)(ws + WS_P) + (size_t)s * SEG_ELEMS; }
__device__ __forceinline__ float modv(const float* b_ada, const float* modp, int b, int j) {
    float s = b_ada[j];
#pragma unroll
    for (int k = 0; k < 8; ++k) s += modp[(size_t)(k * 4 + b) * 6144 + j];
    return s;
}

__device__ __forceinline__ void p0_transpose_item(const float* W, int K, int N, int src_col0, bf16* WT, int dst_row0, int kb, int ncols, LAS float* scr, int lane) {
    const int k0 = 64 * kb;
#pragma unroll 8
    for (int i = 0; i < 32; ++i) { const int kk = 2 * i + (lane >> 5); const int n = lane & 31;
        scr[kk * 33 + n] = (n < ncols) ? W[(size_t)(k0 + kk) * N + src_col0 + n] : 0.f; }
    asm volatile("s_waitcnt lgkmcnt(0)" ::: "memory");
    const int c = lane & 7;
#pragma unroll
    for (int j = 0; j < 4; ++j) { const int n = (lane >> 3) + 8 * j; const LAS float* s = scr + (8 * c) * 33 + n;
        v4u o; o.x = pk2(s[0 * 33], s[1 * 33]); o.y = pk2(s[2 * 33], s[3 * 33]); o.z = pk2(s[4 * 33], s[5 * 33]); o.w = pk2(s[6 * 33], s[7 * 33]);
        *(v4u*)(WT + (size_t)(dst_row0 + n) * K + k0 + 8 * c) = o; }
    asm volatile("s_waitcnt lgkmcnt(0)" ::: "memory");
}
__device__ __forceinline__ void p0_transpose(const float* W, int K, int N, int src_col0, int nblk, bf16* WT, int dst_row0, LAS float* scr, int gw, int NGW, int lane) {
    const int kbs = K / 64;
    for (int it = gw; it < nblk * kbs; it += NGW) { const int nb = it / kbs, kb = it % kbs;
        p0_transpose_item(W, K, N, src_col0 + 32 * nb, WT, dst_row0 + 32 * nb, kb, 32, scr, lane); }
}
__device__ __forceinline__ void p0_convert(const float* src, bf16* dst, size_t nchunks8, size_t gtid, size_t gthreads) {
    for (size_t i = gtid; i < nchunks8; i += gthreads) { const f32x4 a = *(const f32x4*)(src + i * 8), b = *(const f32x4*)(src + i * 8 + 4);
        v4u o; o.x = pk2(a[0], a[1]); o.y = pk2(a[2], a[3]); o.z = pk2(b[0], b[1]); o.w = pk2(b[2], b[3]); *(v4u*)(dst + i * 8) = o; }
}
__device__ __forceinline__ void phase_prologue(Frame& F) {
    LAS float* scr = (LAS float*)(F.lds + F.wave * 8704);
    const int gw = blockIdx.x * NWAVES + F.wave, NGW = F.G * NWAVES;
    unsigned char* ws = WSP();
    { const float* w_ada = IN(I_WADA); const float* cc = IN(I_C); float* modp = (float*)(ws + WS_MODP);
    for (int it = gw; it < 768; it += NGW) { const int cgi = it % 96, ks = it / 96, n = cgi * 64 + F.lane, k0 = ks * 128;
        float a0 = 0.f, a1 = 0.f, a2 = 0.f, a3 = 0.f;
#pragma unroll 16
        for (int kk = 0; kk < 128; ++kk) { const int k = k0 + kk; const float w = w_ada[(size_t)k * 6144 + n];
            const float c0 = cc[k], c1 = cc[1024 + k], c2 = cc[2048 + k], c3 = cc[3072 + k];
            a0 += c0 * sigmoidf_(c0) * w; a1 += c1 * sigmoidf_(c1) * w; a2 += c2 * sigmoidf_(c2) * w; a3 += c3 * sigmoidf_(c3) * w; }
        modp[(size_t)(ks * 4 + 0) * 6144 + n] = a0; modp[(size_t)(ks * 4 + 1) * 6144 + n] = a1;
        modp[(size_t)(ks * 4 + 2) * 6144 + n] = a2; modp[(size_t)(ks * 4 + 3) * 6144 + n] = a3; } }
    { const float* w_in = IN(I_WIN); bf16* win_t = (bf16*)(ws + WS_WIN);
    p0_transpose(w_in, 1024, 5648, 0, 112, win_t, 0, scr, gw, NGW, F.lane);
    p0_transpose(w_in, 1024, 5648, 3600, 64, win_t, 3584, scr, gw, NGW, F.lane);
    for (int it = gw; it < 16; it += NGW) p0_transpose_item(w_in, 1024, 5648, 3584, win_t, 5632, it, 16, scr, F.lane);
    { const size_t gtid = (size_t)blockIdx.x * NTHR + F.tid, gth = (size_t)F.G * NTHR;
      for (size_t i = gtid; i < (size_t)224 * 128; i += gth) *(v4u*)(win_t + (size_t)5664 * 1024 + i * 8) = (v4u){0u, 0u, 0u, 0u}; } }
    p0_transpose(IN(I_WQ), 1024, 2048, 0, 64, (bf16*)(ws + WS_WQ), 0, scr, gw, NGW, F.lane);
    p0_transpose(IN(I_WSC), 512, 1024, 0, 32, (bf16*)(ws + WS_WSC), 0, scr, gw, NGW, F.lane);
    p0_transpose(IN(I_WDN), 512, 1024, 0, 32, (bf16*)(ws + WS_WDN), 0, scr, gw, NGW, F.lane);
    p0_transpose(IN(I_WMIX), 1024, 1024, 0, 32, (bf16*)(ws + WS_WMIX), 0, scr, gw, NGW, F.lane);
    { const size_t gtid = (size_t)blockIdx.x * NTHR + F.tid, gth = (size_t)F.G * NTHR;
      p0_convert(IN(I_SUBK), (bf16*)(ws + WS_SK), (size_t)16 * 128 * 128 / 8, gtid, gth);
      p0_convert(IN(I_PU), (bf16*)(ws + WS_TU), (size_t)16384 * 1024 / 8, gtid, gth);
      p0_convert(IN(I_PV), (bf16*)(ws + WS_TV), (size_t)16384 * 1024 / 8, gtid, gth); }
}

__device__ __forceinline__ void phase_h1(Frame& F, bf16* H1) {
    LAS float* gv = (LAS float*)F.lds; LAS float* sv = gv + 1024;
    const float* xin = IN(I_X); const float* npm = IN(I_NPREMIX); const float* b_ada = IN(I_BADA); const float* modp = (const float*)(WSP() + WS_MODP);
    for (int rb = blockIdx.x; rb < M / 128; rb += F.G) {
        const int row0 = rb * 128, b = row0 / SEQ;
        __syncthreads();
        for (int k = F.tid; k < 1024; k += NTHR) { gv[k] = npm[k] * (1.f + modv(b_ada, modp, b, 1024 + k)); sv[k] = modv(b_ada, modp, b, k); }
        __syncthreads();
        for (int r = 0; r < 16; ++r) { const int row = row0 + F.wave * 16 + r;
            const f32x4* xr = (const f32x4*)(xin + (size_t)row * D) + F.lane;
            f32x4 v[4]; float ss = 0.f;
#pragma unroll
            for (int j = 0; j < 4; ++j) { v[j] = xr[64 * j]; ss += (v[j][0] * v[j][0] + v[j][1] * v[j][1]) + (v[j][2] * v[j][2] + v[j][3] * v[j][3]); }
            const float rstd = rsqrtf(wave_sum(ss) * (1.f / D) + EPS);
            v2u* o8 = (v2u*)(H1 + (size_t)row * D) + F.lane;
#pragma unroll
            for (int j = 0; j < 4; ++j) { const int k = 4 * F.lane + 256 * j; const f32x4 g = *(const LAS f32x4*)(gv + k), s = *(const LAS f32x4*)(sv + k);
                v2u o; o.x = pk2(v[j][0] * rstd * g[0] + s[0], v[j][1] * rstd * g[1] + s[1]); o.y = pk2(v[j][2] * rstd * g[2] + s[2], v[j][3] * rstd * g[3] + s[3]); o8[64 * j] = o; }
        }
    }
}

__device__ __forceinline__ void phase_scprep(Frame& F) {
    unsigned char* ws = WSP(); bf16* sb = segp(ws, 0); const bf16* scc = segp(ws, 1); const bf16* scx = segp(ws, 2); const float* scw = IN(I_SCCONV);
    const int gtid = blockIdx.x * NTHR + F.tid, gth = F.G * NTHR;
    for (int it = gtid; it < (M / 16) * 64; it += gth) {
        const int cgp = it & 63, tb = it >> 6, m0 = tb * 16, c0 = cgp * 8;
        float w0[8], w1[8], w2[8], p2[8], p1[8];
#pragma unroll
        for (int e = 0; e < 8; ++e) { w0[e] = scw[c0 + e]; w1[e] = scw[512 + c0 + e]; w2[e] = scw[1024 + c0 + e]; p2[e] = 0.f; p1[e] = 0.f; }
        if ((m0 % SEQ) != 0) {
#pragma unroll
            for (int q = 0; q < 2; ++q) { const size_t off = (size_t)(m0 - 2 + q) * 512 + c0; const v4u cv = *(const v4u*)(scc + off), xv = *(const v4u*)(scx + off);
                float t[8] = {bflo(cv.x) * bflo(xv.x), bfhi(cv.x) * bfhi(xv.x), bflo(cv.y) * bflo(xv.y), bfhi(cv.y) * bfhi(xv.y), bflo(cv.z) * bflo(xv.z), bfhi(cv.z) * bfhi(xv.z), bflo(cv.w) * bflo(xv.w), bfhi(cv.w) * bfhi(xv.w)};
#pragma unroll
                for (int e = 0; e < 8; ++e) { if (q == 0) p2[e] = t[e]; else p1[e] = t[e]; } }
        }
        for (int t = 0; t < 16; ++t) { const size_t off = (size_t)(m0 + t) * 512 + c0;
            const v4u cv = *(const v4u*)(scc + off), xv = *(const v4u*)(scx + off), bv = *(const v4u*)(sb + off);
            float cur[8] = {bflo(cv.x) * bflo(xv.x), bfhi(cv.x) * bfhi(xv.x), bflo(cv.y) * bflo(xv.y), bfhi(cv.y) * bfhi(xv.y), bflo(cv.z) * bflo(xv.z), bfhi(cv.z) * bfhi(xv.z), bflo(cv.w) * bflo(xv.w), bfhi(cv.w) * bfhi(xv.w)};
            float bb[8] = {bflo(bv.x), bfhi(bv.x), bflo(bv.y), bfhi(bv.y), bflo(bv.z), bfhi(bv.z), bflo(bv.w), bfhi(bv.w)};
            float o[8];
#pragma unroll
            for (int e = 0; e < 8; ++e) { o[e] = bb[e] * (w0[e] * p2[e] + w1[e] * p1[e] + w2[e] * cur[e]); p2[e] = p1[e]; p1[e] = cur[e]; }
            v4u ov; ov.x = pk2(o[0], o[1]); ov.y = pk2(o[2], o[3]); ov.z = pk2(o[4], o[5]); ov.w = pk2(o[6], o[7]);
            *(v4u*)(sb + off) = ov; }
    }
}

__device__ __forceinline__ void phase_dnprep(Frame& F, bf16* Wn, bf16* U, bf16* QG, bf16* A, bf16* KD) {
    LAS unsigned char* L = F.lds;
    LAS bf16* raw = (LAS bf16*)L;
    LAS float* R = (LAS float*)L;
    LAS float* qc = (LAS float*)(L + 32768);
    LAS float* kc = (LAS float*)(L + 32768 + 16640);
    LAS float* vc = (LAS float*)(L + 32768 + 2 * 16640);
    LAS bf16* kh = (LAS bf16*)(L + 82688);
    LAS bf16* qh = (LAS bf16*)(L + 82688 + 9216);
    LAS float* Lm = (LAS float*)(L + 101120);
    LAS float* sG = (LAS float*)(L + 117504);
    LAS float* sBeta = sG + 64; LAS float* sEG = sG + 128; LAS float* sRq = sG + 192; LAS float* sRk = sG + 256; LAS float* sEd = sG + 320;
    LAS bf16* stg = (LAS bf16*)(L + 119040);
    LAS bf16* stg2 = (LAS bf16*)(L + 127232);
    const int tid = F.tid, lane = F.lane, wave = F.wave;
    unsigned char* ws = WSP(); const bf16* segq = segp(ws, 3); const bf16* segab = segp(ws, 11); float* glp = (float*)(ws + WS_GL);
    const float* cw = IN(I_DNCONV); const float* alog = IN(I_ALOG); const float* dtb = IN(I_DTBIAS);
    for (int it = blockIdx.x; it < NITEM; it += F.G) {
        const int bh = it >> 7, n = it & 127, b = bh >> 3, h = bh & 7, m0 = b * SEQ + n * 64;
        __syncthreads();
        for (int ci = tid; ci < 1608; ci += NTHR) { const int s = ci / 536, rem = ci % 536, r = rem >> 3, c8 = rem & 7;
            v4u v = (v4u){0u, 0u, 0u, 0u};
            if (n * 64 - 3 + r >= 0) v = *(const v4u*)(segq + (size_t)s * SEG_ELEMS + (size_t)(m0 - 3 + r) * 512 + h * 64 + c8 * 8);
            *(LAS v4u*)(raw + (s * 67 + r) * 64 + c8 * 8) = v; }
        __syncthreads();
        for (int oi = tid; oi < 12288; oi += NTHR) { const int s = oi >> 12, t = (oi >> 6) & 63, c = oi & 63; const int ch = s * 512 + h * 64 + c;
            float acc = 0.f;
#pragma unroll
            for (int k = 0; k < 4; ++k) acc += cw[k * 1536 + ch] * bf2f(raw[(s * 67 + t + k) * 64 + c]);
            const float val = acc * sigmoidf_(acc);
            (s == 0 ? qc : (s == 1 ? kc : vc))[t * 65 + c] = val; }
        __syncthreads();
        if (wave == 0) { float ss = 0.f; for (int c = 0; c < 64; ++c) { const float q = qc[lane * 65 + c]; ss += q * q; } sRq[lane] = rsqrtf(ss + EPS) * 0.125f; }
        else if (wave == 1) { float ss = 0.f; for (int c = 0; c < 64; ++c) { const float q = kc[lane * 65 + c]; ss += q * q; } sRk[lane] = rsqrtf(ss + EPS); }
        else if (wave == 2) {
            const float av = bf2f(segab[(size_t)(m0 + lane) * 512 + h]) + dtb[h], bv = bf2f(segab[(size_t)(m0 + lane) * 512 + 8 + h]);
            const float sp = (av > 20.f) ? av : log1pf(__expf(av));
            float g = -__expf(alog[h]) * sp;
#pragma unroll
            for (int o = 1; o < 64; o <<= 1) { const float t = __shfl_up(g, o); if (lane >= o) g += t; }
            const float g63 = __shfl(g, 63);
            sG[lane] = g; sBeta[lane] = sigmoidf_(bv); sEG[lane] = __expf(g); sEd[lane] = __expf(g63 - g);
            if (lane == 63) glp[it] = __expf(g);
        }
        __syncthreads();
        for (int oi = tid; oi < 4096; oi += NTHR) { const int t = oi >> 6, c = oi & 63;
            const float q = qc[t * 65 + c] * sRq[t], k = kc[t * 65 + c] * sRk[t];
            qc[t * 65 + c] = q; kc[t * 65 + c] = k; qh[t * 72 + c] = (bf16)f2bf(q); kh[t * 72 + c] = (bf16)f2bf(k); }
        __syncthreads();
        {
            const int fr = lane & 15, g4 = lane >> 4;
#pragma unroll
            for (int x = 0; x < 2; ++x) { const int tile = 2 * wave + x, ti = tile >> 2, tj = tile & 3;
                f32x4 ckk = (f32x4){0.f, 0.f, 0.f, 0.f}, cqk = (f32x4){0.f, 0.f, 0.f, 0.f};
#pragma unroll
                for (int ks = 0; ks < 2; ++ks) {
                    const bf16x8 ak = *(const LAS bf16x8*)(kh + (16 * ti + fr) * 72 + 32 * ks + 8 * g4);
                    const bf16x8 aq = *(const LAS bf16x8*)(qh + (16 * ti + fr) * 72 + 32 * ks + 8 * g4);
                    const bf16x8 bk = *(const LAS bf16x8*)(kh + (16 * tj + fr) * 72 + 32 * ks + 8 * g4);
                    ckk = __builtin_amdgcn_mfma_f32_16x16x32_bf16(ak, bk, ckk, 0, 0, 0);
                    cqk = __builtin_amdgcn_mfma_f32_16x16x32_bf16(aq, bk, cqk, 0, 0, 0); }
                const int j = 16 * tj + fr; const float gj = sG[j];
#pragma unroll
                for (int r = 0; r < 4; ++r) { const int i = 16 * ti + 4 * g4 + r;
                    const float dec = __expf(fminf(sG[i] - gj, 0.f));
                    Lm[i * 64 + j] = (j < i) ? sBeta[i] * ckk[r] * dec : 0.f;
                    stg[i * 64 + j] = (bf16)f2bf((j <= i) ? cqk[r] * dec : 0.f); }
            }
        }
        for (int oi = tid; oi < 8192; oi += NTHR) { const int i = oi >> 7, c = oi & 127;
            R[i * 128 + c] = (c < 64) ? vc[i * 65 + c] * sBeta[i] : kc[i * 65 + (c - 64)] * sBeta[i] * sEG[i]; }
        __syncthreads();
        { const size_t ob = (size_t)it * 4096 + (size_t)tid * 8;
          *(v4u*)(A + ob) = *(const LAS v4u*)(stg + tid * 8);
          const int i = tid >> 3, k0 = (tid & 7) * 8; const float e = sEG[i];
          v4u o; o.x = pk2(qc[i * 65 + k0] * e, qc[i * 65 + k0 + 1] * e); o.y = pk2(qc[i * 65 + k0 + 2] * e, qc[i * 65 + k0 + 3] * e);
          o.z = pk2(qc[i * 65 + k0 + 4] * e, qc[i * 65 + k0 + 5] * e); o.w = pk2(qc[i * 65 + k0 + 6] * e, qc[i * 65 + k0 + 7] * e);
          *(v4u*)(QG + ob) = o;
          const int kk = tid >> 3, c0 = (tid & 7) * 8;
          v4u p; p.x = pk2(kc[(c0 + 0) * 65 + kk] * sEd[c0 + 0], kc[(c0 + 1) * 65 + kk] * sEd[c0 + 1]); p.y = pk2(kc[(c0 + 2) * 65 + kk] * sEd[c0 + 2], kc[(c0 + 3) * 65 + kk] * sEd[c0 + 3]);
          p.z = pk2(kc[(c0 + 4) * 65 + kk] * sEd[c0 + 4], kc[(c0 + 5) * 65 + kk] * sEd[c0 + 5]); p.w = pk2(kc[(c0 + 6) * 65 + kk] * sEd[c0 + 6], kc[(c0 + 7) * 65 + kk] * sEd[c0 + 7]);
          *(v4u*)(KD + ob) = p; }
        if (tid < 128) {
            float xs[64];
#pragma unroll
            for (int i = 0; i < 64; ++i) { float acc = R[i * 128 + tid];
#pragma unroll
                for (int j = 0; j < i; ++j) acc -= Lm[i * 64 + j] * xs[j];
                xs[i] = acc; stg2[i * 128 + tid] = (bf16)f2bf(tid < 64 ? acc : -acc); }
        }
        __syncthreads();
        for (int ci = tid; ci < 1024; ci += NTHR) { const int i = ci >> 4, c8 = ci & 15; const v4u v = *(const LAS v4u*)(stg2 + i * 128 + c8 * 8);
            if (c8 < 8) *(v4u*)(U + (size_t)it * 4096 + i * 64 + c8 * 8) = v; else *(v4u*)(Wn + (size_t)it * 4096 + i * 64 + (c8 - 8) * 8) = v; }
    }
}

__device__ __forceinline__ void phase_scan(Frame& F, const bf16* Wn, const bf16* U, const bf16* QG, const bf16* A, const bf16* KD, bf16* O) {
    if (blockIdx.x >= 32) return;
    LAS unsigned char* L = F.lds; const float* glp = (const float*)(WSP() + WS_GL);
    const int bh = blockIdx.x, b = bh >> 3, h = bh & 7, tid = F.tid, lane = F.lane, wave = F.wave;
    const int fr = lane & 15, g4 = lane >> 4, ct = wave >> 1, vt0 = 2 * (wave & 1);
    LAS bf16* St = (LAS bf16*)(L + 92160); LAS bf16* Vt = (LAS bf16*)(L + 101376);
#define OPB(buf, mat) ((LAS bf16*)(L + (buf) * 46080 + (mat) * 9216))
    for (int i = tid; i < 64 * 72; i += NTHR) St[i] = 0;
    const int lrow = tid >> 3, lc8 = tid & 7, loff = lrow * 72 + lc8 * 8;
    const bf16* srcs[5] = {Wn, U, QG, A, KD};
    v4u ld[5];
    { const size_t ob = (size_t)(bh * NCHUNK) * 4096 + (size_t)tid * 8;
#pragma unroll
      for (int mt = 0; mt < 5; ++mt) ld[mt] = *(const v4u*)(srcs[mt] + ob);
#pragma unroll
      for (int mt = 0; mt < 5; ++mt) *(LAS v4u*)(OPB(0, mt) + loff) = ld[mt]; }
    f32x4 S[2] = {(f32x4){0.f, 0.f, 0.f, 0.f}, (f32x4){0.f, 0.f, 0.f, 0.f}};
    __syncthreads();
    for (int n = 0; n < NCHUNK; ++n) {
        const int buf = n & 1; const int item = bh * NCHUNK + n;
        if (n + 1 < NCHUNK) { const size_t ob = (size_t)(item + 1) * 4096 + (size_t)tid * 8;
#pragma unroll
            for (int mt = 0; mt < 5; ++mt) ld[mt] = *(const v4u*)(srcs[mt] + ob); }
        const float glast = glp[item];
        f32x4 acco[2];
#pragma unroll
        for (int x = 0; x < 2; ++x) { const int vt = vt0 + x;
            f32x4 av;
#pragma unroll
            for (int r = 0; r < 4; ++r) av[r] = bf2f(OPB(buf, 1)[(16 * ct + 4 * g4 + r) * 72 + 16 * vt + fr]);
            f32x4 ao = (f32x4){0.f, 0.f, 0.f, 0.f};
#pragma unroll
            for (int ks = 0; ks < 2; ++ks) {
                const bf16x8 aw = *(const LAS bf16x8*)(OPB(buf, 0) + (16 * ct + fr) * 72 + 32 * ks + 8 * g4);
                const bf16x8 aq = *(const LAS bf16x8*)(OPB(buf, 2) + (16 * ct + fr) * 72 + 32 * ks + 8 * g4);
                const bf16x8 bs = *(const LAS bf16x8*)(St + (16 * vt + fr) * 72 + 32 * ks + 8 * g4);
                av = __builtin_amdgcn_mfma_f32_16x16x32_bf16(aw, bs, av, 0, 0, 0);
                ao = __builtin_amdgcn_mfma_f32_16x16x32_bf16(aq, bs, ao, 0, 0, 0); }
            v2u pv; pv.x = pk2(av[0], av[1]); pv.y = pk2(av[2], av[3]);
            *(LAS v2u*)(Vt + (16 * vt + fr) * 72 + 16 * ct + 4 * g4) = pv;
            acco[x] = ao; }
        __syncthreads();
        const int m0 = b * SEQ + n * 64;
#pragma unroll
        for (int x = 0; x < 2; ++x) { const int vt = vt0 + x;
            f32x4 ao = acco[x], as = S[x] * glast;
#pragma unroll
            for (int ks = 0; ks < 2; ++ks) {
                const bf16x8 aa = *(const LAS bf16x8*)(OPB(buf, 3) + (16 * ct + fr) * 72 + 32 * ks + 8 * g4);
                const bf16x8 ak = *(const LAS bf16x8*)(OPB(buf, 4) + (16 * ct + fr) * 72 + 32 * ks + 8 * g4);
                const bf16x8 bv = *(const LAS bf16x8*)(Vt + (16 * vt + fr) * 72 + 32 * ks + 8 * g4);
                ao = __builtin_amdgcn_mfma_f32_16x16x32_bf16(aa, bv, ao, 0, 0, 0);
                as = __builtin_amdgcn_mfma_f32_16x16x32_bf16(ak, bv, as, 0, 0, 0); }
            S[x] = as;
#pragma unroll
            for (int r = 0; r < 4; ++r) O[(size_t)(m0 + 16 * ct + 4 * g4 + r) * 512 + h * 64 + 16 * vt + fr] = (bf16)f2bf(ao[r]);
            v2u ps; ps.x = pk2(as[0], as[1]); ps.y = pk2(as[2], as[3]);
            *(LAS v2u*)(St + (16 * vt + fr) * 72 + 16 * ct + 4 * g4) = ps; }
        if (n + 1 < NCHUNK) {
#pragma unroll
            for (int mt = 0; mt < 5; ++mt) *(LAS v4u*)(OPB(buf ^ 1, mt) + loff) = ld[mt]; }
        __syncthreads();
    }
#undef OPB
}

__device__ __forceinline__ void phase_og(Frame& F, bf16* O, const bf16* Z) {
    const float* onw = IN(I_OUTNORM);
    const int gtid = blockIdx.x * NTHR + F.tid, gth = F.G * NTHR;
    for (int it = gtid; it < M * 64; it += gth) {
        const int cgp = it & 63; const size_t off = (size_t)(it >> 6) * 512 + cgp * 8;
        const v4u ov = *(const v4u*)(O + off), zv = *(const v4u*)(Z + off);
        float o[8] = {bflo(ov.x), bfhi(ov.x), bflo(ov.y), bfhi(ov.y), bflo(ov.z), bfhi(ov.z), bflo(ov.w), bfhi(ov.w)};
        float z[8] = {bflo(zv.x), bfhi(zv.x), bflo(zv.y), bfhi(zv.y), bflo(zv.z), bfhi(zv.z), bflo(zv.w), bfhi(zv.w)};
        float ss = 0.f;
#pragma unroll
        for (int e = 0; e < 8; ++e) ss += o[e] * o[e];
        ss += __shfl_xor(ss, 1); ss += __shfl_xor(ss, 2); ss += __shfl_xor(ss, 4);
        const float rstd = rsqrtf(ss * (1.f / 64.f) + EPS);
        const int c0 = (cgp & 7) * 8; float r[8];
#pragma unroll
        for (int e = 0; e < 8; ++e) r[e] = o[e] * rstd * onw[c0 + e] * (z[e] * sigmoidf_(z[e]));
        v4u w; w.x = pk2(r[0], r[1]); w.y = pk2(r[2], r[3]); w.z = pk2(r[4], r[5]); w.w = pk2(r[6], r[7]);
        *(v4u*)(O + off) = w;
    }
}

__device__ __forceinline__ void phase_x1h2(Frame& F, const bf16* Y, bf16* H2) {
    LAS float* a1 = (LAS float*)F.lds; LAS float* g2 = a1 + 1024; LAS float* s2 = g2 + 1024;
    const float* xin = IN(I_X); const float* npost = IN(I_NPOSTMIX); const float* npre = IN(I_NPREFFN); const float* b_ada = IN(I_BADA); const float* modp = (const float*)(WSP() + WS_MODP); float* outp = OUTP();
    for (int rb = blockIdx.x; rb < M / 128; rb += F.G) {
        const int row0 = rb * 128, b = row0 / SEQ;
        __syncthreads();
        for (int k = F.tid; k < 1024; k += NTHR) { a1[k] = modv(b_ada, modp, b, 2048 + k) * npost[k]; g2[k] = npre[k] * (1.f + modv(b_ada, modp, b, 4096 + k)); s2[k] = modv(b_ada, modp, b, 3072 + k); }
        __syncthreads();
        for (int r = 0; r < 16; ++r) { const int row = row0 + F.wave * 16 + r;
            const v2u* yr = (const v2u*)(Y + (size_t)row * D) + F.lane; const f32x4* xr = (const f32x4*)(xin + (size_t)row * D) + F.lane;
            f32x4 y[4], xv[4]; float ss = 0.f;
#pragma unroll
            for (int j = 0; j < 4; ++j) { const v2u t = yr[64 * j]; y[j] = (f32x4){bflo(t.x), bfhi(t.x), bflo(t.y), bfhi(t.y)}; xv[j] = xr[64 * j];
                ss += (y[j][0] * y[j][0] + y[j][1] * y[j][1]) + (y[j][2] * y[j][2] + y[j][3] * y[j][3]); }
            const float rstd = rsqrtf(wave_sum(ss) * (1.f / D) + EPS); float s1 = 0.f;
            f32x4* orow = (f32x4*)(outp + (size_t)row * D) + F.lane;
#pragma unroll
            for (int j = 0; j < 4; ++j) { const int k = 4 * F.lane + 256 * j; const f32x4 a = *(const LAS f32x4*)(a1 + k);
                xv[j] = xv[j] + a * (y[j] * rstd); orow[64 * j] = xv[j];
                s1 += (xv[j][0] * xv[j][0] + xv[j][1] * xv[j][1]) + (xv[j][2] * xv[j][2] + xv[j][3] * xv[j][3]); }
            const float rstd1 = rsqrtf(wave_sum(s1) * (1.f / D) + EPS);
            v2u* o8 = (v2u*)(H2 + (size_t)row * D) + F.lane;
#pragma unroll
            for (int j = 0; j < 4; ++j) { const int k = 4 * F.lane + 256 * j; const f32x4 g = *(const LAS f32x4*)(g2 + k), s = *(const LAS f32x4*)(s2 + k);
                v2u o; o.x = pk2(xv[j][0] * rstd1 * g[0] + s[0], xv[j][1] * rstd1 * g[1] + s[1]); o.y = pk2(xv[j][2] * rstd1 * g[2] + s[2], xv[j][3] * rstd1 * g[3] + s[3]); o8[64 * j] = o; }
        }
    }
}

__device__ __forceinline__ unsigned mono(float f) { const unsigned u = __float_as_uint(f); return u ^ ((unsigned)((int)u >> 31) | 0x80000000u); }
__device__ __forceinline__ float unmono(unsigned k) { return __uint_as_float((k & 0x80000000u) ? (k ^ 0x80000000u) : ~k); }
#define CE_DESC(a, b) do { const unsigned _mx = max((a), (b)), _mn = min((a), (b)); (a) = _mx; (b) = _mn; } while (0)
__device__ __forceinline__ void top16_of_64(unsigned (&x)[64]) {
#pragma unroll
    for (int g = 0; g < 4; ++g)
#pragma unroll
        for (int k = 2; k <= 16; k <<= 1)
#pragma unroll
            for (int j = k >> 1; j > 0; j >>= 1)
#pragma unroll
                for (int i = 0; i < 16; ++i) { const int l = i ^ j; if (l > i) { if ((i & k) == 0) CE_DESC(x[16 * g + i], x[16 * g + l]); else CE_DESC(x[16 * g + l], x[16 * g + i]); } }
#pragma unroll
    for (int s = 0; s < 3; ++s) { const int a = (s == 1) ? 32 : 0, b2 = (s == 0) ? 16 : (s == 1 ? 48 : 32);
#pragma unroll
        for (int i = 0; i < 16; ++i) x[a + i] = max(x[a + i], x[b2 + 15 - i]);
#pragma unroll
        for (int j = 8; j > 0; j >>= 1)
#pragma unroll
            for (int i = 0; i < 16; ++i) { const int l = i ^ j; if (l > i) CE_DESC(x[a + i], x[a + l]); } }
}
__device__ __forceinline__ void phase_topk(Frame& F, const bf16* Q2, int* EI, float* GA) {
    const int lane = F.lane, wave = F.wave, r = lane & 31, hh = lane >> 5, tsub = wave & 3, hgrp = wave >> 2;
    const bf16* skp = (const bf16*)(WSP() + WS_SK);
    LAS unsigned char* itab = F.lds + wave * 1024;
    for (int tile = blockIdx.x; tile < M / 128; tile += F.G) {
        const int m = tile * 128 + tsub * 32 + r;
#pragma unroll 1
        for (int hd = 0; hd < 4; ++hd) { const int h = hgrp * 4 + hd;
            unsigned k12[2][16];
#pragma unroll
            for (int p = 0; p < 2; ++p) {
                bf16x8 bq[8];
#pragma unroll
                for (int ks = 0; ks < 8; ++ks) bq[ks] = *(const bf16x8*)(Q2 + (size_t)m * 2048 + h * 256 + p * 128 + ks * 16 + hh * 8);
                unsigned keys[64];
#pragma unroll
                for (int kt = 0; kt < 4; ++kt) {
                    f32x16 acc;
#pragma unroll
                    for (int i = 0; i < 16; ++i) acc[i] = 0.f;
                    const bf16* skr = skp + ((size_t)(h * 2 + p) * 128 + kt * 32 + r) * 128 + hh * 8;
#pragma unroll
                    for (int ks = 0; ks < 8; ++ks) { const bf16x8 a = *(const bf16x8*)(skr + ks * 16); acc = __builtin_amdgcn_mfma_f32_32x32x16_bf16(a, bq[ks], acc, 0, 0, 0); }
#pragma unroll
                    for (int i = 0; i < 16; ++i) { const int keyidx = kt * 32 + (i & 3) + 8 * (i >> 2) + 4 * hh; keys[kt * 16 + i] = (mono(acc[i]) & ~127u) | (unsigned)(127 - keyidx); }
                }
                top16_of_64(keys);
                unsigned oth[16];
#pragma unroll
                for (int i = 0; i < 16; ++i) oth[i] = (unsigned)__shfl_xor((int)keys[i], 32);
#pragma unroll
                for (int i = 0; i < 16; ++i) keys[i] = max(keys[i], oth[15 - i]);
#pragma unroll
                for (int j = 8; j > 0; j >>= 1)
#pragma unroll
                    for (int i = 0; i < 16; ++i) { const int l = i ^ j; if (l > i) CE_DESC(keys[i], keys[l]); }
#pragma unroll
                for (int i = 0; i < 16; ++i) k12[p][i] = keys[i];
            }
            float v1[16], v2[16];
#pragma unroll
            for (int i = 0; i < 16; ++i) { v1[i] = unmono(k12[0][i] & ~127u); v2[i] = unmono(k12[1][i] & ~127u); }
            if (hh == 0) {
                v4u w0, w1;
#define PK4(K, b) ((127u - ((K)[b] & 127u)) | ((127u - ((K)[b + 1] & 127u)) << 8) | ((127u - ((K)[b + 2] & 127u)) << 16) | ((127u - ((K)[b + 3] & 127u)) << 24))
                w0.x = PK4(k12[0], 0); w0.y = PK4(k12[0], 4); w0.z = PK4(k12[0], 8); w0.w = PK4(k12[0], 12);
                w1.x = PK4(k12[1], 0); w1.y = PK4(k12[1], 4); w1.z = PK4(k12[1], 8); w1.w = PK4(k12[1], 12);
#undef PK4
                *(LAS v4u*)(itab + r * 32) = w0; *(LAS v4u*)(itab + r * 32 + 16) = w1; }
            unsigned ck[64];
            { int nn = 0;
#pragma unroll
              for (int i = 0; i < 16; ++i)
#pragma unroll
                  for (int j = 0; j < 16; ++j) if ((i + 1) * (j + 1) <= 16) { ck[nn] = (mono(v1[i] + v2[j]) & ~255u) | (unsigned)(255 - (i * 16 + j)); ++nn; }
#pragma unroll
              for (int q = 50; q < 64; ++q) ck[q] = 0u; }
            top16_of_64(ck);
            asm volatile("s_waitcnt lgkmcnt(0)" ::: "memory");
            float ts[16], es[16]; int ei[16]; float sum = 0.f;
#pragma unroll
            for (int q = 0; q < 16; ++q) { ts[q] = unmono(ck[q] & ~255u); const unsigned pos = 255u - (ck[q] & 255u);
                const unsigned e1 = itab[r * 32 + (pos >> 4)], e2 = itab[r * 32 + 16 + (pos & 15u)]; ei[q] = (int)(e1 * 128u + e2); }
#pragma unroll
            for (int q = 0; q < 16; ++q) { es[q] = __expf(ts[q] - ts[0]); sum += es[q]; }
            const float inv = 1.0f / sum;
            int eo[8]; float go[8];
#pragma unroll
            for (int q = 0; q < 8; ++q) { eo[q] = hh ? ei[q + 8] : ei[q]; go[q] = (hh ? es[q + 8] : es[q]) * inv; }
            int* ep = EI + (size_t)m * 128 + h * 16 + hh * 8; float* gp = GA + (size_t)m * 128 + h * 16 + hh * 8;
            *(v4u*)ep = (v4u){(unsigned)eo[0], (unsigned)eo[1], (unsigned)eo[2], (unsigned)eo[3]}; *(v4u*)(ep + 4) = (v4u){(unsigned)eo[4], (unsigned)eo[5], (unsigned)eo[6], (unsigned)eo[7]};
            *(f32x4*)gp = (f32x4){go[0], go[1], go[2], go[3]}; *(f32x4*)(gp + 4) = (f32x4){go[4], go[5], go[6], go[7]};
            asm volatile("s_waitcnt lgkmcnt(0)" ::: "memory");
        }
    }
}

__device__ __forceinline__ float dot2bf(unsigned a, unsigned b, float acc) { return acc + bflo(a) * bflo(b) + bfhi(a) * bfhi(b); }
__device__ __forceinline__ void phase_gather(Frame& F, const bf16* H2, const int* EI, const float* GA) {
    LAS float* a2 = (LAS float*)F.lds;
    unsigned char* ws = WSP(); const bf16* tu = (const bf16*)(ws + WS_TU); const bf16* tv = (const bf16*)(ws + WS_TV); float* outp = OUTP();
    const float* npf = IN(I_NPOSTFFN); const float* b_ada = IN(I_BADA); const float* modp = (const float*)(ws + WS_MODP);
    const int lane = F.lane, g = lane >> 4, j = lane & 15;
    for (int rb = blockIdx.x; rb < M / 128; rb += F.G) {
        const int row0 = rb * 128, b = row0 / SEQ;
        __syncthreads();
        for (int k = F.tid; k < 1024; k += NTHR) a2[k] = modv(b_ada, modp, b, 5120 + k) * npf[k];
        __syncthreads();
        for (int ti = 0; ti < 16; ++ti) { const int m = row0 + F.wave * 16 + ti;
            v4u hr[8];
#pragma unroll
            for (int i = 0; i < 8; ++i) hr[i] = *(const v4u*)(H2 + (size_t)m * D + 8 * (i * 16 + j));
            const int e_lo = EI[(size_t)m * 128 + lane], e_hi = EI[(size_t)m * 128 + 64 + lane];
            const float g_lo = GA[(size_t)m * 128 + lane], g_hi = GA[(size_t)m * 128 + 64 + lane];
            float y[64];
#pragma unroll
            for (int q = 0; q < 64; ++q) y[q] = 0.f;
#pragma unroll 1
            for (int eg = 0; eg < 32; ++eg) {
                const int src = (eg * 4 + g) & 63;
                const int eidx = __shfl(eg < 16 ? e_lo : e_hi, src); const float gate = __shfl(eg < 16 ? g_lo : g_hi, src);
                const bf16* ur = tu + (size_t)eidx * D + 8 * j; const bf16* vr = tv + (size_t)eidx * D + 8 * j;
                v4u uu[8], vv[8];
#pragma unroll
                for (int i = 0; i < 8; ++i) uu[i] = *(const v4u*)(ur + 128 * i);
#pragma unroll
                for (int i = 0; i < 8; ++i) vv[i] = *(const v4u*)(vr + 128 * i);
                float d = 0.f;
#pragma unroll
                for (int i = 0; i < 8; ++i) { d = dot2bf(hr[i].x, uu[i].x, d); d = dot2bf(hr[i].y, uu[i].y, d); d = dot2bf(hr[i].z, uu[i].z, d); d = dot2bf(hr[i].w, uu[i].w, d); }
                d += __shfl_xor(d, 1); d += __shfl_xor(d, 2); d += __shfl_xor(d, 4); d += __shfl_xor(d, 8);
                const float wgt = gate * 0.5f * d * (1.0f + erff(d * 0.70710678118654752f));
#pragma unroll
                for (int i = 0; i < 8; ++i) {
                    y[i * 8 + 0] += wgt * bflo(vv[i].x); y[i * 8 + 1] += wgt * bfhi(vv[i].x); y[i * 8 + 2] += wgt * bflo(vv[i].y); y[i * 8 + 3] += wgt * bfhi(vv[i].y);
                    y[i * 8 + 4] += wgt * bflo(vv[i].z); y[i * 8 + 5] += wgt * bfhi(vv[i].z); y[i * 8 + 6] += wgt * bflo(vv[i].w); y[i * 8 + 7] += wgt * bfhi(vv[i].w); }
            }
            float ss = 0.f;
#pragma unroll
            for (int q = 0; q < 64; ++q) { y[q] += __shfl_xor(y[q], 16); y[q] += __shfl_xor(y[q], 32); ss += y[q] * y[q]; }
            ss += __shfl_xor(ss, 1); ss += __shfl_xor(ss, 2); ss += __shfl_xor(ss, 4); ss += __shfl_xor(ss, 8);
            const float rstd = rsqrtf(ss * (1.f / D) + EPS);
#pragma unroll
            for (int ii = 0; ii < 2; ++ii) {
                float yy[8];
#pragma unroll
                for (int e = 0; e < 8; ++e) { const float t0 = y[(0 + ii) * 8 + e], t1 = y[(2 + ii) * 8 + e], t2 = y[(4 + ii) * 8 + e], t3 = y[(6 + ii) * 8 + e]; yy[e] = (g == 0) ? t0 : (g == 1) ? t1 : (g == 2) ? t2 : t3; }
                const int k = 8 * ((2 * g + ii) * 16 + j);
                f32x4* op = (f32x4*)(outp + (size_t)m * D + k);
                f32x4 x0 = op[0], x1 = op[1]; const f32x4 a0 = *(const LAS f32x4*)(a2 + k), a1 = *(const LAS f32x4*)(a2 + k + 4);
                x0[0] += a0[0] * yy[0] * rstd; x0[1] += a0[1] * yy[1] * rstd; x0[2] += a0[2] * yy[2] * rstd; x0[3] += a0[3] * yy[3] * rstd;
                x1[0] += a1[0] * yy[4] * rstd; x1[1] += a1[1] * yy[5] * rstd; x1[2] += a1[2] * yy[6] * rstd; x1[3] += a1[3] * yy[7] * rstd;
                op[0] = x0; op[1] = x1; }
        }
    }
}

struct Args { const float* in[21]; float* out; unsigned char* ws; };
__global__ void __launch_bounds__(NTHR, 2) fwd_megakernel(Args args) {
    extern __shared__ __attribute__((aligned(16))) unsigned char lds[];
    cg::grid_group grid = cg::this_grid();
    Frame F;
    F.lds = (LAS unsigned char*)lds; F.tid = threadIdx.x; F.lane = F.tid & 63; F.wave = __builtin_amdgcn_readfirstlane(F.tid >> 6); F.G = gridDim.x;
#define WSB(off) ((bf16*)(WSP() + (off)))
#define SEGP(s) segp(WSP(), (s))
    phase_prologue(F);
    grid.sync();
    phase_h1(F, (bf16*)OUTP());
    grid.sync();
    {
        pg8::Gemm g{(const bf16*)OUTP(), WSB(WS_WIN), M, NIN, D}; pg8::StaticOrder S; S.init(M, NIN, F.G, (int)blockIdx.x);
        pg8::EpiBf16<0> E{SEGP(0), 512, nullptr, 512, SEG_ELEMS, 1.f};
        pg8::gemm_phase<pg8::EpiBf16<0>, pg8::StaticOrder, true, true>(F.lds, g, S, E);
    }
    grid.sync();
    phase_scprep(F);
    { bf16* dW = (bf16*)OUTP(); phase_dnprep(F, dW, dW + (size_t)NITEM * 4096, dW + (size_t)2 * NITEM * 4096, dW + (size_t)3 * NITEM * 4096, WSB(WS_KD)); }
    grid.sync();
    { const bf16* dW = (const bf16*)OUTP(); phase_scan(F, dW, dW + (size_t)NITEM * 4096, dW + (size_t)2 * NITEM * 4096, dW + (size_t)3 * NITEM * 4096, WSB(WS_KD), SEGP(3)); }
    grid.sync();
    phase_og(F, SEGP(3), SEGP(6));
    grid.sync();
    {
        pg8::StaticOrder S; S.init(M, D, F.G, (int)blockIdx.x);
        { pg8::Gemm g{SEGP(0), WSB(WS_WSC), M, D, 512}; pg8::EpiGate<false> E{SEGP(4), SEGP(7), SEG_ELEMS};
          pg8::gemm_phase<pg8::EpiGate<false>, pg8::StaticOrder, true, true>(F.lds, g, S, E); }
        { pg8::Gemm g{SEGP(3), WSB(WS_WDN), M, D, 512}; pg8::EpiGate<true> E{SEGP(4), SEGP(9), SEG_ELEMS};
          pg8::gemm_phase<pg8::EpiGate<true>, pg8::StaticOrder, true, true>(F.lds, g, S, E); }
    }
    grid.sync();
    {
        pg8::Gemm g{SEGP(4), WSB(WS_WMIX), M, D, D}; pg8::StaticOrder S; S.init(M, D, F.G, (int)blockIdx.x);
        pg8::EpiBf16<0> E{SEGP(1), D, nullptr, 0, 0, 1.f};
        pg8::gemm_phase<pg8::EpiBf16<0>, pg8::StaticOrder, true, true>(F.lds, g, S, E);
    }
    grid.sync();
    phase_x1h2(F, SEGP(1), SEGP(7));
    grid.sync();
    {
        pg8::Gemm g{SEGP(7), WSB(WS_WQ), M, 2048, D}; pg8::StaticOrder S; S.init(M, 2048, F.G, (int)blockIdx.x);
        pg8::EpiBf16<0> E{SEGP(3), 2048, nullptr, 0, 0, 1.f};
        pg8::gemm_phase<pg8::EpiBf16<0>, pg8::StaticOrder, true, true>(F.lds, g, S, E);
    }
    grid.sync();
    phase_topk(F, SEGP(3), (int*)SEGP(0), (float*)((unsigned char*)SEGP(0) + 16 * MiB));
    grid.sync();
    phase_gather(F, SEGP(7), (const int*)SEGP(0), (const float*)((unsigned char*)SEGP(0) + 16 * MiB));
}

extern "C" void kernel_launch(void* const* d_in, const int* in_sizes, int n_in, void* d_out, int out_size, void* d_ws, size_t ws_size, hipStream_t stream) {
    static int grid = 0;
    if (grid == 0) {
        if (n_in != 21 || out_size != M * D || ws_size < WS_END) { fprintf(stderr, "kernel_launch: unexpected problem (n_in %d, out %d, ws %zu)\n", n_in, out_size, ws_size); grid = -1; return; }
        int dev = 0, cus = 0, per_cu = 0;
        hipGetDevice(&dev); hipDeviceGetAttribute(&cus, hipDeviceAttributeMultiprocessorCount, dev);
        hipFuncSetAttribute((const void*)fwd_megakernel, hipFuncAttributeMaxDynamicSharedMemorySize, LDS_BYTES);
        hipOccupancyMaxActiveBlocksPerMultiprocessor(&per_cu, (const void*)fwd_megakernel, NTHR, LDS_BYTES);
        if (per_cu < 1) { fprintf(stderr, "kernel_launch: occupancy query says %d blocks per CU\n", per_cu); per_cu = 1; }
        if (per_cu > 1) per_cu = 1;
        grid = cus * per_cu; if (grid > 256) grid = 256;
        (void)hipGetLastError();
    }
    if (grid < 0) return;
    Args a{};
    for (int i = 0; i < 21; ++i) a.in[i] = (const float*)d_in[i];
    a.out = (float*)d_out; a.ws = (unsigned char*)d_ws;
    void* kargs[] = {&a};
    hipError_t e = hipLaunchCooperativeKernel((const void*)fwd_megakernel, dim3(grid), dim3(NTHR), kargs, LDS_BYTES, stream);
    if (e != hipSuccess) fprintf(stderr, "cooperative launch failed: %s (grid %d)\n", hipGetErrorString(e), grid);
}
```

```cpp
#include <hip/hip_runtime.h>
#include <hip/hip_cooperative_groups.h>
#include <cstdio>
#include <cstdint>
namespace cg = cooperative_groups;
namespace pg8 {
#define PG8_LAS __attribute__((address_space(3)))
typedef unsigned short bf16_t;
typedef short bf16x8 __attribute__((ext_vector_type(8)));
typedef float f32x4 __attribute__((ext_vector_type(4)));
typedef unsigned u32x4 __attribute__((ext_vector_type(4)));
constexpr int BM = 256, BK = 64, HALF = 128, HTB = HALF * BK * 2  , STAGE_BYTES = 8 * HTB, NXCD = 8, WGM = 8;

__host__ __device__ __forceinline__ int lds_byte(int r, int c) { const int st = (r >> 4) * 2 + (c >> 5), rr = r & 15, cc = c & 31, ob = rr * 64 + cc * 2; return st * 1024 + (ob ^ (((ob >> 9) & 1) << 5)); }
__host__ __device__ __forceinline__ void stage_rc(int b, int& R, int& C) { const int st = b / 1024, sb = b % 1024, swz = sb ^ (((sb >> 9) & 1) << 5); R = (st >> 1) * 16 + swz / 64; C = (st & 1) * 32 + (swz % 64) / 2; }
__host__ __device__ __forceinline__ int perm32(int rho) { const int n = rho >> 4, i = rho & 15; return 8 * (i >> 2) + 4 * n + (i & 3); }

struct Unit { int pm, pn; };
struct Gemm { const bf16_t* A; const bf16_t* Bt; int M, N, K; };

struct StaticOrder {
    int nM, nN, nwg, G, c;
    __host__ __device__ void init(int M, int N, int G_, int c_) { nM = M / BM; nN = N / BM; nwg = nM * nN; G = G_; c = c_; }
    __host__ __device__ bool next(int i, Unit& u) const {
        const long L = (long)i * G + c; if (L >= nwg) return false;
        int wgid = (int)L; { const int q = nwg / NXCD, r = nwg % NXCD, xcd = wgid % NXCD, off = wgid / NXCD; wgid = (xcd < r ? xcd * (q + 1) : r * (q + 1) + (xcd - r) * q) + off; }
        const int nig = WGM * nN, gid = wgid / nig, fm = gid * WGM, gsz = (nM - fm) < WGM ? (nM - fm) : WGM;
        u.pm = fm + ((wgid % nig) % gsz); u.pn = (wgid % nig) / gsz; return true;
    }
    __device__ __forceinline__ void a_ready(const Unit&) const {}
    __device__ __forceinline__ void done(const Unit&) const {}
};

__device__ __forceinline__ unsigned cvt_pk_bf16(float lo, float hi) { unsigned r; asm volatile("v_cvt_pk_bf16_f32 %0, %1, %2" : "=v"(r) : "v"(lo), "v"(hi)); return r; }
typedef float f32x2 __attribute__((ext_vector_type(2)));
__device__ __forceinline__ f32x2 gelu_pk(f32x2 v) {
    const f32x2 av = __builtin_elementwise_abs(v), d = av * 0.2316418882f + 1.0f;
    f32x2 t; t.x = __builtin_amdgcn_rcpf(d.x); t.y = __builtin_amdgcn_rcpf(d.y);
    f32x2 q = t * 0.5307027145f + (-0.7265760135f); q = q * t + 0.7107068705f; q = q * t + (-0.142248368f); q = q * t + 0.127414796f; q = q * t;
    const f32x2 s = (v * v) * (-0.72134752044f);
    f32x2 e; e.x = __builtin_amdgcn_exp2f(s.x); e.y = __builtin_amdgcn_exp2f(s.y);
    const f32x2 m = v * (q * e), r = v - m;
    f32x2 o; o.x = v.x < 0.f ? m.x : r.x; o.y = v.y < 0.f ? m.y : r.y; return o;
}

template <int ACT  > struct EpiBf16 {
    static constexpr bool PERM = true, AFTER_DRAIN = false; static_assert(ACT == 0 || ACT == 1, "EpiBf16: ACT is 0 (none) or 1 (gelu_pk)");
    bf16_t* O; int ldc; const float* bias; int split_cols; size_t split_stride; float scale0;
    __device__ __forceinline__ void operator()(const f32x4 (&acc)[2][2][4][2], const Unit& u, int wr, int wc, int fr, int fq) const {
        const int row0 = u.pm * BM + wr * 64 + fr; int colt = u.pn * BM; bf16_t* base = O;
        float sc = 1.f; if (split_cols) { const int t = colt / split_cols; base += (size_t)t * split_stride; colt -= t * split_cols; if (t == 0) sc = scale0; }
        const int col0 = colt + wc * 32 + 8 * fq, bcol0 = u.pn * BM + wc * 32 + 8 * fq;
        f32x4 bv[2][2];
#pragma unroll
        for (int bj = 0; bj < 2; ++bj)
#pragma unroll
            for (int n = 0; n < 2; ++n) bv[bj][n] = bias ? *(const f32x4*)(bias + bcol0 + bj * HALF + 4 * n) : (f32x4){0.f, 0.f, 0.f, 0.f};
#pragma unroll
        for (int ai = 0; ai < 2; ++ai)
#pragma unroll
            for (int m = 0; m < 4; ++m) { bf16_t* rowp = base + (size_t)(row0 + ai * HALF + m * 16) * ldc + col0;
#pragma unroll
                for (int bj = 0; bj < 2; ++bj) { f32x4 v0 = acc[ai][bj][m][0] + bv[bj][0], v1 = acc[ai][bj][m][1] + bv[bj][1];
                    if (ACT == 1) { f32x2 a = gelu_pk((f32x2){v0[0], v0[1]}), b = gelu_pk((f32x2){v0[2], v0[3]}), c = gelu_pk((f32x2){v1[0], v1[1]}), d = gelu_pk((f32x2){v1[2], v1[3]});
                        v0 = (f32x4){a.x, a.y, b.x, b.y}; v1 = (f32x4){c.x, c.y, d.x, d.y}; }
                    v0 = v0 * sc; v1 = v1 * sc; u32x4 w; w.x = cvt_pk_bf16(v0[0], v0[1]); w.y = cvt_pk_bf16(v0[2], v0[3]); w.z = cvt_pk_bf16(v1[0], v1[1]); w.w = cvt_pk_bf16(v1[2], v1[3]);
                    *(u32x4*)(rowp + bj * HALF) = w; } }
    }
};
__device__ __forceinline__ float bf_lo(unsigned u) { return __uint_as_float(u << 16); }
__device__ __forceinline__ float bf_hi(unsigned u) { return __uint_as_float(u & 0xffff0000u); }
__device__ __forceinline__ float sigm(float x) { return __builtin_amdgcn_rcpf(1.0f + __builtin_amdgcn_exp2f(-1.4426950408889634f * x)); }
template <bool ADD> struct EpiGate {
    static constexpr bool PERM = true, AFTER_DRAIN = false;
    bf16_t* O; const bf16_t* gate; size_t seg_elems;
    __device__ __forceinline__ void operator()(const f32x4 (&acc)[2][2][4][2], const Unit& u, int wr, int wc, int fr, int fq) const {
        const int row0 = u.pm * BM + wr * 64 + fr, col0 = u.pn * BM + wc * 32 + 8 * fq;
#pragma unroll
        for (int ai = 0; ai < 2; ++ai)
#pragma unroll
            for (int m = 0; m < 4; ++m) { const int row = row0 + ai * HALF + m * 16;
#pragma unroll
                for (int bj = 0; bj < 2; ++bj) { const int col = col0 + bj * HALF;
                    const u32x4 gv = *(const u32x4*)(gate + (size_t)(col >> 9) * seg_elems + (size_t)row * 512 + (col & 511));
                    bf16_t* op = O + (size_t)row * 1024 + col;
                    f32x4 v0 = acc[ai][bj][m][0], v1 = acc[ai][bj][m][1];
                    v0[0] *= sigm(bf_lo(gv.x)); v0[1] *= sigm(bf_hi(gv.x)); v0[2] *= sigm(bf_lo(gv.y)); v0[3] *= sigm(bf_hi(gv.y));
                    v1[0] *= sigm(bf_lo(gv.z)); v1[1] *= sigm(bf_hi(gv.z)); v1[2] *= sigm(bf_lo(gv.w)); v1[3] *= sigm(bf_hi(gv.w));
                    if (ADD) { const u32x4 ov = *(const u32x4*)op;
                        v0[0] += bf_lo(ov.x); v0[1] += bf_hi(ov.x); v0[2] += bf_lo(ov.y); v0[3] += bf_hi(ov.y);
                        v1[0] += bf_lo(ov.z); v1[1] += bf_hi(ov.z); v1[2] += bf_lo(ov.w); v1[3] += bf_hi(ov.w); }
                    u32x4 w; w.x = cvt_pk_bf16(v0[0], v0[1]); w.y = cvt_pk_bf16(v0[2], v0[3]); w.z = cvt_pk_bf16(v1[0], v1[1]); w.w = cvt_pk_bf16(v1[2], v1[3]);
                    *(u32x4*)op = w; } }
    }
};
template <class Epi, class Sched, bool ALIGN_EPI = false, bool SP2 = false>
__device__ __forceinline__ void gemm_phase(PG8_LAS unsigned char* lds, const Gemm g, const Sched& S, const Epi& E) {
    int tid_ = threadIdx.x; asm volatile("" : "+v"(tid_));
    const int tid = tid_, wid = __builtin_amdgcn_readfirstlane(tid >> 6), lane = tid & 63, wr = wid >> 2, wc = wid & 3, fr = lane & 15, fq = lane >> 4;
    const int K = g.K, nt = K / BK;
    unsigned voffA[2], voffB[2];
#pragma unroll
    for (int i = 0; i < 2; ++i) { int R, C; stage_rc(tid * 16 + i * 8192, R, C); const int Rb = Epi::PERM ? ((R & ~31) + perm32(R & 31)) : R;
        voffA[i] = (unsigned)(R * K + C) * 2u; voffB[i] = (unsigned)(Rb * K + C) * 2u; }
    const size_t kstep = (size_t)(BK * 2);
    const size_t hstep = (size_t)HALF * K * 2;
    const size_t tstep = 2 * hstep;
    const unsigned ldsw = (unsigned)wid * 1024u;
    const int aoff = lds_byte(wr * 64 + fr, fq * 8), boff = lds_byte(wc * 32 + fr, fq * 8);
#define PG8_SA(b, h) (((b) * 2 + (h)) * HTB)
#define PG8_SB(b, h) ((4 + (b) * 2 + (h)) * HTB)
#define PG8_STAGE(bufoff, gbase, voff) do { _Pragma("unroll") for (int _i = 0; _i < 2; ++_i) \
        __builtin_amdgcn_global_load_lds((const unsigned*)((const char*)(gbase) + (voff)[_i]), (PG8_LAS unsigned*)(lds + (bufoff) + ldsw + _i * 8192), 16, 0, 0); } while (0)
#define PG8_LDA(dst, b, h) do { _Pragma("unroll") for (int m = 0; m < 4; ++m) _Pragma("unroll") for (int k = 0; k < 2; ++k) dst[m][k] = *(const PG8_LAS bf16x8*)(lds + PG8_SA(b, h) + aoff + m * 2048 + k * 1024); } while (0)
#define PG8_LDB(dst, b, h) do { _Pragma("unroll") for (int n = 0; n < 2; ++n) _Pragma("unroll") for (int k = 0; k < 2; ++k) dst[n][k] = *(const PG8_LAS bf16x8*)(lds + PG8_SB(b, h) + boff + n * 2048 + k * 1024); } while (0)
#define PG8_MMA(ai, bj, At, Bt) do { __builtin_amdgcn_s_setprio(1); _Pragma("unroll") for (int m = 0; m < 4; ++m) _Pragma("unroll") for (int n = 0; n < 2; ++n) _Pragma("unroll") for (int k = 0; k < 2; ++k) \
        acc[ai][bj][m][n] = __builtin_amdgcn_mfma_f32_16x16x32_bf16(Bt[n][k], At[m][k], acc[ai][bj][m][n], 0, 0, 0); __builtin_amdgcn_s_setprio(0); } while (0)
#define PG8_WAIT_V(n) asm volatile("s_waitcnt vmcnt(" #n ")" ::: "memory")
#define PG8_WAIT_L(n) asm volatile("s_waitcnt lgkmcnt(" #n ")" ::: "memory")
#define PG8_BAR __builtin_amdgcn_s_barrier()
#define PG8_SCHED __builtin_amdgcn_sched_barrier(0)
    Unit cur, nxt; int ui = 0;
    if (!S.next(0, cur)) return;
    f32x4 acc[2][2][4][2];
#pragma unroll
    for (int a = 0; a < 2; ++a)
#pragma unroll
        for (int b = 0; b < 2; ++b)
#pragma unroll
            for (int m = 0; m < 4; ++m)
#pragma unroll
                for (int n = 0; n < 2; ++n) acc[a][b][m][n] = (f32x4){0.f, 0.f, 0.f, 0.f};
    bf16x8 At[4][2], B0[2][2], B1[2][2];
    const char* cA = (const char*)g.A + (size_t)cur.pm * tstep; const char* cB = (const char*)g.Bt + (size_t)cur.pn * tstep;
    S.a_ready(cur);
    if constexpr (SP2) {
        PG8_STAGE(PG8_SB(0, 0), cB, voffB); PG8_STAGE(PG8_SB(0, 1), cB + hstep, voffB); PG8_STAGE(PG8_SA(0, 0), cA, voffA); PG8_STAGE(PG8_SA(0, 1), cA + hstep, voffA);
        if (wr == 1) PG8_BAR;
        PG8_WAIT_V(2); PG8_BAR;
        PG8_STAGE(PG8_SB(1, 0), cB + kstep, voffB); PG8_STAGE(PG8_SA(1, 0), cA + kstep, voffA); PG8_STAGE(PG8_SB(1, 1), cB + hstep + kstep, voffB);
        PG8_WAIT_V(6); PG8_BAR;
    } else {
        PG8_STAGE(PG8_SB(0, 0), cB, voffB); PG8_STAGE(PG8_SA(0, 0), cA, voffA); PG8_STAGE(PG8_SB(0, 1), cB + hstep, voffB); PG8_STAGE(PG8_SA(0, 1), cA + hstep, voffA);
        if (wr == 1) PG8_BAR;
        PG8_WAIT_V(4); PG8_BAR;
        PG8_STAGE(PG8_SB(1, 0), cB + kstep, voffB); PG8_STAGE(PG8_SA(1, 0), cA + kstep, voffA); PG8_STAGE(PG8_SB(1, 1), cB + hstep + kstep, voffB);
        PG8_WAIT_V(6); PG8_BAR;
    }
    for (;;) {
        const bool has_next = S.next(ui + 1, nxt);
        const char* nA = has_next ? (const char*)g.A + (size_t)nxt.pm * tstep : cA; const char* nB = has_next ? (const char*)g.Bt + (size_t)nxt.pn * tstep : cB;
        for (int t = 0; t < nt; t += 2) {
            const bool last = (t == nt - 2);
            const char* a1 = cA + (size_t)(t + 1) * kstep;
            const char* a2 = last ? nA : cA + (size_t)(t + 2) * kstep; const char* b2 = last ? nB : cB + (size_t)(t + 2) * kstep;
            const char* a3 = a2 + kstep; const char* b3 = b2 + kstep;
            if (last && has_next) S.a_ready(nxt);
            if constexpr (SP2) {
            PG8_LDB(B0, 0, 0); PG8_LDB(B1, 0, 1); PG8_SCHED; PG8_LDA(At, 0, 0); PG8_STAGE(PG8_SA(1, 1), a1 + hstep, voffA);
            PG8_WAIT_V(8); PG8_WAIT_L(0); PG8_BAR; PG8_MMA(0, 0, At, B0); PG8_MMA(0, 1, At, B1); PG8_BAR; PG8_SCHED;
            PG8_LDA(At, 0, 1); PG8_STAGE(PG8_SB(0, 0), b2, voffB); PG8_STAGE(PG8_SB(0, 1), b2 + hstep, voffB); PG8_STAGE(PG8_SA(0, 0), a2, voffA);
            PG8_WAIT_V(8); PG8_WAIT_L(0); PG8_BAR; PG8_MMA(1, 0, At, B0); PG8_MMA(1, 1, At, B1); PG8_BAR; PG8_SCHED;
            PG8_LDB(B0, 1, 0); PG8_LDB(B1, 1, 1); PG8_SCHED; PG8_LDA(At, 1, 0); PG8_STAGE(PG8_SA(0, 1), a2 + hstep, voffA);
            PG8_WAIT_V(8); PG8_WAIT_L(0); PG8_BAR; PG8_MMA(0, 0, At, B0); PG8_MMA(0, 1, At, B1); PG8_BAR; PG8_SCHED;
            PG8_LDA(At, 1, 1); PG8_STAGE(PG8_SB(1, 0), b3, voffB); PG8_STAGE(PG8_SB(1, 1), b3 + hstep, voffB); PG8_STAGE(PG8_SA(1, 0), a3, voffA);
            PG8_WAIT_V(8); PG8_WAIT_L(0); PG8_BAR; PG8_MMA(1, 0, At, B0); PG8_MMA(1, 1, At, B1); PG8_BAR; PG8_SCHED;
            } else {
            PG8_LDB(B0, 0, 0); PG8_SCHED; PG8_LDA(At, 0, 0); PG8_STAGE(PG8_SA(1, 1), a1 + hstep, voffA);
            PG8_WAIT_L(8); PG8_BAR; PG8_WAIT_L(0); PG8_MMA(0, 0, At, B0); PG8_BAR; PG8_SCHED;
            PG8_LDB(B1, 0, 1); PG8_STAGE(PG8_SB(0, 0), b2, voffB);
            PG8_BAR; PG8_WAIT_L(0); PG8_MMA(0, 1, At, B1); PG8_BAR;
            PG8_LDA(At, 0, 1); PG8_STAGE(PG8_SA(0, 0), a2, voffA);
            PG8_BAR; PG8_WAIT_L(0); PG8_MMA(1, 0, At, B0); PG8_BAR; PG8_SCHED;
            PG8_STAGE(PG8_SB(0, 1), b2 + hstep, voffB);
            PG8_WAIT_V(6); PG8_BAR; PG8_MMA(1, 1, At, B1); PG8_BAR;
            PG8_LDB(B0, 1, 0); PG8_SCHED; PG8_LDA(At, 1, 0); PG8_STAGE(PG8_SA(0, 1), a2 + hstep, voffA);
            PG8_WAIT_L(8); PG8_BAR; PG8_WAIT_L(0); PG8_MMA(0, 0, At, B0); PG8_BAR; PG8_SCHED;
            PG8_LDB(B1, 1, 1); PG8_STAGE(PG8_SB(1, 0), b3, voffB);
            PG8_BAR; PG8_WAIT_L(0); PG8_MMA(0, 1, At, B1); PG8_BAR;
            PG8_LDA(At, 1, 1); PG8_STAGE(PG8_SA(1, 0), a3, voffA);
            PG8_BAR; PG8_WAIT_L(0); PG8_MMA(1, 0, At, B0); PG8_BAR; PG8_SCHED;
            PG8_STAGE(PG8_SB(1, 1), b3 + hstep, voffB);
            PG8_WAIT_V(6); PG8_BAR; PG8_MMA(1, 1, At, B1); PG8_BAR;
            }
        }
        if constexpr (ALIGN_EPI) { if (wr == 0) PG8_BAR; }
        if constexpr (!Epi::AFTER_DRAIN) { E(acc, cur, wr, wc, fr, fq); S.done(cur); }
        if (!has_next) break;
#pragma unroll
        for (int a = 0; a < 2; ++a)
#pragma unroll
            for (int b = 0; b < 2; ++b)
#pragma unroll
                for (int m = 0; m < 4; ++m)
#pragma unroll
                    for (int n = 0; n < 2; ++n) acc[a][b][m][n] = (f32x4){0.f, 0.f, 0.f, 0.f};
        cur = nxt; cA = nA; cB = nB; ++ui;
        if constexpr (ALIGN_EPI) { if (wr == 1) PG8_BAR; }
    }
    PG8_WAIT_V(0);
    if constexpr (!ALIGN_EPI) { if (wr == 0) PG8_BAR; }
    PG8_BAR;
    if constexpr (Epi::AFTER_DRAIN) { E.fused(acc, cur, wr, wc, fr, fq, lds, wid, lane); S.done(cur); }
#undef PG8_SA
#undef PG8_SB
#undef PG8_STAGE
#undef PG8_LDA
#undef PG8_LDB
#undef PG8_MMA
#undef PG8_WAIT_V
#undef PG8_WAIT_L
#undef PG8_BAR
#undef PG8_SCHED
}
}
constexpr int NWAVES = 8, NTHR = 512;
constexpr int M = 32768, D = 1024, SEQ = 8192, NBATCH = 4;
constexpr int NIN = 5888;
constexpr int NCHUNK = 128, NITEM = 32 * NCHUNK;
constexpr float EPS = 1e-6f;
constexpr size_t MiB = 1u << 20;
constexpr size_t SEG_ELEMS = (size_t)M * 512;
constexpr size_t WS_CTL = 0, WS_MODP = 1 * MiB, WS_WIN = 2 * MiB, WS_WQ = 14 * MiB, WS_WSC = 18 * MiB, WS_WDN = 19 * MiB, WS_WMIX = 20 * MiB,
                 WS_SK = 22 * MiB, WS_GL = 23 * MiB, WS_SU = 23 * MiB + 65536, WS_SV = 23 * MiB + 131072, WS_TU = 24 * MiB, WS_TV = 56 * MiB, WS_P = 88 * MiB, WS_KD = 472 * MiB, WS_END = 504 * MiB;
constexpr int LDS_BYTES = 147456;

#define GAS __attribute__((address_space(1)))
#define LAS __attribute__((address_space(3)))
typedef unsigned short bf16;
typedef unsigned v4u __attribute__((ext_vector_type(4)));
typedef unsigned v2u __attribute__((ext_vector_type(2)));
typedef float f32x4 __attribute__((ext_vector_type(4)));
typedef float f32x16 __attribute__((ext_vector_type(16)));
typedef short bf16x8 __attribute__((ext_vector_type(8)));

__device__ __forceinline__ unsigned f2bf(float f) { unsigned u = __builtin_bit_cast(unsigned, f); return (u + 0x7fffu + ((u >> 16) & 1u)) >> 16; }
__device__ __forceinline__ unsigned pk2(float lo, float hi) { return f2bf(lo) | (f2bf(hi) << 16); }
__device__ __forceinline__ float bflo(unsigned u) { return __uint_as_float(u << 16); }
__device__ __forceinline__ float bfhi(unsigned u) { return __uint_as_float(u & 0xffff0000u); }
__device__ __forceinline__ float bf2f(bf16 h) { return __uint_as_float((unsigned)h << 16); }
__device__ __forceinline__ float sigmoidf_(float x) { return 1.0f / (1.0f + __expf(-x)); }
__device__ __forceinline__ float wave_sum(float v) {
#pragma unroll
    for (int o = 1; o < 64; o <<= 1) v += __shfl_xor(v, o);
    return v;
}

struct Frame { LAS unsigned char* lds; int tid, lane, wave, G; };
__device__ __forceinline__ const void* karg(int i) {
    const char __attribute__((address_space(4)))* kp = (const char __attribute__((address_space(4)))*)__builtin_amdgcn_kernarg_segment_ptr();
    asm volatile("" : "+s"(i));
    return *(const void* const __attribute__((address_space(4)))*)(kp + 8 * i);
}
__device__ __forceinline__ const float* IN(int i) { return (const float*)karg(i); }
__device__ __forceinline__ float* OUTP() { return (float*)karg(21); }
__device__ __forceinline__ unsigned char* WSP() { return (unsigned char*)karg(22); }
enum { I_X = 0, I_C, I_WADA, I_BADA, I_NPREMIX, I_NPOSTMIX, I_WIN, I_SCCONV, I_DNCONV, I_ALOG, I_DTBIAS, I_OUTNORM, I_WSC, I_WDN, I_WMIX, I_NPREFFN, I_NPOSTFFN, I_WQ, I_SUBK, I_PU, I_PV };
__device__ __forceinline__ bf16* segp(unsigned char* ws, int s) { return (bf16*)(ws + WS_P) + (size_t)s * SEG_ELEMS; }
__device__ __forceinline__ float modv(const float* b_ada, const float* modp, int b, int j) {
    float s = b_ada[j];
#pragma unroll
    for (int k = 0; k < 8; ++k) s += modp[(size_t)(k * 4 + b) * 6144 + j];
    return s;
}

__device__ __forceinline__ void p0_transpose_item(const float* W, int K, int N, int src_col0, bf16* WT, int dst_row0, int kb, int ncols, LAS float* scr, int lane) {
    const int k0 = 64 * kb;
#pragma unroll 8
    for (int i = 0; i < 32; ++i) { const int kk = 2 * i + (lane >> 5); const int n = lane & 31;
        scr[kk * 33 + n] = (n < ncols) ? W[(size_t)(k0 + kk) * N + src_col0 + n] : 0.f; }
    asm volatile("s_waitcnt lgkmcnt(0)" ::: "memory");
    const int c = lane & 7;
#pragma unroll
    for (int j = 0; j < 4; ++j) { const int n = (lane >> 3) + 8 * j; const LAS float* s = scr + (8 * c) * 33 + n;
        v4u o; o.x = pk2(s[0 * 33], s[1 * 33]); o.y = pk2(s[2 * 33], s[3 * 33]); o.z = pk2(s[4 * 33], s[5 * 33]); o.w = pk2(s[6 * 33], s[7 * 33]);
        *(v4u*)(WT + (size_t)(dst_row0 + n) * K + k0 + 8 * c) = o; }
    asm volatile("s_waitcnt lgkmcnt(0)" ::: "memory");
}
__device__ __forceinline__ void p0_transpose(const float* W, int K, int N, int src_col0, int nblk, bf16* WT, int dst_row0, LAS float* scr, int gw, int NGW, int lane) {
    const int kbs = K / 64;
    for (int it = gw; it < nblk * kbs; it += NGW) { const int nb = it / kbs, kb = it % kbs;
        p0_transpose_item(W, K, N, src_col0 + 32 * nb, WT, dst_row0 + 32 * nb, kb, 32, scr, lane); }
}
__device__ __forceinline__ void p0_convert(const float* src, bf16* dst, size_t nchunks8, size_t gtid, size_t gthreads) {
    for (size_t i = gtid; i < nchunks8; i += gthreads) { const f32x4 a = *(const f32x4*)(src + i * 8), b = *(const f32x4*)(src + i * 8 + 4);
        v4u o; o.x = pk2(a[0], a[1]); o.y = pk2(a[2], a[3]); o.z = pk2(b[0], b[1]); o.w = pk2(b[2], b[3]); *(v4u*)(dst + i * 8) = o; }
}
__device__ __forceinline__ void p0_table_fp8(const float* T, unsigned char* T8, float* SC, int gw, int NGW, int lane) {
    for (int row = gw; row < 16384; row += NGW) {
        const f32x4* src = (const f32x4*)(T + (size_t)row * 1024) + lane;
        f32x4 v[4]; float am = 0.f;
#pragma unroll
        for (int i = 0; i < 4; ++i) { v[i] = src[64 * i]; am = fmaxf(am, fmaxf(fmaxf(fabsf(v[i][0]), fabsf(v[i][1])), fmaxf(fabsf(v[i][2]), fabsf(v[i][3])))); }
#pragma unroll
        for (int o = 1; o < 64; o <<= 1) am = fmaxf(am, __shfl_xor(am, o));
        const unsigned rb = __float_as_uint(240.0f / fmaxf(am, 1e-30f)) & 0x7f800000u;
        const float sp = __uint_as_float(rb), inv = __uint_as_float((254u << 23) - rb);
        unsigned* dst = (unsigned*)(T8 + (size_t)row * 1024) + lane;
#pragma unroll
        for (int i = 0; i < 4; ++i) { unsigned p = 0u; p = __builtin_amdgcn_cvt_pk_fp8_f32(v[i][0] * sp, v[i][1] * sp, p, false); p = __builtin_amdgcn_cvt_pk_fp8_f32(v[i][2] * sp, v[i][3] * sp, p, true); dst[64 * i] = p; }
        if (lane == 0) SC[row] = inv;
    }
}
__device__ __forceinline__ void phase_prologue(Frame& F) {
    LAS float* scr = (LAS float*)(F.lds + F.wave * 8704);
    const int gw = blockIdx.x * NWAVES + F.wave, NGW = F.G * NWAVES;
    unsigned char* ws = WSP();
    { const float* w_ada = IN(I_WADA); const float* cc = IN(I_C); float* modp = (float*)(ws + WS_MODP);
    for (int it = gw; it < 768; it += NGW) { const int cgi = it % 96, ks = it / 96, n = cgi * 64 + F.lane, k0 = ks * 128;
        float a0 = 0.f, a1 = 0.f, a2 = 0.f, a3 = 0.f;
#pragma unroll 16
        for (int kk = 0; kk < 128; ++kk) { const int k = k0 + kk; const float w = w_ada[(size_t)k * 6144 + n];
            const float c0 = cc[k], c1 = cc[1024 + k], c2 = cc[2048 + k], c3 = cc[3072 + k];
            a0 += c0 * sigmoidf_(c0) * w; a1 += c1 * sigmoidf_(c1) * w; a2 += c2 * sigmoidf_(c2) * w; a3 += c3 * sigmoidf_(c3) * w; }
        modp[(size_t)(ks * 4 + 0) * 6144 + n] = a0; modp[(size_t)(ks * 4 + 1) * 6144 + n] = a1;
        modp[(size_t)(ks * 4 + 2) * 6144 + n] = a2; modp[(size_t)(ks * 4 + 3) * 6144 + n] = a3; } }
    { const float* w_in = IN(I_WIN); bf16* win_t = (bf16*)(ws + WS_WIN);
    p0_transpose(w_in, 1024, 5648, 0, 112, win_t, 0, scr, gw, NGW, F.lane);
    p0_transpose(w_in, 1024, 5648, 3600, 64, win_t, 3584, scr, gw, NGW, F.lane);
    for (int it = gw; it < 16; it += NGW) p0_transpose_item(w_in, 1024, 5648, 3584, win_t, 5632, it, 16, scr, F.lane);
    { const size_t gtid = (size_t)blockIdx.x * NTHR + F.tid, gth = (size_t)F.G * NTHR;
      for (size_t i = gtid; i < (size_t)224 * 128; i += gth) *(v4u*)(win_t + (size_t)5664 * 1024 + i * 8) = (v4u){0u, 0u, 0u, 0u}; } }
    p0_transpose(IN(I_WQ), 1024, 2048, 0, 64, (bf16*)(ws + WS_WQ), 0, scr, gw, NGW, F.lane);
    p0_transpose(IN(I_WSC), 512, 1024, 0, 32, (bf16*)(ws + WS_WSC), 0, scr, gw, NGW, F.lane);
    p0_transpose(IN(I_WDN), 512, 1024, 0, 32, (bf16*)(ws + WS_WDN), 0, scr, gw, NGW, F.lane);
    p0_transpose(IN(I_WMIX), 1024, 1024, 0, 32, (bf16*)(ws + WS_WMIX), 0, scr, gw, NGW, F.lane);
    { const size_t gtid = (size_t)blockIdx.x * NTHR + F.tid, gth = (size_t)F.G * NTHR;
      p0_convert(IN(I_SUBK), (bf16*)(ws + WS_SK), (size_t)16 * 128 * 128 / 8, gtid, gth);
    }
    p0_table_fp8(IN(I_PU), ws + WS_TU, (float*)(ws + WS_SU), gw, NGW, F.lane);
    p0_table_fp8(IN(I_PV), ws + WS_TV, (float*)(ws + WS_SV), gw, NGW, F.lane);
}

__device__ __forceinline__ void phase_h1(Frame& F, bf16* H1) {
    LAS float* gv = (LAS float*)F.lds; LAS float* sv = gv + 1024;
    const float* xin = IN(I_X); const float* npm = IN(I_NPREMIX); const float* b_ada = IN(I_BADA); const float* modp = (const float*)(WSP() + WS_MODP);
    for (int rb = blockIdx.x; rb < M / 128; rb += F.G) {
        const int row0 = rb * 128, b = row0 / SEQ;
        __syncthreads();
        for (int k = F.tid; k < 1024; k += NTHR) { gv[k] = npm[k] * (1.f + modv(b_ada, modp, b, 1024 + k)); sv[k] = modv(b_ada, modp, b, k); }
        __syncthreads();
        for (int r = 0; r < 16; ++r) { const int row = row0 + F.wave * 16 + r;
            const f32x4* xr = (const f32x4*)(xin + (size_t)row * D) + F.lane;
            f32x4 v[4]; float ss = 0.f;
#pragma unroll
            for (int j = 0; j < 4; ++j) { v[j] = xr[64 * j]; ss += (v[j][0] * v[j][0] + v[j][1] * v[j][1]) + (v[j][2] * v[j][2] + v[j][3] * v[j][3]); }
            const float rstd = rsqrtf(wave_sum(ss) * (1.f / D) + EPS);
            v2u* o8 = (v2u*)(H1 + (size_t)row * D) + F.lane;
#pragma unroll
            for (int j = 0; j < 4; ++j) { const int k = 4 * F.lane + 256 * j; const f32x4 g = *(const LAS f32x4*)(gv + k), s = *(const LAS f32x4*)(sv + k);
                v2u o; o.x = pk2(v[j][0] * rstd * g[0] + s[0], v[j][1] * rstd * g[1] + s[1]); o.y = pk2(v[j][2] * rstd * g[2] + s[2], v[j][3] * rstd * g[3] + s[3]); o8[64 * j] = o; }
        }
    }
}

__device__ __forceinline__ void phase_scprep(Frame& F) {
    unsigned char* ws = WSP(); bf16* sb = segp(ws, 0); const bf16* scc = segp(ws, 1); const bf16* scx = segp(ws, 2); const float* scw = IN(I_SCCONV);
    const int gtid = blockIdx.x * NTHR + F.tid, gth = F.G * NTHR;
    for (int it = gtid; it < (M / 16) * 64; it += gth) {
        const int cgp = it & 63, tb = it >> 6, m0 = tb * 16, c0 = cgp * 8;
        float w0[8], w1[8], w2[8], p2[8], p1[8];
#pragma unroll
        for (int e = 0; e < 8; ++e) { w0[e] = scw[c0 + e]; w1[e] = scw[512 + c0 + e]; w2[e] = scw[1024 + c0 + e]; p2[e] = 0.f; p1[e] = 0.f; }
        if ((m0 % SEQ) != 0) {
#pragma unroll
            for (int q = 0; q < 2; ++q) { const size_t off = (size_t)(m0 - 2 + q) * 512 + c0; const v4u cv = *(const v4u*)(scc + off), xv = *(const v4u*)(scx + off);
                float t[8] = {bflo(cv.x) * bflo(xv.x), bfhi(cv.x) * bfhi(xv.x), bflo(cv.y) * bflo(xv.y), bfhi(cv.y) * bfhi(xv.y), bflo(cv.z) * bflo(xv.z), bfhi(cv.z) * bfhi(xv.z), bflo(cv.w) * bflo(xv.w), bfhi(cv.w) * bfhi(xv.w)};
#pragma unroll
                for (int e = 0; e < 8; ++e) { if (q == 0) p2[e] = t[e]; else p1[e] = t[e]; } }
        }
        for (int t = 0; t < 16; ++t) { const size_t off = (size_t)(m0 + t) * 512 + c0;
            const v4u cv = *(const v4u*)(scc + off), xv = *(const v4u*)(scx + off), bv = *(const v4u*)(sb + off);
            float cur[8] = {bflo(cv.x) * bflo(xv.x), bfhi(cv.x) * bfhi(xv.x), bflo(cv.y) * bflo(xv.y), bfhi(cv.y) * bfhi(xv.y), bflo(cv.z) * bflo(xv.z), bfhi(cv.z) * bfhi(xv.z), bflo(cv.w) * bflo(xv.w), bfhi(cv.w) * bfhi(xv.w)};
            float bb[8] = {bflo(bv.x), bfhi(bv.x), bflo(bv.y), bfhi(bv.y), bflo(bv.z), bfhi(bv.z), bflo(bv.w), bfhi(bv.w)};
            float o[8];
#pragma unroll
            for (int e = 0; e < 8; ++e) { o[e] = bb[e] * (w0[e] * p2[e] + w1[e] * p1[e] + w2[e] * cur[e]); p2[e] = p1[e]; p1[e] = cur[e]; }
            v4u ov; ov.x = pk2(o[0], o[1]); ov.y = pk2(o[2], o[3]); ov.z = pk2(o[4], o[5]); ov.w = pk2(o[6], o[7]);
            *(v4u*)(sb + off) = ov; }
    }
}

__device__ __forceinline__ void phase_dnprep(Frame& F, bf16* Wn, bf16* U, bf16* QG, bf16* A, bf16* KD) {
    LAS unsigned char* L = F.lds;
    LAS bf16* raw = (LAS bf16*)L;
    LAS float* R = (LAS float*)L;
    LAS float* qc = (LAS float*)(L + 32768);
    LAS float* kc = (LAS float*)(L + 32768 + 16640);
    LAS float* vc = (LAS float*)(L + 32768 + 2 * 16640);
    LAS bf16* kh = (LAS bf16*)(L + 82688);
    LAS bf16* qh = (LAS bf16*)(L + 82688 + 9216);
    LAS float* Lm = (LAS float*)(L + 101120);
    LAS float* sG = (LAS float*)(L + 117504);
    LAS float* sBeta = sG + 64; LAS float* sEG = sG + 128; LAS float* sRq = sG + 192; LAS float* sRk = sG + 256; LAS float* sEd = sG + 320;
    LAS bf16* stg = (LAS bf16*)(L + 119040);
    LAS bf16* stg2 = (LAS bf16*)(L + 127232);
    const int tid = F.tid, lane = F.lane, wave = F.wave;
    unsigned char* ws = WSP(); const bf16* segq = segp(ws, 3); const bf16* segab = segp(ws, 11); float* glp = (float*)(ws + WS_GL);
    const float* cw = IN(I_DNCONV); const float* alog = IN(I_ALOG); const float* dtb = IN(I_DTBIAS);
    for (int it = blockIdx.x; it < NITEM; it += F.G) {
        const int bh = it >> 7, n = it & 127, b = bh >> 3, h = bh & 7, m0 = b * SEQ + n * 64;
        __syncthreads();
        for (int ci = tid; ci < 1608; ci += NTHR) { const int s = ci / 536, rem = ci % 536, r = rem >> 3, c8 = rem & 7;
            v4u v = (v4u){0u, 0u, 0u, 0u};
            if (n * 64 - 3 + r >= 0) v = *(const v4u*)(segq + (size_t)s * SEG_ELEMS + (size_t)(m0 - 3 + r) * 512 + h * 64 + c8 * 8);
            *(LAS v4u*)(raw + (s * 67 + r) * 64 + c8 * 8) = v; }
        __syncthreads();
        for (int oi = tid; oi < 12288; oi += NTHR) { const int s = oi >> 12, t = (oi >> 6) & 63, c = oi & 63; const int ch = s * 512 + h * 64 + c;
            float acc = 0.f;
#pragma unroll
            for (int k = 0; k < 4; ++k) acc += cw[k * 1536 + ch] * bf2f(raw[(s * 67 + t + k) * 64 + c]);
            const float val = acc * sigmoidf_(acc);
            (s == 0 ? qc : (s == 1 ? kc : vc))[t * 65 + c] = val; }
        __syncthreads();
        if (wave == 0) { float ss = 0.f; for (int c = 0; c < 64; ++c) { const float q = qc[lane * 65 + c]; ss += q * q; } sRq[lane] = rsqrtf(ss + EPS) * 0.125f; }
        else if (wave == 1) { float ss = 0.f; for (int c = 0; c < 64; ++c) { const float q = kc[lane * 65 + c]; ss += q * q; } sRk[lane] = rsqrtf(ss + EPS); }
        else if (wave == 2) {
            const float av = bf2f(segab[(size_t)(m0 + lane) * 512 + h]) + dtb[h], bv = bf2f(segab[(size_t)(m0 + lane) * 512 + 8 + h]);
            const float sp = (av > 20.f) ? av : log1pf(__expf(av));
            float g = -__expf(alog[h]) * sp;
#pragma unroll
            for (int o = 1; o < 64; o <<= 1) { const float t = __shfl_up(g, o); if (lane >= o) g += t; }
            const float g63 = __shfl(g, 63);
            sG[lane] = g; sBeta[lane] = sigmoidf_(bv); sEG[lane] = __expf(g); sEd[lane] = __expf(g63 - g);
            if (lane == 63) glp[it] = __expf(g);
        }
        __syncthreads();
        for (int oi = tid; oi < 4096; oi += NTHR) { const int t = oi >> 6, c = oi & 63;
            const float q = qc[t * 65 + c] * sRq[t], k = kc[t * 65 + c] * sRk[t];
            qc[t * 65 + c] = q; kc[t * 65 + c] = k; qh[t * 72 + c] = (bf16)f2bf(q); kh[t * 72 + c] = (bf16)f2bf(k); }
        __syncthreads();
        {
            const int fr = lane & 15, g4 = lane >> 4;
#pragma unroll
            for (int x = 0; x < 2; ++x) { const int tile = 2 * wave + x, ti = tile >> 2, tj = tile & 3;
                f32x4 ckk = (f32x4){0.f, 0.f, 0.f, 0.f}, cqk = (f32x4){0.f, 0.f, 0.f, 0.f};
#pragma unroll
                for (int ks = 0; ks < 2; ++ks) {
                    const bf16x8 ak = *(const LAS bf16x8*)(kh + (16 * ti + fr) * 72 + 32 * ks + 8 * g4);
                    const bf16x8 aq = *(const LAS bf16x8*)(qh + (16 * ti + fr) * 72 + 32 * ks + 8 * g4);
                    const bf16x8 bk = *(const LAS bf16x8*)(kh + (16 * tj + fr) * 72 + 32 * ks + 8 * g4);
                    ckk = __builtin_amdgcn_mfma_f32_16x16x32_bf16(ak, bk, ckk, 0, 0, 0);
                    cqk = __builtin_amdgcn_mfma_f32_16x16x32_bf16(aq, bk, cqk, 0, 0, 0); }
                const int j = 16 * tj + fr; const float gj = sG[j];
#pragma unroll
                for (int r = 0; r < 4; ++r) { const int i = 16 * ti + 4 * g4 + r;
                    const float dec = __expf(fminf(sG[i] - gj, 0.f));
                    Lm[i * 64 + j] = (j < i) ? sBeta[i] * ckk[r] * dec : 0.f;
                    stg[i * 64 + j] = (bf16)f2bf((j <= i) ? cqk[r] * dec : 0.f); }
            }
        }
        for (int oi = tid; oi < 8192; oi += NTHR) { const int i = oi >> 7, c = oi & 127;
            R[i * 128 + c] = (c < 64) ? vc[i * 65 + c] * sBeta[i] : kc[i * 65 + (c - 64)] * sBeta[i] * sEG[i]; }
        __syncthreads();
        { const size_t ob = (size_t)it * 4096 + (size_t)tid * 8;
          *(v4u*)(A + ob) = *(const LAS v4u*)(stg + tid * 8);
          const int i = tid >> 3, k0 = (tid & 7) * 8; const float e = sEG[i];
          v4u o; o.x = pk2(qc[i * 65 + k0] * e, qc[i * 65 + k0 + 1] * e); o.y = pk2(qc[i * 65 + k0 + 2] * e, qc[i * 65 + k0 + 3] * e);
          o.z = pk2(qc[i * 65 + k0 + 4] * e, qc[i * 65 + k0 + 5] * e); o.w = pk2(qc[i * 65 + k0 + 6] * e, qc[i * 65 + k0 + 7] * e);
          *(v4u*)(QG + ob) = o;
          const int kk = tid >> 3, c0 = (tid & 7) * 8;
          v4u p; p.x = pk2(kc[(c0 + 0) * 65 + kk] * sEd[c0 + 0], kc[(c0 + 1) * 65 + kk] * sEd[c0 + 1]); p.y = pk2(kc[(c0 + 2) * 65 + kk] * sEd[c0 + 2], kc[(c0 + 3) * 65 + kk] * sEd[c0 + 3]);
          p.z = pk2(kc[(c0 + 4) * 65 + kk] * sEd[c0 + 4], kc[(c0 + 5) * 65 + kk] * sEd[c0 + 5]); p.w = pk2(kc[(c0 + 6) * 65 + kk] * sEd[c0 + 6], kc[(c0 + 7) * 65 + kk] * sEd[c0 + 7]);
          *(v4u*)(KD + ob) = p; }
        if (tid < 128) {
            float xs[64];
#pragma unroll
            for (int i = 0; i < 64; ++i) { float acc = R[i * 128 + tid];
#pragma unroll
                for (int j = 0; j < i; ++j) acc -= Lm[i * 64 + j] * xs[j];
                xs[i] = acc; stg2[i * 128 + tid] = (bf16)f2bf(tid < 64 ? acc : -acc); }
        }
        __syncthreads();
        for (int ci = tid; ci < 1024; ci += NTHR) { const int i = ci >> 4, c8 = ci & 15; const v4u v = *(const LAS v4u*)(stg2 + i * 128 + c8 * 8);
            if (c8 < 8) *(v4u*)(U + (size_t)it * 4096 + i * 64 + c8 * 8) = v; else *(v4u*)(Wn + (size_t)it * 4096 + i * 64 + (c8 - 8) * 8) = v; }
    }
}

__device__ __forceinline__ void phase_scan(Frame& F, const bf16* Wn, const bf16* U, const bf16* QG, const bf16* A, const bf16* KD, bf16* O) {
    if (blockIdx.x >= 32) return;
    LAS unsigned char* L = F.lds; const float* glp = (const float*)(WSP() + WS_GL);
    const int bh = blockIdx.x, b = bh >> 3, h = bh & 7, tid = F.tid, lane = F.lane, wave = F.wave;
    const int fr = lane & 15, g4 = lane >> 4, ct = wave >> 1, vt0 = 2 * (wave & 1);
    LAS bf16* St = (LAS bf16*)(L + 92160); LAS bf16* Vt = (LAS bf16*)(L + 101376);
#define OPB(buf, mat) ((LAS bf16*)(L + (buf) * 46080 + (mat) * 9216))
    for (int i = tid; i < 64 * 72; i += NTHR) St[i] = 0;
    const int lrow = tid >> 3, lc8 = tid & 7, loff = lrow * 72 + lc8 * 8;
    const bf16* srcs[5] = {Wn, U, QG, A, KD};
    v4u ld[5];
    { const size_t ob = (size_t)(bh * NCHUNK) * 4096 + (size_t)tid * 8;
#pragma unroll
      for (int mt = 0; mt < 5; ++mt) ld[mt] = *(const v4u*)(srcs[mt] + ob);
#pragma unroll
      for (int mt = 0; mt < 5; ++mt) *(LAS v4u*)(OPB(0, mt) + loff) = ld[mt]; }
    f32x4 S[2] = {(f32x4){0.f, 0.f, 0.f, 0.f}, (f32x4){0.f, 0.f, 0.f, 0.f}};
    __syncthreads();
    for (int n = 0; n < NCHUNK; ++n) {
        const int buf = n & 1; const int item = bh * NCHUNK + n;
        if (n + 1 < NCHUNK) { const size_t ob = (size_t)(item + 1) * 4096 + (size_t)tid * 8;
#pragma unroll
            for (int mt = 0; mt < 5; ++mt) ld[mt] = *(const v4u*)(srcs[mt] + ob); }
        const float glast = glp[item];
        f32x4 acco[2];
#pragma unroll
        for (int x = 0; x < 2; ++x) { const int vt = vt0 + x;
            f32x4 av;
#pragma unroll
            for (int r = 0; r < 4; ++r) av[r] = bf2f(OPB(buf, 1)[(16 * ct + 4 * g4 + r) * 72 + 16 * vt + fr]);
            f32x4 ao = (f32x4){0.f, 0.f, 0.f, 0.f};
#pragma unroll
            for (int ks = 0; ks < 2; ++ks) {
                const bf16x8 aw = *(const LAS bf16x8*)(OPB(buf, 0) + (16 * ct + fr) * 72 + 32 * ks + 8 * g4);
                const bf16x8 aq = *(const LAS bf16x8*)(OPB(buf, 2) + (16 * ct + fr) * 72 + 32 * ks + 8 * g4);
                const bf16x8 bs = *(const LAS bf16x8*)(St + (16 * vt + fr) * 72 + 32 * ks + 8 * g4);
                av = __builtin_amdgcn_mfma_f32_16x16x32_bf16(aw, bs, av, 0, 0, 0);
                ao = __builtin_amdgcn_mfma_f32_16x16x32_bf16(aq, bs, ao, 0, 0, 0); }
            v2u pv; pv.x = pk2(av[0], av[1]); pv.y = pk2(av[2], av[3]);
            *(LAS v2u*)(Vt + (16 * vt + fr) * 72 + 16 * ct + 4 * g4) = pv;
            acco[x] = ao; }
        __syncthreads();
        const int m0 = b * SEQ + n * 64;
#pragma unroll
        for (int x = 0; x < 2; ++x) { const int vt = vt0 + x;
            f32x4 ao = acco[x], as = S[x] * glast;
#pragma unroll
            for (int ks = 0; ks < 2; ++ks) {
                const bf16x8 aa = *(const LAS bf16x8*)(OPB(buf, 3) + (16 * ct + fr) * 72 + 32 * ks + 8 * g4);
                const bf16x8 ak = *(const LAS bf16x8*)(OPB(buf, 4) + (16 * ct + fr) * 72 + 32 * ks + 8 * g4);
                const bf16x8 bv = *(const LAS bf16x8*)(Vt + (16 * vt + fr) * 72 + 32 * ks + 8 * g4);
                ao = __builtin_amdgcn_mfma_f32_16x16x32_bf16(aa, bv, ao, 0, 0, 0);
                as = __builtin_amdgcn_mfma_f32_16x16x32_bf16(ak, bv, as, 0, 0, 0); }
            S[x] = as;
#pragma unroll
            for (int r = 0; r < 4; ++r) O[(size_t)(m0 + 16 * ct + 4 * g4 + r) * 512 + h * 64 + 16 * vt + fr] = (bf16)f2bf(ao[r]);
            v2u ps; ps.x = pk2(as[0], as[1]); ps.y = pk2(as[2], as[3]);
            *(LAS v2u*)(St + (16 * vt + fr) * 72 + 16 * ct + 4 * g4) = ps; }
        if (n + 1 < NCHUNK) {
#pragma unroll
            for (int mt = 0; mt < 5; ++mt) *(LAS v4u*)(OPB(buf ^ 1, mt) + loff) = ld[mt]; }
        __syncthreads();
    }
#undef OPB
}

__device__ __forceinline__ void phase_og(Frame& F, bf16* O, const bf16* Z) {
    const float* onw = IN(I_OUTNORM);
    const int gtid = blockIdx.x * NTHR + F.tid, gth = F.G * NTHR;
    for (int it = gtid; it < M * 64; it += gth) {
        const int cgp = it & 63; const size_t off = (size_t)(it >> 6) * 512 + cgp * 8;
        const v4u ov = *(const v4u*)(O + off), zv = *(const v4u*)(Z + off);
        float o[8] = {bflo(ov.x), bfhi(ov.x), bflo(ov.y), bfhi(ov.y), bflo(ov.z), bfhi(ov.z), bflo(ov.w), bfhi(ov.w)};
        float z[8] = {bflo(zv.x), bfhi(zv.x), bflo(zv.y), bfhi(zv.y), bflo(zv.z), bfhi(zv.z), bflo(zv.w), bfhi(zv.w)};
        float ss = 0.f;
#pragma unroll
        for (int e = 0; e < 8; ++e) ss += o[e] * o[e];
        ss += __shfl_xor(ss, 1); ss += __shfl_xor(ss, 2); ss += __shfl_xor(ss, 4);
        const float rstd = rsqrtf(ss * (1.f / 64.f) + EPS);
        const int c0 = (cgp & 7) * 8; float r[8];
#pragma unroll
        for (int e = 0; e < 8; ++e) r[e] = o[e] * rstd * onw[c0 + e] * (z[e] * sigmoidf_(z[e]));
        v4u w; w.x = pk2(r[0], r[1]); w.y = pk2(r[2], r[3]); w.z = pk2(r[4], r[5]); w.w = pk2(r[6], r[7]);
        *(v4u*)(O + off) = w;
    }
}

__device__ __forceinline__ void phase_x1h2(Frame& F, const bf16* Y, bf16* H2) {
    LAS float* a1 = (LAS float*)F.lds; LAS float* g2 = a1 + 1024; LAS float* s2 = g2 + 1024;
    const float* xin = IN(I_X); const float* npost = IN(I_NPOSTMIX); const float* npre = IN(I_NPREFFN); const float* b_ada = IN(I_BADA); const float* modp = (const float*)(WSP() + WS_MODP); float* outp = OUTP();
    for (int rb = blockIdx.x; rb < M / 128; rb += F.G) {
        const int row0 = rb * 128, b = row0 / SEQ;
        __syncthreads();
        for (int k = F.tid; k < 1024; k += NTHR) { a1[k] = modv(b_ada, modp, b, 2048 + k) * npost[k]; g2[k] = npre[k] * (1.f + modv(b_ada, modp, b, 4096 + k)); s2[k] = modv(b_ada, modp, b, 3072 + k); }
        __syncthreads();
        for (int r = 0; r < 16; ++r) { const int row = row0 + F.wave * 16 + r;
            const v2u* yr = (const v2u*)(Y + (size_t)row * D) + F.lane; const f32x4* xr = (const f32x4*)(xin + (size_t)row * D) + F.lane;
            f32x4 y[4], xv[4]; float ss = 0.f;
#pragma unroll
            for (int j = 0; j < 4; ++j) { const v2u t = yr[64 * j]; y[j] = (f32x4){bflo(t.x), bfhi(t.x), bflo(t.y), bfhi(t.y)}; xv[j] = xr[64 * j];
                ss += (y[j][0] * y[j][0] + y[j][1] * y[j][1]) + (y[j][2] * y[j][2] + y[j][3] * y[j][3]); }
            const float rstd = rsqrtf(wave_sum(ss) * (1.f / D) + EPS); float s1 = 0.f;
            f32x4* orow = (f32x4*)(outp + (size_t)row * D) + F.lane;
#pragma unroll
            for (int j = 0; j < 4; ++j) { const int k = 4 * F.lane + 256 * j; const f32x4 a = *(const LAS f32x4*)(a1 + k);
                xv[j] = xv[j] + a * (y[j] * rstd); orow[64 * j] = xv[j];
                s1 += (xv[j][0] * xv[j][0] + xv[j][1] * xv[j][1]) + (xv[j][2] * xv[j][2] + xv[j][3] * xv[j][3]); }
            const float rstd1 = rsqrtf(wave_sum(s1) * (1.f / D) + EPS);
            v2u* o8 = (v2u*)(H2 + (size_t)row * D) + F.lane;
#pragma unroll
            for (int j = 0; j < 4; ++j) { const int k = 4 * F.lane + 256 * j; const f32x4 g = *(const LAS f32x4*)(g2 + k), s = *(const LAS f32x4*)(s2 + k);
                v2u o; o.x = pk2(xv[j][0] * rstd1 * g[0] + s[0], xv[j][1] * rstd1 * g[1] + s[1]); o.y = pk2(xv[j][2] * rstd1 * g[2] + s[2], xv[j][3] * rstd1 * g[3] + s[3]); o8[64 * j] = o; }
        }
    }
}

__device__ __forceinline__ unsigned mono(float f) { const unsigned u = __float_as_uint(f); return u ^ ((unsigned)((int)u >> 31) | 0x80000000u); }
__device__ __forceinline__ float unmono(unsigned k) { return __uint_as_float((k & 0x80000000u) ? (k ^ 0x80000000u) : ~k); }
#define CE_DESC(a, b) do { const unsigned _mx = max((a), (b)), _mn = min((a), (b)); (a) = _mx; (b) = _mn; } while (0)
__device__ __forceinline__ void top16_of_64(unsigned (&x)[64]) {
#pragma unroll
    for (int g = 0; g < 4; ++g)
#pragma unroll
        for (int k = 2; k <= 16; k <<= 1)
#pragma unroll
            for (int j = k >> 1; j > 0; j >>= 1)
#pragma unroll
                for (int i = 0; i < 16; ++i) { const int l = i ^ j; if (l > i) { if ((i & k) == 0) CE_DESC(x[16 * g + i], x[16 * g + l]); else CE_DESC(x[16 * g + l], x[16 * g + i]); } }
#pragma unroll
    for (int s = 0; s < 3; ++s) { const int a = (s == 1) ? 32 : 0, b2 = (s == 0) ? 16 : (s == 1 ? 48 : 32);
#pragma unroll
        for (int i = 0; i < 16; ++i) x[a + i] = max(x[a + i], x[b2 + 15 - i]);
#pragma unroll
        for (int j = 8; j > 0; j >>= 1)
#pragma unroll
            for (int i = 0; i < 16; ++i) { const int l = i ^ j; if (l > i) CE_DESC(x[a + i], x[a + l]); } }
}
__device__ __forceinline__ void phase_topk(Frame& F, const bf16* Q2, int* EI, float* GA) {
    const int lane = F.lane, wave = F.wave, r = lane & 31, hh = lane >> 5, tsub = wave & 3, hgrp = wave >> 2;
    const bf16* skp = (const bf16*)(WSP() + WS_SK);
    LAS unsigned char* itab = F.lds + wave * 1024;
    for (int tile = blockIdx.x; tile < M / 128; tile += F.G) {
        const int m = tile * 128 + tsub * 32 + r;
#pragma unroll 1
        for (int hd = 0; hd < 4; ++hd) { const int h = hgrp * 4 + hd;
            unsigned k12[2][16];
#pragma unroll
            for (int p = 0; p < 2; ++p) {
                bf16x8 bq[8];
#pragma unroll
                for (int ks = 0; ks < 8; ++ks) bq[ks] = *(const bf16x8*)(Q2 + (size_t)m * 2048 + h * 256 + p * 128 + ks * 16 + hh * 8);
                unsigned keys[64];
#pragma unroll
                for (int kt = 0; kt < 4; ++kt) {
                    f32x16 acc;
#pragma unroll
                    for (int i = 0; i < 16; ++i) acc[i] = 0.f;
                    const bf16* skr = skp + ((size_t)(h * 2 + p) * 128 + kt * 32 + r) * 128 + hh * 8;
#pragma unroll
                    for (int ks = 0; ks < 8; ++ks) { const bf16x8 a = *(const bf16x8*)(skr + ks * 16); acc = __builtin_amdgcn_mfma_f32_32x32x16_bf16(a, bq[ks], acc, 0, 0, 0); }
#pragma unroll
                    for (int i = 0; i < 16; ++i) { const int keyidx = kt * 32 + (i & 3) + 8 * (i >> 2) + 4 * hh; keys[kt * 16 + i] = (mono(acc[i]) & ~127u) | (unsigned)(127 - keyidx); }
                }
                top16_of_64(keys);
                unsigned oth[16];
#pragma unroll
                for (int i = 0; i < 16; ++i) oth[i] = (unsigned)__shfl_xor((int)keys[i], 32);
#pragma unroll
                for (int i = 0; i < 16; ++i) keys[i] = max(keys[i], oth[15 - i]);
#pragma unroll
                for (int j = 8; j > 0; j >>= 1)
#pragma unroll
                    for (int i = 0; i < 16; ++i) { const int l = i ^ j; if (l > i) CE_DESC(keys[i], keys[l]); }
#pragma unroll
                for (int i = 0; i < 16; ++i) k12[p][i] = keys[i];
            }
            float v1[16], v2[16];
#pragma unroll
            for (int i = 0; i < 16; ++i) { v1[i] = unmono(k12[0][i] & ~127u); v2[i] = unmono(k12[1][i] & ~127u); }
            if (hh == 0) {
                v4u w0, w1;
#define PK4(K, b) ((127u - ((K)[b] & 127u)) | ((127u - ((K)[b + 1] & 127u)) << 8) | ((127u - ((K)[b + 2] & 127u)) << 16) | ((127u - ((K)[b + 3] & 127u)) << 24))
                w0.x = PK4(k12[0], 0); w0.y = PK4(k12[0], 4); w0.z = PK4(k12[0], 8); w0.w = PK4(k12[0], 12);
                w1.x = PK4(k12[1], 0); w1.y = PK4(k12[1], 4); w1.z = PK4(k12[1], 8); w1.w = PK4(k12[1], 12);
#undef PK4
                *(LAS v4u*)(itab + r * 32) = w0; *(LAS v4u*)(itab + r * 32 + 16) = w1; }
            unsigned ck[64];
            { int nn = 0;
#pragma unroll
              for (int i = 0; i < 16; ++i)
#pragma unroll
                  for (int j = 0; j < 16; ++j) if ((i + 1) * (j + 1) <= 16) { ck[nn] = (mono(v1[i] + v2[j]) & ~255u) | (unsigned)(255 - (i * 16 + j)); ++nn; }
#pragma unroll
              for (int q = 50; q < 64; ++q) ck[q] = 0u; }
            top16_of_64(ck);
            asm volatile("s_waitcnt lgkmcnt(0)" ::: "memory");
            float ts[16], es[16]; int ei[16]; float sum = 0.f;
#pragma unroll
            for (int q = 0; q < 16; ++q) { ts[q] = unmono(ck[q] & ~255u); const unsigned pos = 255u - (ck[q] & 255u);
                const unsigned e1 = itab[r * 32 + (pos >> 4)], e2 = itab[r * 32 + 16 + (pos & 15u)]; ei[q] = (int)(e1 * 128u + e2); }
#pragma unroll
            for (int q = 0; q < 16; ++q) { es[q] = __expf(ts[q] - ts[0]); sum += es[q]; }
            const float inv = 1.0f / sum;
            int eo[8]; float go[8];
#pragma unroll
            for (int q = 0; q < 8; ++q) { eo[q] = hh ? ei[q + 8] : ei[q]; go[q] = (hh ? es[q + 8] : es[q]) * inv; }
            int* ep = EI + (size_t)m * 128 + h * 16 + hh * 8; float* gp = GA + (size_t)m * 128 + h * 16 + hh * 8;
            *(v4u*)ep = (v4u){(unsigned)eo[0], (unsigned)eo[1], (unsigned)eo[2], (unsigned)eo[3]}; *(v4u*)(ep + 4) = (v4u){(unsigned)eo[4], (unsigned)eo[5], (unsigned)eo[6], (unsigned)eo[7]};
            *(f32x4*)gp = (f32x4){go[0], go[1], go[2], go[3]}; *(f32x4*)(gp + 4) = (f32x4){go[4], go[5], go[6], go[7]};
            asm volatile("s_waitcnt lgkmcnt(0)" ::: "memory");
        }
    }
}

typedef float f32x2 __attribute__((ext_vector_type(2)));
struct RowBuf { v4u u[2], v[2]; float su, svg; };
__device__ __forceinline__ void gather_load(RowBuf& B, int step, int g, int j, int e_lo, int e_hi, float g_lo, float g_hi, const unsigned char* tu, const unsigned char* tv, const float* su, const float* sv) {
    const int src = (step * 2 + g) & 63;
    const int eidx = __shfl(step < 32 ? e_lo : e_hi, src); const float gate = __shfl(step < 32 ? g_lo : g_hi, src);
    const unsigned char* ur = tu + (size_t)eidx * 1024 + 32 * j; const unsigned char* vr = tv + (size_t)eidx * 1024 + 32 * j;
    B.u[0] = *(const v4u*)ur; B.u[1] = *(const v4u*)(ur + 16); B.v[0] = *(const v4u*)vr; B.v[1] = *(const v4u*)(vr + 16);
    B.su = su[eidx]; B.svg = gate * sv[eidx];
}
__device__ __forceinline__ void gather_compute(const RowBuf& B, const unsigned (&hp)[16], float (&y)[32]) {
    float d0 = 0.f, d1 = 0.f;
#pragma unroll
    for (int i = 0; i < 2; ++i)
#pragma unroll
        for (int q = 0; q < 4; ++q) { const f32x2 a = __builtin_amdgcn_cvt_pk_f32_fp8(B.u[i][q], false), b = __builtin_amdgcn_cvt_pk_f32_fp8(B.u[i][q], true);
            const unsigned w0 = hp[i * 8 + 2 * q], w1 = hp[i * 8 + 2 * q + 1];
            d0 += a.x * bflo(w0) + a.y * bfhi(w0); d1 += b.x * bflo(w1) + b.y * bfhi(w1); }
    float d = d0 + d1;
    d += __shfl_xor(d, 1); d += __shfl_xor(d, 2); d += __shfl_xor(d, 4); d += __shfl_xor(d, 8); d += __shfl_xor(d, 16);
    d *= B.su;
    const float wgt = B.svg * 0.5f * d * (1.0f + erff(d * 0.70710678118654752f));
#pragma unroll
    for (int i = 0; i < 2; ++i)
#pragma unroll
        for (int q = 0; q < 4; ++q) { const f32x2 a = __builtin_amdgcn_cvt_pk_f32_fp8(B.v[i][q], false), b = __builtin_amdgcn_cvt_pk_f32_fp8(B.v[i][q], true);
            y[i * 16 + 4 * q] += wgt * a.x; y[i * 16 + 4 * q + 1] += wgt * a.y; y[i * 16 + 4 * q + 2] += wgt * b.x; y[i * 16 + 4 * q + 3] += wgt * b.y; }
}
__device__ __forceinline__ void phase_gather(Frame& F, const bf16* H2, const int* EI, const float* GA) {
    LAS float* a2 = (LAS float*)F.lds;
    unsigned char* ws = WSP(); const unsigned char* tu = ws + WS_TU; const unsigned char* tv = ws + WS_TV; const float* su = (const float*)(ws + WS_SU); const float* sv = (const float*)(ws + WS_SV); float* outp = OUTP();
    const float* npf = IN(I_NPOSTFFN); const float* b_ada = IN(I_BADA); const float* modp = (const float*)(ws + WS_MODP);
    const int lane = F.lane, g = lane >> 5, j = lane & 31;
    for (int rb = blockIdx.x; rb < M / 128; rb += F.G) {
        const int row0 = rb * 128, b = row0 / SEQ;
        __syncthreads();
        for (int k = F.tid; k < 1024; k += NTHR) a2[k] = modv(b_ada, modp, b, 5120 + k) * npf[k];
        __syncthreads();
        for (int ti = 0; ti < 16; ++ti) { const int m = row0 + F.wave * 16 + ti;
            unsigned hp[16];
#pragma unroll
            for (int i = 0; i < 4; ++i) { const v4u h0 = *(const v4u*)(H2 + (size_t)m * D + 32 * j + 8 * i); hp[i * 4 + 0] = h0.x; hp[i * 4 + 1] = h0.y; hp[i * 4 + 2] = h0.z; hp[i * 4 + 3] = h0.w; }
            const int e_lo = EI[(size_t)m * 128 + lane], e_hi = EI[(size_t)m * 128 + 64 + lane];
            const float g_lo = GA[(size_t)m * 128 + lane], g_hi = GA[(size_t)m * 128 + 64 + lane];
            float y[32];
#pragma unroll
            for (int q = 0; q < 32; ++q) y[q] = 0.f;
            RowBuf B0, B1, B2, B3;
#define GLOAD(B, st) gather_load(B, (st), g, j, e_lo, e_hi, g_lo, g_hi, tu, tv, su, sv)
            GLOAD(B0, 0); GLOAD(B1, 1); GLOAD(B2, 2);
#pragma unroll 1
            for (int st = 0; st < 64; st += 4) {
#define SB() __builtin_amdgcn_sched_barrier(0)
                GLOAD(B3, st + 3); SB(); gather_compute(B0, hp, y); SB();
                if (st + 4 < 64) GLOAD(B0, st + 4); SB(); gather_compute(B1, hp, y); SB();
                if (st + 4 < 64) GLOAD(B1, st + 5); SB(); gather_compute(B2, hp, y); SB();
                if (st + 4 < 64) GLOAD(B2, st + 6); SB(); gather_compute(B3, hp, y); SB();
#undef SB
            }
#undef GLOAD
            float ss = 0.f;
#pragma unroll
            for (int q = 0; q < 32; ++q) { y[q] += __shfl_xor(y[q], 32); ss += y[q] * y[q]; }
            ss += __shfl_xor(ss, 1); ss += __shfl_xor(ss, 2); ss += __shfl_xor(ss, 4); ss += __shfl_xor(ss, 8); ss += __shfl_xor(ss, 16);
            const float rstd = rsqrtf(ss * (1.f / D) + EPS);
            const int k = 32 * j + 16 * g;
            f32x4* op = (f32x4*)(outp + (size_t)m * D + k);
#pragma unroll
            for (int q = 0; q < 4; ++q) { f32x4 xv = op[q]; const f32x4 av = *(const LAS f32x4*)(a2 + k + 4 * q);
#pragma unroll
                for (int t = 0; t < 4; ++t) { const int e = 4 * q + t; const float yy = g ? y[16 + e] : y[e]; xv[t] += av[t] * yy * rstd; }
                op[q] = xv; }
        }
    }
}

struct Args { const float* in[21]; float* out; unsigned char* ws; };
__global__ void __launch_bounds__(NTHR, 2) fwd_megakernel(Args args) {
    extern __shared__ __attribute__((aligned(16))) unsigned char lds[];
#define MKFRAME() Frame F; { int t_ = threadIdx.x; asm volatile("" : "+v"(t_)); F.lds = (LAS unsigned char*)lds; F.tid = t_; F.lane = t_ & 63; F.wave = __builtin_amdgcn_readfirstlane(t_ >> 6); F.G = gridDim.x; }
#define GRID_SYNC() cg::this_grid().sync()
#define WSB(off) ((bf16*)(WSP() + (off)))
#define SEGP(s) segp(WSP(), (s))
    { MKFRAME();
    phase_prologue(F);
    }
    GRID_SYNC();
    { MKFRAME();
    phase_h1(F, (bf16*)OUTP());
    }
    GRID_SYNC();
    { MKFRAME();
    {
        pg8::Gemm g{(const bf16*)OUTP(), WSB(WS_WIN), M, NIN, D}; pg8::StaticOrder S; S.init(M, NIN, F.G, (int)blockIdx.x);
        pg8::EpiBf16<0> E{SEGP(0), 512, nullptr, 512, SEG_ELEMS, 1.f};
        pg8::gemm_phase<pg8::EpiBf16<0>, pg8::StaticOrder, true, true>(F.lds, g, S, E);
    }
    }
    GRID_SYNC();
    { MKFRAME();
    phase_scprep(F);
    { bf16* dW = (bf16*)OUTP(); phase_dnprep(F, dW, dW + (size_t)NITEM * 4096, dW + (size_t)2 * NITEM * 4096, dW + (size_t)3 * NITEM * 4096, WSB(WS_KD)); }
    }
    GRID_SYNC();
    { MKFRAME();
    { const bf16* dW = (const bf16*)OUTP(); phase_scan(F, dW, dW + (size_t)NITEM * 4096, dW + (size_t)2 * NITEM * 4096, dW + (size_t)3 * NITEM * 4096, WSB(WS_KD), SEGP(3)); }
    }
    GRID_SYNC();
    { MKFRAME();
    phase_og(F, SEGP(3), SEGP(6));
    }
    GRID_SYNC();
    { MKFRAME();
    {
        pg8::StaticOrder S; S.init(M, D, F.G, (int)blockIdx.x);
        { pg8::Gemm g{SEGP(0), WSB(WS_WSC), M, D, 512}; pg8::EpiGate<false> E{SEGP(4), SEGP(7), SEG_ELEMS};
          pg8::gemm_phase<pg8::EpiGate<false>, pg8::StaticOrder, true, true>(F.lds, g, S, E); }
        { pg8::Gemm g{SEGP(3), WSB(WS_WDN), M, D, 512}; pg8::EpiGate<true> E{SEGP(4), SEGP(9), SEG_ELEMS};
          pg8::gemm_phase<pg8::EpiGate<true>, pg8::StaticOrder, true, true>(F.lds, g, S, E); }
    }
    }
    GRID_SYNC();
    { MKFRAME();
    {
        pg8::Gemm g{SEGP(4), WSB(WS_WMIX), M, D, D}; pg8::StaticOrder S; S.init(M, D, F.G, (int)blockIdx.x);
        pg8::EpiBf16<0> E{SEGP(1), D, nullptr, 0, 0, 1.f};
        pg8::gemm_phase<pg8::EpiBf16<0>, pg8::StaticOrder, true, true>(F.lds, g, S, E);
    }
    }
    GRID_SYNC();
    { MKFRAME();
    phase_x1h2(F, SEGP(1), SEGP(7));
    }
    GRID_SYNC();
    { MKFRAME();
    {
        pg8::Gemm g{SEGP(7), WSB(WS_WQ), M, 2048, D}; pg8::StaticOrder S; S.init(M, 2048, F.G, (int)blockIdx.x);
        pg8::EpiBf16<0> E{SEGP(3), 2048, nullptr, 0, 0, 1.f};
        pg8::gemm_phase<pg8::EpiBf16<0>, pg8::StaticOrder, true, true>(F.lds, g, S, E);
    }
    }
    GRID_SYNC();
    { MKFRAME();
    phase_topk(F, SEGP(3), (int*)SEGP(0), (float*)((unsigned char*)SEGP(0) + 16 * MiB));
    }
    GRID_SYNC();
    { MKFRAME();
    phase_gather(F, SEGP(7), (const int*)SEGP(0), (const float*)((unsigned char*)SEGP(0) + 16 * MiB));
    }
}

extern "C" void kernel_launch(void* const* d_in, const int* in_sizes, int n_in, void* d_out, int out_size, void* d_ws, size_t ws_size, hipStream_t stream) {
    static int grid = 0;
    if (grid == 0) {
        if (n_in != 21 || out_size != M * D || ws_size < WS_END) { fprintf(stderr, "kernel_launch: unexpected problem (n_in %d, out %d, ws %zu)\n", n_in, out_size, ws_size); grid = -1; return; }
        int dev = 0, cus = 0, per_cu = 0;
        hipGetDevice(&dev); hipDeviceGetAttribute(&cus, hipDeviceAttributeMultiprocessorCount, dev);
        hipFuncSetAttribute((const void*)fwd_megakernel, hipFuncAttributeMaxDynamicSharedMemorySize, LDS_BYTES);
        hipOccupancyMaxActiveBlocksPerMultiprocessor(&per_cu, (const void*)fwd_megakernel, NTHR, LDS_BYTES);
        if (per_cu < 1) { fprintf(stderr, "kernel_launch: occupancy query says %d blocks per CU\n", per_cu); per_cu = 1; }
        if (per_cu > 1) per_cu = 1;
        grid = cus * per_cu; if (grid > 256) grid = 256;
        (void)hipGetLastError();
    }
    if (grid < 0) return;
    Args a{};
    for (int i = 0; i < 21; ++i) a.in[i] = (const float*)d_in[i];
    a.out = (float*)d_out; a.ws = (unsigned char*)d_ws;
    void* kargs[] = {&a};
    hipError_t e = hipLaunchCooperativeKernel((const void*)fwd_megakernel, dim3(grid), dim3(NTHR), kargs, LDS_BYTES, stream);
    if (e != hipSuccess) fprintf(stderr, "cooperative launch failed: %s (grid %d)\n", hipGetErrorString(e), grid);
}
```

```cpp
#include <hip/hip_runtime.h>
#include <hip/hip_cooperative_groups.h>
#include <cstdio>
#include <cstdint>
namespace cg = cooperative_groups;
namespace pg8 {
#define PG8_LAS __attribute__((address_space(3)))
typedef unsigned short bf16_t;
typedef short bf16x8 __attribute__((ext_vector_type(8)));
typedef float f32x4 __attribute__((ext_vector_type(4)));
typedef unsigned u32x4 __attribute__((ext_vector_type(4)));
constexpr int BM = 256, BK = 64, HALF = 128, HTB = HALF * BK * 2  , STAGE_BYTES = 8 * HTB, NXCD = 8, WGM = 8;

__host__ __device__ __forceinline__ int lds_byte(int r, int c) { const int st = (r >> 4) * 2 + (c >> 5), rr = r & 15, cc = c & 31, ob = rr * 64 + cc * 2; return st * 1024 + (ob ^ (((ob >> 9) & 1) << 5)); }
__host__ __device__ __forceinline__ void stage_rc(int b, int& R, int& C) { const int st = b / 1024, sb = b % 1024, swz = sb ^ (((sb >> 9) & 1) << 5); R = (st >> 1) * 16 + swz / 64; C = (st & 1) * 32 + (swz % 64) / 2; }
__host__ __device__ __forceinline__ int perm32(int rho) { const int n = rho >> 4, i = rho & 15; return 8 * (i >> 2) + 4 * n + (i & 3); }

struct Unit { int pm, pn; };
struct Gemm { const bf16_t* A; const bf16_t* Bt; int M, N, K; };

struct StaticOrder {
    int nM, nN, nwg, G, c;
    __host__ __device__ void init(int M, int N, int G_, int c_) { nM = M / BM; nN = N / BM; nwg = nM * nN; G = G_; c = c_; }
    __host__ __device__ bool next(int i, Unit& u) const {
        const long L = (long)i * G + c; if (L >= nwg) return false;
        int wgid = (int)L; { const int q = nwg / NXCD, r = nwg % NXCD, xcd = wgid % NXCD, off = wgid / NXCD; wgid = (xcd < r ? xcd * (q + 1) : r * (q + 1) + (xcd - r) * q) + off; }
        const int nig = WGM * nN, gid = wgid / nig, fm = gid * WGM, gsz = (nM - fm) < WGM ? (nM - fm) : WGM;
        u.pm = fm + ((wgid % nig) % gsz); u.pn = (wgid % nig) / gsz; return true;
    }
    __device__ __forceinline__ void a_ready(const Unit&) const {}
    __device__ __forceinline__ void done(const Unit&) const {}
};

__device__ __forceinline__ unsigned cvt_pk_bf16(float lo, float hi) { unsigned r; asm volatile("v_cvt_pk_bf16_f32 %0, %1, %2" : "=v"(r) : "v"(lo), "v"(hi)); return r; }
typedef float f32x2 __attribute__((ext_vector_type(2)));
__device__ __forceinline__ f32x2 gelu_pk(f32x2 v) {
    const f32x2 av = __builtin_elementwise_abs(v), d = av * 0.2316418882f + 1.0f;
    f32x2 t; t.x = __builtin_amdgcn_rcpf(d.x); t.y = __builtin_amdgcn_rcpf(d.y);
    f32x2 q = t * 0.5307027145f + (-0.7265760135f); q = q * t + 0.7107068705f; q = q * t + (-0.142248368f); q = q * t + 0.127414796f; q = q * t;
    const f32x2 s = (v * v) * (-0.72134752044f);
    f32x2 e; e.x = __builtin_amdgcn_exp2f(s.x); e.y = __builtin_amdgcn_exp2f(s.y);
    const f32x2 m = v * (q * e), r = v - m;
    f32x2 o; o.x = v.x < 0.f ? m.x : r.x; o.y = v.y < 0.f ? m.y : r.y; return o;
}

template <int ACT  > struct EpiBf16 {
    static constexpr bool PERM = true, AFTER_DRAIN = false; static_assert(ACT == 0 || ACT == 1, "EpiBf16: ACT is 0 (none) or 1 (gelu_pk)");
    bf16_t* O; int ldc; const float* bias; int split_cols; size_t split_stride; float scale0;
    __device__ __forceinline__ void operator()(const f32x4 (&acc)[2][2][4][2], const Unit& u, int wr, int wc, int fr, int fq) const {
        const int row0 = u.pm * BM + wr * 64 + fr; int colt = u.pn * BM; bf16_t* base = O;
        float sc = 1.f; if (split_cols) { const int t = colt / split_cols; base += (size_t)t * split_stride; colt -= t * split_cols; if (t == 0) sc = scale0; }
        const int col0 = colt + wc * 32 + 8 * fq, bcol0 = u.pn * BM + wc * 32 + 8 * fq;
        f32x4 bv[2][2];
#pragma unroll
        for (int bj = 0; bj < 2; ++bj)
#pragma unroll
            for (int n = 0; n < 2; ++n) bv[bj][n] = bias ? *(const f32x4*)(bias + bcol0 + bj * HALF + 4 * n) : (f32x4){0.f, 0.f, 0.f, 0.f};
#pragma unroll
        for (int ai = 0; ai < 2; ++ai)
#pragma unroll
            for (int m = 0; m < 4; ++m) { bf16_t* rowp = base + (size_t)(row0 + ai * HALF + m * 16) * ldc + col0;
#pragma unroll
                for (int bj = 0; bj < 2; ++bj) { f32x4 v0 = acc[ai][bj][m][0] + bv[bj][0], v1 = acc[ai][bj][m][1] + bv[bj][1];
                    if (ACT == 1) { f32x2 a = gelu_pk((f32x2){v0[0], v0[1]}), b = gelu_pk((f32x2){v0[2], v0[3]}), c = gelu_pk((f32x2){v1[0], v1[1]}), d = gelu_pk((f32x2){v1[2], v1[3]});
                        v0 = (f32x4){a.x, a.y, b.x, b.y}; v1 = (f32x4){c.x, c.y, d.x, d.y}; }
                    v0 = v0 * sc; v1 = v1 * sc; u32x4 w; w.x = cvt_pk_bf16(v0[0], v0[1]); w.y = cvt_pk_bf16(v0[2], v0[3]); w.z = cvt_pk_bf16(v1[0], v1[1]); w.w = cvt_pk_bf16(v1[2], v1[3]);
                    *(u32x4*)(rowp + bj * HALF) = w; } }
    }
};
__device__ __forceinline__ float bf_lo(unsigned u) { return __uint_as_float(u << 16); }
__device__ __forceinline__ float bf_hi(unsigned u) { return __uint_as_float(u & 0xffff0000u); }
__device__ __forceinline__ float sigm(float x) { return __builtin_amdgcn_rcpf(1.0f + __builtin_amdgcn_exp2f(-1.4426950408889634f * x)); }
template <bool ADD> struct EpiGate {
    static constexpr bool PERM = true, AFTER_DRAIN = false;
    bf16_t* O; const bf16_t* gate; size_t seg_elems;
    __device__ __forceinline__ void operator()(const f32x4 (&acc)[2][2][4][2], const Unit& u, int wr, int wc, int fr, int fq) const {
        const int row0 = u.pm * BM + wr * 64 + fr, col0 = u.pn * BM + wc * 32 + 8 * fq;
#pragma unroll
        for (int ai = 0; ai < 2; ++ai)
#pragma unroll
            for (int m = 0; m < 4; ++m) { const int row = row0 + ai * HALF + m * 16;
#pragma unroll
                for (int bj = 0; bj < 2; ++bj) { const int col = col0 + bj * HALF;
                    const u32x4 gv = *(const u32x4*)(gate + (size_t)(col >> 9) * seg_elems + (size_t)row * 512 + (col & 511));
                    bf16_t* op = O + (size_t)row * 1024 + col;
                    f32x4 v0 = acc[ai][bj][m][0], v1 = acc[ai][bj][m][1];
                    v0[0] *= sigm(bf_lo(gv.x)); v0[1] *= sigm(bf_hi(gv.x)); v0[2] *= sigm(bf_lo(gv.y)); v0[3] *= sigm(bf_hi(gv.y));
                    v1[0] *= sigm(bf_lo(gv.z)); v1[1] *= sigm(bf_hi(gv.z)); v1[2] *= sigm(bf_lo(gv.w)); v1[3] *= sigm(bf_hi(gv.w));
                    if (ADD) { const u32x4 ov = *(const u32x4*)op;
                        v0[0] += bf_lo(ov.x); v0[1] += bf_hi(ov.x); v0[2] += bf_lo(ov.y); v0[3] += bf_hi(ov.y);
                        v1[0] += bf_lo(ov.z); v1[1] += bf_hi(ov.z); v1[2] += bf_lo(ov.w); v1[3] += bf_hi(ov.w); }
                    u32x4 w; w.x = cvt_pk_bf16(v0[0], v0[1]); w.y = cvt_pk_bf16(v0[2], v0[3]); w.z = cvt_pk_bf16(v1[0], v1[1]); w.w = cvt_pk_bf16(v1[2], v1[3]);
                    *(u32x4*)op = w; } }
    }
};
template <class Epi, class Sched, bool ALIGN_EPI = false, bool SP2 = false>
__device__ __forceinline__ void gemm_phase(PG8_LAS unsigned char* lds, const Gemm g, const Sched& S, const Epi& E) {
    int tid_ = threadIdx.x; asm volatile("" : "+v"(tid_));
    const int tid = tid_, wid = __builtin_amdgcn_readfirstlane(tid >> 6), lane = tid & 63, wr = wid >> 2, wc = wid & 3, fr = lane & 15, fq = lane >> 4;
    const int K = g.K, nt = K / BK;
    unsigned voffA[2], voffB[2];
#pragma unroll
    for (int i = 0; i < 2; ++i) { int R, C; stage_rc(tid * 16 + i * 8192, R, C); const int Rb = Epi::PERM ? ((R & ~31) + perm32(R & 31)) : R;
        voffA[i] = (unsigned)(R * K + C) * 2u; voffB[i] = (unsigned)(Rb * K + C) * 2u; }
    const size_t kstep = (size_t)(BK * 2);
    const size_t hstep = (size_t)HALF * K * 2;
    const size_t tstep = 2 * hstep;
    const unsigned ldsw = (unsigned)wid * 1024u;
    const int aoff = lds_byte(wr * 64 + fr, fq * 8), boff = lds_byte(wc * 32 + fr, fq * 8);
#define PG8_SA(b, h) (((b) * 2 + (h)) * HTB)
#define PG8_SB(b, h) ((4 + (b) * 2 + (h)) * HTB)
#define PG8_STAGE(bufoff, gbase, voff) do { _Pragma("unroll") for (int _i = 0; _i < 2; ++_i) \
        __builtin_amdgcn_global_load_lds((const unsigned*)((const char*)(gbase) + (voff)[_i]), (PG8_LAS unsigned*)(lds + (bufoff) + ldsw + _i * 8192), 16, 0, 0); } while (0)
#define PG8_LDA(dst, b, h) do { _Pragma("unroll") for (int m = 0; m < 4; ++m) _Pragma("unroll") for (int k = 0; k < 2; ++k) dst[m][k] = *(const PG8_LAS bf16x8*)(lds + PG8_SA(b, h) + aoff + m * 2048 + k * 1024); } while (0)
#define PG8_LDB(dst, b, h) do { _Pragma("unroll") for (int n = 0; n < 2; ++n) _Pragma("unroll") for (int k = 0; k < 2; ++k) dst[n][k] = *(const PG8_LAS bf16x8*)(lds + PG8_SB(b, h) + boff + n * 2048 + k * 1024); } while (0)
#define PG8_MMA(ai, bj, At, Bt) do { __builtin_amdgcn_s_setprio(1); _Pragma("unroll") for (int m = 0; m < 4; ++m) _Pragma("unroll") for (int n = 0; n < 2; ++n) _Pragma("unroll") for (int k = 0; k < 2; ++k) \
        acc[ai][bj][m][n] = __builtin_amdgcn_mfma_f32_16x16x32_bf16(Bt[n][k], At[m][k], acc[ai][bj][m][n], 0, 0, 0); __builtin_amdgcn_s_setprio(0); } while (0)
#define PG8_WAIT_V(n) asm volatile("s_waitcnt vmcnt(" #n ")" ::: "memory")
#define PG8_WAIT_L(n) asm volatile("s_waitcnt lgkmcnt(" #n ")" ::: "memory")
#define PG8_BAR __builtin_amdgcn_s_barrier()
#define PG8_SCHED __builtin_amdgcn_sched_barrier(0)
    Unit cur, nxt; int ui = 0;
    if (!S.next(0, cur)) return;
    f32x4 acc[2][2][4][2];
#pragma unroll
    for (int a = 0; a < 2; ++a)
#pragma unroll
        for (int b = 0; b < 2; ++b)
#pragma unroll
            for (int m = 0; m < 4; ++m)
#pragma unroll
                for (int n = 0; n < 2; ++n) acc[a][b][m][n] = (f32x4){0.f, 0.f, 0.f, 0.f};
    bf16x8 At[4][2], B0[2][2], B1[2][2];
    const char* cA = (const char*)g.A + (size_t)cur.pm * tstep; const char* cB = (const char*)g.Bt + (size_t)cur.pn * tstep;
    S.a_ready(cur);
    if constexpr (SP2) {
        PG8_STAGE(PG8_SB(0, 0), cB, voffB); PG8_STAGE(PG8_SB(0, 1), cB + hstep, voffB); PG8_STAGE(PG8_SA(0, 0), cA, voffA); PG8_STAGE(PG8_SA(0, 1), cA + hstep, voffA);
        if (wr == 1) PG8_BAR;
        PG8_WAIT_V(2); PG8_BAR;
        PG8_STAGE(PG8_SB(1, 0), cB + kstep, voffB); PG8_STAGE(PG8_SA(1, 0), cA + kstep, voffA); PG8_STAGE(PG8_SB(1, 1), cB + hstep + kstep, voffB);
        PG8_WAIT_V(6); PG8_BAR;
    } else {
        PG8_STAGE(PG8_SB(0, 0), cB, voffB); PG8_STAGE(PG8_SA(0, 0), cA, voffA); PG8_STAGE(PG8_SB(0, 1), cB + hstep, voffB); PG8_STAGE(PG8_SA(0, 1), cA + hstep, voffA);
        if (wr == 1) PG8_BAR;
        PG8_WAIT_V(4); PG8_BAR;
        PG8_STAGE(PG8_SB(1, 0), cB + kstep, voffB); PG8_STAGE(PG8_SA(1, 0), cA + kstep, voffA); PG8_STAGE(PG8_SB(1, 1), cB + hstep + kstep, voffB);
        PG8_WAIT_V(6); PG8_BAR;
    }
    for (;;) {
        const bool has_next = S.next(ui + 1, nxt);
        const char* nA = has_next ? (const char*)g.A + (size_t)nxt.pm * tstep : cA; const char* nB = has_next ? (const char*)g.Bt + (size_t)nxt.pn * tstep : cB;
        for (int t = 0; t < nt; t += 2) {
            const bool last = (t == nt - 2);
            const char* a1 = cA + (size_t)(t + 1) * kstep;
            const char* a2 = last ? nA : cA + (size_t)(t + 2) * kstep; const char* b2 = last ? nB : cB + (size_t)(t + 2) * kstep;
            const char* a3 = a2 + kstep; const char* b3 = b2 + kstep;
            if (last && has_next) S.a_ready(nxt);
            if constexpr (SP2) {
            PG8_LDB(B0, 0, 0); PG8_LDB(B1, 0, 1); PG8_SCHED; PG8_LDA(At, 0, 0); PG8_STAGE(PG8_SA(1, 1), a1 + hstep, voffA);
            PG8_WAIT_V(8); PG8_WAIT_L(0); PG8_BAR; PG8_MMA(0, 0, At, B0); PG8_MMA(0, 1, At, B1); PG8_BAR; PG8_SCHED;
            PG8_LDA(At, 0, 1); PG8_STAGE(PG8_SB(0, 0), b2, voffB); PG8_STAGE(PG8_SB(0, 1), b2 + hstep, voffB); PG8_STAGE(PG8_SA(0, 0), a2, voffA);
            PG8_WAIT_V(8); PG8_WAIT_L(0); PG8_BAR; PG8_MMA(1, 0, At, B0); PG8_MMA(1, 1, At, B1); PG8_BAR; PG8_SCHED;
            PG8_LDB(B0, 1, 0); PG8_LDB(B1, 1, 1); PG8_SCHED; PG8_LDA(At, 1, 0); PG8_STAGE(PG8_SA(0, 1), a2 + hstep, voffA);
            PG8_WAIT_V(8); PG8_WAIT_L(0); PG8_BAR; PG8_MMA(0, 0, At, B0); PG8_MMA(0, 1, At, B1); PG8_BAR; PG8_SCHED;
            PG8_LDA(At, 1, 1); PG8_STAGE(PG8_SB(1, 0), b3, voffB); PG8_STAGE(PG8_SB(1, 1), b3 + hstep, voffB); PG8_STAGE(PG8_SA(1, 0), a3, voffA);
            PG8_WAIT_V(8); PG8_WAIT_L(0); PG8_BAR; PG8_MMA(1, 0, At, B0); PG8_MMA(1, 1, At, B1); PG8_BAR; PG8_SCHED;
            } else {
            PG8_LDB(B0, 0, 0); PG8_SCHED; PG8_LDA(At, 0, 0); PG8_STAGE(PG8_SA(1, 1), a1 + hstep, voffA);
            PG8_WAIT_L(8); PG8_BAR; PG8_WAIT_L(0); PG8_MMA(0, 0, At, B0); PG8_BAR; PG8_SCHED;
            PG8_LDB(B1, 0, 1); PG8_STAGE(PG8_SB(0, 0), b2, voffB);
            PG8_BAR; PG8_WAIT_L(0); PG8_MMA(0, 1, At, B1); PG8_BAR;
            PG8_LDA(At, 0, 1); PG8_STAGE(PG8_SA(0, 0), a2, voffA);
            PG8_BAR; PG8_WAIT_L(0); PG8_MMA(1, 0, At, B0); PG8_BAR; PG8_SCHED;
            PG8_STAGE(PG8_SB(0, 1), b2 + hstep, voffB);
            PG8_WAIT_V(6); PG8_BAR; PG8_MMA(1, 1, At, B1); PG8_BAR;
            PG8_LDB(B0, 1, 0); PG8_SCHED; PG8_LDA(At, 1, 0); PG8_STAGE(PG8_SA(0, 1), a2 + hstep, voffA);
            PG8_WAIT_L(8); PG8_BAR; PG8_WAIT_L(0); PG8_MMA(0, 0, At, B0); PG8_BAR; PG8_SCHED;
            PG8_LDB(B1, 1, 1); PG8_STAGE(PG8_SB(1, 0), b3, voffB);
            PG8_BAR; PG8_WAIT_L(0); PG8_MMA(0, 1, At, B1); PG8_BAR;
            PG8_LDA(At, 1, 1); PG8_STAGE(PG8_SA(1, 0), a3, voffA);
            PG8_BAR; PG8_WAIT_L(0); PG8_MMA(1, 0, At, B0); PG8_BAR; PG8_SCHED;
            PG8_STAGE(PG8_SB(1, 1), b3 + hstep, voffB);
            PG8_WAIT_V(6); PG8_BAR; PG8_MMA(1, 1, At, B1); PG8_BAR;
            }
        }
        if constexpr (ALIGN_EPI) { if (wr == 0) PG8_BAR; }
        if constexpr (!Epi::AFTER_DRAIN) { E(acc, cur, wr, wc, fr, fq); S.done(cur); }
        if (!has_next) break;
#pragma unroll
        for (int a = 0; a < 2; ++a)
#pragma unroll
            for (int b = 0; b < 2; ++b)
#pragma unroll
                for (int m = 0; m < 4; ++m)
#pragma unroll
                    for (int n = 0; n < 2; ++n) acc[a][b][m][n] = (f32x4){0.f, 0.f, 0.f, 0.f};
        cur = nxt; cA = nA; cB = nB; ++ui;
        if constexpr (ALIGN_EPI) { if (wr == 1) PG8_BAR; }
    }
    PG8_WAIT_V(0);
    if constexpr (!ALIGN_EPI) { if (wr == 0) PG8_BAR; }
    PG8_BAR;
    if constexpr (Epi::AFTER_DRAIN) { E.fused(acc, cur, wr, wc, fr, fq, lds, wid, lane); S.done(cur); }
#undef PG8_SA
#undef PG8_SB
#undef PG8_STAGE
#undef PG8_LDA
#undef PG8_LDB
#undef PG8_MMA
#undef PG8_WAIT_V
#undef PG8_WAIT_L
#undef PG8_BAR
#undef PG8_SCHED
}
}
constexpr int NWAVES = 8, NTHR = 512;
constexpr int M = 32768, D = 1024, SEQ = 8192, NBATCH = 4;
constexpr int NIN = 5888;
constexpr int NCHUNK = 128, NITEM = 32 * NCHUNK;
constexpr float EPS = 1e-6f;
constexpr size_t MiB = 1u << 20;
constexpr size_t SEG_ELEMS = (size_t)M * 512;
constexpr size_t WS_CTL = 0, WS_MODP = 1 * MiB, WS_WIN = 2 * MiB, WS_WQ = 14 * MiB, WS_WSC = 18 * MiB, WS_WDN = 19 * MiB, WS_WMIX = 20 * MiB,
                 WS_SK = 22 * MiB, WS_GL = 23 * MiB, WS_SU = 23 * MiB + 65536, WS_SV = 23 * MiB + 131072, WS_TU = 24 * MiB, WS_TV = 56 * MiB, WS_P = 88 * MiB, WS_KD = 472 * MiB, WS_END = 504 * MiB;
constexpr int LDS_BYTES = 147456;

#define GAS __attribute__((address_space(1)))
#define LAS __attribute__((address_space(3)))
typedef unsigned short bf16;
typedef unsigned v4u __attribute__((ext_vector_type(4)));
typedef unsigned v2u __attribute__((ext_vector_type(2)));
typedef float f32x4 __attribute__((ext_vector_type(4)));
typedef float f32x16 __attribute__((ext_vector_type(16)));
typedef short bf16x8 __attribute__((ext_vector_type(8)));

__device__ __forceinline__ unsigned f2bf(float f) { unsigned u = __builtin_bit_cast(unsigned, f); return (u + 0x7fffu + ((u >> 16) & 1u)) >> 16; }
__device__ __forceinline__ unsigned pk2(float lo, float hi) { return f2bf(lo) | (f2bf(hi) << 16); }
__device__ __forceinline__ float bflo(unsigned u) { return __uint_as_float(u << 16); }
__device__ __forceinline__ float bfhi(unsigned u) { return __uint_as_float(u & 0xffff0000u); }
__device__ __forceinline__ float bf2f(bf16 h) { return __uint_as_float((unsigned)h << 16); }
__device__ __forceinline__ float sigmoidf_(float x) { return 1.0f / (1.0f + __expf(-x)); }
__device__ __forceinline__ float wave_sum(float v) {
#pragma unroll
    for (int o = 1; o < 64; o <<= 1) v += __shfl_xor(v, o);
    return v;
}

struct Frame { LAS unsigned char* lds; int tid, lane, wave, G; };
__device__ __forceinline__ const void* karg(int i) {
    const char __attribute__((address_space(4)))* kp = (const char __attribute__((address_space(4)))*)__builtin_amdgcn_kernarg_segment_ptr();
    asm volatile("" : "+s"(i));
    return *(const void* const __attribute__((address_space(4)))*)(kp + 8 * i);
}
__device__ __forceinline__ const float* IN(int i) { return (const float*)karg(i); }
__device__ __forceinline__ float* OUTP() { return (float*)karg(21); }
__device__ __forceinline__ unsigned char* WSP() { return (unsigned char*)karg(22); }
enum { I_X = 0, I_C, I_WADA, I_BADA, I_NPREMIX, I_NPOSTMIX, I_WIN, I_SCCONV, I_DNCONV, I_ALOG, I_DTBIAS, I_OUTNORM, I_WSC, I_WDN, I_WMIX, I_NPREFFN, I_NPOSTFFN, I_WQ, I_SUBK, I_PU, I_PV };
__device__ __forceinline__ bf16* segp(unsigned char* ws, int s) { return (bf16*)(ws + WS_P) + (size_t)s * SEG_ELEMS; }
__device__ __forceinline__ float modv(const float* b_ada, const float* modp, int b, int j) {
    float s = b_ada[j];
#pragma unroll
    for (int k = 0; k < 8; ++k) s += modp[(size_t)(k * 4 + b) * 6144 + j];
    return s;
}

__device__ __forceinline__ void p0_transpose_item(const float* W, int K, int N, int src_col0, bf16* WT, int dst_row0, int kb, int ncols, LAS float* scr, int lane) {
    const int k0 = 64 * kb;
#pragma unroll 8
    for (int i = 0; i < 32; ++i) { const int kk = 2 * i + (lane >> 5); const int n = lane & 31;
        scr[kk * 33 + n] = (n < ncols) ? W[(size_t)(k0 + kk) * N + src_col0 + n] : 0.f; }
    asm volatile("s_waitcnt lgkmcnt(0)" ::: "memory");
    const int c = lane & 7;
#pragma unroll
    for (int j = 0; j < 4; ++j) { const int n = (lane >> 3) + 8 * j; const LAS float* s = scr + (8 * c) * 33 + n;
        v4u o; o.x = pk2(s[0 * 33], s[1 * 33]); o.y = pk2(s[2 * 33], s[3 * 33]); o.z = pk2(s[4 * 33], s[5 * 33]); o.w = pk2(s[6 * 33], s[7 * 33]);
        *(v4u*)(WT + (size_t)(dst_row0 + n) * K + k0 + 8 * c) = o; }
    asm volatile("s_waitcnt lgkmcnt(0)" ::: "memory");
}
__device__ __forceinline__ void p0_transpose(const float* W, int K, int N, int src_col0, int nblk, bf16* WT, int dst_row0, LAS float* scr, int gw, int NGW, int lane) {
    const int kbs = K / 64;
    for (int it = gw; it < nblk * kbs; it += NGW) { const int nb = it / kbs, kb = it % kbs;
        p0_transpose_item(W, K, N, src_col0 + 32 * nb, WT, dst_row0 + 32 * nb, kb, 32, scr, lane); }
}
__device__ __forceinline__ void p0_convert(const float* src, bf16* dst, size_t nchunks8, size_t gtid, size_t gthreads) {
    for (size_t i = gtid; i < nchunks8; i += gthreads) { const f32x4 a = *(const f32x4*)(src + i * 8), b = *(const f32x4*)(src + i * 8 + 4);
        v4u o; o.x = pk2(a[0], a[1]); o.y = pk2(a[2], a[3]); o.z = pk2(b[0], b[1]); o.w = pk2(b[2], b[3]); *(v4u*)(dst + i * 8) = o; }
}
__device__ __forceinline__ void p0_table_fp8(const float* T, unsigned char* T8, float* SC, int gw, int NGW, int lane) {
    for (int row = gw; row < 16384; row += NGW) {
        const f32x4* src = (const f32x4*)(T + (size_t)row * 1024) + lane;
        f32x4 v[4]; float am = 0.f;
#pragma unroll
        for (int i = 0; i < 4; ++i) { v[i] = src[64 * i]; am = fmaxf(am, fmaxf(fmaxf(fabsf(v[i][0]), fabsf(v[i][1])), fmaxf(fabsf(v[i][2]), fabsf(v[i][3])))); }
#pragma unroll
        for (int o = 1; o < 64; o <<= 1) am = fmaxf(am, __shfl_xor(am, o));
        const unsigned rb = __float_as_uint(240.0f / fmaxf(am, 1e-30f)) & 0x7f800000u;
        const float sp = __uint_as_float(rb), inv = __uint_as_float((254u << 23) - rb);
        unsigned* dst = (unsigned*)(T8 + (size_t)row * 1024) + lane;
#pragma unroll
        for (int i = 0; i < 4; ++i) { unsigned p = 0u; p = __builtin_amdgcn_cvt_pk_fp8_f32(v[i][0] * sp, v[i][1] * sp, p, false); p = __builtin_amdgcn_cvt_pk_fp8_f32(v[i][2] * sp, v[i][3] * sp, p, true); dst[64 * i] = p; }
        if (lane == 0) SC[row] = inv;
    }
}
__device__ __forceinline__ void phase_prologue(Frame& F) {
    LAS float* scr = (LAS float*)(F.lds + F.wave * 8704);
    const int gw = blockIdx.x * NWAVES + F.wave, NGW = F.G * NWAVES;
    unsigned char* ws = WSP();
    { const float* w_ada = IN(I_WADA); const float* cc = IN(I_C); float* modp = (float*)(ws + WS_MODP);
    for (int it = gw; it < 768; it += NGW) { const int cgi = it % 96, ks = it / 96, n = cgi * 64 + F.lane, k0 = ks * 128;
        float a0 = 0.f, a1 = 0.f, a2 = 0.f, a3 = 0.f;
#pragma unroll 16
        for (int kk = 0; kk < 128; ++kk) { const int k = k0 + kk; const float w = w_ada[(size_t)k * 6144 + n];
            const float c0 = cc[k], c1 = cc[1024 + k], c2 = cc[2048 + k], c3 = cc[3072 + k];
            a0 += c0 * sigmoidf_(c0) * w; a1 += c1 * sigmoidf_(c1) * w; a2 += c2 * sigmoidf_(c2) * w; a3 += c3 * sigmoidf_(c3) * w; }
        modp[(size_t)(ks * 4 + 0) * 6144 + n] = a0; modp[(size_t)(ks * 4 + 1) * 6144 + n] = a1;
        modp[(size_t)(ks * 4 + 2) * 6144 + n] = a2; modp[(size_t)(ks * 4 + 3) * 6144 + n] = a3; } }
    { const float* w_in = IN(I_WIN); bf16* win_t = (bf16*)(ws + WS_WIN);
    p0_transpose(w_in, 1024, 5648, 0, 112, win_t, 0, scr, gw, NGW, F.lane);
    p0_transpose(w_in, 1024, 5648, 3600, 64, win_t, 3584, scr, gw, NGW, F.lane);
    for (int it = gw; it < 16; it += NGW) p0_transpose_item(w_in, 1024, 5648, 3584, win_t, 5632, it, 16, scr, F.lane);
    { const size_t gtid = (size_t)blockIdx.x * NTHR + F.tid, gth = (size_t)F.G * NTHR;
      for (size_t i = gtid; i < (size_t)224 * 128; i += gth) *(v4u*)(win_t + (size_t)5664 * 1024 + i * 8) = (v4u){0u, 0u, 0u, 0u}; } }
    p0_transpose(IN(I_WQ), 1024, 2048, 0, 64, (bf16*)(ws + WS_WQ), 0, scr, gw, NGW, F.lane);
    p0_transpose(IN(I_WSC), 512, 1024, 0, 32, (bf16*)(ws + WS_WSC), 0, scr, gw, NGW, F.lane);
    p0_transpose(IN(I_WDN), 512, 1024, 0, 32, (bf16*)(ws + WS_WDN), 0, scr, gw, NGW, F.lane);
    p0_transpose(IN(I_WMIX), 1024, 1024, 0, 32, (bf16*)(ws + WS_WMIX), 0, scr, gw, NGW, F.lane);
    { const size_t gtid = (size_t)blockIdx.x * NTHR + F.tid, gth = (size_t)F.G * NTHR;
      p0_convert(IN(I_SUBK), (bf16*)(ws + WS_SK), (size_t)16 * 128 * 128 / 8, gtid, gth);
    }
    p0_table_fp8(IN(I_PU), ws + WS_TU, (float*)(ws + WS_SU), gw, NGW, F.lane);
    p0_table_fp8(IN(I_PV), ws + WS_TV, (float*)(ws + WS_SV), gw, NGW, F.lane);
}

__device__ __forceinline__ void phase_h1(Frame& F, bf16* H1) {
    LAS float* gv = (LAS float*)F.lds; LAS float* sv = gv + 1024;
    const float* xin = IN(I_X); const float* npm = IN(I_NPREMIX); const float* b_ada = IN(I_BADA); const float* modp = (const float*)(WSP() + WS_MODP);
    for (int rb = blockIdx.x; rb < M / 128; rb += F.G) {
        const int row0 = rb * 128, b = row0 / SEQ;
        __syncthreads();
        for (int k = F.tid; k < 1024; k += NTHR) { gv[k] = npm[k] * (1.f + modv(b_ada, modp, b, 1024 + k)); sv[k] = modv(b_ada, modp, b, k); }
        __syncthreads();
        for (int r = 0; r < 16; ++r) { const int row = row0 + F.wave * 16 + r;
            const f32x4* xr = (const f32x4*)(xin + (size_t)row * D) + F.lane;
            f32x4 v[4]; float ss = 0.f;
#pragma unroll
            for (int j = 0; j < 4; ++j) { v[j] = xr[64 * j]; ss += (v[j][0] * v[j][0] + v[j][1] * v[j][1]) + (v[j][2] * v[j][2] + v[j][3] * v[j][3]); }
            const float rstd = rsqrtf(wave_sum(ss) * (1.f / D) + EPS);
            v2u* o8 = (v2u*)(H1 + (size_t)row * D) + F.lane;
#pragma unroll
            for (int j = 0; j < 4; ++j) { const int k = 4 * F.lane + 256 * j; const f32x4 g = *(const LAS f32x4*)(gv + k), s = *(const LAS f32x4*)(sv + k);
                v2u o; o.x = pk2(v[j][0] * rstd * g[0] + s[0], v[j][1] * rstd * g[1] + s[1]); o.y = pk2(v[j][2] * rstd * g[2] + s[2], v[j][3] * rstd * g[3] + s[3]); o8[64 * j] = o; }
        }
    }
}

__device__ __forceinline__ void phase_scprep(Frame& F) {
    unsigned char* ws = WSP(); bf16* sb = segp(ws, 0); const bf16* scc = segp(ws, 1); const bf16* scx = segp(ws, 2); const float* scw = IN(I_SCCONV);
    const int gtid = blockIdx.x * NTHR + F.tid, gth = F.G * NTHR;
    for (int it = gtid; it < (M / 16) * 64; it += gth) {
        const int cgp = it & 63, tb = it >> 6, m0 = tb * 16, c0 = cgp * 8;
        float w0[8], w1[8], w2[8], p2[8], p1[8];
#pragma unroll
        for (int e = 0; e < 8; ++e) { w0[e] = scw[c0 + e]; w1[e] = scw[512 + c0 + e]; w2[e] = scw[1024 + c0 + e]; p2[e] = 0.f; p1[e] = 0.f; }
        if ((m0 % SEQ) != 0) {
#pragma unroll
            for (int q = 0; q < 2; ++q) { const size_t off = (size_t)(m0 - 2 + q) * 512 + c0; const v4u cv = *(const v4u*)(scc + off), xv = *(const v4u*)(scx + off);
                float t[8] = {bflo(cv.x) * bflo(xv.x), bfhi(cv.x) * bfhi(xv.x), bflo(cv.y) * bflo(xv.y), bfhi(cv.y) * bfhi(xv.y), bflo(cv.z) * bflo(xv.z), bfhi(cv.z) * bfhi(xv.z), bflo(cv.w) * bflo(xv.w), bfhi(cv.w) * bfhi(xv.w)};
#pragma unroll
                for (int e = 0; e < 8; ++e) { if (q == 0) p2[e] = t[e]; else p1[e] = t[e]; } }
        }
        for (int t = 0; t < 16; ++t) { const size_t off = (size_t)(m0 + t) * 512 + c0;
            const v4u cv = *(const v4u*)(scc + off), xv = *(const v4u*)(scx + off), bv = *(const v4u*)(sb + off);
            float cur[8] = {bflo(cv.x) * bflo(xv.x), bfhi(cv.x) * bfhi(xv.x), bflo(cv.y) * bflo(xv.y), bfhi(cv.y) * bfhi(xv.y), bflo(cv.z) * bflo(xv.z), bfhi(cv.z) * bfhi(xv.z), bflo(cv.w) * bflo(xv.w), bfhi(cv.w) * bfhi(xv.w)};
            float bb[8] = {bflo(bv.x), bfhi(bv.x), bflo(bv.y), bfhi(bv.y), bflo(bv.z), bfhi(bv.z), bflo(bv.w), bfhi(bv.w)};
            float o[8];
#pragma unroll
            for (int e = 0; e < 8; ++e) { o[e] = bb[e] * (w0[e] * p2[e] + w1[e] * p1[e] + w2[e] * cur[e]); p2[e] = p1[e]; p1[e] = cur[e]; }
            v4u ov; ov.x = pk2(o[0], o[1]); ov.y = pk2(o[2], o[3]); ov.z = pk2(o[4], o[5]); ov.w = pk2(o[6], o[7]);
            *(v4u*)(sb + off) = ov; }
    }
}

__device__ __forceinline__ void phase_dnprep(Frame& F, bf16* Wn, bf16* U, bf16* QG, bf16* A, bf16* KD) {
    LAS unsigned char* L = F.lds;
    LAS bf16* raw = (LAS bf16*)L;
    LAS float* R = (LAS float*)L;
    LAS float* qc = (LAS float*)(L + 32768);
    LAS float* kc = (LAS float*)(L + 32768 + 16640);
    LAS float* vc = (LAS float*)(L + 32768 + 2 * 16640);
    LAS bf16* kh = (LAS bf16*)(L + 82688);
    LAS bf16* qh = (LAS bf16*)(L + 82688 + 9216);
    LAS float* Lm = (LAS float*)(L + 101120);
    LAS float* sG = (LAS float*)(L + 117504);
    LAS float* sBeta = sG + 64; LAS float* sEG = sG + 128; LAS float* sRq = sG + 192; LAS float* sRk = sG + 256; LAS float* sEd = sG + 320;
    LAS bf16* stg = (LAS bf16*)(L + 119040);
    LAS bf16* stg2 = (LAS bf16*)(L + 127232);
    const int tid = F.tid, lane = F.lane, wave = F.wave;
    unsigned char* ws = WSP(); const bf16* segq = segp(ws, 3); const bf16* segab = segp(ws, 11); float* glp = (float*)(ws + WS_GL);
    const float* cw = IN(I_DNCONV); const float* alog = IN(I_ALOG); const float* dtb = IN(I_DTBIAS);
    for (int it = blockIdx.x; it < NITEM; it += F.G) {
        const int bh = it >> 7, n = it & 127, b = bh >> 3, h = bh & 7, m0 = b * SEQ + n * 64;
        __syncthreads();
        for (int ci = tid; ci < 1608; ci += NTHR) { const int s = ci / 536, rem = ci % 536, r = rem >> 3, c8 = rem & 7;
            v4u v = (v4u){0u, 0u, 0u, 0u};
            if (n * 64 - 3 + r >= 0) v = *(const v4u*)(segq + (size_t)s * SEG_ELEMS + (size_t)(m0 - 3 + r) * 512 + h * 64 + c8 * 8);
            *(LAS v4u*)(raw + (s * 67 + r) * 64 + c8 * 8) = v; }
        __syncthreads();
        for (int oi = tid; oi < 12288; oi += NTHR) { const int s = oi >> 12, t = (oi >> 6) & 63, c = oi & 63; const int ch = s * 512 + h * 64 + c;
            float acc = 0.f;
#pragma unroll
            for (int k = 0; k < 4; ++k) acc += cw[k * 1536 + ch] * bf2f(raw[(s * 67 + t + k) * 64 + c]);
            const float val = acc * sigmoidf_(acc);
            (s == 0 ? qc : (s == 1 ? kc : vc))[t * 65 + c] = val; }
        __syncthreads();
        if (wave == 0) { float ss = 0.f; for (int c = 0; c < 64; ++c) { const float q = qc[lane * 65 + c]; ss += q * q; } sRq[lane] = rsqrtf(ss + EPS) * 0.125f; }
        else if (wave == 1) { float ss = 0.f; for (int c = 0; c < 64; ++c) { const float q = kc[lane * 65 + c]; ss += q * q; } sRk[lane] = rsqrtf(ss + EPS); }
        else if (wave == 2) {
            const float av = bf2f(segab[(size_t)(m0 + lane) * 512 + h]) + dtb[h], bv = bf2f(segab[(size_t)(m0 + lane) * 512 + 8 + h]);
            const float sp = (av > 20.f) ? av : log1pf(__expf(av));
            float g = -__expf(alog[h]) * sp;
#pragma unroll
            for (int o = 1; o < 64; o <<= 1) { const float t = __shfl_up(g, o); if (lane >= o) g += t; }
            const float g63 = __shfl(g, 63);
            sG[lane] = g; sBeta[lane] = sigmoidf_(bv); sEG[lane] = __expf(g); sEd[lane] = __expf(g63 - g);
            if (lane == 63) glp[it] = __expf(g);
        }
        __syncthreads();
        for (int oi = tid; oi < 4096; oi += NTHR) { const int t = oi >> 6, c = oi & 63;
            const float q = qc[t * 65 + c] * sRq[t], k = kc[t * 65 + c] * sRk[t];
            qc[t * 65 + c] = q; kc[t * 65 + c] = k; qh[t * 72 + c] = (bf16)f2bf(q); kh[t * 72 + c] = (bf16)f2bf(k); }
        __syncthreads();
        {
            const int fr = lane & 15, g4 = lane >> 4;
#pragma unroll
            for (int x = 0; x < 2; ++x) { const int tile = 2 * wave + x, ti = tile >> 2, tj = tile & 3;
                f32x4 ckk = (f32x4){0.f, 0.f, 0.f, 0.f}, cqk = (f32x4){0.f, 0.f, 0.f, 0.f};
#pragma unroll
                for (int ks = 0; ks < 2; ++ks) {
                    const bf16x8 ak = *(const LAS bf16x8*)(kh + (16 * ti + fr) * 72 + 32 * ks + 8 * g4);
                    const bf16x8 aq = *(const LAS bf16x8*)(qh + (16 * ti + fr) * 72 + 32 * ks + 8 * g4);
                    const bf16x8 bk = *(const LAS bf16x8*)(kh + (16 * tj + fr) * 72 + 32 * ks + 8 * g4);
                    ckk = __builtin_amdgcn_mfma_f32_16x16x32_bf16(ak, bk, ckk, 0, 0, 0);
                    cqk = __builtin_amdgcn_mfma_f32_16x16x32_bf16(aq, bk, cqk, 0, 0, 0); }
                const int j = 16 * tj + fr; const float gj = sG[j];
#pragma unroll
                for (int r = 0; r < 4; ++r) { const int i = 16 * ti + 4 * g4 + r;
                    const float dec = __expf(fminf(sG[i] - gj, 0.f));
                    Lm[i * 64 + j] = (j < i) ? sBeta[i] * ckk[r] * dec : 0.f;
                    stg[i * 64 + j] = (bf16)f2bf((j <= i) ? cqk[r] * dec : 0.f); }
            }
        }
        for (int oi = tid; oi < 8192; oi += NTHR) { const int i = oi >> 7, c = oi & 127;
            R[i * 128 + c] = (c < 64) ? vc[i * 65 + c] * sBeta[i] : kc[i * 65 + (c - 64)] * sBeta[i] * sEG[i]; }
        __syncthreads();
        { const size_t ob = (size_t)it * 4096 + (size_t)tid * 8;
          *(v4u*)(A + ob) = *(const LAS v4u*)(stg + tid * 8);
          const int i = tid >> 3, k0 = (tid & 7) * 8; const float e = sEG[i];
          v4u o; o.x = pk2(qc[i * 65 + k0] * e, qc[i * 65 + k0 + 1] * e); o.y = pk2(qc[i * 65 + k0 + 2] * e, qc[i * 65 + k0 + 3] * e);
          o.z = pk2(qc[i * 65 + k0 + 4] * e, qc[i * 65 + k0 + 5] * e); o.w = pk2(qc[i * 65 + k0 + 6] * e, qc[i * 65 + k0 + 7] * e);
          *(v4u*)(QG + ob) = o;
          const int kk = tid >> 3, c0 = (tid & 7) * 8;
          v4u p; p.x = pk2(kc[(c0 + 0) * 65 + kk] * sEd[c0 + 0], kc[(c0 + 1) * 65 + kk] * sEd[c0 + 1]); p.y = pk2(kc[(c0 + 2) * 65 + kk] * sEd[c0 + 2], kc[(c0 + 3) * 65 + kk] * sEd[c0 + 3]);
          p.z = pk2(kc[(c0 + 4) * 65 + kk] * sEd[c0 + 4], kc[(c0 + 5) * 65 + kk] * sEd[c0 + 5]); p.w = pk2(kc[(c0 + 6) * 65 + kk] * sEd[c0 + 6], kc[(c0 + 7) * 65 + kk] * sEd[c0 + 7]);
          *(v4u*)(KD + ob) = p; }
        if (tid < 128) {
            float xs[64];
#pragma unroll
            for (int i = 0; i < 64; ++i) { float acc = R[i * 128 + tid];
#pragma unroll
                for (int j = 0; j < i; ++j) acc -= Lm[i * 64 + j] * xs[j];
                xs[i] = acc; stg2[i * 128 + tid] = (bf16)f2bf(tid < 64 ? acc : -acc); }
        }
        __syncthreads();
        for (int ci = tid; ci < 1024; ci += NTHR) { const int i = ci >> 4, c8 = ci & 15; const v4u v = *(const LAS v4u*)(stg2 + i * 128 + c8 * 8);
            if (c8 < 8) *(v4u*)(U + (size_t)it * 4096 + i * 64 + c8 * 8) = v; else *(v4u*)(Wn + (size_t)it * 4096 + i * 64 + (c8 - 8) * 8) = v; }
    }
}

__device__ __forceinline__ void phase_scan(Frame& F, const bf16* Wn, const bf16* U, const bf16* QG, const bf16* A, const bf16* KD, bf16* O) {
    if (blockIdx.x >= 32) return;
    LAS unsigned char* L = F.lds; const float* glp = (const float*)(WSP() + WS_GL);
    const int bh = blockIdx.x, b = bh >> 3, h = bh & 7, tid = F.tid, lane = F.lane, wave = F.wave;
    const int fr = lane & 15, g4 = lane >> 4, ct = wave >> 1, vt0 = 2 * (wave & 1);
    LAS bf16* St = (LAS bf16*)(L + 92160); LAS bf16* Vt = (LAS bf16*)(L + 101376);
#define OPB(buf, mat) ((LAS bf16*)(L + (buf) * 46080 + (mat) * 9216))
    for (int i = tid; i < 64 * 72; i += NTHR) St[i] = 0;
    const int lrow = tid >> 3, lc8 = tid & 7, loff = lrow * 72 + lc8 * 8;
    const bf16* srcs[5] = {Wn, U, QG, A, KD};
    v4u ld[5];
    { const size_t ob = (size_t)(bh * NCHUNK) * 4096 + (size_t)tid * 8;
#pragma unroll
      for (int mt = 0; mt < 5; ++mt) ld[mt] = *(const v4u*)(srcs[mt] + ob);
#pragma unroll
      for (int mt = 0; mt < 5; ++mt) *(LAS v4u*)(OPB(0, mt) + loff) = ld[mt]; }
    f32x4 S[2] = {(f32x4){0.f, 0.f, 0.f, 0.f}, (f32x4){0.f, 0.f, 0.f, 0.f}};
    __syncthreads();
    for (int n = 0; n < NCHUNK; ++n) {
        const int buf = n & 1; const int item = bh * NCHUNK + n;
        if (n + 1 < NCHUNK) { const size_t ob = (size_t)(item + 1) * 4096 + (size_t)tid * 8;
#pragma unroll
            for (int mt = 0; mt < 5; ++mt) ld[mt] = *(const v4u*)(srcs[mt] + ob); }
        const float glast = glp[item];
        f32x4 acco[2];
#pragma unroll
        for (int x = 0; x < 2; ++x) { const int vt = vt0 + x;
            f32x4 av;
#pragma unroll
            for (int r = 0; r < 4; ++r) av[r] = bf2f(OPB(buf, 1)[(16 * ct + 4 * g4 + r) * 72 + 16 * vt + fr]);
            f32x4 ao = (f32x4){0.f, 0.f, 0.f, 0.f};
#pragma unroll
            for (int ks = 0; ks < 2; ++ks) {
                const bf16x8 aw = *(const LAS bf16x8*)(OPB(buf, 0) + (16 * ct + fr) * 72 + 32 * ks + 8 * g4);
                const bf16x8 aq = *(const LAS bf16x8*)(OPB(buf, 2) + (16 * ct + fr) * 72 + 32 * ks + 8 * g4);
                const bf16x8 bs = *(const LAS bf16x8*)(St + (16 * vt + fr) * 72 + 32 * ks + 8 * g4);
                av = __builtin_amdgcn_mfma_f32_16x16x32_bf16(aw, bs, av, 0, 0, 0);
                ao = __builtin_amdgcn_mfma_f32_16x16x32_bf16(aq, bs, ao, 0, 0, 0); }
            v2u pv; pv.x = pk2(av[0], av[1]); pv.y = pk2(av[2], av[3]);
            *(LAS v2u*)(Vt + (16 * vt + fr) * 72 + 16 * ct + 4 * g4) = pv;
            acco[x] = ao; }
        __syncthreads();
        const int m0 = b * SEQ + n * 64;
#pragma unroll
        for (int x = 0; x < 2; ++x) { const int vt = vt0 + x;
            f32x4 ao = acco[x], as = S[x] * glast;
#pragma unroll
            for (int ks = 0; ks < 2; ++ks) {
                const bf16x8 aa = *(const LAS bf16x8*)(OPB(buf, 3) + (16 * ct + fr) * 72 + 32 * ks + 8 * g4);
                const bf16x8 ak = *(const LAS bf16x8*)(OPB(buf, 4) + (16 * ct + fr) * 72 + 32 * ks + 8 * g4);
                const bf16x8 bv = *(const LAS bf16x8*)(Vt + (16 * vt + fr) * 72 + 32 * ks + 8 * g4);
                ao = __builtin_amdgcn_mfma_f32_16x16x32_bf16(aa, bv, ao, 0, 0, 0);
                as = __builtin_amdgcn_mfma_f32_16x16x32_bf16(ak, bv, as, 0, 0, 0); }
            S[x] = as;
#pragma unroll
            for (int r = 0; r < 4; ++r) O[(size_t)(m0 + 16 * ct + 4 * g4 + r) * 512 + h * 64 + 16 * vt + fr] = (bf16)f2bf(ao[r]);
            v2u ps; ps.x = pk2(as[0], as[1]); ps.y = pk2(as[2], as[3]);
            *(LAS v2u*)(St + (16 * vt + fr) * 72 + 16 * ct + 4 * g4) = ps; }
        if (n + 1 < NCHUNK) {
#pragma unroll
            for (int mt = 0; mt < 5; ++mt) *(LAS v4u*)(OPB(buf ^ 1, mt) + loff) = ld[mt]; }
        __syncthreads();
    }
#undef OPB
}

__device__ __forceinline__ void phase_og(Frame& F, bf16* O, const bf16* Z) {
    const float* onw = IN(I_OUTNORM);
    const int gtid = blockIdx.x * NTHR + F.tid, gth = F.G * NTHR;
    for (int it = gtid; it < M * 64; it += gth) {
        const int cgp = it & 63; const size_t off = (size_t)(it >> 6) * 512 + cgp * 8;
        const v4u ov = *(const v4u*)(O + off), zv = *(const v4u*)(Z + off);
        float o[8] = {bflo(ov.x), bfhi(ov.x), bflo(ov.y), bfhi(ov.y), bflo(ov.z), bfhi(ov.z), bflo(ov.w), bfhi(ov.w)};
        float z[8] = {bflo(zv.x), bfhi(zv.x), bflo(zv.y), bfhi(zv.y), bflo(zv.z), bfhi(zv.z), bflo(zv.w), bfhi(zv.w)};
        float ss = 0.f;
#pragma unroll
        for (int e = 0; e < 8; ++e) ss += o[e] * o[e];
        ss += __shfl_xor(ss, 1); ss += __shfl_xor(ss, 2); ss += __shfl_xor(ss, 4);
        const float rstd = rsqrtf(ss * (1.f / 64.f) + EPS);
        const int c0 = (cgp & 7) * 8; float r[8];
#pragma unroll
        for (int e = 0; e < 8; ++e) r[e] = o[e] * rstd * onw[c0 + e] * (z[e] * sigmoidf_(z[e]));
        v4u w; w.x = pk2(r[0], r[1]); w.y = pk2(r[2], r[3]); w.z = pk2(r[4], r[5]); w.w = pk2(r[6], r[7]);
        *(v4u*)(O + off) = w;
    }
}

__device__ __forceinline__ void phase_x1h2(Frame& F, const bf16* Y, bf16* H2) {
    LAS float* a1 = (LAS float*)F.lds; LAS float* g2 = a1 + 1024; LAS float* s2 = g2 + 1024;
    const float* xin = IN(I_X); const float* npost = IN(I_NPOSTMIX); const float* npre = IN(I_NPREFFN); const float* b_ada = IN(I_BADA); const float* modp = (const float*)(WSP() + WS_MODP); float* outp = OUTP();
    for (int rb = blockIdx.x; rb < M / 128; rb += F.G) {
        const int row0 = rb * 128, b = row0 / SEQ;
        __syncthreads();
        for (int k = F.tid; k < 1024; k += NTHR) { a1[k] = modv(b_ada, modp, b, 2048 + k) * npost[k]; g2[k] = npre[k] * (1.f + modv(b_ada, modp, b, 4096 + k)); s2[k] = modv(b_ada, modp, b, 3072 + k); }
        __syncthreads();
        for (int r = 0; r < 16; ++r) { const int row = row0 + F.wave * 16 + r;
            const v2u* yr = (const v2u*)(Y + (size_t)row * D) + F.lane; const f32x4* xr = (const f32x4*)(xin + (size_t)row * D) + F.lane;
            f32x4 y[4], xv[4]; float ss = 0.f;
#pragma unroll
            for (int j = 0; j < 4; ++j) { const v2u t = yr[64 * j]; y[j] = (f32x4){bflo(t.x), bfhi(t.x), bflo(t.y), bfhi(t.y)}; xv[j] = xr[64 * j];
                ss += (y[j][0] * y[j][0] + y[j][1] * y[j][1]) + (y[j][2] * y[j][2] + y[j][3] * y[j][3]); }
            const float rstd = rsqrtf(wave_sum(ss) * (1.f / D) + EPS); float s1 = 0.f;
            f32x4* orow = (f32x4*)(outp + (size_t)row * D) + F.lane;
#pragma unroll
            for (int j = 0; j < 4; ++j) { const int k = 4 * F.lane + 256 * j; const f32x4 a = *(const LAS f32x4*)(a1 + k);
                xv[j] = xv[j] + a * (y[j] * rstd); orow[64 * j] = xv[j];
                s1 += (xv[j][0] * xv[j][0] + xv[j][1] * xv[j][1]) + (xv[j][2] * xv[j][2] + xv[j][3] * xv[j][3]); }
            const float rstd1 = rsqrtf(wave_sum(s1) * (1.f / D) + EPS);
            v2u* o8 = (v2u*)(H2 + (size_t)row * D) + F.lane;
#pragma unroll
            for (int j = 0; j < 4; ++j) { const int k = 4 * F.lane + 256 * j; const f32x4 g = *(const LAS f32x4*)(g2 + k), s = *(const LAS f32x4*)(s2 + k);
                v2u o; o.x = pk2(xv[j][0] * rstd1 * g[0] + s[0], xv[j][1] * rstd1 * g[1] + s[1]); o.y = pk2(xv[j][2] * rstd1 * g[2] + s[2], xv[j][3] * rstd1 * g[3] + s[3]); o8[64 * j] = o; }
        }
    }
}

__device__ __forceinline__ unsigned mono(float f) { const unsigned u = __float_as_uint(f); return u ^ ((unsigned)((int)u >> 31) | 0x80000000u); }
__device__ __forceinline__ float unmono(unsigned k) { return __uint_as_float((k & 0x80000000u) ? (k ^ 0x80000000u) : ~k); }
#define CE_DESC(a, b) do { const unsigned _mx = max((a), (b)), _mn = min((a), (b)); (a) = _mx; (b) = _mn; } while (0)
__device__ __forceinline__ void top16_of_64(unsigned (&x)[64]) {
#pragma unroll
    for (int g = 0; g < 4; ++g)
#pragma unroll
        for (int k = 2; k <= 16; k <<= 1)
#pragma unroll
            for (int j = k >> 1; j > 0; j >>= 1)
#pragma unroll
                for (int i = 0; i < 16; ++i) { const int l = i ^ j; if (l > i) { if ((i & k) == 0) CE_DESC(x[16 * g + i], x[16 * g + l]); else CE_DESC(x[16 * g + l], x[16 * g + i]); } }
#pragma unroll
    for (int s = 0; s < 3; ++s) { const int a = (s == 1) ? 32 : 0, b2 = (s == 0) ? 16 : (s == 1 ? 48 : 32);
#pragma unroll
        for (int i = 0; i < 16; ++i) x[a + i] = max(x[a + i], x[b2 + 15 - i]);
#pragma unroll
        for (int j = 8; j > 0; j >>= 1)
#pragma unroll
            for (int i = 0; i < 16; ++i) { const int l = i ^ j; if (l > i) CE_DESC(x[a + i], x[a + l]); } }
}
__device__ __forceinline__ void phase_topk(Frame& F, const bf16* Q2, int* EI, float* GA) {
    const int lane = F.lane, wave = F.wave, r = lane & 31, hh = lane >> 5, tsub = wave & 3, hgrp = wave >> 2;
    const bf16* skp = (const bf16*)(WSP() + WS_SK);
    LAS unsigned char* itab = F.lds + wave * 1024;
    for (int tile = blockIdx.x; tile < M / 128; tile += F.G) {
        const int m = tile * 128 + tsub * 32 + r;
#pragma unroll 1
        for (int hd = 0; hd < 4; ++hd) { const int h = hgrp * 4 + hd;
            unsigned k12[2][16];
#pragma unroll
            for (int p = 0; p < 2; ++p) {
                bf16x8 bq[8];
#pragma unroll
                for (int ks = 0; ks < 8; ++ks) bq[ks] = *(const bf16x8*)(Q2 + (size_t)m * 2048 + h * 256 + p * 128 + ks * 16 + hh * 8);
                unsigned keys[64];
#pragma unroll
                for (int kt = 0; kt < 4; ++kt) {
                    f32x16 acc;
#pragma unroll
                    for (int i = 0; i < 16; ++i) acc[i] = 0.f;
                    const bf16* skr = skp + ((size_t)(h * 2 + p) * 128 + kt * 32 + r) * 128 + hh * 8;
#pragma unroll
                    for (int ks = 0; ks < 8; ++ks) { const bf16x8 a = *(const bf16x8*)(skr + ks * 16); acc = __builtin_amdgcn_mfma_f32_32x32x16_bf16(a, bq[ks], acc, 0, 0, 0); }
#pragma unroll
                    for (int i = 0; i < 16; ++i) { const int keyidx = kt * 32 + (i & 3) + 8 * (i >> 2) + 4 * hh; keys[kt * 16 + i] = (mono(acc[i]) & ~127u) | (unsigned)(127 - keyidx); }
                }
                top16_of_64(keys);
                unsigned oth[16];
#pragma unroll
                for (int i = 0; i < 16; ++i) oth[i] = (unsigned)__shfl_xor((int)keys[i], 32);
#pragma unroll
                for (int i = 0; i < 16; ++i) keys[i] = max(keys[i], oth[15 - i]);
#pragma unroll
                for (int j = 8; j > 0; j >>= 1)
#pragma unroll
                    for (int i = 0; i < 16; ++i) { const int l = i ^ j; if (l > i) CE_DESC(keys[i], keys[l]); }
#pragma unroll
                for (int i = 0; i < 16; ++i) k12[p][i] = keys[i];
            }
            float v1[16], v2[16];
#pragma unroll
            for (int i = 0; i < 16; ++i) { v1[i] = unmono(k12[0][i] & ~127u); v2[i] = unmono(k12[1][i] & ~127u); }
            if (hh == 0) {
                v4u w0, w1;
#define PK4(K, b) ((127u - ((K)[b] & 127u)) | ((127u - ((K)[b + 1] & 127u)) << 8) | ((127u - ((K)[b + 2] & 127u)) << 16) | ((127u - ((K)[b + 3] & 127u)) << 24))
                w0.x = PK4(k12[0], 0); w0.y = PK4(k12[0], 4); w0.z = PK4(k12[0], 8); w0.w = PK4(k12[0], 12);
                w1.x = PK4(k12[1], 0); w1.y = PK4(k12[1], 4); w1.z = PK4(k12[1], 8); w1.w = PK4(k12[1], 12);
#undef PK4
                *(LAS v4u*)(itab + r * 32) = w0; *(LAS v4u*)(itab + r * 32 + 16) = w1; }
            unsigned ck[64];
            { int nn = 0;
#pragma unroll
              for (int i = 0; i < 16; ++i)
#pragma unroll
                  for (int j = 0; j < 16; ++j) if ((i + 1) * (j + 1) <= 16) { ck[nn] = (mono(v1[i] + v2[j]) & ~255u) | (unsigned)(255 - (i * 16 + j)); ++nn; }
#pragma unroll
              for (int q = 50; q < 64; ++q) ck[q] = 0u; }
            top16_of_64(ck);
            asm volatile("s_waitcnt lgkmcnt(0)" ::: "memory");
            float ts[16], es[16]; int ei[16]; float sum = 0.f;
#pragma unroll
            for (int q = 0; q < 16; ++q) { ts[q] = unmono(ck[q] & ~255u); const unsigned pos = 255u - (ck[q] & 255u);
                const unsigned e1 = itab[r * 32 + (pos >> 4)], e2 = itab[r * 32 + 16 + (pos & 15u)]; ei[q] = (int)(e1 * 128u + e2); }
#pragma unroll
            for (int q = 0; q < 16; ++q) { es[q] = __expf(ts[q] - ts[0]); sum += es[q]; }
            const float inv = 1.0f / sum;
            int eo[8]; float go[8];
#pragma unroll
            for (int q = 0; q < 8; ++q) { eo[q] = hh ? ei[q + 8] : ei[q]; go[q] = (hh ? es[q + 8] : es[q]) * inv; }
            int* ep = EI + (size_t)m * 128 + h * 16 + hh * 8; float* gp = GA + (size_t)m * 128 + h * 16 + hh * 8;
            *(v4u*)ep = (v4u){(unsigned)eo[0], (unsigned)eo[1], (unsigned)eo[2], (unsigned)eo[3]}; *(v4u*)(ep + 4) = (v4u){(unsigned)eo[4], (unsigned)eo[5], (unsigned)eo[6], (unsigned)eo[7]};
            *(f32x4*)gp = (f32x4){go[0], go[1], go[2], go[3]}; *(f32x4*)(gp + 4) = (f32x4){go[4], go[5], go[6], go[7]};
            asm volatile("s_waitcnt lgkmcnt(0)" ::: "memory");
        }
    }
}

typedef float f32x2 __attribute__((ext_vector_type(2)));
struct RowBuf { v4u u[2], v[2]; float su, svg; };
__device__ __forceinline__ void gather_load(RowBuf& B, int step, int g, int j, int e_lo, int e_hi, float g_lo, float g_hi, const unsigned char* tu, const unsigned char* tv, const float* su, const float* sv) {
    const int src = (step * 2 + g) & 63;
    const int eidx = __shfl(step < 32 ? e_lo : e_hi, src); const float gate = __shfl(step < 32 ? g_lo : g_hi, src);
    const unsigned char* ur = tu + (size_t)eidx * 1024 + 32 * j; const unsigned char* vr = tv + (size_t)eidx * 1024 + 32 * j;
    B.u[0] = *(const v4u*)ur; B.u[1] = *(const v4u*)(ur + 16); B.v[0] = *(const v4u*)vr; B.v[1] = *(const v4u*)(vr + 16);
    B.su = su[eidx]; B.svg = gate * sv[eidx];
}
__device__ __forceinline__ void gather_compute(const RowBuf& B, const unsigned (&hp)[16], float (&y)[32]) {
    float d0 = 0.f, d1 = 0.f;
#pragma unroll
    for (int i = 0; i < 2; ++i)
#pragma unroll
        for (int q = 0; q < 4; ++q) { const f32x2 a = __builtin_amdgcn_cvt_pk_f32_fp8(B.u[i][q], false), b = __builtin_amdgcn_cvt_pk_f32_fp8(B.u[i][q], true);
            const unsigned w0 = hp[i * 8 + 2 * q], w1 = hp[i * 8 + 2 * q + 1];
            d0 += a.x * bflo(w0) + a.y * bfhi(w0); d1 += b.x * bflo(w1) + b.y * bfhi(w1); }
    float d = d0 + d1;
    d += __shfl_xor(d, 1); d += __shfl_xor(d, 2); d += __shfl_xor(d, 4); d += __shfl_xor(d, 8); d += __shfl_xor(d, 16);
    d *= B.su;
    const float wgt = B.svg * 0.5f * d * (1.0f + erff(d * 0.70710678118654752f));
#pragma unroll
    for (int i = 0; i < 2; ++i)
#pragma unroll
        for (int q = 0; q < 4; ++q) { const f32x2 a = __builtin_amdgcn_cvt_pk_f32_fp8(B.v[i][q], false), b = __builtin_amdgcn_cvt_pk_f32_fp8(B.v[i][q], true);
            y[i * 16 + 4 * q] += wgt * a.x; y[i * 16 + 4 * q + 1] += wgt * a.y; y[i * 16 + 4 * q + 2] += wgt * b.x; y[i * 16 + 4 * q + 3] += wgt * b.y; }
}
__device__ __forceinline__ void phase_gather(Frame& F, const bf16* H2, const int* EI, const float* GA) {
    LAS float* a2 = (LAS float*)F.lds;
    unsigned char* ws = WSP(); const unsigned char* tu = ws + WS_TU; const unsigned char* tv = ws + WS_TV; const float* su = (const float*)(ws + WS_SU); const float* sv = (const float*)(ws + WS_SV); float* outp = OUTP();
    const float* npf = IN(I_NPOSTFFN); const float* b_ada = IN(I_BADA); const float* modp = (const float*)(ws + WS_MODP);
    const int lane = F.lane, g = lane >> 5, j = lane & 31;
    for (int rb = blockIdx.x; rb < M / 128; rb += F.G) {
        const int row0 = rb * 128, b = row0 / SEQ;
        __syncthreads();
        for (int k = F.tid; k < 1024; k += NTHR) a2[k] = modv(b_ada, modp, b, 5120 + k) * npf[k];
        __syncthreads();
        for (int ti = 0; ti < 16; ++ti) { const int m = row0 + F.wave * 16 + ti;
            unsigned hp[16];
#pragma unroll
            for (int i = 0; i < 4; ++i) { const v4u h0 = *(const v4u*)(H2 + (size_t)m * D + 32 * j + 8 * i); hp[i * 4 + 0] = h0.x; hp[i * 4 + 1] = h0.y; hp[i * 4 + 2] = h0.z; hp[i * 4 + 3] = h0.w; }
            const int e_lo = EI[(size_t)m * 128 + lane], e_hi = EI[(size_t)m * 128 + 64 + lane];
            const float g_lo = GA[(size_t)m * 128 + lane], g_hi = GA[(size_t)m * 128 + 64 + lane];
            float y[32];
#pragma unroll
            for (int q = 0; q < 32; ++q) y[q] = 0.f;
            RowBuf B0, B1, B2, B3;
#define GLOAD(B, st) gather_load(B, (st), g, j, e_lo, e_hi, g_lo, g_hi, tu, tv, su, sv)
            GLOAD(B0, 0); GLOAD(B1, 1); GLOAD(B2, 2);
#pragma unroll 1
            for (int st = 0; st < 64; st += 4) {
#define SB() __builtin_amdgcn_sched_barrier(0)
                GLOAD(B3, st + 3); SB(); gather_compute(B0, hp, y); SB();
                if (st + 4 < 64) GLOAD(B0, st + 4); SB(); gather_compute(B1, hp, y); SB();
                if (st + 4 < 64) GLOAD(B1, st + 5); SB(); gather_compute(B2, hp, y); SB();
                if (st + 4 < 64) GLOAD(B2, st + 6); SB(); gather_compute(B3, hp, y); SB();
#undef SB
            }
#undef GLOAD
            float ss = 0.f;
#pragma unroll
            for (int q = 0; q < 32; ++q) { y[q] += __shfl_xor(y[q], 32); ss += y[q] * y[q]; }
            ss += __shfl_xor(ss, 1); ss += __shfl_xor(ss, 2); ss += __shfl_xor(ss, 4); ss += __shfl_xor(ss, 8); ss += __shfl_xor(ss, 16);
            const float rstd = rsqrtf(ss * (1.f / D) + EPS);
            const int k = 32 * j + 16 * g;
            f32x4* op = (f32x4*)(outp + (size_t)m * D + k);
#pragma unroll
            for (int q = 0; q < 4; ++q) { f32x4 xv = op[q]; const f32x4 av = *(const LAS f32x4*)(a2 + k + 4 * q);
#pragma unroll
                for (int t = 0; t < 4; ++t) { const int e = 4 * q + t; const float yy = g ? y[16 + e] : y[e]; xv[t] += av[t] * yy * rstd; }
                op[q] = xv; }
        }
    }
}

typedef GAS unsigned gu32;
#define XB_TMO      128
#define XB_XCNT(j)  (256  + 64 * (j))
#define XB_XSUB(j)  (1280 + 64 * (j))
#define XB_XGEN(j)  (2304 + 64 * (j))
#define XB_TOP      3328
#define XB_TOPGEN   3392
#define XCD_BAR_WORDS 3456
#define XB_SPIN_CAP (1u << 18)

__device__ __forceinline__ unsigned xb_ld(unsigned* p)              { return __hip_atomic_load(p, __ATOMIC_RELAXED, __HIP_MEMORY_SCOPE_AGENT); }
__device__ __forceinline__ unsigned xb_add(unsigned* p, unsigned v) { return __hip_atomic_fetch_add(p, v, __ATOMIC_RELAXED, __HIP_MEMORY_SCOPE_AGENT); }
__device__ __forceinline__ unsigned xb_xcc_id() { return (unsigned)__builtin_amdgcn_s_getreg((3 << 11) | 20) & 0xFu; }
#define XB_SPIN(cond, bar) do { unsigned _sp = 0; while (cond) { __builtin_amdgcn_s_sleep(1); \
    if ((++_sp & 255u) == 0u) { if (xb_ld(&(bar)[XB_TMO])) break; if (_sp > XB_SPIN_CAP) { atomicAdd(&(bar)[XB_TMO], 1u); break; } } } } while (0)

struct XcdBarrier {
    unsigned* bar; unsigned x;
    volatile LAS unsigned* st;
};

__device__ __forceinline__ XcdBarrier xcd_barrier_post(unsigned* bar, volatile LAS unsigned* st) {
    XcdBarrier b; b.bar = bar; b.x = xb_xcc_id(); b.st = st;
    if (threadIdx.x == 0) (void)xb_add(&bar[XB_XCNT(b.x)], 1u);
    return b;
}
__device__ __forceinline__ void xcd_barrier_complete(unsigned* bar, unsigned x, unsigned& nloc, unsigned& nx) {
    const unsigned G = gridDim.x * gridDim.y * gridDim.z;
    unsigned sum, cnt, mine, sp = 0u;
    for (;;) {
        sum = 0u; cnt = 0u; mine = 0u;
#pragma unroll
        for (unsigned j = 0; j < 16; ++j) { const unsigned c = xb_ld(&bar[XB_XCNT(j)]); sum += c; cnt += (c > 0u) ? 1u : 0u; mine = (j == x) ? c : mine; }
        if (sum == G) break;
        __builtin_amdgcn_s_sleep(1);
        if ((++sp & 255u) == 0u) { if (xb_ld(&bar[XB_TMO])) break; if (sp > XB_SPIN_CAP) { atomicAdd(&bar[XB_TMO], 1u); break; } }
    }
    nloc = mine > 0u ? mine : 1u; nx = cnt > 0u ? cnt : 1u;
}

__device__ __forceinline__ void xcd_barrier(const XcdBarrier& b) {
    asm volatile("s_waitcnt vmcnt(0)" ::: "memory");
    __syncthreads();
    if (threadIdx.x == 0) {
        unsigned* bar = b.bar;
        __builtin_amdgcn_s_waitcnt(0);
        unsigned nloc = b.st[0], nx = b.st[1];
        if (nloc == 0u) { xcd_barrier_complete(bar, b.x, nloc, nx); b.st[0] = nloc; b.st[1] = nx; }
        const unsigned old = xb_add(&bar[XB_XSUB(b.x)], 1u);
        const unsigned gen = old / nloc;
        if (old + 1u == (gen + 1u) * nloc) {
            __builtin_amdgcn_fence(__ATOMIC_RELEASE, "agent");
            asm volatile("s_waitcnt vmcnt(0)" ::: "memory");
            const unsigned og = xb_add(&bar[XB_TOP], 1u);
            const unsigned tg = og / nx;
            if (og + 1u == (tg + 1u) * nx) xb_add(&bar[XB_TOPGEN], 1u);
            else XB_SPIN(xb_ld(&bar[XB_TOPGEN]) == tg, bar);
            __builtin_amdgcn_fence(__ATOMIC_ACQUIRE, "agent");
            xb_add(&bar[XB_XGEN(b.x)], 1u);
            asm volatile("s_waitcnt vmcnt(0)" ::: "memory");
        } else {
            XB_SPIN(xb_ld(&bar[XB_XGEN(b.x)]) == gen, bar);
            __builtin_amdgcn_fence(__ATOMIC_ACQUIRE, "agent");
            asm volatile("s_waitcnt vmcnt(0)" ::: "memory");
        }
    }
    __syncthreads();
}

struct Args { const float* in[21]; float* out; unsigned char* ws; };
__global__ void __launch_bounds__(NTHR, 2) fwd_megakernel(Args args) {
    extern __shared__ __attribute__((aligned(16))) unsigned char lds[];
#define MKFRAME() Frame F; { int t_ = threadIdx.x; asm volatile("" : "+v"(t_)); F.lds = (LAS unsigned char*)lds; F.tid = t_; F.lane = t_ & 63; F.wave = __builtin_amdgcn_readfirstlane(t_ >> 6); F.G = gridDim.x; }
#define GRID_SYNC() cg::this_grid().sync()
    volatile LAS unsigned* bst = (volatile LAS unsigned*)((LAS unsigned char*)lds + LDS_BYTES - 64);
    if (threadIdx.x < 16) bst[threadIdx.x] = 0u;
    __syncthreads();
    const XcdBarrier xbar = xcd_barrier_post((unsigned*)(WSP() + WS_CTL) + 1024, bst);
#define XSYNC() xcd_barrier(xbar)
#define WSB(off) ((bf16*)(WSP() + (off)))
#define SEGP(s) segp(WSP(), (s))
    { MKFRAME();
    phase_prologue(F);
    }
    GRID_SYNC();
    { MKFRAME();
    phase_h1(F, (bf16*)OUTP());
    }
    XSYNC();
    { MKFRAME();
    {
        pg8::Gemm g{(const bf16*)OUTP(), WSB(WS_WIN), M, NIN, D}; pg8::StaticOrder S; S.init(M, NIN, F.G, (int)blockIdx.x);
        pg8::EpiBf16<0> E{SEGP(0), 512, nullptr, 512, SEG_ELEMS, 1.f};
        pg8::gemm_phase<pg8::EpiBf16<0>, pg8::StaticOrder, true, true>(F.lds, g, S, E);
    }
    }
    XSYNC();
    { MKFRAME();
    phase_scprep(F);
    { bf16* dW = (bf16*)OUTP(); phase_dnprep(F, dW, dW + (size_t)NITEM * 4096, dW + (size_t)2 * NITEM * 4096, dW + (size_t)3 * NITEM * 4096, WSB(WS_KD)); }
    }
    XSYNC();
    { MKFRAME();
    { const bf16* dW = (const bf16*)OUTP(); phase_scan(F, dW, dW + (size_t)NITEM * 4096, dW + (size_t)2 * NITEM * 4096, dW + (size_t)3 * NITEM * 4096, WSB(WS_KD), SEGP(3)); }
    }
    XSYNC();
    { MKFRAME();
    phase_og(F, SEGP(3), SEGP(6));
    }
    XSYNC();
    { MKFRAME();
    {
        pg8::StaticOrder S; S.init(M, D, F.G, (int)blockIdx.x);
        { pg8::Gemm g{SEGP(0), WSB(WS_WSC), M, D, 512}; pg8::EpiGate<false> E{SEGP(4), SEGP(7), SEG_ELEMS};
          pg8::gemm_phase<pg8::EpiGate<false>, pg8::StaticOrder, true, true>(F.lds, g, S, E); }
        { pg8::Gemm g{SEGP(3), WSB(WS_WDN), M, D, 512}; pg8::EpiGate<true> E{SEGP(4), SEGP(9), SEG_ELEMS};
          pg8::gemm_phase<pg8::EpiGate<true>, pg8::StaticOrder, true, true>(F.lds, g, S, E); }
    }
    }
    XSYNC();
    { MKFRAME();
    {
        pg8::Gemm g{SEGP(4), WSB(WS_WMIX), M, D, D}; pg8::StaticOrder S; S.init(M, D, F.G, (int)blockIdx.x);
        pg8::EpiBf16<0> E{SEGP(1), D, nullptr, 0, 0, 1.f};
        pg8::gemm_phase<pg8::EpiBf16<0>, pg8::StaticOrder, true, true>(F.lds, g, S, E);
    }
    }
    XSYNC();
    { MKFRAME();
    phase_x1h2(F, SEGP(1), SEGP(7));
    }
    XSYNC();
    { MKFRAME();
    {
        pg8::Gemm g{SEGP(7), WSB(WS_WQ), M, 2048, D}; pg8::StaticOrder S; S.init(M, 2048, F.G, (int)blockIdx.x);
        pg8::EpiBf16<0> E{SEGP(3), 2048, nullptr, 0, 0, 1.f};
        pg8::gemm_phase<pg8::EpiBf16<0>, pg8::StaticOrder, true, true>(F.lds, g, S, E);
    }
    }
    XSYNC();
    { MKFRAME();
    phase_topk(F, SEGP(3), (int*)SEGP(0), (float*)((unsigned char*)SEGP(0) + 16 * MiB));
    }
    XSYNC();
    { MKFRAME();
    phase_gather(F, SEGP(7), (const int*)SEGP(0), (const float*)((unsigned char*)SEGP(0) + 16 * MiB));
    }
}

extern "C" void kernel_launch(void* const* d_in, const int* in_sizes, int n_in, void* d_out, int out_size, void* d_ws, size_t ws_size, hipStream_t stream) {
    static int grid = 0;
    if (grid == 0) {
        if (n_in != 21 || out_size != M * D || ws_size < WS_END) { fprintf(stderr, "kernel_launch: unexpected problem (n_in %d, out %d, ws %zu)\n", n_in, out_size, ws_size); grid = -1; return; }
        int dev = 0, cus = 0, per_cu = 0;
        hipGetDevice(&dev); hipDeviceGetAttribute(&cus, hipDeviceAttributeMultiprocessorCount, dev);
        hipFuncSetAttribute((const void*)fwd_megakernel, hipFuncAttributeMaxDynamicSharedMemorySize, LDS_BYTES);
        hipOccupancyMaxActiveBlocksPerMultiprocessor(&per_cu, (const void*)fwd_megakernel, NTHR, LDS_BYTES);
        if (per_cu < 1) { fprintf(stderr, "kernel_launch: occupancy query says %d blocks per CU\n", per_cu); per_cu = 1; }
        if (per_cu > 1) per_cu = 1;
        grid = cus * per_cu; if (grid > 256) grid = 256;
        (void)hipGetLastError();
    }
    if (grid < 0) return;
    if (hipMemsetAsync((char*)d_ws + WS_CTL, 0, 65536, stream) != hipSuccess) { fprintf(stderr, "kernel_launch: memset of the barrier words failed\n"); return; }
    Args a{};
    for (int i = 0; i < 21; ++i) a.in[i] = (const float*)d_in[i];
    a.out = (float*)d_out; a.ws = (unsigned char*)d_ws;
    void* kargs[] = {&a};
    hipError_t e = hipLaunchCooperativeKernel((const void*)fwd_megakernel, dim3(grid), dim3(NTHR), kargs, LDS_BYTES, stream);
    if (e != hipSuccess) fprintf(stderr, "cooperative launch failed: %s (grid %d)\n", hipGetErrorString(e), grid);
}
```

```cpp
#include <hip/hip_runtime.h>
#include <hip/hip_cooperative_groups.h>
#include <cstdio>
#include <cstdint>
namespace cg = cooperative_groups;
namespace pg8 {
#define PG8_LAS __attribute__((address_space(3)))
typedef unsigned short bf16_t;
typedef short bf16x8 __attribute__((ext_vector_type(8)));
typedef float f32x4 __attribute__((ext_vector_type(4)));
typedef unsigned u32x4 __attribute__((ext_vector_type(4)));
constexpr int BM = 256, BK = 64, HALF = 128, HTB = HALF * BK * 2  , STAGE_BYTES = 8 * HTB, NXCD = 8, WGM = 8;

__host__ __device__ __forceinline__ int lds_byte(int r, int c) { const int st = (r >> 4) * 2 + (c >> 5), rr = r & 15, cc = c & 31, ob = rr * 64 + cc * 2; return st * 1024 + (ob ^ (((ob >> 9) & 1) << 5)); }
__host__ __device__ __forceinline__ void stage_rc(int b, int& R, int& C) { const int st = b / 1024, sb = b % 1024, swz = sb ^ (((sb >> 9) & 1) << 5); R = (st >> 1) * 16 + swz / 64; C = (st & 1) * 32 + (swz % 64) / 2; }
__host__ __device__ __forceinline__ int perm32(int rho) { const int n = rho >> 4, i = rho & 15; return 8 * (i >> 2) + 4 * n + (i & 3); }

struct Unit { int pm, pn; };
struct Gemm { const bf16_t* A; const bf16_t* Bt; int M, N, K; };

struct StaticOrder {
    int nM, nN, nwg, G, c;
    __host__ __device__ void init(int M, int N, int G_, int c_) { nM = M / BM; nN = N / BM; nwg = nM * nN; G = G_; c = c_; }
    __host__ __device__ bool next(int i, Unit& u) const {
        const long L = (long)i * G + c; if (L >= nwg) return false;
        int wgid = (int)L; { const int q = nwg / NXCD, r = nwg % NXCD, xcd = wgid % NXCD, off = wgid / NXCD; wgid = (xcd < r ? xcd * (q + 1) : r * (q + 1) + (xcd - r) * q) + off; }
        const int nig = WGM * nN, gid = wgid / nig, fm = gid * WGM, gsz = (nM - fm) < WGM ? (nM - fm) : WGM;
        u.pm = fm + ((wgid % nig) % gsz); u.pn = (wgid % nig) / gsz; return true;
    }
    __device__ __forceinline__ void a_ready(const Unit&) const {}
    __device__ __forceinline__ void done(const Unit&) const {}
};

__device__ __forceinline__ unsigned cvt_pk_bf16(float lo, float hi) { unsigned r; asm volatile("v_cvt_pk_bf16_f32 %0, %1, %2" : "=v"(r) : "v"(lo), "v"(hi)); return r; }
typedef float f32x2 __attribute__((ext_vector_type(2)));
__device__ __forceinline__ f32x2 gelu_pk(f32x2 v) {
    const f32x2 av = __builtin_elementwise_abs(v), d = av * 0.2316418882f + 1.0f;
    f32x2 t; t.x = __builtin_amdgcn_rcpf(d.x); t.y = __builtin_amdgcn_rcpf(d.y);
    f32x2 q = t * 0.5307027145f + (-0.7265760135f); q = q * t + 0.7107068705f; q = q * t + (-0.142248368f); q = q * t + 0.127414796f; q = q * t;
    const f32x2 s = (v * v) * (-0.72134752044f);
    f32x2 e; e.x = __builtin_amdgcn_exp2f(s.x); e.y = __builtin_amdgcn_exp2f(s.y);
    const f32x2 m = v * (q * e), r = v - m;
    f32x2 o; o.x = v.x < 0.f ? m.x : r.x; o.y = v.y < 0.f ? m.y : r.y; return o;
}

template <int ACT  > struct EpiBf16 {
    static constexpr bool PERM = true, AFTER_DRAIN = false; static_assert(ACT == 0 || ACT == 1, "EpiBf16: ACT is 0 (none) or 1 (gelu_pk)");
    bf16_t* O; int ldc; const float* bias; int split_cols; size_t split_stride; float scale0;
    __device__ __forceinline__ void operator()(const f32x4 (&acc)[2][2][4][2], const Unit& u, int wr, int wc, int fr, int fq) const {
        const int row0 = u.pm * BM + wr * 64 + fr; int colt = u.pn * BM; bf16_t* base = O;
        float sc = 1.f; if (split_cols) { const int t = colt / split_cols; base += (size_t)t * split_stride; colt -= t * split_cols; if (t == 0) sc = scale0; }
        const int col0 = colt + wc * 32 + 8 * fq, bcol0 = u.pn * BM + wc * 32 + 8 * fq;
        f32x4 bv[2][2];
#pragma unroll
        for (int bj = 0; bj < 2; ++bj)
#pragma unroll
            for (int n = 0; n < 2; ++n) bv[bj][n] = bias ? *(const f32x4*)(bias + bcol0 + bj * HALF + 4 * n) : (f32x4){0.f, 0.f, 0.f, 0.f};
#pragma unroll
        for (int ai = 0; ai < 2; ++ai)
#pragma unroll
            for (int m = 0; m < 4; ++m) { bf16_t* rowp = base + (size_t)(row0 + ai * HALF + m * 16) * ldc + col0;
#pragma unroll
                for (int bj = 0; bj < 2; ++bj) { f32x4 v0 = acc[ai][bj][m][0] + bv[bj][0], v1 = acc[ai][bj][m][1] + bv[bj][1];
                    if (ACT == 1) { f32x2 a = gelu_pk((f32x2){v0[0], v0[1]}), b = gelu_pk((f32x2){v0[2], v0[3]}), c = gelu_pk((f32x2){v1[0], v1[1]}), d = gelu_pk((f32x2){v1[2], v1[3]});
                        v0 = (f32x4){a.x, a.y, b.x, b.y}; v1 = (f32x4){c.x, c.y, d.x, d.y}; }
                    v0 = v0 * sc; v1 = v1 * sc; u32x4 w; w.x = cvt_pk_bf16(v0[0], v0[1]); w.y = cvt_pk_bf16(v0[2], v0[3]); w.z = cvt_pk_bf16(v1[0], v1[1]); w.w = cvt_pk_bf16(v1[2], v1[3]);
                    *(u32x4*)(rowp + bj * HALF) = w; } }
    }
};
__device__ __forceinline__ float bf_lo(unsigned u) { return __uint_as_float(u << 16); }
__device__ __forceinline__ float bf_hi(unsigned u) { return __uint_as_float(u & 0xffff0000u); }
__device__ __forceinline__ float sigm(float x) { return __builtin_amdgcn_rcpf(1.0f + __builtin_amdgcn_exp2f(-1.4426950408889634f * x)); }
template <bool ADD> struct EpiGate {
    static constexpr bool PERM = true, AFTER_DRAIN = false;
    bf16_t* O; const bf16_t* gate; size_t seg_elems;
    __device__ __forceinline__ void operator()(const f32x4 (&acc)[2][2][4][2], const Unit& u, int wr, int wc, int fr, int fq) const {
        const int row0 = u.pm * BM + wr * 64 + fr, col0 = u.pn * BM + wc * 32 + 8 * fq;
#pragma unroll
        for (int ai = 0; ai < 2; ++ai)
#pragma unroll
            for (int m = 0; m < 4; ++m) { const int row = row0 + ai * HALF + m * 16;
#pragma unroll
                for (int bj = 0; bj < 2; ++bj) { const int col = col0 + bj * HALF;
                    const u32x4 gv = *(const u32x4*)(gate + (size_t)(col >> 9) * seg_elems + (size_t)row * 512 + (col & 511));
                    bf16_t* op = O + (size_t)row * 1024 + col;
                    f32x4 v0 = acc[ai][bj][m][0], v1 = acc[ai][bj][m][1];
                    v0[0] *= sigm(bf_lo(gv.x)); v0[1] *= sigm(bf_hi(gv.x)); v0[2] *= sigm(bf_lo(gv.y)); v0[3] *= sigm(bf_hi(gv.y));
                    v1[0] *= sigm(bf_lo(gv.z)); v1[1] *= sigm(bf_hi(gv.z)); v1[2] *= sigm(bf_lo(gv.w)); v1[3] *= sigm(bf_hi(gv.w));
                    if (ADD) { const u32x4 ov = *(const u32x4*)op;
                        v0[0] += bf_lo(ov.x); v0[1] += bf_hi(ov.x); v0[2] += bf_lo(ov.y); v0[3] += bf_hi(ov.y);
                        v1[0] += bf_lo(ov.z); v1[1] += bf_hi(ov.z); v1[2] += bf_lo(ov.w); v1[3] += bf_hi(ov.w); }
                    u32x4 w; w.x = cvt_pk_bf16(v0[0], v0[1]); w.y = cvt_pk_bf16(v0[2], v0[3]); w.z = cvt_pk_bf16(v1[0], v1[1]); w.w = cvt_pk_bf16(v1[2], v1[3]);
                    *(u32x4*)op = w; } }
    }
};
template <class Epi, class Sched, bool ALIGN_EPI = false, bool SP2 = false>
__device__ __forceinline__ void gemm_phase(PG8_LAS unsigned char* lds, const Gemm g, const Sched& S, const Epi& E) {
    int tid_ = threadIdx.x; asm volatile("" : "+v"(tid_));
    const int tid = tid_, wid = __builtin_amdgcn_readfirstlane(tid >> 6), lane = tid & 63, wr = wid >> 2, wc = wid & 3, fr = lane & 15, fq = lane >> 4;
    const int K = g.K, nt = K / BK;
    unsigned voffA[2], voffB[2];
#pragma unroll
    for (int i = 0; i < 2; ++i) { int R, C; stage_rc(tid * 16 + i * 8192, R, C); const int Rb = Epi::PERM ? ((R & ~31) + perm32(R & 31)) : R;
        voffA[i] = (unsigned)(R * K + C) * 2u; voffB[i] = (unsigned)(Rb * K + C) * 2u; }
    const size_t kstep = (size_t)(BK * 2);
    const size_t hstep = (size_t)HALF * K * 2;
    const size_t tstep = 2 * hstep;
    const unsigned ldsw = (unsigned)wid * 1024u;
    const int aoff = lds_byte(wr * 64 + fr, fq * 8), boff = lds_byte(wc * 32 + fr, fq * 8);
#define PG8_SA(b, h) (((b) * 2 + (h)) * HTB)
#define PG8_SB(b, h) ((4 + (b) * 2 + (h)) * HTB)
#define PG8_STAGE(bufoff, gbase, voff) do { _Pragma("unroll") for (int _i = 0; _i < 2; ++_i) \
        __builtin_amdgcn_global_load_lds((const unsigned*)((const char*)(gbase) + (voff)[_i]), (PG8_LAS unsigned*)(lds + (bufoff) + ldsw + _i * 8192), 16, 0, 0); } while (0)
#define PG8_LDA(dst, b, h) do { _Pragma("unroll") for (int m = 0; m < 4; ++m) _Pragma("unroll") for (int k = 0; k < 2; ++k) dst[m][k] = *(const PG8_LAS bf16x8*)(lds + PG8_SA(b, h) + aoff + m * 2048 + k * 1024); } while (0)
#define PG8_LDB(dst, b, h) do { _Pragma("unroll") for (int n = 0; n < 2; ++n) _Pragma("unroll") for (int k = 0; k < 2; ++k) dst[n][k] = *(const PG8_LAS bf16x8*)(lds + PG8_SB(b, h) + boff + n * 2048 + k * 1024); } while (0)
#define PG8_MMA(ai, bj, At, Bt) do { __builtin_amdgcn_s_setprio(1); _Pragma("unroll") for (int m = 0; m < 4; ++m) _Pragma("unroll") for (int n = 0; n < 2; ++n) _Pragma("unroll") for (int k = 0; k < 2; ++k) \
        acc[ai][bj][m][n] = __builtin_amdgcn_mfma_f32_16x16x32_bf16(Bt[n][k], At[m][k], acc[ai][bj][m][n], 0, 0, 0); __builtin_amdgcn_s_setprio(0); } while (0)
#define PG8_WAIT_V(n) asm volatile("s_waitcnt vmcnt(" #n ")" ::: "memory")
#define PG8_WAIT_L(n) asm volatile("s_waitcnt lgkmcnt(" #n ")" ::: "memory")
#define PG8_BAR __builtin_amdgcn_s_barrier()
#define PG8_SCHED __builtin_amdgcn_sched_barrier(0)
    Unit cur, nxt; int ui = 0;
    if (!S.next(0, cur)) return;
    f32x4 acc[2][2][4][2];
#pragma unroll
    for (int a = 0; a < 2; ++a)
#pragma unroll
        for (int b = 0; b < 2; ++b)
#pragma unroll
            for (int m = 0; m < 4; ++m)
#pragma unroll
                for (int n = 0; n < 2; ++n) acc[a][b][m][n] = (f32x4){0.f, 0.f, 0.f, 0.f};
    bf16x8 At[4][2], B0[2][2], B1[2][2];
    const char* cA = (const char*)g.A + (size_t)cur.pm * tstep; const char* cB = (const char*)g.Bt + (size_t)cur.pn * tstep;
    S.a_ready(cur);
    if constexpr (SP2) {
        PG8_STAGE(PG8_SB(0, 0), cB, voffB); PG8_STAGE(PG8_SB(0, 1), cB + hstep, voffB); PG8_STAGE(PG8_SA(0, 0), cA, voffA); PG8_STAGE(PG8_SA(0, 1), cA + hstep, voffA);
        if (wr == 1) PG8_BAR;
        PG8_WAIT_V(2); PG8_BAR;
        PG8_STAGE(PG8_SB(1, 0), cB + kstep, voffB); PG8_STAGE(PG8_SA(1, 0), cA + kstep, voffA); PG8_STAGE(PG8_SB(1, 1), cB + hstep + kstep, voffB);
        PG8_WAIT_V(6); PG8_BAR;
    } else {
        PG8_STAGE(PG8_SB(0, 0), cB, voffB); PG8_STAGE(PG8_SA(0, 0), cA, voffA); PG8_STAGE(PG8_SB(0, 1), cB + hstep, voffB); PG8_STAGE(PG8_SA(0, 1), cA + hstep, voffA);
        if (wr == 1) PG8_BAR;
        PG8_WAIT_V(4); PG8_BAR;
        PG8_STAGE(PG8_SB(1, 0), cB + kstep, voffB); PG8_STAGE(PG8_SA(1, 0), cA + kstep, voffA); PG8_STAGE(PG8_SB(1, 1), cB + hstep + kstep, voffB);
        PG8_WAIT_V(6); PG8_BAR;
    }
    for (;;) {
        const bool has_next = S.next(ui + 1, nxt);
        const char* nA = has_next ? (const char*)g.A + (size_t)nxt.pm * tstep : cA; const char* nB = has_next ? (const char*)g.Bt + (size_t)nxt.pn * tstep : cB;
        for (int t = 0; t < nt; t += 2) {
            const bool last = (t == nt - 2);
            const char* a1 = cA + (size_t)(t + 1) * kstep;
            const char* a2 = last ? nA : cA + (size_t)(t + 2) * kstep; const char* b2 = last ? nB : cB + (size_t)(t + 2) * kstep;
            const char* a3 = a2 + kstep; const char* b3 = b2 + kstep;
            if (last && has_next) S.a_ready(nxt);
            if constexpr (SP2) {
            PG8_LDB(B0, 0, 0); PG8_LDB(B1, 0, 1); PG8_SCHED; PG8_LDA(At, 0, 0); PG8_STAGE(PG8_SA(1, 1), a1 + hstep, voffA);
            PG8_WAIT_V(8); PG8_WAIT_L(0); PG8_BAR; PG8_MMA(0, 0, At, B0); PG8_MMA(0, 1, At, B1); PG8_BAR; PG8_SCHED;
            PG8_LDA(At, 0, 1); PG8_STAGE(PG8_SB(0, 0), b2, voffB); PG8_STAGE(PG8_SB(0, 1), b2 + hstep, voffB); PG8_STAGE(PG8_SA(0, 0), a2, voffA);
            PG8_WAIT_V(8); PG8_WAIT_L(0); PG8_BAR; PG8_MMA(1, 0, At, B0); PG8_MMA(1, 1, At, B1); PG8_BAR; PG8_SCHED;
            PG8_LDB(B0, 1, 0); PG8_LDB(B1, 1, 1); PG8_SCHED; PG8_LDA(At, 1, 0); PG8_STAGE(PG8_SA(0, 1), a2 + hstep, voffA);
            PG8_WAIT_V(8); PG8_WAIT_L(0); PG8_BAR; PG8_MMA(0, 0, At, B0); PG8_MMA(0, 1, At, B1); PG8_BAR; PG8_SCHED;
            PG8_LDA(At, 1, 1); PG8_STAGE(PG8_SB(1, 0), b3, voffB); PG8_STAGE(PG8_SB(1, 1), b3 + hstep, voffB); PG8_STAGE(PG8_SA(1, 0), a3, voffA);
            PG8_WAIT_V(8); PG8_WAIT_L(0); PG8_BAR; PG8_MMA(1, 0, At, B0); PG8_MMA(1, 1, At, B1); PG8_BAR; PG8_SCHED;
            } else {
            PG8_LDB(B0, 0, 0); PG8_SCHED; PG8_LDA(At, 0, 0); PG8_STAGE(PG8_SA(1, 1), a1 + hstep, voffA);
            PG8_WAIT_L(8); PG8_BAR; PG8_WAIT_L(0); PG8_MMA(0, 0, At, B0); PG8_BAR; PG8_SCHED;
            PG8_LDB(B1, 0, 1); PG8_STAGE(PG8_SB(0, 0), b2, voffB);
            PG8_BAR; PG8_WAIT_L(0); PG8_MMA(0, 1, At, B1); PG8_BAR;
            PG8_LDA(At, 0, 1); PG8_STAGE(PG8_SA(0, 0), a2, voffA);
            PG8_BAR; PG8_WAIT_L(0); PG8_MMA(1, 0, At, B0); PG8_BAR; PG8_SCHED;
            PG8_STAGE(PG8_SB(0, 1), b2 + hstep, voffB);
            PG8_WAIT_V(6); PG8_BAR; PG8_MMA(1, 1, At, B1); PG8_BAR;
            PG8_LDB(B0, 1, 0); PG8_SCHED; PG8_LDA(At, 1, 0); PG8_STAGE(PG8_SA(0, 1), a2 + hstep, voffA);
            PG8_WAIT_L(8); PG8_BAR; PG8_WAIT_L(0); PG8_MMA(0, 0, At, B0); PG8_BAR; PG8_SCHED;
            PG8_LDB(B1, 1, 1); PG8_STAGE(PG8_SB(1, 0), b3, voffB);
            PG8_BAR; PG8_WAIT_L(0); PG8_MMA(0, 1, At, B1); PG8_BAR;
            PG8_LDA(At, 1, 1); PG8_STAGE(PG8_SA(1, 0), a3, voffA);
            PG8_BAR; PG8_WAIT_L(0); PG8_MMA(1, 0, At, B0); PG8_BAR; PG8_SCHED;
            PG8_STAGE(PG8_SB(1, 1), b3 + hstep, voffB);
            PG8_WAIT_V(6); PG8_BAR; PG8_MMA(1, 1, At, B1); PG8_BAR;
            }
        }
        if constexpr (ALIGN_EPI) { if (wr == 0) PG8_BAR; }
        if constexpr (!Epi::AFTER_DRAIN) { E(acc, cur, wr, wc, fr, fq); S.done(cur); }
        if (!has_next) break;
#pragma unroll
        for (int a = 0; a < 2; ++a)
#pragma unroll
            for (int b = 0; b < 2; ++b)
#pragma unroll
                for (int m = 0; m < 4; ++m)
#pragma unroll
                    for (int n = 0; n < 2; ++n) acc[a][b][m][n] = (f32x4){0.f, 0.f, 0.f, 0.f};
        cur = nxt; cA = nA; cB = nB; ++ui;
        if constexpr (ALIGN_EPI) { if (wr == 1) PG8_BAR; }
    }
    PG8_WAIT_V(0);
    if constexpr (!ALIGN_EPI) { if (wr == 0) PG8_BAR; }
    PG8_BAR;
    if constexpr (Epi::AFTER_DRAIN) { E.fused(acc, cur, wr, wc, fr, fq, lds, wid, lane); S.done(cur); }
#undef PG8_SA
#undef PG8_SB
#undef PG8_STAGE
#undef PG8_LDA
#undef PG8_LDB
#undef PG8_MMA
#undef PG8_WAIT_V
#undef PG8_WAIT_L
#undef PG8_BAR
#undef PG8_SCHED
}
}
constexpr int NWAVES = 8, NTHR = 512;
constexpr int M = 32768, D = 1024, SEQ = 8192, NBATCH = 4;
constexpr int NIN = 5888;
constexpr int NCHUNK = 128, NITEM = 32 * NCHUNK;
constexpr float EPS = 1e-6f;
constexpr size_t MiB = 1u << 20;
constexpr size_t SEG_ELEMS = (size_t)M * 512;
constexpr size_t WS_CTL = 0, WS_MODP = 1 * MiB, WS_WIN = 2 * MiB, WS_WQ = 14 * MiB, WS_WSC = 18 * MiB, WS_WDN = 19 * MiB, WS_WMIX = 20 * MiB,
                 WS_SK = 22 * MiB, WS_GL = 23 * MiB, WS_SU = 23 * MiB + 65536, WS_SV = 23 * MiB + 131072, WS_TU = 24 * MiB, WS_TV = 56 * MiB, WS_P = 88 * MiB, WS_KD = 472 * MiB, WS_END = 504 * MiB;
constexpr int LDS_BYTES = 147456;

#define GAS __attribute__((address_space(1)))
#define LAS __attribute__((address_space(3)))
typedef unsigned short bf16;
typedef unsigned v4u __attribute__((ext_vector_type(4)));
typedef unsigned v2u __attribute__((ext_vector_type(2)));
typedef float f32x4 __attribute__((ext_vector_type(4)));
typedef float f32x16 __attribute__((ext_vector_type(16)));
typedef short bf16x8 __attribute__((ext_vector_type(8)));

__device__ __forceinline__ unsigned f2bf(float f) { unsigned u = __builtin_bit_cast(unsigned, f); return (u + 0x7fffu + ((u >> 16) & 1u)) >> 16; }
__device__ __forceinline__ unsigned pk2(float lo, float hi) { return f2bf(lo) | (f2bf(hi) << 16); }
__device__ __forceinline__ float bflo(unsigned u) { return __uint_as_float(u << 16); }
__device__ __forceinline__ float bfhi(unsigned u) { return __uint_as_float(u & 0xffff0000u); }
__device__ __forceinline__ float bf2f(bf16 h) { return __uint_as_float((unsigned)h << 16); }
__device__ __forceinline__ float sigmoidf_(float x) { return 1.0f / (1.0f + __expf(-x)); }
__device__ __forceinline__ float wave_sum(float v) {
#pragma unroll
    for (int o = 1; o < 64; o <<= 1) v += __shfl_xor(v, o);
    return v;
}

struct Frame { LAS unsigned char* lds; int tid, lane, wave, G; };
__device__ __forceinline__ const void* karg(int i) {
    const char __attribute__((address_space(4)))* kp = (const char __attribute__((address_space(4)))*)__builtin_amdgcn_kernarg_segment_ptr();
    asm volatile("" : "+s"(i));
    return *(const void* const __attribute__((address_space(4)))*)(kp + 8 * i);
}
__device__ __forceinline__ const float* IN(int i) { return (const float*)karg(i); }
__device__ __forceinline__ float* OUTP() { return (float*)karg(21); }
__device__ __forceinline__ unsigned char* WSP() { return (unsigned char*)karg(22); }
enum { I_X = 0, I_C, I_WADA, I_BADA, I_NPREMIX, I_NPOSTMIX, I_WIN, I_SCCONV, I_DNCONV, I_ALOG, I_DTBIAS, I_OUTNORM, I_WSC, I_WDN, I_WMIX, I_NPREFFN, I_NPOSTFFN, I_WQ, I_SUBK, I_PU, I_PV };
__device__ __forceinline__ bf16* segp(unsigned char* ws, int s) { return (bf16*)(ws + WS_P) + (size_t)s * SEG_ELEMS; }
__device__ __forceinline__ float modv(const float* b_ada, const float* modp, int b, int j) {
    float s = b_ada[j];
#pragma unroll
    for (int k = 0; k < 8; ++k) s += modp[(size_t)(k * 4 + b) * 6144 + j];
    return s;
}

__device__ __forceinline__ void p0_transpose_item(const float* W, int K, int N, int src_col0, bf16* WT, int dst_row0, int kb, int ncols, LAS float* scr, int lane) {
    const int k0 = 64 * kb;
#pragma unroll 8
    for (int i = 0; i < 32; ++i) { const int kk = 2 * i + (lane >> 5); const int n = lane & 31;
        scr[kk * 33 + n] = (n < ncols) ? W[(size_t)(k0 + kk) * N + src_col0 + n] : 0.f; }
    asm volatile("s_waitcnt lgkmcnt(0)" ::: "memory");
    const int c = lane & 7;
#pragma unroll
    for (int j = 0; j < 4; ++j) { const int n = (lane >> 3) + 8 * j; const LAS float* s = scr + (8 * c) * 33 + n;
        v4u o; o.x = pk2(s[0 * 33], s[1 * 33]); o.y = pk2(s[2 * 33], s[3 * 33]); o.z = pk2(s[4 * 33], s[5 * 33]); o.w = pk2(s[6 * 33], s[7 * 33]);
        *(v4u*)(WT + (size_t)(dst_row0 + n) * K + k0 + 8 * c) = o; }
    asm volatile("s_waitcnt lgkmcnt(0)" ::: "memory");
}
__device__ __forceinline__ void p0_transpose(const float* W, int K, int N, int src_col0, int nblk, bf16* WT, int dst_row0, LAS float* scr, int gw, int NGW, int lane) {
    const int kbs = K / 64;
    for (int it = gw; it < nblk * kbs; it += NGW) { const int nb = it / kbs, kb = it % kbs;
        p0_transpose_item(W, K, N, src_col0 + 32 * nb, WT, dst_row0 + 32 * nb, kb, 32, scr, lane); }
}
__device__ __forceinline__ void p0_convert(const float* src, bf16* dst, size_t nchunks8, size_t gtid, size_t gthreads) {
    for (size_t i = gtid; i < nchunks8; i += gthreads) { const f32x4 a = *(const f32x4*)(src + i * 8), b = *(const f32x4*)(src + i * 8 + 4);
        v4u o; o.x = pk2(a[0], a[1]); o.y = pk2(a[2], a[3]); o.z = pk2(b[0], b[1]); o.w = pk2(b[2], b[3]); *(v4u*)(dst + i * 8) = o; }
}
__device__ __forceinline__ void p0_table_fp8(const float* T, unsigned char* T8, float* SC, int gw, int NGW, int lane) {
    for (int row = gw; row < 16384; row += NGW) {
        const f32x4* src = (const f32x4*)(T + (size_t)row * 1024) + lane;
        f32x4 v[4]; float am = 0.f;
#pragma unroll
        for (int i = 0; i < 4; ++i) { v[i] = src[64 * i]; am = fmaxf(am, fmaxf(fmaxf(fabsf(v[i][0]), fabsf(v[i][1])), fmaxf(fabsf(v[i][2]), fabsf(v[i][3])))); }
#pragma unroll
        for (int o = 1; o < 64; o <<= 1) am = fmaxf(am, __shfl_xor(am, o));
        const unsigned rb = __float_as_uint(240.0f / fmaxf(am, 1e-30f)) & 0x7f800000u;
        const float sp = __uint_as_float(rb), inv = __uint_as_float((254u << 23) - rb);
        unsigned* dst = (unsigned*)(T8 + (size_t)row * 1024) + lane;
#pragma unroll
        for (int i = 0; i < 4; ++i) { unsigned p = 0u; p = __builtin_amdgcn_cvt_pk_fp8_f32(v[i][0] * sp, v[i][1] * sp, p, false); p = __builtin_amdgcn_cvt_pk_fp8_f32(v[i][2] * sp, v[i][3] * sp, p, true); dst[64 * i] = p; }
        if (lane == 0) SC[row] = inv;
    }
}
__device__ __forceinline__ void phase_prologue(Frame& F) {
    LAS float* scr = (LAS float*)(F.lds + F.wave * 8704);
    const int gw = blockIdx.x * NWAVES + F.wave, NGW = F.G * NWAVES;
    unsigned char* ws = WSP();
    { const float* w_ada = IN(I_WADA); const float* cc = IN(I_C); float* modp = (float*)(ws + WS_MODP);
    for (int it = gw; it < 768; it += NGW) { const int cgi = it % 96, ks = it / 96, n = cgi * 64 + F.lane, k0 = ks * 128;
        float a0 = 0.f, a1 = 0.f, a2 = 0.f, a3 = 0.f;
#pragma unroll 16
        for (int kk = 0; kk < 128; ++kk) { const int k = k0 + kk; const float w = w_ada[(size_t)k * 6144 + n];
            const float c0 = cc[k], c1 = cc[1024 + k], c2 = cc[2048 + k], c3 = cc[3072 + k];
            a0 += c0 * sigmoidf_(c0) * w; a1 += c1 * sigmoidf_(c1) * w; a2 += c2 * sigmoidf_(c2) * w; a3 += c3 * sigmoidf_(c3) * w; }
        modp[(size_t)(ks * 4 + 0) * 6144 + n] = a0; modp[(size_t)(ks * 4 + 1) * 6144 + n] = a1;
        modp[(size_t)(ks * 4 + 2) * 6144 + n] = a2; modp[(size_t)(ks * 4 + 3) * 6144 + n] = a3; } }
    { const float* w_in = IN(I_WIN); bf16* win_t = (bf16*)(ws + WS_WIN);
    p0_transpose(w_in, 1024, 5648, 0, 112, win_t, 0, scr, gw, NGW, F.lane);
    p0_transpose(w_in, 1024, 5648, 3600, 64, win_t, 3584, scr, gw, NGW, F.lane);
    for (int it = gw; it < 16; it += NGW) p0_transpose_item(w_in, 1024, 5648, 3584, win_t, 5632, it, 16, scr, F.lane);
    { const size_t gtid = (size_t)blockIdx.x * NTHR + F.tid, gth = (size_t)F.G * NTHR;
      for (size_t i = gtid; i < (size_t)224 * 128; i += gth) *(v4u*)(win_t + (size_t)5664 * 1024 + i * 8) = (v4u){0u, 0u, 0u, 0u}; } }
    p0_transpose(IN(I_WQ), 1024, 2048, 0, 64, (bf16*)(ws + WS_WQ), 0, scr, gw, NGW, F.lane);
    p0_transpose(IN(I_WSC), 512, 1024, 0, 32, (bf16*)(ws + WS_WSC), 0, scr, gw, NGW, F.lane);
    p0_transpose(IN(I_WDN), 512, 1024, 0, 32, (bf16*)(ws + WS_WDN), 0, scr, gw, NGW, F.lane);
    p0_transpose(IN(I_WMIX), 1024, 1024, 0, 32, (bf16*)(ws + WS_WMIX), 0, scr, gw, NGW, F.lane);
    { const size_t gtid = (size_t)blockIdx.x * NTHR + F.tid, gth = (size_t)F.G * NTHR;
      p0_convert(IN(I_SUBK), (bf16*)(ws + WS_SK), (size_t)16 * 128 * 128 / 8, gtid, gth);
    }
    p0_table_fp8(IN(I_PU), ws + WS_TU, (float*)(ws + WS_SU), gw, NGW, F.lane);
    p0_table_fp8(IN(I_PV), ws + WS_TV, (float*)(ws + WS_SV), gw, NGW, F.lane);
}

__device__ __forceinline__ void phase_h1(Frame& F, bf16* H1) {
    LAS float* gv = (LAS float*)F.lds; LAS float* sv = gv + 1024;
    const float* xin = IN(I_X); const float* npm = IN(I_NPREMIX); const float* b_ada = IN(I_BADA); const float* modp = (const float*)(WSP() + WS_MODP);
    for (int rb = blockIdx.x; rb < M / 128; rb += F.G) {
        const int row0 = rb * 128, b = row0 / SEQ;
        __syncthreads();
        for (int k = F.tid; k < 1024; k += NTHR) { gv[k] = npm[k] * (1.f + modv(b_ada, modp, b, 1024 + k)); sv[k] = modv(b_ada, modp, b, k); }
        __syncthreads();
        for (int r = 0; r < 16; ++r) { const int row = row0 + F.wave * 16 + r;
            const f32x4* xr = (const f32x4*)(xin + (size_t)row * D) + F.lane;
            f32x4 v[4]; float ss = 0.f;
#pragma unroll
            for (int j = 0; j < 4; ++j) { v[j] = xr[64 * j]; ss += (v[j][0] * v[j][0] + v[j][1] * v[j][1]) + (v[j][2] * v[j][2] + v[j][3] * v[j][3]); }
            const float rstd = rsqrtf(wave_sum(ss) * (1.f / D) + EPS);
            v2u* o8 = (v2u*)(H1 + (size_t)row * D) + F.lane;
#pragma unroll
            for (int j = 0; j < 4; ++j) { const int k = 4 * F.lane + 256 * j; const f32x4 g = *(const LAS f32x4*)(gv + k), s = *(const LAS f32x4*)(sv + k);
                v2u o; o.x = pk2(v[j][0] * rstd * g[0] + s[0], v[j][1] * rstd * g[1] + s[1]); o.y = pk2(v[j][2] * rstd * g[2] + s[2], v[j][3] * rstd * g[3] + s[3]); o8[64 * j] = o; }
        }
    }
}

__device__ __forceinline__ void phase_scprep(Frame& F) {
    unsigned char* ws = WSP(); bf16* sb = segp(ws, 0); const bf16* scc = segp(ws, 1); const bf16* scx = segp(ws, 2); const float* scw = IN(I_SCCONV);
    const int gtid = blockIdx.x * NTHR + F.tid, gth = F.G * NTHR;
    for (int it = gtid; it < (M / 16) * 64; it += gth) {
        const int cgp = it & 63, tb = it >> 6, m0 = tb * 16, c0 = cgp * 8;
        float w0[8], w1[8], w2[8], p2[8], p1[8];
#pragma unroll
        for (int e = 0; e < 8; ++e) { w0[e] = scw[c0 + e]; w1[e] = scw[512 + c0 + e]; w2[e] = scw[1024 + c0 + e]; p2[e] = 0.f; p1[e] = 0.f; }
        if ((m0 % SEQ) != 0) {
#pragma unroll
            for (int q = 0; q < 2; ++q) { const size_t off = (size_t)(m0 - 2 + q) * 512 + c0; const v4u cv = *(const v4u*)(scc + off), xv = *(const v4u*)(scx + off);
                float t[8] = {bflo(cv.x) * bflo(xv.x), bfhi(cv.x) * bfhi(xv.x), bflo(cv.y) * bflo(xv.y), bfhi(cv.y) * bfhi(xv.y), bflo(cv.z) * bflo(xv.z), bfhi(cv.z) * bfhi(xv.z), bflo(cv.w) * bflo(xv.w), bfhi(cv.w) * bfhi(xv.w)};
#pragma unroll
                for (int e = 0; e < 8; ++e) { if (q == 0) p2[e] = t[e]; else p1[e] = t[e]; } }
        }
        for (int t = 0; t < 16; ++t) { const size_t off = (size_t)(m0 + t) * 512 + c0;
            const v4u cv = *(const v4u*)(scc + off), xv = *(const v4u*)(scx + off), bv = *(const v4u*)(sb + off);
            float cur[8] = {bflo(cv.x) * bflo(xv.x), bfhi(cv.x) * bfhi(xv.x), bflo(cv.y) * bflo(xv.y), bfhi(cv.y) * bfhi(xv.y), bflo(cv.z) * bflo(xv.z), bfhi(cv.z) * bfhi(xv.z), bflo(cv.w) * bflo(xv.w), bfhi(cv.w) * bfhi(xv.w)};
            float bb[8] = {bflo(bv.x), bfhi(bv.x), bflo(bv.y), bfhi(bv.y), bflo(bv.z), bfhi(bv.z), bflo(bv.w), bfhi(bv.w)};
            float o[8];
#pragma unroll
            for (int e = 0; e < 8; ++e) { o[e] = bb[e] * (w0[e] * p2[e] + w1[e] * p1[e] + w2[e] * cur[e]); p2[e] = p1[e]; p1[e] = cur[e]; }
            v4u ov; ov.x = pk2(o[0], o[1]); ov.y = pk2(o[2], o[3]); ov.z = pk2(o[4], o[5]); ov.w = pk2(o[6], o[7]);
            *(v4u*)(sb + off) = ov; }
    }
}

#define MM4(dst, aptr, X) do { const f32x4 av_ = *(const LAS f32x4*)(aptr); \
    dst = __builtin_amdgcn_mfma_f32_16x16x4f32(av_[0], (X)[0], dst, 0, 0, 0); dst = __builtin_amdgcn_mfma_f32_16x16x4f32(av_[1], (X)[1], dst, 0, 0, 0); \
    dst = __builtin_amdgcn_mfma_f32_16x16x4f32(av_[2], (X)[2], dst, 0, 0, 0); dst = __builtin_amdgcn_mfma_f32_16x16x4f32(av_[3], (X)[3], dst, 0, 0, 0); } while (0)
__device__ __forceinline__ void phase_dnprep(Frame& F, bf16* Wn, bf16* U, bf16* QG, bf16* A, bf16* KD) {
    LAS unsigned char* L = F.lds;
    LAS bf16* raw = (LAS bf16*)L;
    LAS bf16* stg2 = (LAS bf16*)L;
    LAS float* qc = (LAS float*)(L + 32768);
    LAS float* kc = (LAS float*)(L + 32768 + 17408);
    LAS float* vc = (LAS float*)(L + 32768 + 2 * 17408);
    LAS bf16* kh = (LAS bf16*)(L + 84992);
    LAS bf16* qh = (LAS bf16*)(L + 94208);
    LAS float* Ln = (LAS float*)(L + 103424);
    LAS float* Tm = (LAS float*)(L + 120832);
    LAS float* sG = (LAS float*)(L + 124928);
    LAS float* sBeta = sG + 64; LAS float* sEG = sG + 128; LAS float* sEd = sG + 192;
    LAS float* cwl = (LAS float*)(L + 125952);
    LAS bf16* stg = (LAS bf16*)(L + 129024);
    const int tid = F.tid, lane = F.lane, wave = F.wave;
    unsigned char* ws = WSP(); const bf16* segq = segp(ws, 3); const bf16* segab = segp(ws, 11); float* glp = (float*)(ws + WS_GL);
    const float* cw = IN(I_DNCONV); const float* alog = IN(I_ALOG); const float* dtb = IN(I_DTBIAS);
    for (int it = blockIdx.x; it < NITEM; it += F.G) {
        const int bh = it >> 7, n = it & 127, b = bh >> 3, h = bh & 7, m0 = b * SEQ + n * 64;
        __syncthreads();
        for (int ci = tid; ci < 1608; ci += NTHR) { const int s = ci / 536, rem = ci % 536, r = rem >> 3, c8 = rem & 7;
            v4u v = (v4u){0u, 0u, 0u, 0u};
            if (n * 64 - 3 + r >= 0) v = *(const v4u*)(segq + (size_t)s * SEG_ELEMS + (size_t)(m0 - 3 + r) * 512 + h * 64 + c8 * 8);
            *(LAS v4u*)(raw + (s * 67 + r) * 64 + c8 * 8) = v; }
        for (int ci = tid; ci < 768; ci += NTHR) { const int s = ci >> 8, k = (ci >> 6) & 3, c = ci & 63; cwl[ci] = cw[k * 1536 + s * 512 + h * 64 + c]; }
        __syncthreads();
        for (int wu = tid; wu < 3072; wu += NTHR) { const int c4 = wu & 15, t = (wu >> 4) & 63, s = wu >> 10;
            f32x4 acc = (f32x4){0.f, 0.f, 0.f, 0.f};
#pragma unroll
            for (int k = 0; k < 4; ++k) { const f32x4 w = *(const LAS f32x4*)(cwl + (s * 4 + k) * 64 + 4 * c4); const v2u r = *(const LAS v2u*)(raw + (s * 67 + t + k) * 64 + 4 * c4);
                acc[0] += w[0] * bflo(r.x); acc[1] += w[1] * bfhi(r.x); acc[2] += w[2] * bflo(r.y); acc[3] += w[3] * bfhi(r.y); }
#pragma unroll
            for (int e = 0; e < 4; ++e) acc[e] = acc[e] * sigmoidf_(acc[e]);
            *(LAS f32x4*)((s == 0 ? qc : (s == 1 ? kc : vc)) + t * 68 + 4 * c4) = acc; }
        __syncthreads();
        if (wave == 0) {
            const float av = bf2f(segab[(size_t)(m0 + lane) * 512 + h]) + dtb[h], bv = bf2f(segab[(size_t)(m0 + lane) * 512 + 8 + h]);
            const float sp = (av > 20.f) ? av : log1pf(__expf(av));
            float g = -__expf(alog[h]) * sp;
#pragma unroll
            for (int o = 1; o < 64; o <<= 1) { const float t = __shfl_up(g, o); if (lane >= o) g += t; }
            const float g63 = __shfl(g, 63);
            sG[lane] = g; sBeta[lane] = sigmoidf_(bv); sEG[lane] = __expf(g); sEd[lane] = __expf(g63 - g);
            if (lane == 63) glp[it] = __expf(g);
        }
        { const int t = tid >> 3, p = tid & 7;
          f32x4 q0 = *(const LAS f32x4*)(qc + t * 68 + 8 * p), q1 = *(const LAS f32x4*)(qc + t * 68 + 8 * p + 4), k0 = *(const LAS f32x4*)(kc + t * 68 + 8 * p), k1 = *(const LAS f32x4*)(kc + t * 68 + 8 * p + 4);
          float sq = (q0[0] * q0[0] + q0[1] * q0[1]) + (q0[2] * q0[2] + q0[3] * q0[3]) + (q1[0] * q1[0] + q1[1] * q1[1]) + (q1[2] * q1[2] + q1[3] * q1[3]);
          float sk = (k0[0] * k0[0] + k0[1] * k0[1]) + (k0[2] * k0[2] + k0[3] * k0[3]) + (k1[0] * k1[0] + k1[1] * k1[1]) + (k1[2] * k1[2] + k1[3] * k1[3]);
          sq += __shfl_xor(sq, 1); sq += __shfl_xor(sq, 2); sq += __shfl_xor(sq, 4); sk += __shfl_xor(sk, 1); sk += __shfl_xor(sk, 2); sk += __shfl_xor(sk, 4);
          const float rq = rsqrtf(sq + EPS) * 0.125f, rk = rsqrtf(sk + EPS);
          q0 = q0 * rq; q1 = q1 * rq; k0 = k0 * rk; k1 = k1 * rk;
          *(LAS f32x4*)(qc + t * 68 + 8 * p) = q0; *(LAS f32x4*)(qc + t * 68 + 8 * p + 4) = q1; *(LAS f32x4*)(kc + t * 68 + 8 * p) = k0; *(LAS f32x4*)(kc + t * 68 + 8 * p + 4) = k1;
          v4u qb, kb; qb.x = pk2(q0[0], q0[1]); qb.y = pk2(q0[2], q0[3]); qb.z = pk2(q1[0], q1[1]); qb.w = pk2(q1[2], q1[3]);
          kb.x = pk2(k0[0], k0[1]); kb.y = pk2(k0[2], k0[3]); kb.z = pk2(k1[0], k1[1]); kb.w = pk2(k1[2], k1[3]);
          *(LAS v4u*)(qh + t * 72 + 8 * p) = qb; *(LAS v4u*)(kh + t * 72 + 8 * p) = kb; }
        __syncthreads();
        {
            const int fr = lane & 15, g4 = lane >> 4;
#pragma unroll
            for (int x = 0; x < 2; ++x) { const int tile = 2 * wave + x, ti = tile >> 2, tj = tile & 3;
                f32x4 ckk = (f32x4){0.f, 0.f, 0.f, 0.f}, cqk = (f32x4){0.f, 0.f, 0.f, 0.f};
#pragma unroll
                for (int ks = 0; ks < 2; ++ks) {
                    const bf16x8 ak = *(const LAS bf16x8*)(kh + (16 * ti + fr) * 72 + 32 * ks + 8 * g4);
                    const bf16x8 aq = *(const LAS bf16x8*)(qh + (16 * ti + fr) * 72 + 32 * ks + 8 * g4);
                    const bf16x8 bk = *(const LAS bf16x8*)(kh + (16 * tj + fr) * 72 + 32 * ks + 8 * g4);
                    ckk = __builtin_amdgcn_mfma_f32_16x16x32_bf16(ak, bk, ckk, 0, 0, 0);
                    cqk = __builtin_amdgcn_mfma_f32_16x16x32_bf16(aq, bk, cqk, 0, 0, 0); }
                const int j = 16 * tj + fr; const float gj = sG[j];
#pragma unroll
                for (int r = 0; r < 4; ++r) { const int i = 16 * ti + 4 * g4 + r;
                    const float dec = __expf(fminf(sG[i] - gj, 0.f));
                    Ln[i * 68 + j] = (j < i) ? -(sBeta[i] * ckk[r] * dec) : 0.f;
                    stg[i * 64 + j] = (bf16)f2bf((j <= i) ? cqk[r] * dec : 0.f); }
            }
        }
        __syncthreads();
        if (wave == 0) {
            const int bb = lane >> 4, c = lane & 15; float t[16];
#pragma unroll
            for (int i = 0; i < 16; ++i) { float acc = (i == c) ? 1.f : 0.f;
#pragma unroll
                for (int j = 0; j < i; ++j) acc += Ln[(16 * bb + i) * 68 + 16 * bb + j] * t[j];
                t[i] = acc; Tm[(bb * 16 + i) * 16 + c] = acc; }
        } else {
            for (int ct = tid - 64; ct < 1536; ct += NTHR - 64) { const int kind = ct >> 9, idx = ct & 511; const size_t ob = (size_t)it * 4096 + (size_t)idx * 8;
                if (kind == 0) { *(v4u*)(A + ob) = *(const LAS v4u*)(stg + idx * 8); }
                else if (kind == 1) { const int i = idx >> 3, k0 = (idx & 7) * 8; const float e = sEG[i]; const f32x4 a = *(const LAS f32x4*)(qc + i * 68 + k0), c = *(const LAS f32x4*)(qc + i * 68 + k0 + 4);
                    v4u o; o.x = pk2(a[0] * e, a[1] * e); o.y = pk2(a[2] * e, a[3] * e); o.z = pk2(c[0] * e, c[1] * e); o.w = pk2(c[2] * e, c[3] * e); *(v4u*)(QG + ob) = o; }
                else { const int kk = idx >> 3, c0 = (idx & 7) * 8;
                    v4u p; p.x = pk2(kc[(c0 + 0) * 68 + kk] * sEd[c0 + 0], kc[(c0 + 1) * 68 + kk] * sEd[c0 + 1]); p.y = pk2(kc[(c0 + 2) * 68 + kk] * sEd[c0 + 2], kc[(c0 + 3) * 68 + kk] * sEd[c0 + 3]);
                    p.z = pk2(kc[(c0 + 4) * 68 + kk] * sEd[c0 + 4], kc[(c0 + 5) * 68 + kk] * sEd[c0 + 5]); p.w = pk2(kc[(c0 + 6) * 68 + kk] * sEd[c0 + 6], kc[(c0 + 7) * 68 + kk] * sEd[c0 + 7]);
                    *(v4u*)(KD + ob) = p; } }
        }
        __syncthreads();
        {
            const int nn = lane & 15, g4 = lane >> 4; const LAS float* src = (wave < 4) ? vc : kc; const int cc = 16 * (wave & 3) + nn;
            f32x4 R[4];
#pragma unroll
            for (int bb = 0; bb < 4; ++bb)
#pragma unroll
                for (int r = 0; r < 4; ++r) { const int i = 16 * bb + 4 * g4 + r; float v = src[i * 68 + cc] * sBeta[i]; if (wave >= 4) v *= sEG[i]; R[bb][r] = v; }
            const f32x4 Z4 = (f32x4){0.f, 0.f, 0.f, 0.f};
            f32x4 X0 = Z4, X1 = Z4, X2 = Z4, X3 = Z4;
            MM4(X0, Tm + (0 * 16 + nn) * 16 + 4 * g4, R[0]);
            MM4(R[1], Ln + (16 + nn) * 68 + 0 + 4 * g4, X0);
            MM4(X1, Tm + (1 * 16 + nn) * 16 + 4 * g4, R[1]);
            MM4(R[2], Ln + (32 + nn) * 68 + 0 + 4 * g4, X0); MM4(R[2], Ln + (32 + nn) * 68 + 16 + 4 * g4, X1);
            MM4(X2, Tm + (2 * 16 + nn) * 16 + 4 * g4, R[2]);
            MM4(R[3], Ln + (48 + nn) * 68 + 0 + 4 * g4, X0); MM4(R[3], Ln + (48 + nn) * 68 + 16 + 4 * g4, X1); MM4(R[3], Ln + (48 + nn) * 68 + 32 + 4 * g4, X2);
            MM4(X3, Tm + (3 * 16 + nn) * 16 + 4 * g4, R[3]);
            const float sgn = (wave < 4) ? 1.f : -1.f; const int col = 16 * wave + nn;
#pragma unroll
            for (int r = 0; r < 4; ++r) { const int i = 4 * g4 + r;
                stg2[(i) * 128 + col] = (bf16)f2bf(sgn * X0[r]); stg2[(16 + i) * 128 + col] = (bf16)f2bf(sgn * X1[r]);
                stg2[(32 + i) * 128 + col] = (bf16)f2bf(sgn * X2[r]); stg2[(48 + i) * 128 + col] = (bf16)f2bf(sgn * X3[r]); }
        }
        __syncthreads();
        for (int ci = tid; ci < 1024; ci += NTHR) { const int i = ci >> 4, c8 = ci & 15; const v4u v = *(const LAS v4u*)(stg2 + i * 128 + c8 * 8);
            if (c8 < 8) *(v4u*)(U + (size_t)it * 4096 + i * 64 + c8 * 8) = v; else *(v4u*)(Wn + (size_t)it * 4096 + i * 64 + (c8 - 8) * 8) = v; }
    }
}
#undef MM4

__device__ __forceinline__ bf16x8 pack_b(const f32x4& t0, const f32x4& t1) { v4u w; w.x = pk2(t0[0], t0[1]); w.y = pk2(t0[2], t0[3]); w.z = pk2(t1[0], t1[1]); w.w = pk2(t1[2], t1[3]); return __builtin_bit_cast(bf16x8, w); }
__device__ __forceinline__ bf16x8 afrag(const LAS bf16* base, int row, int ks, int g4) {
    const v2u lo = *(const LAS v2u*)(base + row * 72 + 32 * ks + 4 * g4), hi = *(const LAS v2u*)(base + row * 72 + 32 * ks + 16 + 4 * g4);
    v4u w; w.x = lo.x; w.y = lo.y; w.z = hi.x; w.w = hi.y; return __builtin_bit_cast(bf16x8, w); }
#define SCAN_BAR() do { asm volatile("s_waitcnt lgkmcnt(0)" ::: "memory"); __builtin_amdgcn_s_barrier(); asm volatile("" ::: "memory"); } while (0)
__device__ __forceinline__ void phase_scan(Frame& F, const bf16* Wn, const bf16* U, const bf16* QG, const bf16* A, const bf16* KD, bf16* OG, const bf16* Z) {
    if (blockIdx.x >= 32) return;
    LAS unsigned char* L = F.lds; const float* glp = (const float*)(WSP() + WS_GL); const float* onw = IN(I_OUTNORM);
    const int bh = blockIdx.x, b = bh >> 3, h = bh & 7, tid = F.tid, lane = F.lane, wave = F.wave;
    const int nn = lane & 15, g4 = lane >> 4;
#define OPB(buf, mat) ((LAS bf16*)(L + (buf) * 46080 + (mat) * 9216))
#define OST(buf) ((LAS bf16*)(L + 92160 + (buf) * 9216))
    if (wave >= 4) {
        const int ht = tid - 256;
        const bf16* s0 = Wn + (size_t)bh * NCHUNK * 4096 + (size_t)ht * 8; const bf16* s1 = U + (size_t)bh * NCHUNK * 4096 + (size_t)ht * 8; const bf16* s2 = QG + (size_t)bh * NCHUNK * 4096 + (size_t)ht * 8;
        const bf16* s3 = A + (size_t)bh * NCHUNK * 4096 + (size_t)ht * 8; const bf16* s4 = KD + (size_t)bh * NCHUNK * 4096 + (size_t)ht * 8;
        const int lo0 = (ht >> 3) * 72 + (ht & 7) * 8, lo1 = lo0 + 32 * 72;
        v4u ra[10], rb[10];
#define HLOAD(R, st) do { const size_t o_ = (size_t)(st) * 4096; R[0] = *(const v4u*)(s0 + o_); R[1] = *(const v4u*)(s0 + o_ + 2048); R[2] = *(const v4u*)(s1 + o_); R[3] = *(const v4u*)(s1 + o_ + 2048); \
        R[4] = *(const v4u*)(s2 + o_); R[5] = *(const v4u*)(s2 + o_ + 2048); R[6] = *(const v4u*)(s3 + o_); R[7] = *(const v4u*)(s3 + o_ + 2048); R[8] = *(const v4u*)(s4 + o_); R[9] = *(const v4u*)(s4 + o_ + 2048); } while (0)
#define HSTORE(R, buf) do { _Pragma("unroll") for (int mt_ = 0; mt_ < 5; ++mt_) { *(LAS v4u*)(OPB(buf, mt_) + lo0) = R[2 * mt_]; *(LAS v4u*)(OPB(buf, mt_) + lo1) = R[2 * mt_ + 1]; } } while (0)
        const int ot = ht >> 2, op = ht & 3;
        const bf16* zp = Z + (size_t)(b * SEQ + ot) * 512 + h * 64 + 16 * op; bf16* ogp = OG + (size_t)(b * SEQ + ot) * 512 + h * 64 + 16 * op;
        float wn[16];
#pragma unroll
        for (int e = 0; e < 16; ++e) wn[e] = onw[16 * op + e];
        v4u zr[2][2];
#define ZLOAD(par, st) do { zr[par][0] = *(const v4u*)(zp + (size_t)(st) * 64 * 512); zr[par][1] = *(const v4u*)(zp + (size_t)(st) * 64 * 512 + 8); } while (0)
#define OUT_STAGE(par, st) do { const v4u o0 = *(const LAS v4u*)(OST(par) + ot * 72 + 16 * op), o1 = *(const LAS v4u*)(OST(par) + ot * 72 + 16 * op + 8); \
        float ov[16] = {bflo(o0.x), bfhi(o0.x), bflo(o0.y), bfhi(o0.y), bflo(o0.z), bfhi(o0.z), bflo(o0.w), bfhi(o0.w), bflo(o1.x), bfhi(o1.x), bflo(o1.y), bfhi(o1.y), bflo(o1.z), bfhi(o1.z), bflo(o1.w), bfhi(o1.w)}; \
        float zv[16] = {bflo(zr[par][0].x), bfhi(zr[par][0].x), bflo(zr[par][0].y), bfhi(zr[par][0].y), bflo(zr[par][0].z), bfhi(zr[par][0].z), bflo(zr[par][0].w), bfhi(zr[par][0].w), \
                        bflo(zr[par][1].x), bfhi(zr[par][1].x), bflo(zr[par][1].y), bfhi(zr[par][1].y), bflo(zr[par][1].z), bfhi(zr[par][1].z), bflo(zr[par][1].w), bfhi(zr[par][1].w)}; \
        float ss_ = 0.f; _Pragma("unroll") for (int e = 0; e < 16; ++e) ss_ += ov[e] * ov[e]; \
        ss_ += __shfl_xor(ss_, 1); ss_ += __shfl_xor(ss_, 2); const float rs_ = rsqrtf(ss_ * (1.f / 64.f) + EPS); float rr[16]; \
        _Pragma("unroll") for (int e = 0; e < 16; ++e) rr[e] = ov[e] * rs_ * wn[e] * (zv[e] * sigmoidf_(zv[e])); \
        v4u w0, w1; w0.x = pk2(rr[0], rr[1]); w0.y = pk2(rr[2], rr[3]); w0.z = pk2(rr[4], rr[5]); w0.w = pk2(rr[6], rr[7]); w1.x = pk2(rr[8], rr[9]); w1.y = pk2(rr[10], rr[11]); w1.z = pk2(rr[12], rr[13]); w1.w = pk2(rr[14], rr[15]); \
        *(v4u*)(ogp + (size_t)(st) * 64 * 512) = w0; *(v4u*)(ogp + (size_t)(st) * 64 * 512 + 8) = w1; } while (0)
        HLOAD(ra, 0); HSTORE(ra, 0); HLOAD(ra, 1); HLOAD(rb, 2); ZLOAD(0, 0);
        SCAN_BAR();
#pragma unroll 1
        for (int n = 0; n < NCHUNK; n += 2) {
            HSTORE(ra, 1); if (n + 3 < NCHUNK) HLOAD(ra, n + 3);
            if (n >= 1) OUT_STAGE(1, n - 1);
            ZLOAD(1, n + 1);
            SCAN_BAR();
            if (n + 2 < NCHUNK) { HSTORE(rb, 0); if (n + 4 < NCHUNK) HLOAD(rb, n + 4); }
            OUT_STAGE(0, n);
            if (n + 2 < NCHUNK) ZLOAD(0, n + 2);
            SCAN_BAR();
        }
        OUT_STAGE(1, NCHUNK - 1);
#undef HLOAD
#undef HSTORE
#undef ZLOAD
#undef OUT_STAGE
    } else {
        const int cs = wave;
        f32x4 S[4];
#pragma unroll
        for (int t = 0; t < 4; ++t) S[t] = (f32x4){0.f, 0.f, 0.f, 0.f};
        SCAN_BAR();
#pragma unroll 1
        for (int n = 0; n < NCHUNK; ++n) {
            const int buf = n & 1; const float glast = glp[bh * NCHUNK + n];
            const bf16x8 sb0 = pack_b(S[0], S[1]), sb1 = pack_b(S[2], S[3]);
            f32x4 vn[4], oa[4];
#pragma unroll
            for (int ct = 0; ct < 4; ++ct) {
                f32x4 av;
#pragma unroll
                for (int r = 0; r < 4; ++r) av[r] = bf2f(OPB(buf, 1)[(16 * ct + 4 * g4 + r) * 72 + 16 * cs + nn]);
                f32x4 ao = (f32x4){0.f, 0.f, 0.f, 0.f};
                av = __builtin_amdgcn_mfma_f32_16x16x32_bf16(afrag(OPB(buf, 0), 16 * ct + nn, 0, g4), sb0, av, 0, 0, 0);
                av = __builtin_amdgcn_mfma_f32_16x16x32_bf16(afrag(OPB(buf, 0), 16 * ct + nn, 1, g4), sb1, av, 0, 0, 0);
                ao = __builtin_amdgcn_mfma_f32_16x16x32_bf16(afrag(OPB(buf, 2), 16 * ct + nn, 0, g4), sb0, ao, 0, 0, 0);
                ao = __builtin_amdgcn_mfma_f32_16x16x32_bf16(afrag(OPB(buf, 2), 16 * ct + nn, 1, g4), sb1, ao, 0, 0, 0);
                vn[ct] = av; oa[ct] = ao; }
            const bf16x8 vb0 = pack_b(vn[0], vn[1]), vb1 = pack_b(vn[2], vn[3]);
#pragma unroll
            for (int ct = 0; ct < 4; ++ct) {
                f32x4 ao = oa[ct], as = S[ct] * glast;
                ao = __builtin_amdgcn_mfma_f32_16x16x32_bf16(afrag(OPB(buf, 3), 16 * ct + nn, 0, g4), vb0, ao, 0, 0, 0);
                ao = __builtin_amdgcn_mfma_f32_16x16x32_bf16(afrag(OPB(buf, 3), 16 * ct + nn, 1, g4), vb1, ao, 0, 0, 0);
                as = __builtin_amdgcn_mfma_f32_16x16x32_bf16(afrag(OPB(buf, 4), 16 * ct + nn, 0, g4), vb0, as, 0, 0, 0);
                as = __builtin_amdgcn_mfma_f32_16x16x32_bf16(afrag(OPB(buf, 4), 16 * ct + nn, 1, g4), vb1, as, 0, 0, 0);
                S[ct] = as;
#pragma unroll
                for (int r = 0; r < 4; ++r) OST(buf)[(16 * ct + 4 * g4 + r) * 72 + 16 * cs + nn] = (bf16)f2bf(ao[r]); }
            SCAN_BAR();
        }
    }
#undef OPB
#undef OST
}
#undef SCAN_BAR

__device__ __forceinline__ void phase_x1h2(Frame& F, const bf16* Y, bf16* H2) {
    LAS float* a1 = (LAS float*)F.lds; LAS float* g2 = a1 + 1024; LAS float* s2 = g2 + 1024;
    const float* xin = IN(I_X); const float* npost = IN(I_NPOSTMIX); const float* npre = IN(I_NPREFFN); const float* b_ada = IN(I_BADA); const float* modp = (const float*)(WSP() + WS_MODP); float* outp = OUTP();
    for (int rb = blockIdx.x; rb < M / 128; rb += F.G) {
        const int row0 = rb * 128, b = row0 / SEQ;
        __syncthreads();
        for (int k = F.tid; k < 1024; k += NTHR) { a1[k] = modv(b_ada, modp, b, 2048 + k) * npost[k]; g2[k] = npre[k] * (1.f + modv(b_ada, modp, b, 4096 + k)); s2[k] = modv(b_ada, modp, b, 3072 + k); }
        __syncthreads();
        for (int r = 0; r < 16; ++r) { const int row = row0 + F.wave * 16 + r;
            const v2u* yr = (const v2u*)(Y + (size_t)row * D) + F.lane; const f32x4* xr = (const f32x4*)(xin + (size_t)row * D) + F.lane;
            f32x4 y[4], xv[4]; float ss = 0.f;
#pragma unroll
            for (int j = 0; j < 4; ++j) { const v2u t = yr[64 * j]; y[j] = (f32x4){bflo(t.x), bfhi(t.x), bflo(t.y), bfhi(t.y)}; xv[j] = xr[64 * j];
                ss += (y[j][0] * y[j][0] + y[j][1] * y[j][1]) + (y[j][2] * y[j][2] + y[j][3] * y[j][3]); }
            const float rstd = rsqrtf(wave_sum(ss) * (1.f / D) + EPS); float s1 = 0.f;
            f32x4* orow = (f32x4*)(outp + (size_t)row * D) + F.lane;
#pragma unroll
            for (int j = 0; j < 4; ++j) { const int k = 4 * F.lane + 256 * j; const f32x4 a = *(const LAS f32x4*)(a1 + k);
                xv[j] = xv[j] + a * (y[j] * rstd); orow[64 * j] = xv[j];
                s1 += (xv[j][0] * xv[j][0] + xv[j][1] * xv[j][1]) + (xv[j][2] * xv[j][2] + xv[j][3] * xv[j][3]); }
            const float rstd1 = rsqrtf(wave_sum(s1) * (1.f / D) + EPS);
            v2u* o8 = (v2u*)(H2 + (size_t)row * D) + F.lane;
#pragma unroll
            for (int j = 0; j < 4; ++j) { const int k = 4 * F.lane + 256 * j; const f32x4 g = *(const LAS f32x4*)(g2 + k), s = *(const LAS f32x4*)(s2 + k);
                v2u o; o.x = pk2(xv[j][0] * rstd1 * g[0] + s[0], xv[j][1] * rstd1 * g[1] + s[1]); o.y = pk2(xv[j][2] * rstd1 * g[2] + s[2], xv[j][3] * rstd1 * g[3] + s[3]); o8[64 * j] = o; }
        }
    }
}

__device__ __forceinline__ unsigned mono(float f) { const unsigned u = __float_as_uint(f); return u ^ ((unsigned)((int)u >> 31) | 0x80000000u); }
__device__ __forceinline__ float unmono(unsigned k) { return __uint_as_float((k & 0x80000000u) ? (k ^ 0x80000000u) : ~k); }
#define CE_DESC(a, b) do { const unsigned _mx = max((a), (b)), _mn = min((a), (b)); (a) = _mx; (b) = _mn; } while (0)
__device__ __forceinline__ void top16_of_64(unsigned (&x)[64]) {
#pragma unroll
    for (int g = 0; g < 4; ++g)
#pragma unroll
        for (int k = 2; k <= 16; k <<= 1)
#pragma unroll
            for (int j = k >> 1; j > 0; j >>= 1)
#pragma unroll
                for (int i = 0; i < 16; ++i) { const int l = i ^ j; if (l > i) { if ((i & k) == 0) CE_DESC(x[16 * g + i], x[16 * g + l]); else CE_DESC(x[16 * g + l], x[16 * g + i]); } }
#pragma unroll
    for (int s = 0; s < 3; ++s) { const int a = (s == 1) ? 32 : 0, b2 = (s == 0) ? 16 : (s == 1 ? 48 : 32);
#pragma unroll
        for (int i = 0; i < 16; ++i) x[a + i] = max(x[a + i], x[b2 + 15 - i]);
#pragma unroll
        for (int j = 8; j > 0; j >>= 1)
#pragma unroll
            for (int i = 0; i < 16; ++i) { const int l = i ^ j; if (l > i) CE_DESC(x[a + i], x[a + l]); } }
}
__device__ __forceinline__ void phase_topk(Frame& F, const bf16* Q2, int* EI, float* GA) {
    const int lane = F.lane, wave = F.wave, r = lane & 31, hh = lane >> 5, tsub = wave & 3, hgrp = wave >> 2;
    const bf16* skp = (const bf16*)(WSP() + WS_SK);
    LAS unsigned char* itab = F.lds + wave * 1024;
    for (int tile = blockIdx.x; tile < M / 128; tile += F.G) {
        const int m = tile * 128 + tsub * 32 + r;
#pragma unroll 1
        for (int hd = 0; hd < 4; ++hd) { const int h = hgrp * 4 + hd;
            unsigned k12[2][16];
#pragma unroll
            for (int p = 0; p < 2; ++p) {
                bf16x8 bq[8];
#pragma unroll
                for (int ks = 0; ks < 8; ++ks) bq[ks] = *(const bf16x8*)(Q2 + (size_t)m * 2048 + h * 256 + p * 128 + ks * 16 + hh * 8);
                unsigned keys[64];
#pragma unroll
                for (int kt = 0; kt < 4; ++kt) {
                    f32x16 acc;
#pragma unroll
                    for (int i = 0; i < 16; ++i) acc[i] = 0.f;
                    const bf16* skr = skp + ((size_t)(h * 2 + p) * 128 + kt * 32 + r) * 128 + hh * 8;
#pragma unroll
                    for (int ks = 0; ks < 8; ++ks) { const bf16x8 a = *(const bf16x8*)(skr + ks * 16); acc = __builtin_amdgcn_mfma_f32_32x32x16_bf16(a, bq[ks], acc, 0, 0, 0); }
#pragma unroll
                    for (int i = 0; i < 16; ++i) { const int keyidx = kt * 32 + (i & 3) + 8 * (i >> 2) + 4 * hh; keys[kt * 16 + i] = (mono(acc[i]) & ~127u) | (unsigned)(127 - keyidx); }
                }
                top16_of_64(keys);
                unsigned oth[16];
#pragma unroll
                for (int i = 0; i < 16; ++i) oth[i] = (unsigned)__shfl_xor((int)keys[i], 32);
#pragma unroll
                for (int i = 0; i < 16; ++i) keys[i] = max(keys[i], oth[15 - i]);
#pragma unroll
                for (int j = 8; j > 0; j >>= 1)
#pragma unroll
                    for (int i = 0; i < 16; ++i) { const int l = i ^ j; if (l > i) CE_DESC(keys[i], keys[l]); }
#pragma unroll
                for (int i = 0; i < 16; ++i) k12[p][i] = keys[i];
            }
            float v1[16], v2[16];
#pragma unroll
            for (int i = 0; i < 16; ++i) { v1[i] = unmono(k12[0][i] & ~127u); v2[i] = unmono(k12[1][i] & ~127u); }
            if (hh == 0) {
                v4u w0, w1;
#define PK4(K, b) ((127u - ((K)[b] & 127u)) | ((127u - ((K)[b + 1] & 127u)) << 8) | ((127u - ((K)[b + 2] & 127u)) << 16) | ((127u - ((K)[b + 3] & 127u)) << 24))
                w0.x = PK4(k12[0], 0); w0.y = PK4(k12[0], 4); w0.z = PK4(k12[0], 8); w0.w = PK4(k12[0], 12);
                w1.x = PK4(k12[1], 0); w1.y = PK4(k12[1], 4); w1.z = PK4(k12[1], 8); w1.w = PK4(k12[1], 12);
#undef PK4
                *(LAS v4u*)(itab + r * 32) = w0; *(LAS v4u*)(itab + r * 32 + 16) = w1; }
            unsigned ck[64];
            { int nn = 0;
#pragma unroll
              for (int i = 0; i < 16; ++i)
#pragma unroll
                  for (int j = 0; j < 16; ++j) if ((i + 1) * (j + 1) <= 16) { ck[nn] = (mono(v1[i] + v2[j]) & ~255u) | (unsigned)(255 - (i * 16 + j)); ++nn; }
#pragma unroll
              for (int q = 50; q < 64; ++q) ck[q] = 0u; }
            top16_of_64(ck);
            asm volatile("s_waitcnt lgkmcnt(0)" ::: "memory");
            float ts[16], es[16]; int ei[16]; float sum = 0.f;
#pragma unroll
            for (int q = 0; q < 16; ++q) { ts[q] = unmono(ck[q] & ~255u); const unsigned pos = 255u - (ck[q] & 255u);
                const unsigned e1 = itab[r * 32 + (pos >> 4)], e2 = itab[r * 32 + 16 + (pos & 15u)]; ei[q] = (int)(e1 * 128u + e2); }
#pragma unroll
            for (int q = 0; q < 16; ++q) { es[q] = __expf(ts[q] - ts[0]); sum += es[q]; }
            const float inv = 1.0f / sum;
            int eo[8]; float go[8];
#pragma unroll
            for (int q = 0; q < 8; ++q) { eo[q] = hh ? ei[q + 8] : ei[q]; go[q] = (hh ? es[q + 8] : es[q]) * inv; }
            int* ep = EI + (size_t)m * 128 + h * 16 + hh * 8; float* gp = GA + (size_t)m * 128 + h * 16 + hh * 8;
            *(v4u*)ep = (v4u){(unsigned)eo[0], (unsigned)eo[1], (unsigned)eo[2], (unsigned)eo[3]}; *(v4u*)(ep + 4) = (v4u){(unsigned)eo[4], (unsigned)eo[5], (unsigned)eo[6], (unsigned)eo[7]};
            *(f32x4*)gp = (f32x4){go[0], go[1], go[2], go[3]}; *(f32x4*)(gp + 4) = (f32x4){go[4], go[5], go[6], go[7]};
            asm volatile("s_waitcnt lgkmcnt(0)" ::: "memory");
        }
    }
}

typedef float f32x2 __attribute__((ext_vector_type(2)));
struct RowBuf { v4u u[2], v[2]; float su, svg; };
__device__ __forceinline__ void gather_load(RowBuf& B, int step, int g, int j, int e_lo, int e_hi, float g_lo, float g_hi, const unsigned char* tu, const unsigned char* tv, const float* su, const float* sv) {
    const int src = (step * 2 + g) & 63;
    const int eidx = __shfl(step < 32 ? e_lo : e_hi, src); const float gate = __shfl(step < 32 ? g_lo : g_hi, src);
    const unsigned char* ur = tu + (size_t)eidx * 1024 + 32 * j; const unsigned char* vr = tv + (size_t)eidx * 1024 + 32 * j;
    B.u[0] = *(const v4u*)ur; B.u[1] = *(const v4u*)(ur + 16); B.v[0] = *(const v4u*)vr; B.v[1] = *(const v4u*)(vr + 16);
    B.su = su[eidx]; B.svg = gate * sv[eidx];
}
__device__ __forceinline__ void gather_compute(const RowBuf& B, const unsigned (&hp)[16], float (&y)[32]) {
    float d0 = 0.f, d1 = 0.f;
#pragma unroll
    for (int i = 0; i < 2; ++i)
#pragma unroll
        for (int q = 0; q < 4; ++q) { const f32x2 a = __builtin_amdgcn_cvt_pk_f32_fp8(B.u[i][q], false), b = __builtin_amdgcn_cvt_pk_f32_fp8(B.u[i][q], true);
            const unsigned w0 = hp[i * 8 + 2 * q], w1 = hp[i * 8 + 2 * q + 1];
            d0 += a.x * bflo(w0) + a.y * bfhi(w0); d1 += b.x * bflo(w1) + b.y * bfhi(w1); }
    float d = d0 + d1;
    d += __shfl_xor(d, 1); d += __shfl_xor(d, 2); d += __shfl_xor(d, 4); d += __shfl_xor(d, 8); d += __shfl_xor(d, 16);
    d *= B.su;
    const float wgt = B.svg * 0.5f * d * (1.0f + erff(d * 0.70710678118654752f));
#pragma unroll
    for (int i = 0; i < 2; ++i)
#pragma unroll
        for (int q = 0; q < 4; ++q) { const f32x2 a = __builtin_amdgcn_cvt_pk_f32_fp8(B.v[i][q], false), b = __builtin_amdgcn_cvt_pk_f32_fp8(B.v[i][q], true);
            y[i * 16 + 4 * q] += wgt * a.x; y[i * 16 + 4 * q + 1] += wgt * a.y; y[i * 16 + 4 * q + 2] += wgt * b.x; y[i * 16 + 4 * q + 3] += wgt * b.y; }
}
__device__ __forceinline__ void phase_gather(Frame& F, const bf16* H2, const int* EI, const float* GA) {
    LAS float* a2 = (LAS float*)F.lds;
    unsigned char* ws = WSP(); const unsigned char* tu = ws + WS_TU; const unsigned char* tv = ws + WS_TV; const float* su = (const float*)(ws + WS_SU); const float* sv = (const float*)(ws + WS_SV); float* outp = OUTP();
    const float* npf = IN(I_NPOSTFFN); const float* b_ada = IN(I_BADA); const float* modp = (const float*)(ws + WS_MODP);
    const int lane = F.lane, g = lane >> 5, j = lane & 31;
    for (int rb = blockIdx.x; rb < M / 128; rb += F.G) {
        const int row0 = rb * 128, b = row0 / SEQ;
        __syncthreads();
        for (int k = F.tid; k < 1024; k += NTHR) a2[k] = modv(b_ada, modp, b, 5120 + k) * npf[k];
        __syncthreads();
        for (int ti = 0; ti < 16; ++ti) { const int m = row0 + F.wave * 16 + ti;
            unsigned hp[16];
#pragma unroll
            for (int i = 0; i < 4; ++i) { const v4u h0 = *(const v4u*)(H2 + (size_t)m * D + 32 * j + 8 * i); hp[i * 4 + 0] = h0.x; hp[i * 4 + 1] = h0.y; hp[i * 4 + 2] = h0.z; hp[i * 4 + 3] = h0.w; }
            const int e_lo = EI[(size_t)m * 128 + lane], e_hi = EI[(size_t)m * 128 + 64 + lane];
            const float g_lo = GA[(size_t)m * 128 + lane], g_hi = GA[(size_t)m * 128 + 64 + lane];
            float y[32];
#pragma unroll
            for (int q = 0; q < 32; ++q) y[q] = 0.f;
            RowBuf B0, B1, B2, B3;
#define GLOAD(B, st) gather_load(B, (st), g, j, e_lo, e_hi, g_lo, g_hi, tu, tv, su, sv)
            GLOAD(B0, 0); GLOAD(B1, 1); GLOAD(B2, 2);
#pragma unroll 1
            for (int st = 0; st < 64; st += 4) {
#define SB() __builtin_amdgcn_sched_barrier(0)
                GLOAD(B3, st + 3); SB(); gather_compute(B0, hp, y); SB();
                if (st + 4 < 64) GLOAD(B0, st + 4); SB(); gather_compute(B1, hp, y); SB();
                if (st + 4 < 64) GLOAD(B1, st + 5); SB(); gather_compute(B2, hp, y); SB();
                if (st + 4 < 64) GLOAD(B2, st + 6); SB(); gather_compute(B3, hp, y); SB();
#undef SB
            }
#undef GLOAD
            float ss = 0.f;
#pragma unroll
            for (int q = 0; q < 32; ++q) { y[q] += __shfl_xor(y[q], 32); ss += y[q] * y[q]; }
            ss += __shfl_xor(ss, 1); ss += __shfl_xor(ss, 2); ss += __shfl_xor(ss, 4); ss += __shfl_xor(ss, 8); ss += __shfl_xor(ss, 16);
            const float rstd = rsqrtf(ss * (1.f / D) + EPS);
            const int k = 32 * j + 16 * g;
            f32x4* op = (f32x4*)(outp + (size_t)m * D + k);
#pragma unroll
            for (int q = 0; q < 4; ++q) { f32x4 xv = op[q]; const f32x4 av = *(const LAS f32x4*)(a2 + k + 4 * q);
#pragma unroll
                for (int t = 0; t < 4; ++t) { const int e = 4 * q + t; const float yy = g ? y[16 + e] : y[e]; xv[t] += av[t] * yy * rstd; }
                op[q] = xv; }
        }
    }
}

typedef GAS unsigned gu32;
#define XB_TMO      128
#define XB_XCNT(j)  (256  + 64 * (j))
#define XB_XSUB(j)  (1280 + 64 * (j))
#define XB_XGEN(j)  (2304 + 64 * (j))
#define XB_TOP      3328
#define XB_TOPGEN   3392
#define XCD_BAR_WORDS 3456
#define XB_SPIN_CAP (1u << 18)

__device__ __forceinline__ unsigned xb_ld(unsigned* p)              { return __hip_atomic_load(p, __ATOMIC_RELAXED, __HIP_MEMORY_SCOPE_AGENT); }
__device__ __forceinline__ unsigned xb_add(unsigned* p, unsigned v) { return __hip_atomic_fetch_add(p, v, __ATOMIC_RELAXED, __HIP_MEMORY_SCOPE_AGENT); }
__device__ __forceinline__ unsigned xb_xcc_id() { return (unsigned)__builtin_amdgcn_s_getreg((3 << 11) | 20) & 0xFu; }
#define XB_SPIN(cond, bar) do { unsigned _sp = 0; while (cond) { __builtin_amdgcn_s_sleep(1); \
    if ((++_sp & 255u) == 0u) { if (xb_ld(&(bar)[XB_TMO])) break; if (_sp > XB_SPIN_CAP) { atomicAdd(&(bar)[XB_TMO], 1u); break; } } } } while (0)

struct XcdBarrier {
    unsigned* bar; unsigned x;
    volatile LAS unsigned* st;
};

__device__ __forceinline__ XcdBarrier xcd_barrier_post(unsigned* bar, volatile LAS unsigned* st) {
    XcdBarrier b; b.bar = bar; b.x = xb_xcc_id(); b.st = st;
    if (threadIdx.x == 0) (void)xb_add(&bar[XB_XCNT(b.x)], 1u);
    return b;
}
__device__ __forceinline__ void xcd_barrier_complete(unsigned* bar, unsigned x, unsigned& nloc, unsigned& nx) {
    const unsigned G = gridDim.x * gridDim.y * gridDim.z;
    unsigned sum, cnt, mine, sp = 0u;
    for (;;) {
        sum = 0u; cnt = 0u; mine = 0u;
#pragma unroll
        for (unsigned j = 0; j < 16; ++j) { const unsigned c = xb_ld(&bar[XB_XCNT(j)]); sum += c; cnt += (c > 0u) ? 1u : 0u; mine = (j == x) ? c : mine; }
        if (sum == G) break;
        __builtin_amdgcn_s_sleep(1);
        if ((++sp & 255u) == 0u) { if (xb_ld(&bar[XB_TMO])) break; if (sp > XB_SPIN_CAP) { atomicAdd(&bar[XB_TMO], 1u); break; } }
    }
    nloc = mine > 0u ? mine : 1u; nx = cnt > 0u ? cnt : 1u;
}

__device__ __forceinline__ void xcd_barrier(const XcdBarrier& b) {
    asm volatile("s_waitcnt vmcnt(0)" ::: "memory");
    __syncthreads();
    if (threadIdx.x == 0) {
        unsigned* bar = b.bar;
        __builtin_amdgcn_s_waitcnt(0);
        unsigned nloc = b.st[0], nx = b.st[1];
        if (nloc == 0u) { xcd_barrier_complete(bar, b.x, nloc, nx); b.st[0] = nloc; b.st[1] = nx; }
        const unsigned old = xb_add(&bar[XB_XSUB(b.x)], 1u);
        const unsigned gen = old / nloc;
        if (old + 1u == (gen + 1u) * nloc) {
            __builtin_amdgcn_fence(__ATOMIC_RELEASE, "agent");
            asm volatile("s_waitcnt vmcnt(0)" ::: "memory");
            const unsigned og = xb_add(&bar[XB_TOP], 1u);
            const unsigned tg = og / nx;
            if (og + 1u == (tg + 1u) * nx) xb_add(&bar[XB_TOPGEN], 1u);
            else XB_SPIN(xb_ld(&bar[XB_TOPGEN]) == tg, bar);
            __builtin_amdgcn_fence(__ATOMIC_ACQUIRE, "agent");
            xb_add(&bar[XB_XGEN(b.x)], 1u);
            asm volatile("s_waitcnt vmcnt(0)" ::: "memory");
        } else {
            XB_SPIN(xb_ld(&bar[XB_XGEN(b.x)]) == gen, bar);
            __builtin_amdgcn_fence(__ATOMIC_ACQUIRE, "agent");
            asm volatile("s_waitcnt vmcnt(0)" ::: "memory");
        }
    }
    __syncthreads();
}

struct Args { const float* in[21]; float* out; unsigned char* ws; };
__global__ void __launch_bounds__(NTHR, 2) fwd_megakernel(Args args) {
    extern __shared__ __attribute__((aligned(16))) unsigned char lds[];
#define MKFRAME() Frame F; { int t_ = threadIdx.x; asm volatile("" : "+v"(t_)); F.lds = (LAS unsigned char*)lds; F.tid = t_; F.lane = t_ & 63; F.wave = __builtin_amdgcn_readfirstlane(t_ >> 6); F.G = gridDim.x; }
#define GRID_SYNC() cg::this_grid().sync()
    volatile LAS unsigned* bst = (volatile LAS unsigned*)((LAS unsigned char*)lds + LDS_BYTES - 64);
    if (threadIdx.x < 16) bst[threadIdx.x] = 0u;
    __syncthreads();
    const XcdBarrier xbar = xcd_barrier_post((unsigned*)(WSP() + WS_CTL) + 1024, bst);
#define XSYNC() xcd_barrier(xbar)
#define WSB(off) ((bf16*)(WSP() + (off)))
#define SEGP(s) segp(WSP(), (s))
    { MKFRAME();
    phase_prologue(F);
    }
    GRID_SYNC();
    { MKFRAME();
    phase_h1(F, (bf16*)OUTP());
    }
    XSYNC();
    { MKFRAME();
    {
        pg8::Gemm g{(const bf16*)OUTP(), WSB(WS_WIN), M, NIN, D}; pg8::StaticOrder S; S.init(M, NIN, F.G, (int)blockIdx.x);
        pg8::EpiBf16<0> E{SEGP(0), 512, nullptr, 512, SEG_ELEMS, 1.f};
        pg8::gemm_phase<pg8::EpiBf16<0>, pg8::StaticOrder, true, true>(F.lds, g, S, E);
    }
    }
    XSYNC();
    { MKFRAME();
    phase_scprep(F);
    { bf16* dW = (bf16*)OUTP(); phase_dnprep(F, dW, dW + (size_t)NITEM * 4096, dW + (size_t)2 * NITEM * 4096, dW + (size_t)3 * NITEM * 4096, WSB(WS_KD)); }
    }
    XSYNC();
    { MKFRAME();
    { const bf16* dW = (const bf16*)OUTP(); phase_scan(F, dW, dW + (size_t)NITEM * 4096, dW + (size_t)2 * NITEM * 4096, dW + (size_t)3 * NITEM * 4096, WSB(WS_KD), SEGP(3), SEGP(6)); }
    }
    XSYNC();
    { MKFRAME();
    {
        pg8::StaticOrder S; S.init(M, D, F.G, (int)blockIdx.x);
        { pg8::Gemm g{SEGP(0), WSB(WS_WSC), M, D, 512}; pg8::EpiGate<false> E{SEGP(4), SEGP(7), SEG_ELEMS};
          pg8::gemm_phase<pg8::EpiGate<false>, pg8::StaticOrder, true, true>(F.lds, g, S, E); }
        { pg8::Gemm g{SEGP(3), WSB(WS_WDN), M, D, 512}; pg8::EpiGate<true> E{SEGP(4), SEGP(9), SEG_ELEMS};
          pg8::gemm_phase<pg8::EpiGate<true>, pg8::StaticOrder, true, true>(F.lds, g, S, E); }
    }
    }
    XSYNC();
    { MKFRAME();
    {
        pg8::Gemm g{SEGP(4), WSB(WS_WMIX), M, D, D}; pg8::StaticOrder S; S.init(M, D, F.G, (int)blockIdx.x);
        pg8::EpiBf16<0> E{SEGP(1), D, nullptr, 0, 0, 1.f};
        pg8::gemm_phase<pg8::EpiBf16<0>, pg8::StaticOrder, true, true>(F.lds, g, S, E);
    }
    }
    XSYNC();
    { MKFRAME();
    phase_x1h2(F, SEGP(1), SEGP(7));
    }
    XSYNC();
    { MKFRAME();
    {
        pg8::Gemm g{SEGP(7), WSB(WS_WQ), M, 2048, D}; pg8::StaticOrder S; S.init(M, 2048, F.G, (int)blockIdx.x);
        pg8::EpiBf16<0> E{SEGP(3), 2048, nullptr, 0, 0, 1.f};
        pg8::gemm_phase<pg8::EpiBf16<0>, pg8::StaticOrder, true, true>(F.lds, g, S, E);
    }
    }
    XSYNC();
    { MKFRAME();
    phase_topk(F, SEGP(3), (int*)SEGP(0), (float*)((unsigned char*)SEGP(0) + 16 * MiB));
    }
    XSYNC();
    { MKFRAME();
    phase_gather(F, SEGP(7), (const int*)SEGP(0), (const float*)((unsigned char*)SEGP(0) + 16 * MiB));
    }
}

extern "C" void kernel_launch(void* const* d_in, const int* in_sizes, int n_in, void* d_out, int out_size, void* d_ws, size_t ws_size, hipStream_t stream) {
    static int grid = 0;
    if (grid == 0) {
        if (n_in != 21 || out_size != M * D || ws_size < WS_END) { fprintf(stderr, "kernel_launch: unexpected problem (n_in %d, out %d, ws %zu)\n", n_in, out_size, ws_size); grid = -1; return; }
        int dev = 0, cus = 0, per_cu = 0;
        hipGetDevice(&dev); hipDeviceGetAttribute(&cus, hipDeviceAttributeMultiprocessorCount, dev);
        hipFuncSetAttribute((const void*)fwd_megakernel, hipFuncAttributeMaxDynamicSharedMemorySize, LDS_BYTES);
        hipOccupancyMaxActiveBlocksPerMultiprocessor(&per_cu, (const void*)fwd_megakernel, NTHR, LDS_BYTES);
        if (per_cu < 1) { fprintf(stderr, "kernel_launch: occupancy query says %d blocks per CU\n", per_cu); per_cu = 1; }
        if (per_cu > 1) per_cu = 1;
        grid = cus * per_cu; if (grid > 256) grid = 256;
        (void)hipGetLastError();
    }
    if (grid < 0) return;
    if (hipMemsetAsync((char*)d_ws + WS_CTL, 0, 65536, stream) != hipSuccess) { fprintf(stderr, "kernel_launch: memset of the barrier words failed\n"); return; }
    Args a{};
    for (int i = 0; i < 21; ++i) a.in[i] = (const float*)d_in[i];
    a.out = (float*)d_out; a.ws = (unsigned char*)d_ws;
    void* kargs[] = {&a};
    hipError_t e = hipLaunchCooperativeKernel((const void*)fwd_megakernel, dim3(grid), dim3(NTHR), kargs, LDS_BYTES, stream);
    if (e != hipSuccess) fprintf(stderr, "cooperative launch failed: %s (grid %d)\n", hipGetErrorString(e), grid);
}
```

```cpp
#include <hip/hip_runtime.h>
#include <hip/hip_cooperative_groups.h>
#include <cstdio>
#include <cstdint>
namespace cg = cooperative_groups;
namespace pg8 {
#define PG8_LAS __attribute__((address_space(3)))
typedef unsigned short bf16_t;
typedef short bf16x8 __attribute__((ext_vector_type(8)));
typedef float f32x4 __attribute__((ext_vector_type(4)));
typedef unsigned u32x4 __attribute__((ext_vector_type(4)));
constexpr int BM = 256, BK = 64, HALF = 128, HTB = HALF * BK * 2  , STAGE_BYTES = 8 * HTB, NXCD = 8, WGM = 8;

__host__ __device__ __forceinline__ int lds_byte(int r, int c) { const int st = (r >> 4) * 2 + (c >> 5), rr = r & 15, cc = c & 31, ob = rr * 64 + cc * 2; return st * 1024 + (ob ^ (((ob >> 9) & 1) << 5)); }
__host__ __device__ __forceinline__ void stage_rc(int b, int& R, int& C) { const int st = b / 1024, sb = b % 1024, swz = sb ^ (((sb >> 9) & 1) << 5); R = (st >> 1) * 16 + swz / 64; C = (st & 1) * 32 + (swz % 64) / 2; }
__host__ __device__ __forceinline__ int perm32(int rho) { const int n = rho >> 4, i = rho & 15; return 8 * (i >> 2) + 4 * n + (i & 3); }

struct Unit { int pm, pn; };
struct Gemm { const bf16_t* A; const bf16_t* Bt; int M, N, K; };

struct StaticOrder {
    int nM, nN, nwg, G, c;
    __host__ __device__ void init(int M, int N, int G_, int c_) { nM = M / BM; nN = N / BM; nwg = nM * nN; G = G_; c = c_; }
    __host__ __device__ bool next(int i, Unit& u) const {
        const long L = (long)i * G + c; if (L >= nwg) return false;
        int wgid = (int)L; { const int q = nwg / NXCD, r = nwg % NXCD, xcd = wgid % NXCD, off = wgid / NXCD; wgid = (xcd < r ? xcd * (q + 1) : r * (q + 1) + (xcd - r) * q) + off; }
        const int nig = WGM * nN, gid = wgid / nig, fm = gid * WGM, gsz = (nM - fm) < WGM ? (nM - fm) : WGM;
        u.pm = fm + ((wgid % nig) % gsz); u.pn = (wgid % nig) / gsz; return true;
    }
    __device__ __forceinline__ void a_ready(const Unit&) const {}
    __device__ __forceinline__ void done(const Unit&) const {}
};

__device__ __forceinline__ unsigned cvt_pk_bf16(float lo, float hi) { unsigned r; asm volatile("v_cvt_pk_bf16_f32 %0, %1, %2" : "=v"(r) : "v"(lo), "v"(hi)); return r; }
typedef float f32x2 __attribute__((ext_vector_type(2)));
__device__ __forceinline__ f32x2 gelu_pk(f32x2 v) {
    const f32x2 av = __builtin_elementwise_abs(v), d = av * 0.2316418882f + 1.0f;
    f32x2 t; t.x = __builtin_amdgcn_rcpf(d.x); t.y = __builtin_amdgcn_rcpf(d.y);
    f32x2 q = t * 0.5307027145f + (-0.7265760135f); q = q * t + 0.7107068705f; q = q * t + (-0.142248368f); q = q * t + 0.127414796f; q = q * t;
    const f32x2 s = (v * v) * (-0.72134752044f);
    f32x2 e; e.x = __builtin_amdgcn_exp2f(s.x); e.y = __builtin_amdgcn_exp2f(s.y);
    const f32x2 m = v * (q * e), r = v - m;
    f32x2 o; o.x = v.x < 0.f ? m.x : r.x; o.y = v.y < 0.f ? m.y : r.y; return o;
}

template <int ACT  > struct EpiBf16 {
    static constexpr bool PERM = true, AFTER_DRAIN = false; static_assert(ACT == 0 || ACT == 1, "EpiBf16: ACT is 0 (none) or 1 (gelu_pk)");
    bf16_t* O; int ldc; const float* bias; int split_cols; size_t split_stride; float scale0;
    __device__ __forceinline__ void operator()(const f32x4 (&acc)[2][2][4][2], const Unit& u, int wr, int wc, int fr, int fq) const {
        const int row0 = u.pm * BM + wr * 64 + fr; int colt = u.pn * BM; bf16_t* base = O;
        float sc = 1.f; if (split_cols) { const int t = colt / split_cols; base += (size_t)t * split_stride; colt -= t * split_cols; if (t == 0) sc = scale0; }
        const int col0 = colt + wc * 32 + 8 * fq, bcol0 = u.pn * BM + wc * 32 + 8 * fq;
        f32x4 bv[2][2];
#pragma unroll
        for (int bj = 0; bj < 2; ++bj)
#pragma unroll
            for (int n = 0; n < 2; ++n) bv[bj][n] = bias ? *(const f32x4*)(bias + bcol0 + bj * HALF + 4 * n) : (f32x4){0.f, 0.f, 0.f, 0.f};
#pragma unroll
        for (int ai = 0; ai < 2; ++ai)
#pragma unroll
            for (int m = 0; m < 4; ++m) { bf16_t* rowp = base + (size_t)(row0 + ai * HALF + m * 16) * ldc + col0;
#pragma unroll
                for (int bj = 0; bj < 2; ++bj) { f32x4 v0 = acc[ai][bj][m][0] + bv[bj][0], v1 = acc[ai][bj][m][1] + bv[bj][1];
                    if (ACT == 1) { f32x2 a = gelu_pk((f32x2){v0[0], v0[1]}), b = gelu_pk((f32x2){v0[2], v0[3]}), c = gelu_pk((f32x2){v1[0], v1[1]}), d = gelu_pk((f32x2){v1[2], v1[3]});
                        v0 = (f32x4){a.x, a.y, b.x, b.y}; v1 = (f32x4){c.x, c.y, d.x, d.y}; }
                    v0 = v0 * sc; v1 = v1 * sc; u32x4 w; w.x = cvt_pk_bf16(v0[0], v0[1]); w.y = cvt_pk_bf16(v0[2], v0[3]); w.z = cvt_pk_bf16(v1[0], v1[1]); w.w = cvt_pk_bf16(v1[2], v1[3]);
                    *(u32x4*)(rowp + bj * HALF) = w; } }
    }
};
__device__ __forceinline__ float bf_lo(unsigned u) { return __uint_as_float(u << 16); }
__device__ __forceinline__ float bf_hi(unsigned u) { return __uint_as_float(u & 0xffff0000u); }
__device__ __forceinline__ float sigm(float x) { return __builtin_amdgcn_rcpf(1.0f + __builtin_amdgcn_exp2f(-1.4426950408889634f * x)); }
template <bool ADD> struct EpiGate {
    static constexpr bool PERM = true, AFTER_DRAIN = false;
    bf16_t* O; const bf16_t* gate; size_t seg_elems;
    __device__ __forceinline__ void operator()(const f32x4 (&acc)[2][2][4][2], const Unit& u, int wr, int wc, int fr, int fq) const {
        const int row0 = u.pm * BM + wr * 64 + fr, col0 = u.pn * BM + wc * 32 + 8 * fq;
#pragma unroll
        for (int ai = 0; ai < 2; ++ai)
#pragma unroll
            for (int m = 0; m < 4; ++m) { const int row = row0 + ai * HALF + m * 16;
#pragma unroll
                for (int bj = 0; bj < 2; ++bj) { const int col = col0 + bj * HALF;
                    const u32x4 gv = *(const u32x4*)(gate + (size_t)(col >> 9) * seg_elems + (size_t)row * 512 + (col & 511));
                    bf16_t* op = O + (size_t)row * 1024 + col;
                    f32x4 v0 = acc[ai][bj][m][0], v1 = acc[ai][bj][m][1];
                    v0[0] *= sigm(bf_lo(gv.x)); v0[1] *= sigm(bf_hi(gv.x)); v0[2] *= sigm(bf_lo(gv.y)); v0[3] *= sigm(bf_hi(gv.y));
                    v1[0] *= sigm(bf_lo(gv.z)); v1[1] *= sigm(bf_hi(gv.z)); v1[2] *= sigm(bf_lo(gv.w)); v1[3] *= sigm(bf_hi(gv.w));
                    if (ADD) { const u32x4 ov = *(const u32x4*)op;
                        v0[0] += bf_lo(ov.x); v0[1] += bf_hi(ov.x); v0[2] += bf_lo(ov.y); v0[3] += bf_hi(ov.y);
                        v1[0] += bf_lo(ov.z); v1[1] += bf_hi(ov.z); v1[2] += bf_lo(ov.w); v1[3] += bf_hi(ov.w); }
                    u32x4 w; w.x = cvt_pk_bf16(v0[0], v0[1]); w.y = cvt_pk_bf16(v0[2], v0[3]); w.z = cvt_pk_bf16(v1[0], v1[1]); w.w = cvt_pk_bf16(v1[2], v1[3]);
                    *(u32x4*)op = w; } }
    }
};
template <class Epi, class Sched, bool ALIGN_EPI = false, bool SP2 = false>
__device__ __forceinline__ void gemm_phase(PG8_LAS unsigned char* lds, const Gemm g, const Sched& S, const Epi& E) {
    int tid_ = threadIdx.x; asm volatile("" : "+v"(tid_));
    const int tid = tid_, wid = __builtin_amdgcn_readfirstlane(tid >> 6), lane = tid & 63, wr = wid >> 2, wc = wid & 3, fr = lane & 15, fq = lane >> 4;
    const int K = g.K, nt = K / BK;
    unsigned voffA[2], voffB[2];
#pragma unroll
    for (int i = 0; i < 2; ++i) { int R, C; stage_rc(tid * 16 + i * 8192, R, C); const int Rb = Epi::PERM ? ((R & ~31) + perm32(R & 31)) : R;
        voffA[i] = (unsigned)(R * K + C) * 2u; voffB[i] = (unsigned)(Rb * K + C) * 2u; }
    const size_t kstep = (size_t)(BK * 2);
    const size_t hstep = (size_t)HALF * K * 2;
    const size_t tstep = 2 * hstep;
    const unsigned ldsw = (unsigned)wid * 1024u;
    const int aoff = lds_byte(wr * 64 + fr, fq * 8), boff = lds_byte(wc * 32 + fr, fq * 8);
#define PG8_SA(b, h) (((b) * 2 + (h)) * HTB)
#define PG8_SB(b, h) ((4 + (b) * 2 + (h)) * HTB)
#define PG8_STAGE(bufoff, gbase, voff) do { _Pragma("unroll") for (int _i = 0; _i < 2; ++_i) \
        __builtin_amdgcn_global_load_lds((const unsigned*)((const char*)(gbase) + (voff)[_i]), (PG8_LAS unsigned*)(lds + (bufoff) + ldsw + _i * 8192), 16, 0, 0); } while (0)
#define PG8_LDA(dst, b, h) do { _Pragma("unroll") for (int m = 0; m < 4; ++m) _Pragma("unroll") for (int k = 0; k < 2; ++k) dst[m][k] = *(const PG8_LAS bf16x8*)(lds + PG8_SA(b, h) + aoff + m * 2048 + k * 1024); } while (0)
#define PG8_LDB(dst, b, h) do { _Pragma("unroll") for (int n = 0; n < 2; ++n) _Pragma("unroll") for (int k = 0; k < 2; ++k) dst[n][k] = *(const PG8_LAS bf16x8*)(lds + PG8_SB(b, h) + boff + n * 2048 + k * 1024); } while (0)
#define PG8_MMA(ai, bj, At, Bt) do { __builtin_amdgcn_s_setprio(1); _Pragma("unroll") for (int m = 0; m < 4; ++m) _Pragma("unroll") for (int n = 0; n < 2; ++n) _Pragma("unroll") for (int k = 0; k < 2; ++k) \
        acc[ai][bj][m][n] = __builtin_amdgcn_mfma_f32_16x16x32_bf16(Bt[n][k], At[m][k], acc[ai][bj][m][n], 0, 0, 0); __builtin_amdgcn_s_setprio(0); } while (0)
#define PG8_WAIT_V(n) asm volatile("s_waitcnt vmcnt(" #n ")" ::: "memory")
#define PG8_WAIT_L(n) asm volatile("s_waitcnt lgkmcnt(" #n ")" ::: "memory")
#define PG8_BAR __builtin_amdgcn_s_barrier()
#define PG8_SCHED __builtin_amdgcn_sched_barrier(0)
    Unit cur, nxt; int ui = 0;
    if (!S.next(0, cur)) return;
    f32x4 acc[2][2][4][2];
#pragma unroll
    for (int a = 0; a < 2; ++a)
#pragma unroll
        for (int b = 0; b < 2; ++b)
#pragma unroll
            for (int m = 0; m < 4; ++m)
#pragma unroll
                for (int n = 0; n < 2; ++n) acc[a][b][m][n] = (f32x4){0.f, 0.f, 0.f, 0.f};
    bf16x8 At[4][2], B0[2][2], B1[2][2];
    const char* cA = (const char*)g.A + (size_t)cur.pm * tstep; const char* cB = (const char*)g.Bt + (size_t)cur.pn * tstep;
    S.a_ready(cur);
    if constexpr (SP2) {
        PG8_STAGE(PG8_SB(0, 0), cB, voffB); PG8_STAGE(PG8_SB(0, 1), cB + hstep, voffB); PG8_STAGE(PG8_SA(0, 0), cA, voffA); PG8_STAGE(PG8_SA(0, 1), cA + hstep, voffA);
        if (wr == 1) PG8_BAR;
        PG8_WAIT_V(2); PG8_BAR;
        PG8_STAGE(PG8_SB(1, 0), cB + kstep, voffB); PG8_STAGE(PG8_SA(1, 0), cA + kstep, voffA); PG8_STAGE(PG8_SB(1, 1), cB + hstep + kstep, voffB);
        PG8_WAIT_V(6); PG8_BAR;
    } else {
        PG8_STAGE(PG8_SB(0, 0), cB, voffB); PG8_STAGE(PG8_SA(0, 0), cA, voffA); PG8_STAGE(PG8_SB(0, 1), cB + hstep, voffB); PG8_STAGE(PG8_SA(0, 1), cA + hstep, voffA);
        if (wr == 1) PG8_BAR;
        PG8_WAIT_V(4); PG8_BAR;
        PG8_STAGE(PG8_SB(1, 0), cB + kstep, voffB); PG8_STAGE(PG8_SA(1, 0), cA + kstep, voffA); PG8_STAGE(PG8_SB(1, 1), cB + hstep + kstep, voffB);
        PG8_WAIT_V(6); PG8_BAR;
    }
    for (;;) {
        const bool has_next = S.next(ui + 1, nxt);
        const char* nA = has_next ? (const char*)g.A + (size_t)nxt.pm * tstep : cA; const char* nB = has_next ? (const char*)g.Bt + (size_t)nxt.pn * tstep : cB;
        for (int t = 0; t < nt; t += 2) {
            const bool last = (t == nt - 2);
            const char* a1 = cA + (size_t)(t + 1) * kstep;
            const char* a2 = last ? nA : cA + (size_t)(t + 2) * kstep; const char* b2 = last ? nB : cB + (size_t)(t + 2) * kstep;
            const char* a3 = a2 + kstep; const char* b3 = b2 + kstep;
            if (last && has_next) S.a_ready(nxt);
            if constexpr (SP2) {
            PG8_LDB(B0, 0, 0); PG8_LDB(B1, 0, 1); PG8_SCHED; PG8_LDA(At, 0, 0); PG8_STAGE(PG8_SA(1, 1), a1 + hstep, voffA);
            PG8_WAIT_V(8); PG8_WAIT_L(0); PG8_BAR; PG8_MMA(0, 0, At, B0); PG8_MMA(0, 1, At, B1); PG8_BAR; PG8_SCHED;
            PG8_LDA(At, 0, 1); PG8_STAGE(PG8_SB(0, 0), b2, voffB); PG8_STAGE(PG8_SB(0, 1), b2 + hstep, voffB); PG8_STAGE(PG8_SA(0, 0), a2, voffA);
            PG8_WAIT_V(8); PG8_WAIT_L(0); PG8_BAR; PG8_MMA(1, 0, At, B0); PG8_MMA(1, 1, At, B1); PG8_BAR; PG8_SCHED;
            PG8_LDB(B0, 1, 0); PG8_LDB(B1, 1, 1); PG8_SCHED; PG8_LDA(At, 1, 0); PG8_STAGE(PG8_SA(0, 1), a2 + hstep, voffA);
            PG8_WAIT_V(8); PG8_WAIT_L(0); PG8_BAR; PG8_MMA(0, 0, At, B0); PG8_MMA(0, 1, At, B1); PG8_BAR; PG8_SCHED;
            PG8_LDA(At, 1, 1); PG8_STAGE(PG8_SB(1, 0), b3, voffB); PG8_STAGE(PG8_SB(1, 1), b3 + hstep, voffB); PG8_STAGE(PG8_SA(1, 0), a3, voffA);
            PG8_WAIT_V(8); PG8_WAIT_L(0); PG8_BAR; PG8_MMA(1, 0, At, B0); PG8_MMA(1, 1, At, B1); PG8_BAR; PG8_SCHED;
            } else {
            PG8_LDB(B0, 0, 0); PG8_SCHED; PG8_LDA(At, 0, 0); PG8_STAGE(PG8_SA(1, 1), a1 + hstep, voffA);
            PG8_WAIT_L(8); PG8_BAR; PG8_WAIT_L(0); PG8_MMA(0, 0, At, B0); PG8_BAR; PG8_SCHED;
            PG8_LDB(B1, 0, 1); PG8_STAGE(PG8_SB(0, 0), b2, voffB);
            PG8_BAR; PG8_WAIT_L(0); PG8_MMA(0, 1, At, B1); PG8_BAR;
            PG8_LDA(At, 0, 1); PG8_STAGE(PG8_SA(0, 0), a2, voffA);
            PG8_BAR; PG8_WAIT_L(0); PG8_MMA(1, 0, At, B0); PG8_BAR; PG8_SCHED;
            PG8_STAGE(PG8_SB(0, 1), b2 + hstep, voffB);
            PG8_WAIT_V(6); PG8_BAR; PG8_MMA(1, 1, At, B1); PG8_BAR;
            PG8_LDB(B0, 1, 0); PG8_SCHED; PG8_LDA(At, 1, 0); PG8_STAGE(PG8_SA(0, 1), a2 + hstep, voffA);
            PG8_WAIT_L(8); PG8_BAR; PG8_WAIT_L(0); PG8_MMA(0, 0, At, B0); PG8_BAR; PG8_SCHED;
            PG8_LDB(B1, 1, 1); PG8_STAGE(PG8_SB(1, 0), b3, voffB);
            PG8_BAR; PG8_WAIT_L(0); PG8_MMA(0, 1, At, B1); PG8_BAR;
            PG8_LDA(At, 1, 1); PG8_STAGE(PG8_SA(1, 0), a3, voffA);
            PG8_BAR; PG8_WAIT_L(0); PG8_MMA(1, 0, At, B0); PG8_BAR; PG8_SCHED;
            PG8_STAGE(PG8_SB(1, 1), b3 + hstep, voffB);
            PG8_WAIT_V(6); PG8_BAR; PG8_MMA(1, 1, At, B1); PG8_BAR;
            }
        }
        if constexpr (ALIGN_EPI) { if (wr == 0) PG8_BAR; }
        if constexpr (!Epi::AFTER_DRAIN) { E(acc, cur, wr, wc, fr, fq); S.done(cur); }
        if (!has_next) break;
#pragma unroll
        for (int a = 0; a < 2; ++a)
#pragma unroll
            for (int b = 0; b < 2; ++b)
#pragma unroll
                for (int m = 0; m < 4; ++m)
#pragma unroll
                    for (int n = 0; n < 2; ++n) acc[a][b][m][n] = (f32x4){0.f, 0.f, 0.f, 0.f};
        cur = nxt; cA = nA; cB = nB; ++ui;
        if constexpr (ALIGN_EPI) { if (wr == 1) PG8_BAR; }
    }
    PG8_WAIT_V(0);
    if constexpr (!ALIGN_EPI) { if (wr == 0) PG8_BAR; }
    PG8_BAR;
    if constexpr (Epi::AFTER_DRAIN) { E.fused(acc, cur, wr, wc, fr, fq, lds, wid, lane); S.done(cur); }
#undef PG8_SA
#undef PG8_SB
#undef PG8_STAGE
#undef PG8_LDA
#undef PG8_LDB
#undef PG8_MMA
#undef PG8_WAIT_V
#undef PG8_WAIT_L
#undef PG8_BAR
#undef PG8_SCHED
}
}
constexpr int NWAVES = 8, NTHR = 512;
constexpr int M = 32768, D = 1024, SEQ = 8192, NBATCH = 4;
constexpr int NIN = 5888;
constexpr int NCHUNK = 128, NITEM = 32 * NCHUNK;
constexpr float EPS = 1e-6f;
constexpr size_t MiB = 1u << 20;
constexpr size_t SEG_ELEMS = (size_t)M * 512;
constexpr size_t WS_CTL = 0, WS_MODP = 1 * MiB, WS_WIN = 2 * MiB, WS_WQ = 14 * MiB, WS_WSC = 18 * MiB, WS_WDN = 19 * MiB, WS_WMIX = 20 * MiB,
                 WS_SK = 22 * MiB, WS_GL = 23 * MiB, WS_SU = 23 * MiB + 65536, WS_SV = 23 * MiB + 131072, WS_TU = 24 * MiB, WS_TV = 56 * MiB, WS_P = 88 * MiB, WS_KD = 472 * MiB, WS_END = 504 * MiB;
constexpr int LDS_BYTES = 147456;

#define GAS __attribute__((address_space(1)))
#define LAS __attribute__((address_space(3)))
typedef unsigned short bf16;
typedef unsigned v4u __attribute__((ext_vector_type(4)));
typedef unsigned v2u __attribute__((ext_vector_type(2)));
typedef float f32x4 __attribute__((ext_vector_type(4)));
typedef float f32x16 __attribute__((ext_vector_type(16)));
typedef short bf16x8 __attribute__((ext_vector_type(8)));

typedef float f32x2_t __attribute__((ext_vector_type(2))); typedef __bf16 bf16x2_t __attribute__((ext_vector_type(2)));
__device__ __forceinline__ unsigned pk2(float lo, float hi) { f32x2_t v = {lo, hi}; bf16x2_t b = __builtin_convertvector(v, bf16x2_t); return __builtin_bit_cast(unsigned, b); }
__device__ __forceinline__ unsigned f2bf(float f) { return pk2(f, 0.f) & 0xffffu; }
__device__ __forceinline__ float bflo(unsigned u) { return __uint_as_float(u << 16); }
__device__ __forceinline__ float bfhi(unsigned u) { return __uint_as_float(u & 0xffff0000u); }
__device__ __forceinline__ float bf2f(bf16 h) { return __uint_as_float((unsigned)h << 16); }
__device__ __forceinline__ float sigmoidf_(float x) { return __builtin_amdgcn_rcpf(1.0f + __builtin_amdgcn_exp2f(-1.4426950408889634f * x)); }
__device__ __forceinline__ float wave_sum(float v) {
#pragma unroll
    for (int o = 1; o < 64; o <<= 1) v += __shfl_xor(v, o);
    return v;
}

struct Frame { LAS unsigned char* lds; int tid, lane, wave, G; };
__device__ __forceinline__ const void* karg(int i) {
    const char __attribute__((address_space(4)))* kp = (const char __attribute__((address_space(4)))*)__builtin_amdgcn_kernarg_segment_ptr();
    asm volatile("" : "+s"(i));
    return *(const void* const __attribute__((address_space(4)))*)(kp + 8 * i);
}
__device__ __forceinline__ const float* IN(int i) { return (const float*)karg(i); }
__device__ __forceinline__ float* OUTP() { return (float*)karg(21); }
__device__ __forceinline__ unsigned char* WSP() { return (unsigned char*)karg(22); }
enum { I_X = 0, I_C, I_WADA, I_BADA, I_NPREMIX, I_NPOSTMIX, I_WIN, I_SCCONV, I_DNCONV, I_ALOG, I_DTBIAS, I_OUTNORM, I_WSC, I_WDN, I_WMIX, I_NPREFFN, I_NPOSTFFN, I_WQ, I_SUBK, I_PU, I_PV };
__device__ __forceinline__ bf16* segp(unsigned char* ws, int s) { return (bf16*)(ws + WS_P) + (size_t)s * SEG_ELEMS; }
__device__ __forceinline__ float modv(const float* b_ada, const float* modp, int b, int j) {
    float s = b_ada[j];
#pragma unroll
    for (int k = 0; k < 8; ++k) s += modp[(size_t)(k * 4 + b) * 6144 + j];
    return s;
}

__device__ __forceinline__ void p0_transpose_item(const float* W, int K, int N, int src_col0, bf16* WT, int dst_row0, int kb, int ncols, LAS float* scr, int lane) {
    const int k0 = 64 * kb;
#pragma unroll 8
    for (int i = 0; i < 32; ++i) { const int kk = 2 * i + (lane >> 5); const int n = lane & 31;
        scr[kk * 33 + n] = (n < ncols) ? W[(size_t)(k0 + kk) * N + src_col0 + n] : 0.f; }
    asm volatile("s_waitcnt lgkmcnt(0)" ::: "memory");
    const int c = lane & 7;
#pragma unroll
    for (int j = 0; j < 4; ++j) { const int n = (lane >> 3) + 8 * j; const LAS float* s = scr + (8 * c) * 33 + n;
        v4u o; o.x = pk2(s[0 * 33], s[1 * 33]); o.y = pk2(s[2 * 33], s[3 * 33]); o.z = pk2(s[4 * 33], s[5 * 33]); o.w = pk2(s[6 * 33], s[7 * 33]);
        *(v4u*)(WT + (size_t)(dst_row0 + n) * K + k0 + 8 * c) = o; }
    asm volatile("s_waitcnt lgkmcnt(0)" ::: "memory");
}
__device__ __forceinline__ void p0_transpose(const float* W, int K, int N, int src_col0, int nblk, bf16* WT, int dst_row0, LAS float* scr, int gw, int NGW, int lane) {
    const int kbs = K / 64;
    for (int it = gw; it < nblk * kbs; it += NGW) { const int nb = it / kbs, kb = it % kbs;
        p0_transpose_item(W, K, N, src_col0 + 32 * nb, WT, dst_row0 + 32 * nb, kb, 32, scr, lane); }
}
__device__ __forceinline__ void p0_convert(const float* src, bf16* dst, size_t nchunks8, size_t gtid, size_t gthreads) {
    for (size_t i = gtid; i < nchunks8; i += gthreads) { const f32x4 a = *(const f32x4*)(src + i * 8), b = *(const f32x4*)(src + i * 8 + 4);
        v4u o; o.x = pk2(a[0], a[1]); o.y = pk2(a[2], a[3]); o.z = pk2(b[0], b[1]); o.w = pk2(b[2], b[3]); *(v4u*)(dst + i * 8) = o; }
}
__device__ __forceinline__ void p0_table_fp8(const float* T, unsigned char* T8, float* SC, int gw, int NGW, int lane) {
    for (int row = gw; row < 16384; row += NGW) {
        const f32x4* src = (const f32x4*)(T + (size_t)row * 1024) + lane;
        f32x4 v[4]; float am = 0.f;
#pragma unroll
        for (int i = 0; i < 4; ++i) { v[i] = src[64 * i]; am = fmaxf(am, fmaxf(fmaxf(fabsf(v[i][0]), fabsf(v[i][1])), fmaxf(fabsf(v[i][2]), fabsf(v[i][3])))); }
#pragma unroll
        for (int o = 1; o < 64; o <<= 1) am = fmaxf(am, __shfl_xor(am, o));
        const unsigned rb = __float_as_uint(240.0f / fmaxf(am, 1e-30f)) & 0x7f800000u;
        const float sp = __uint_as_float(rb), inv = __uint_as_float((254u << 23) - rb);
        unsigned* dst = (unsigned*)(T8 + (size_t)row * 1024) + lane;
#pragma unroll
        for (int i = 0; i < 4; ++i) { unsigned p = 0u; p = __builtin_amdgcn_cvt_pk_fp8_f32(v[i][0] * sp, v[i][1] * sp, p, false); p = __builtin_amdgcn_cvt_pk_fp8_f32(v[i][2] * sp, v[i][3] * sp, p, true); dst[64 * i] = p; }
        if (lane == 0) SC[row] = inv;
    }
}
__device__ __forceinline__ void phase_prologue(Frame& F) {
    LAS float* scr = (LAS float*)(F.lds + F.wave * 8704);
    const int gw = blockIdx.x * NWAVES + F.wave, NGW = F.G * NWAVES;
    unsigned char* ws = WSP();
    { const float* w_ada = IN(I_WADA); const float* cc = IN(I_C); float* modp = (float*)(ws + WS_MODP);
    for (int it = gw; it < 768; it += NGW) { const int cgi = it % 96, ks = it / 96, n = cgi * 64 + F.lane, k0 = ks * 128;
        float a0 = 0.f, a1 = 0.f, a2 = 0.f, a3 = 0.f;
#pragma unroll 16
        for (int kk = 0; kk < 128; ++kk) { const int k = k0 + kk; const float w = w_ada[(size_t)k * 6144 + n];
            const float c0 = cc[k], c1 = cc[1024 + k], c2 = cc[2048 + k], c3 = cc[3072 + k];
            a0 += c0 * sigmoidf_(c0) * w; a1 += c1 * sigmoidf_(c1) * w; a2 += c2 * sigmoidf_(c2) * w; a3 += c3 * sigmoidf_(c3) * w; }
        modp[(size_t)(ks * 4 + 0) * 6144 + n] = a0; modp[(size_t)(ks * 4 + 1) * 6144 + n] = a1;
        modp[(size_t)(ks * 4 + 2) * 6144 + n] = a2; modp[(size_t)(ks * 4 + 3) * 6144 + n] = a3; } }
    { const float* w_in = IN(I_WIN); bf16* win_t = (bf16*)(ws + WS_WIN);
    p0_transpose(w_in, 1024, 5648, 0, 112, win_t, 0, scr, gw, NGW, F.lane);
    p0_transpose(w_in, 1024, 5648, 3600, 64, win_t, 3584, scr, gw, NGW, F.lane);
    for (int it = gw; it < 16; it += NGW) p0_transpose_item(w_in, 1024, 5648, 3584, win_t, 5632, it, 16, scr, F.lane);
    { const size_t gtid = (size_t)blockIdx.x * NTHR + F.tid, gth = (size_t)F.G * NTHR;
      for (size_t i = gtid; i < (size_t)224 * 128; i += gth) *(v4u*)(win_t + (size_t)5664 * 1024 + i * 8) = (v4u){0u, 0u, 0u, 0u}; } }
    p0_transpose(IN(I_WQ), 1024, 2048, 0, 64, (bf16*)(ws + WS_WQ), 0, scr, gw, NGW, F.lane);
    p0_transpose(IN(I_WSC), 512, 1024, 0, 32, (bf16*)(ws + WS_WSC), 0, scr, gw, NGW, F.lane);
    p0_transpose(IN(I_WDN), 512, 1024, 0, 32, (bf16*)(ws + WS_WDN), 0, scr, gw, NGW, F.lane);
    p0_transpose(IN(I_WMIX), 1024, 1024, 0, 32, (bf16*)(ws + WS_WMIX), 0, scr, gw, NGW, F.lane);
    { const size_t gtid = (size_t)blockIdx.x * NTHR + F.tid, gth = (size_t)F.G * NTHR;
      p0_convert(IN(I_SUBK), (bf16*)(ws + WS_SK), (size_t)16 * 128 * 128 / 8, gtid, gth);
    }
    p0_table_fp8(IN(I_PU), ws + WS_TU, (float*)(ws + WS_SU), gw, NGW, F.lane);
    p0_table_fp8(IN(I_PV), ws + WS_TV, (float*)(ws + WS_SV), gw, NGW, F.lane);
}

__device__ __forceinline__ void phase_h1(Frame& F, bf16* H1) {
    LAS float* gv = (LAS float*)F.lds; LAS float* sv = gv + 1024;
    const float* xin = IN(I_X); const float* npm = IN(I_NPREMIX); const float* b_ada = IN(I_BADA); const float* modp = (const float*)(WSP() + WS_MODP);
    for (int rb = blockIdx.x; rb < M / 128; rb += F.G) {
        const int row0 = rb * 128, b = row0 / SEQ;
        __syncthreads();
        for (int k = F.tid; k < 1024; k += NTHR) { gv[k] = npm[k] * (1.f + modv(b_ada, modp, b, 1024 + k)); sv[k] = modv(b_ada, modp, b, k); }
        __syncthreads();
        for (int r = 0; r < 16; ++r) { const int row = row0 + F.wave * 16 + r;
            const f32x4* xr = (const f32x4*)(xin + (size_t)row * D) + F.lane;
            f32x4 v[4]; float ss = 0.f;
#pragma unroll
            for (int j = 0; j < 4; ++j) { v[j] = xr[64 * j]; ss += (v[j][0] * v[j][0] + v[j][1] * v[j][1]) + (v[j][2] * v[j][2] + v[j][3] * v[j][3]); }
            const float rstd = rsqrtf(wave_sum(ss) * (1.f / D) + EPS);
            v2u* o8 = (v2u*)(H1 + (size_t)row * D) + F.lane;
#pragma unroll
            for (int j = 0; j < 4; ++j) { const int k = 4 * F.lane + 256 * j; const f32x4 g = *(const LAS f32x4*)(gv + k), s = *(const LAS f32x4*)(sv + k);
                v2u o; o.x = pk2(v[j][0] * rstd * g[0] + s[0], v[j][1] * rstd * g[1] + s[1]); o.y = pk2(v[j][2] * rstd * g[2] + s[2], v[j][3] * rstd * g[3] + s[3]); o8[64 * j] = o; }
        }
    }
}

__device__ __forceinline__ void phase_scprep(Frame& F) {
    unsigned char* ws = WSP(); bf16* sb = segp(ws, 0); const bf16* scc = segp(ws, 1); const bf16* scx = segp(ws, 2); const float* scw = IN(I_SCCONV);
    const int gtid = blockIdx.x * NTHR + F.tid, gth = F.G * NTHR;
    for (int it = gtid; it < (M / 16) * 64; it += gth) {
        const int cgp = it & 63, tb = it >> 6, m0 = tb * 16, c0 = cgp * 8;
        float w0[8], w1[8], w2[8], p2[8], p1[8];
#pragma unroll
        for (int e = 0; e < 8; ++e) { w0[e] = scw[c0 + e]; w1[e] = scw[512 + c0 + e]; w2[e] = scw[1024 + c0 + e]; p2[e] = 0.f; p1[e] = 0.f; }
        if ((m0 % SEQ) != 0) {
#pragma unroll
            for (int q = 0; q < 2; ++q) { const size_t off = (size_t)(m0 - 2 + q) * 512 + c0; const v4u cv = *(const v4u*)(scc + off), xv = *(const v4u*)(scx + off);
                float t[8] = {bflo(cv.x) * bflo(xv.x), bfhi(cv.x) * bfhi(xv.x), bflo(cv.y) * bflo(xv.y), bfhi(cv.y) * bfhi(xv.y), bflo(cv.z) * bflo(xv.z), bfhi(cv.z) * bfhi(xv.z), bflo(cv.w) * bflo(xv.w), bfhi(cv.w) * bfhi(xv.w)};
#pragma unroll
                for (int e = 0; e < 8; ++e) { if (q == 0) p2[e] = t[e]; else p1[e] = t[e]; } }
        }
        for (int t = 0; t < 16; ++t) { const size_t off = (size_t)(m0 + t) * 512 + c0;
            const v4u cv = *(const v4u*)(scc + off), xv = *(const v4u*)(scx + off), bv = *(const v4u*)(sb + off);
            float cur[8] = {bflo(cv.x) * bflo(xv.x), bfhi(cv.x) * bfhi(xv.x), bflo(cv.y) * bflo(xv.y), bfhi(cv.y) * bfhi(xv.y), bflo(cv.z) * bflo(xv.z), bfhi(cv.z) * bfhi(xv.z), bflo(cv.w) * bflo(xv.w), bfhi(cv.w) * bfhi(xv.w)};
            float bb[8] = {bflo(bv.x), bfhi(bv.x), bflo(bv.y), bfhi(bv.y), bflo(bv.z), bfhi(bv.z), bflo(bv.w), bfhi(bv.w)};
            float o[8];
#pragma unroll
            for (int e = 0; e < 8; ++e) { o[e] = bb[e] * (w0[e] * p2[e] + w1[e] * p1[e] + w2[e] * cur[e]); p2[e] = p1[e]; p1[e] = cur[e]; }
            v4u ov; ov.x = pk2(o[0], o[1]); ov.y = pk2(o[2], o[3]); ov.z = pk2(o[4], o[5]); ov.w = pk2(o[6], o[7]);
            *(v4u*)(sb + off) = ov; }
    }
}

#define MM4(dst, aptr, X) do { const f32x4 av_ = *(const LAS f32x4*)(aptr); \
    dst = __builtin_amdgcn_mfma_f32_16x16x4f32(av_[0], (X)[0], dst, 0, 0, 0); dst = __builtin_amdgcn_mfma_f32_16x16x4f32(av_[1], (X)[1], dst, 0, 0, 0); \
    dst = __builtin_amdgcn_mfma_f32_16x16x4f32(av_[2], (X)[2], dst, 0, 0, 0); dst = __builtin_amdgcn_mfma_f32_16x16x4f32(av_[3], (X)[3], dst, 0, 0, 0); } while (0)
__device__ __forceinline__ void phase_dnprep(Frame& F, bf16* Wn, bf16* U, bf16* QG, bf16* A, bf16* KD) {
    LAS unsigned char* L = F.lds;
    LAS bf16* raw = (LAS bf16*)L;
    LAS bf16* stg2 = (LAS bf16*)L;
    LAS float* qc = (LAS float*)(L + 32768);
    LAS float* kc = (LAS float*)(L + 32768 + 17408);
    LAS float* vc = (LAS float*)(L + 32768 + 2 * 17408);
    LAS bf16* kh = (LAS bf16*)(L + 84992);
    LAS bf16* qh = (LAS bf16*)(L + 94208);
    LAS float* Ln = (LAS float*)(L + 103424);
    LAS float* Tm = (LAS float*)(L + 120832);
    LAS float* sG = (LAS float*)(L + 124928);
    LAS float* sBeta = sG + 64; LAS float* sEG = sG + 128; LAS float* sEd = sG + 192;
    LAS float* cwl = (LAS float*)(L + 125952);
    LAS bf16* stg = (LAS bf16*)(L + 129024);
    const int tid = F.tid, lane = F.lane, wave = F.wave;
    unsigned char* ws = WSP(); const bf16* segq = segp(ws, 3); const bf16* segab = segp(ws, 11); float* glp = (float*)(ws + WS_GL);
    const float* cw = IN(I_DNCONV); const float* alog = IN(I_ALOG); const float* dtb = IN(I_DTBIAS);
    for (int it = blockIdx.x; it < NITEM; it += F.G) {
        const int bh = it >> 7, n = it & 127, b = bh >> 3, h = bh & 7, m0 = b * SEQ + n * 64;
        __syncthreads();
        for (int ci = tid; ci < 1608; ci += NTHR) { const int s = ci / 536, rem = ci % 536, r = rem >> 3, c8 = rem & 7;
            v4u v = (v4u){0u, 0u, 0u, 0u};
            if (n * 64 - 3 + r >= 0) v = *(const v4u*)(segq + (size_t)s * SEG_ELEMS + (size_t)(m0 - 3 + r) * 512 + h * 64 + c8 * 8);
            *(LAS v4u*)(raw + (s * 67 + r) * 64 + c8 * 8) = v; }
        for (int ci = tid; ci < 768; ci += NTHR) { const int s = ci >> 8, k = (ci >> 6) & 3, c = ci & 63; cwl[ci] = cw[k * 1536 + s * 512 + h * 64 + c]; }
        __syncthreads();
        for (int wu = tid; wu < 3072; wu += NTHR) { const int c4 = wu & 15, t = (wu >> 4) & 63, s = wu >> 10;
            f32x4 acc = (f32x4){0.f, 0.f, 0.f, 0.f};
#pragma unroll
            for (int k = 0; k < 4; ++k) { const f32x4 w = *(const LAS f32x4*)(cwl + (s * 4 + k) * 64 + 4 * c4); const v2u r = *(const LAS v2u*)(raw + (s * 67 + t + k) * 64 + 4 * c4);
                acc[0] += w[0] * bflo(r.x); acc[1] += w[1] * bfhi(r.x); acc[2] += w[2] * bflo(r.y); acc[3] += w[3] * bfhi(r.y); }
#pragma unroll
            for (int e = 0; e < 4; ++e) acc[e] = acc[e] * sigmoidf_(acc[e]);
            *(LAS f32x4*)((s == 0 ? qc : (s == 1 ? kc : vc)) + t * 68 + 4 * c4) = acc; }
        __syncthreads();
        if (wave == 0) {
            const float av = bf2f(segab[(size_t)(m0 + lane) * 512 + h]) + dtb[h], bv = bf2f(segab[(size_t)(m0 + lane) * 512 + 8 + h]);
            const float sp = (av > 20.f) ? av : log1pf(__expf(av));
            float g = -__expf(alog[h]) * sp;
#pragma unroll
            for (int o = 1; o < 64; o <<= 1) { const float t = __shfl_up(g, o); if (lane >= o) g += t; }
            const float g63 = __shfl(g, 63);
            sG[lane] = g; sBeta[lane] = sigmoidf_(bv); sEG[lane] = __expf(g); sEd[lane] = __expf(g63 - g);
            if (lane == 63) glp[it] = __expf(g);
        }
        { const int t = tid >> 3, p = tid & 7;
          f32x4 q0 = *(const LAS f32x4*)(qc + t * 68 + 8 * p), q1 = *(const LAS f32x4*)(qc + t * 68 + 8 * p + 4), k0 = *(const LAS f32x4*)(kc + t * 68 + 8 * p), k1 = *(const LAS f32x4*)(kc + t * 68 + 8 * p + 4);
          float sq = (q0[0] * q0[0] + q0[1] * q0[1]) + (q0[2] * q0[2] + q0[3] * q0[3]) + (q1[0] * q1[0] + q1[1] * q1[1]) + (q1[2] * q1[2] + q1[3] * q1[3]);
          float sk = (k0[0] * k0[0] + k0[1] * k0[1]) + (k0[2] * k0[2] + k0[3] * k0[3]) + (k1[0] * k1[0] + k1[1] * k1[1]) + (k1[2] * k1[2] + k1[3] * k1[3]);
          sq += __shfl_xor(sq, 1); sq += __shfl_xor(sq, 2); sq += __shfl_xor(sq, 4); sk += __shfl_xor(sk, 1); sk += __shfl_xor(sk, 2); sk += __shfl_xor(sk, 4);
          const float rq = rsqrtf(sq + EPS) * 0.125f, rk = rsqrtf(sk + EPS);
          q0 = q0 * rq; q1 = q1 * rq; k0 = k0 * rk; k1 = k1 * rk;
          *(LAS f32x4*)(qc + t * 68 + 8 * p) = q0; *(LAS f32x4*)(qc + t * 68 + 8 * p + 4) = q1; *(LAS f32x4*)(kc + t * 68 + 8 * p) = k0; *(LAS f32x4*)(kc + t * 68 + 8 * p + 4) = k1;
          v4u qb, kb; qb.x = pk2(q0[0], q0[1]); qb.y = pk2(q0[2], q0[3]); qb.z = pk2(q1[0], q1[1]); qb.w = pk2(q1[2], q1[3]);
          kb.x = pk2(k0[0], k0[1]); kb.y = pk2(k0[2], k0[3]); kb.z = pk2(k1[0], k1[1]); kb.w = pk2(k1[2], k1[3]);
          *(LAS v4u*)(qh + t * 72 + 8 * p) = qb; *(LAS v4u*)(kh + t * 72 + 8 * p) = kb; }
        __syncthreads();
        {
            const int fr = lane & 15, g4 = lane >> 4;
#pragma unroll
            for (int x = 0; x < 2; ++x) { const int tile = 2 * wave + x, ti = tile >> 2, tj = tile & 3;
                f32x4 ckk = (f32x4){0.f, 0.f, 0.f, 0.f}, cqk = (f32x4){0.f, 0.f, 0.f, 0.f};
#pragma unroll
                for (int ks = 0; ks < 2; ++ks) {
                    const bf16x8 ak = *(const LAS bf16x8*)(kh + (16 * ti + fr) * 72 + 32 * ks + 8 * g4);
                    const bf16x8 aq = *(const LAS bf16x8*)(qh + (16 * ti + fr) * 72 + 32 * ks + 8 * g4);
                    const bf16x8 bk = *(const LAS bf16x8*)(kh + (16 * tj + fr) * 72 + 32 * ks + 8 * g4);
                    ckk = __builtin_amdgcn_mfma_f32_16x16x32_bf16(ak, bk, ckk, 0, 0, 0);
                    cqk = __builtin_amdgcn_mfma_f32_16x16x32_bf16(aq, bk, cqk, 0, 0, 0); }
                const int j = 16 * tj + fr; const float gj = sG[j];
#pragma unroll
                for (int r = 0; r < 4; ++r) { const int i = 16 * ti + 4 * g4 + r;
                    const float dec = __expf(fminf(sG[i] - gj, 0.f));
                    Ln[i * 68 + j] = (j < i) ? -(sBeta[i] * ckk[r] * dec) : 0.f;
                    stg[i * 64 + j] = (bf16)f2bf((j <= i) ? cqk[r] * dec : 0.f); }
            }
        }
        __syncthreads();
        if (wave == 0) {
            const int bb = lane >> 4, c = lane & 15; float t[16];
#pragma unroll
            for (int i = 0; i < 16; ++i) { float acc = (i == c) ? 1.f : 0.f;
#pragma unroll
                for (int j = 0; j < i; ++j) acc += Ln[(16 * bb + i) * 68 + 16 * bb + j] * t[j];
                t[i] = acc; Tm[(bb * 16 + i) * 16 + c] = acc; }
        } else {
            for (int ct = tid - 64; ct < 1536; ct += NTHR - 64) { const int kind = ct >> 9, idx = ct & 511; const size_t ob = (size_t)it * 4096 + (size_t)idx * 8;
                if (kind == 0) { *(v4u*)(A + ob) = *(const LAS v4u*)(stg + idx * 8); }
                else if (kind == 1) { const int i = idx >> 3, k0 = (idx & 7) * 8; const float e = sEG[i]; const f32x4 a = *(const LAS f32x4*)(qc + i * 68 + k0), c = *(const LAS f32x4*)(qc + i * 68 + k0 + 4);
                    v4u o; o.x = pk2(a[0] * e, a[1] * e); o.y = pk2(a[2] * e, a[3] * e); o.z = pk2(c[0] * e, c[1] * e); o.w = pk2(c[2] * e, c[3] * e); *(v4u*)(QG + ob) = o; }
                else { const int kk = idx >> 3, c0 = (idx & 7) * 8;
                    v4u p; p.x = pk2(kc[(c0 + 0) * 68 + kk] * sEd[c0 + 0], kc[(c0 + 1) * 68 + kk] * sEd[c0 + 1]); p.y = pk2(kc[(c0 + 2) * 68 + kk] * sEd[c0 + 2], kc[(c0 + 3) * 68 + kk] * sEd[c0 + 3]);
                    p.z = pk2(kc[(c0 + 4) * 68 + kk] * sEd[c0 + 4], kc[(c0 + 5) * 68 + kk] * sEd[c0 + 5]); p.w = pk2(kc[(c0 + 6) * 68 + kk] * sEd[c0 + 6], kc[(c0 + 7) * 68 + kk] * sEd[c0 + 7]);
                    *(v4u*)(KD + ob) = p; } }
        }
        __syncthreads();
        {
            const int nn = lane & 15, g4 = lane >> 4; const LAS float* src = (wave < 4) ? vc : kc; const int cc = 16 * (wave & 3) + nn;
            f32x4 R[4];
#pragma unroll
            for (int bb = 0; bb < 4; ++bb)
#pragma unroll
                for (int r = 0; r < 4; ++r) { const int i = 16 * bb + 4 * g4 + r; float v = src[i * 68 + cc] * sBeta[i]; if (wave >= 4) v *= sEG[i]; R[bb][r] = v; }
            const f32x4 Z4 = (f32x4){0.f, 0.f, 0.f, 0.f};
            f32x4 X0 = Z4, X1 = Z4, X2 = Z4, X3 = Z4;
            MM4(X0, Tm + (0 * 16 + nn) * 16 + 4 * g4, R[0]);
            MM4(R[1], Ln + (16 + nn) * 68 + 0 + 4 * g4, X0);
            MM4(X1, Tm + (1 * 16 + nn) * 16 + 4 * g4, R[1]);
            MM4(R[2], Ln + (32 + nn) * 68 + 0 + 4 * g4, X0); MM4(R[2], Ln + (32 + nn) * 68 + 16 + 4 * g4, X1);
            MM4(X2, Tm + (2 * 16 + nn) * 16 + 4 * g4, R[2]);
            MM4(R[3], Ln + (48 + nn) * 68 + 0 + 4 * g4, X0); MM4(R[3], Ln + (48 + nn) * 68 + 16 + 4 * g4, X1); MM4(R[3], Ln + (48 + nn) * 68 + 32 + 4 * g4, X2);
            MM4(X3, Tm + (3 * 16 + nn) * 16 + 4 * g4, R[3]);
            const float sgn = (wave < 4) ? 1.f : -1.f; const int col = 16 * wave + nn;
#pragma unroll
            for (int r = 0; r < 4; ++r) { const int i = 4 * g4 + r;
                stg2[(i) * 128 + col] = (bf16)f2bf(sgn * X0[r]); stg2[(16 + i) * 128 + col] = (bf16)f2bf(sgn * X1[r]);
                stg2[(32 + i) * 128 + col] = (bf16)f2bf(sgn * X2[r]); stg2[(48 + i) * 128 + col] = (bf16)f2bf(sgn * X3[r]); }
        }
        __syncthreads();
        for (int ci = tid; ci < 1024; ci += NTHR) { const int i = ci >> 4, c8 = ci & 15; const v4u v = *(const LAS v4u*)(stg2 + i * 128 + c8 * 8);
            if (c8 < 8) *(v4u*)(U + (size_t)it * 4096 + i * 64 + c8 * 8) = v; else *(v4u*)(Wn + (size_t)it * 4096 + i * 64 + (c8 - 8) * 8) = v; }
    }
}
#undef MM4

__device__ __forceinline__ bf16x8 pack_b(const f32x4& t0, const f32x4& t1) { v4u w; w.x = pk2(t0[0], t0[1]); w.y = pk2(t0[2], t0[3]); w.z = pk2(t1[0], t1[1]); w.w = pk2(t1[2], t1[3]); return __builtin_bit_cast(bf16x8, w); }
__device__ __forceinline__ bf16x8 afrag(const LAS bf16* base, int row, int ks, int g4) {
    const v2u lo = *(const LAS v2u*)(base + row * 72 + 32 * ks + 4 * g4), hi = *(const LAS v2u*)(base + row * 72 + 32 * ks + 16 + 4 * g4);
    v4u w; w.x = lo.x; w.y = lo.y; w.z = hi.x; w.w = hi.y; return __builtin_bit_cast(bf16x8, w); }
#define SCAN_BAR() do { asm volatile("s_waitcnt lgkmcnt(0)" ::: "memory"); __builtin_amdgcn_s_barrier(); asm volatile("" ::: "memory"); } while (0)
__device__ __forceinline__ void phase_scan(Frame& F, const bf16* Wn, const bf16* U, const bf16* QG, const bf16* A, const bf16* KD, bf16* OG, const bf16* Z) {
    if (blockIdx.x >= 32) return;
    LAS unsigned char* L = F.lds; const float* glp = (const float*)(WSP() + WS_GL); const float* onw = IN(I_OUTNORM);
    const int bh = blockIdx.x, b = bh >> 3, h = bh & 7, tid = F.tid, lane = F.lane, wave = F.wave;
    const int nn = lane & 15, g4 = lane >> 4;
#define OPB(buf, mat) ((LAS bf16*)(L + (buf) * 46080 + (mat) * 9216))
#define OST(buf) ((LAS bf16*)(L + 92160 + (buf) * 9216))
    LAS float* gll = (LAS float*)(L + 110592);
    if (tid < NCHUNK) gll[tid] = glp[bh * NCHUNK + tid];
    if (wave >= 4) {
        const int ht = tid - 256;
        const unsigned eo0 = (unsigned)(bh * NCHUNK) * 4096u + (unsigned)ht * 8u;
        const int lo0 = (ht >> 3) * 72 + (ht & 7) * 8, lo1 = lo0 + 32 * 72;
        v4u ra[10], rb[10];
#define HLOAD(R, st) do { const unsigned o_ = eo0 + (unsigned)(st) * 4096u; R[0] = *(const v4u*)(Wn + o_); R[1] = *(const v4u*)(Wn + o_ + 2048); R[2] = *(const v4u*)(U + o_); R[3] = *(const v4u*)(U + o_ + 2048); \
        R[4] = *(const v4u*)(QG + o_); R[5] = *(const v4u*)(QG + o_ + 2048); R[6] = *(const v4u*)(A + o_); R[7] = *(const v4u*)(A + o_ + 2048); R[8] = *(const v4u*)(KD + o_); R[9] = *(const v4u*)(KD + o_ + 2048); } while (0)
#define HSTORE(R, buf) do { _Pragma("unroll") for (int mt_ = 0; mt_ < 5; ++mt_) { *(LAS v4u*)(OPB(buf, mt_) + lo0) = R[2 * mt_]; *(LAS v4u*)(OPB(buf, mt_) + lo1) = R[2 * mt_ + 1]; } } while (0)
        const int ot = ht >> 2, op = ht & 3;
        const unsigned zo0 = (unsigned)(b * SEQ + ot) * 512u + (unsigned)(h * 64 + 16 * op);
        LAS float* onl = (LAS float*)(L + 111104);
        if (ht < 64) onl[ht] = onw[ht];
        v4u zr[2][2];
#define ZLOAD(par, st) do { const unsigned zo_ = zo0 + (unsigned)(st) * 32768u; zr[par][0] = *(const v4u*)(Z + zo_); zr[par][1] = *(const v4u*)(Z + zo_ + 8); } while (0)
#define OUT_STAGE(par, st) do { const v4u o0 = *(const LAS v4u*)(OST(par) + ot * 72 + 16 * op), o1 = *(const LAS v4u*)(OST(par) + ot * 72 + 16 * op + 8); \
        float ov[16] = {bflo(o0.x), bfhi(o0.x), bflo(o0.y), bfhi(o0.y), bflo(o0.z), bfhi(o0.z), bflo(o0.w), bfhi(o0.w), bflo(o1.x), bfhi(o1.x), bflo(o1.y), bfhi(o1.y), bflo(o1.z), bfhi(o1.z), bflo(o1.w), bfhi(o1.w)}; \
        float zv[16] = {bflo(zr[par][0].x), bfhi(zr[par][0].x), bflo(zr[par][0].y), bfhi(zr[par][0].y), bflo(zr[par][0].z), bfhi(zr[par][0].z), bflo(zr[par][0].w), bfhi(zr[par][0].w), \
                        bflo(zr[par][1].x), bfhi(zr[par][1].x), bflo(zr[par][1].y), bfhi(zr[par][1].y), bflo(zr[par][1].z), bfhi(zr[par][1].z), bflo(zr[par][1].w), bfhi(zr[par][1].w)}; \
        float ss_ = 0.f; _Pragma("unroll") for (int e = 0; e < 16; ++e) ss_ += ov[e] * ov[e]; \
        ss_ += __shfl_xor(ss_, 1); ss_ += __shfl_xor(ss_, 2); const float rs_ = rsqrtf(ss_ * (1.f / 64.f) + EPS); float rr[16]; \
        _Pragma("unroll") for (int e = 0; e < 16; ++e) rr[e] = ov[e] * rs_ * onl[16 * op + e] * (zv[e] * sigmoidf_(zv[e])); \
        v4u w0, w1; w0.x = pk2(rr[0], rr[1]); w0.y = pk2(rr[2], rr[3]); w0.z = pk2(rr[4], rr[5]); w0.w = pk2(rr[6], rr[7]); w1.x = pk2(rr[8], rr[9]); w1.y = pk2(rr[10], rr[11]); w1.z = pk2(rr[12], rr[13]); w1.w = pk2(rr[14], rr[15]); \
        { const unsigned oo_ = zo0 + (unsigned)(st) * 32768u; *(v4u*)(OG + oo_) = w0; *(v4u*)(OG + oo_ + 8) = w1; } } while (0)
        HLOAD(ra, 0); HSTORE(ra, 0); HLOAD(ra, 1); HLOAD(rb, 2); ZLOAD(0, 0);
        SCAN_BAR();
        HSTORE(ra, 1); HLOAD(ra, 3); ZLOAD(1, 1);
        SCAN_BAR();
#pragma unroll 1
        for (int n = 1; n < NCHUNK - 1; n += 2) {
            const int l3 = (n + 3 < NCHUNK) ? n + 3 : NCHUNK - 1, l4 = (n + 4 < NCHUNK) ? n + 4 : NCHUNK - 1;
#define SB() __builtin_amdgcn_sched_barrier(0)
            HSTORE(rb, 0); SB(); HLOAD(rb, l3); SB(); OUT_STAGE(0, n - 1); SB(); ZLOAD(0, n + 1); SB();
            SCAN_BAR();
            HSTORE(ra, 1); SB(); HLOAD(ra, l4); SB(); OUT_STAGE(1, n); SB(); ZLOAD(1, n + 2); SB();
            SCAN_BAR();
#undef SB
        }
        OUT_STAGE(0, NCHUNK - 2);
        SCAN_BAR();
        OUT_STAGE(1, NCHUNK - 1);
#undef HLOAD
#undef HSTORE
#undef ZLOAD
#undef OUT_STAGE
    } else {
        const int cs = wave;
        f32x4 S[4];
#pragma unroll
        for (int t = 0; t < 4; ++t) S[t] = (f32x4){0.f, 0.f, 0.f, 0.f};
        SCAN_BAR();
#pragma unroll 1
        for (int n = 0; n < NCHUNK; ++n) {
            const int buf = n & 1; const float glast = gll[n];
            const bf16x8 sb0 = pack_b(S[0], S[1]), sb1 = pack_b(S[2], S[3]);
            f32x4 vn[4], oa[4];
#pragma unroll
            for (int ct = 0; ct < 4; ++ct) {
                f32x4 av;
#pragma unroll
                for (int r = 0; r < 4; ++r) av[r] = bf2f(OPB(buf, 1)[(16 * ct + 4 * g4 + r) * 72 + 16 * cs + nn]);
                f32x4 ao = (f32x4){0.f, 0.f, 0.f, 0.f};
                av = __builtin_amdgcn_mfma_f32_16x16x32_bf16(afrag(OPB(buf, 0), 16 * ct + nn, 0, g4), sb0, av, 0, 0, 0);
                av = __builtin_amdgcn_mfma_f32_16x16x32_bf16(afrag(OPB(buf, 0), 16 * ct + nn, 1, g4), sb1, av, 0, 0, 0);
                ao = __builtin_amdgcn_mfma_f32_16x16x32_bf16(afrag(OPB(buf, 2), 16 * ct + nn, 0, g4), sb0, ao, 0, 0, 0);
                ao = __builtin_amdgcn_mfma_f32_16x16x32_bf16(afrag(OPB(buf, 2), 16 * ct + nn, 1, g4), sb1, ao, 0, 0, 0);
                vn[ct] = av; oa[ct] = ao; }
            const bf16x8 vb0 = pack_b(vn[0], vn[1]), vb1 = pack_b(vn[2], vn[3]);
#pragma unroll
            for (int ct = 0; ct < 4; ++ct) {
                f32x4 ao = oa[ct], as = S[ct] * glast;
                ao = __builtin_amdgcn_mfma_f32_16x16x32_bf16(afrag(OPB(buf, 3), 16 * ct + nn, 0, g4), vb0, ao, 0, 0, 0);
                ao = __builtin_amdgcn_mfma_f32_16x16x32_bf16(afrag(OPB(buf, 3), 16 * ct + nn, 1, g4), vb1, ao, 0, 0, 0);
                as = __builtin_amdgcn_mfma_f32_16x16x32_bf16(afrag(OPB(buf, 4), 16 * ct + nn, 0, g4), vb0, as, 0, 0, 0);
                as = __builtin_amdgcn_mfma_f32_16x16x32_bf16(afrag(OPB(buf, 4), 16 * ct + nn, 1, g4), vb1, as, 0, 0, 0);
                S[ct] = as;
#pragma unroll
                for (int r = 0; r < 4; ++r) OST(buf)[(16 * ct + 4 * g4 + r) * 72 + 16 * cs + nn] = (bf16)f2bf(ao[r]); }
            SCAN_BAR();
        }
    }
#undef OPB
#undef OST
}
#undef SCAN_BAR

__device__ __forceinline__ void phase_x1h2(Frame& F, const bf16* Y, bf16* H2) {
    LAS float* a1 = (LAS float*)F.lds; LAS float* g2 = a1 + 1024; LAS float* s2 = g2 + 1024;
    const float* xin = IN(I_X); const float* npost = IN(I_NPOSTMIX); const float* npre = IN(I_NPREFFN); const float* b_ada = IN(I_BADA); const float* modp = (const float*)(WSP() + WS_MODP); float* outp = OUTP();
    for (int rb = blockIdx.x; rb < M / 128; rb += F.G) {
        const int row0 = rb * 128, b = row0 / SEQ;
        __syncthreads();
        for (int k = F.tid; k < 1024; k += NTHR) { a1[k] = modv(b_ada, modp, b, 2048 + k) * npost[k]; g2[k] = npre[k] * (1.f + modv(b_ada, modp, b, 4096 + k)); s2[k] = modv(b_ada, modp, b, 3072 + k); }
        __syncthreads();
        for (int r = 0; r < 16; ++r) { const int row = row0 + F.wave * 16 + r;
            const v2u* yr = (const v2u*)(Y + (size_t)row * D) + F.lane; const f32x4* xr = (const f32x4*)(xin + (size_t)row * D) + F.lane;
            f32x4 y[4], xv[4]; float ss = 0.f;
#pragma unroll
            for (int j = 0; j < 4; ++j) { const v2u t = yr[64 * j]; y[j] = (f32x4){bflo(t.x), bfhi(t.x), bflo(t.y), bfhi(t.y)}; xv[j] = xr[64 * j];
                ss += (y[j][0] * y[j][0] + y[j][1] * y[j][1]) + (y[j][2] * y[j][2] + y[j][3] * y[j][3]); }
            const float rstd = rsqrtf(wave_sum(ss) * (1.f / D) + EPS); float s1 = 0.f;
            f32x4* orow = (f32x4*)(outp + (size_t)row * D) + F.lane;
#pragma unroll
            for (int j = 0; j < 4; ++j) { const int k = 4 * F.lane + 256 * j; const f32x4 a = *(const LAS f32x4*)(a1 + k);
                xv[j] = xv[j] + a * (y[j] * rstd); orow[64 * j] = xv[j];
                s1 += (xv[j][0] * xv[j][0] + xv[j][1] * xv[j][1]) + (xv[j][2] * xv[j][2] + xv[j][3] * xv[j][3]); }
            const float rstd1 = rsqrtf(wave_sum(s1) * (1.f / D) + EPS);
            v2u* o8 = (v2u*)(H2 + (size_t)row * D) + F.lane;
#pragma unroll
            for (int j = 0; j < 4; ++j) { const int k = 4 * F.lane + 256 * j; const f32x4 g = *(const LAS f32x4*)(g2 + k), s = *(const LAS f32x4*)(s2 + k);
                v2u o; o.x = pk2(xv[j][0] * rstd1 * g[0] + s[0], xv[j][1] * rstd1 * g[1] + s[1]); o.y = pk2(xv[j][2] * rstd1 * g[2] + s[2], xv[j][3] * rstd1 * g[3] + s[3]); o8[64 * j] = o; }
        }
    }
}

__device__ __forceinline__ unsigned mono(float f) { const unsigned u = __float_as_uint(f); return u ^ ((unsigned)((int)u >> 31) | 0x80000000u); }
__device__ __forceinline__ float unmono(unsigned k) { return __uint_as_float((k & 0x80000000u) ? (k ^ 0x80000000u) : ~k); }
#define CE_DESC(a, b) do { const unsigned _mx = max((a), (b)), _mn = min((a), (b)); (a) = _mx; (b) = _mn; } while (0)
__device__ __forceinline__ void top16_of_64(unsigned (&x)[64]) {
#pragma unroll
    for (int g = 0; g < 4; ++g)
#pragma unroll
        for (int k = 2; k <= 16; k <<= 1)
#pragma unroll
            for (int j = k >> 1; j > 0; j >>= 1)
#pragma unroll
                for (int i = 0; i < 16; ++i) { const int l = i ^ j; if (l > i) { if ((i & k) == 0) CE_DESC(x[16 * g + i], x[16 * g + l]); else CE_DESC(x[16 * g + l], x[16 * g + i]); } }
#pragma unroll
    for (int s = 0; s < 3; ++s) { const int a = (s == 1) ? 32 : 0, b2 = (s == 0) ? 16 : (s == 1 ? 48 : 32);
#pragma unroll
        for (int i = 0; i < 16; ++i) x[a + i] = max(x[a + i], x[b2 + 15 - i]);
#pragma unroll
        for (int j = 8; j > 0; j >>= 1)
#pragma unroll
            for (int i = 0; i < 16; ++i) { const int l = i ^ j; if (l > i) CE_DESC(x[a + i], x[a + l]); } }
}
__device__ __forceinline__ void phase_topk(Frame& F, const bf16* Q2, int* EI, float* GA) {
    const int lane = F.lane, wave = F.wave, r = lane & 31, hh = lane >> 5, tsub = wave & 3, hgrp = wave >> 2;
    const bf16* skp = (const bf16*)(WSP() + WS_SK);
    LAS unsigned char* itab = F.lds + wave * 1024;
    for (int tile = blockIdx.x; tile < M / 128; tile += F.G) {
        const int m = tile * 128 + tsub * 32 + r;
#pragma unroll 1
        for (int hd = 0; hd < 4; ++hd) { const int h = hgrp * 4 + hd;
            unsigned k12[2][16];
#pragma unroll
            for (int p = 0; p < 2; ++p) {
                bf16x8 bq[8];
#pragma unroll
                for (int ks = 0; ks < 8; ++ks) bq[ks] = *(const bf16x8*)(Q2 + (size_t)m * 2048 + h * 256 + p * 128 + ks * 16 + hh * 8);
                unsigned keys[64];
#pragma unroll
                for (int kt = 0; kt < 4; ++kt) {
                    f32x16 acc;
#pragma unroll
                    for (int i = 0; i < 16; ++i) acc[i] = 0.f;
                    const bf16* skr = skp + ((size_t)(h * 2 + p) * 128 + kt * 32 + r) * 128 + hh * 8;
#pragma unroll
                    for (int ks = 0; ks < 8; ++ks) { const bf16x8 a = *(const bf16x8*)(skr + ks * 16); acc = __builtin_amdgcn_mfma_f32_32x32x16_bf16(a, bq[ks], acc, 0, 0, 0); }
#pragma unroll
                    for (int i = 0; i < 16; ++i) { const int keyidx = kt * 32 + (i & 3) + 8 * (i >> 2) + 4 * hh; keys[kt * 16 + i] = (mono(acc[i]) & ~127u) | (unsigned)(127 - keyidx); }
                }
                top16_of_64(keys);
                unsigned oth[16];
#pragma unroll
                for (int i = 0; i < 16; ++i) oth[i] = (unsigned)__shfl_xor((int)keys[i], 32);
#pragma unroll
                for (int i = 0; i < 16; ++i) keys[i] = max(keys[i], oth[15 - i]);
#pragma unroll
                for (int j = 8; j > 0; j >>= 1)
#pragma unroll
                    for (int i = 0; i < 16; ++i) { const int l = i ^ j; if (l > i) CE_DESC(keys[i], keys[l]); }
#pragma unroll
                for (int i = 0; i < 16; ++i) k12[p][i] = keys[i];
            }
            float v1[16], v2[16];
#pragma unroll
            for (int i = 0; i < 16; ++i) { v1[i] = unmono(k12[0][i] & ~127u); v2[i] = unmono(k12[1][i] & ~127u); }
            if (hh == 0) {
                v4u w0, w1;
#define PK4(K, b) ((127u - ((K)[b] & 127u)) | ((127u - ((K)[b + 1] & 127u)) << 8) | ((127u - ((K)[b + 2] & 127u)) << 16) | ((127u - ((K)[b + 3] & 127u)) << 24))
                w0.x = PK4(k12[0], 0); w0.y = PK4(k12[0], 4); w0.z = PK4(k12[0], 8); w0.w = PK4(k12[0], 12);
                w1.x = PK4(k12[1], 0); w1.y = PK4(k12[1], 4); w1.z = PK4(k12[1], 8); w1.w = PK4(k12[1], 12);
#undef PK4
                *(LAS v4u*)(itab + r * 32) = w0; *(LAS v4u*)(itab + r * 32 + 16) = w1; }
            unsigned ck[64];
            { int nn = 0;
#pragma unroll
              for (int i = 0; i < 16; ++i)
#pragma unroll
                  for (int j = 0; j < 16; ++j) if ((i + 1) * (j + 1) <= 16) { ck[nn] = (mono(v1[i] + v2[j]) & ~255u) | (unsigned)(255 - (i * 16 + j)); ++nn; }
#pragma unroll
              for (int q = 50; q < 64; ++q) ck[q] = 0u; }
            top16_of_64(ck);
            asm volatile("s_waitcnt lgkmcnt(0)" ::: "memory");
            float ts[16], es[16]; int ei[16]; float sum = 0.f;
#pragma unroll
            for (int q = 0; q < 16; ++q) { ts[q] = unmono(ck[q] & ~255u); const unsigned pos = 255u - (ck[q] & 255u);
                const unsigned e1 = itab[r * 32 + (pos >> 4)], e2 = itab[r * 32 + 16 + (pos & 15u)]; ei[q] = (int)(e1 * 128u + e2); }
#pragma unroll
            for (int q = 0; q < 16; ++q) { es[q] = __expf(ts[q] - ts[0]); sum += es[q]; }
            const float inv = 1.0f / sum;
            int eo[8]; float go[8];
#pragma unroll
            for (int q = 0; q < 8; ++q) { eo[q] = hh ? ei[q + 8] : ei[q]; go[q] = (hh ? es[q + 8] : es[q]) * inv; }
            int* ep = EI + (size_t)m * 128 + h * 16 + hh * 8; float* gp = GA + (size_t)m * 128 + h * 16 + hh * 8;
            *(v4u*)ep = (v4u){(unsigned)eo[0], (unsigned)eo[1], (unsigned)eo[2], (unsigned)eo[3]}; *(v4u*)(ep + 4) = (v4u){(unsigned)eo[4], (unsigned)eo[5], (unsigned)eo[6], (unsigned)eo[7]};
            *(f32x4*)gp = (f32x4){go[0], go[1], go[2], go[3]}; *(f32x4*)(gp + 4) = (f32x4){go[4], go[5], go[6], go[7]};
            asm volatile("s_waitcnt lgkmcnt(0)" ::: "memory");
        }
    }
}

typedef float f32x2 __attribute__((ext_vector_type(2)));
struct RowBuf { v4u u[2], v[2]; float su, svg; };
__device__ __forceinline__ void gather_load(RowBuf& B, int step, int g, int j, int e_lo, int e_hi, float g_lo, float g_hi, const unsigned char* tu, const unsigned char* tv, const float* su, const float* sv) {
    const int src = (step * 2 + g) & 63;
    const int eidx = __shfl(step < 32 ? e_lo : e_hi, src); const float gate = __shfl(step < 32 ? g_lo : g_hi, src);
    const unsigned char* ur = tu + (size_t)eidx * 1024 + 32 * j; const unsigned char* vr = tv + (size_t)eidx * 1024 + 32 * j;
    B.u[0] = *(const v4u*)ur; B.u[1] = *(const v4u*)(ur + 16); B.v[0] = *(const v4u*)vr; B.v[1] = *(const v4u*)(vr + 16);
    B.su = su[eidx]; B.svg = gate * sv[eidx];
}
__device__ __forceinline__ void gather_compute(const RowBuf& B, const unsigned (&hp)[16], float (&y)[32]) {
    float d0 = 0.f, d1 = 0.f;
#pragma unroll
    for (int i = 0; i < 2; ++i)
#pragma unroll
        for (int q = 0; q < 4; ++q) { const f32x2 a = __builtin_amdgcn_cvt_pk_f32_fp8(B.u[i][q], false), b = __builtin_amdgcn_cvt_pk_f32_fp8(B.u[i][q], true);
            const unsigned w0 = hp[i * 8 + 2 * q], w1 = hp[i * 8 + 2 * q + 1];
            d0 += a.x * bflo(w0) + a.y * bfhi(w0); d1 += b.x * bflo(w1) + b.y * bfhi(w1); }
    float d = d0 + d1;
    d += __shfl_xor(d, 1); d += __shfl_xor(d, 2); d += __shfl_xor(d, 4); d += __shfl_xor(d, 8); d += __shfl_xor(d, 16);
    d *= B.su;
    const float wgt = B.svg * 0.5f * d * (1.0f + erff(d * 0.70710678118654752f));
#pragma unroll
    for (int i = 0; i < 2; ++i)
#pragma unroll
        for (int q = 0; q < 4; ++q) { const f32x2 a = __builtin_amdgcn_cvt_pk_f32_fp8(B.v[i][q], false), b = __builtin_amdgcn_cvt_pk_f32_fp8(B.v[i][q], true);
            y[i * 16 + 4 * q] += wgt * a.x; y[i * 16 + 4 * q + 1] += wgt * a.y; y[i * 16 + 4 * q + 2] += wgt * b.x; y[i * 16 + 4 * q + 3] += wgt * b.y; }
}
__device__ __forceinline__ void phase_gather(Frame& F, const bf16* H2, const int* EI, const float* GA) {
    LAS float* a2 = (LAS float*)F.lds;
    unsigned char* ws = WSP(); const unsigned char* tu = ws + WS_TU; const unsigned char* tv = ws + WS_TV; const float* su = (const float*)(ws + WS_SU); const float* sv = (const float*)(ws + WS_SV); float* outp = OUTP();
    const float* npf = IN(I_NPOSTFFN); const float* b_ada = IN(I_BADA); const float* modp = (const float*)(ws + WS_MODP);
    const int lane = F.lane, g = lane >> 5, j = lane & 31;
    for (int rb = blockIdx.x; rb < M / 128; rb += F.G) {
        const int row0 = rb * 128, b = row0 / SEQ;
        __syncthreads();
        for (int k = F.tid; k < 1024; k += NTHR) a2[k] = modv(b_ada, modp, b, 5120 + k) * npf[k];
        __syncthreads();
        for (int ti = 0; ti < 16; ++ti) { const int m = row0 + F.wave * 16 + ti;
            unsigned hp[16];
#pragma unroll
            for (int i = 0; i < 4; ++i) { const v4u h0 = *(const v4u*)(H2 + (size_t)m * D + 32 * j + 8 * i); hp[i * 4 + 0] = h0.x; hp[i * 4 + 1] = h0.y; hp[i * 4 + 2] = h0.z; hp[i * 4 + 3] = h0.w; }
            const int e_lo = EI[(size_t)m * 128 + lane], e_hi = EI[(size_t)m * 128 + 64 + lane];
            const float g_lo = GA[(size_t)m * 128 + lane], g_hi = GA[(size_t)m * 128 + 64 + lane];
            float y[32];
#pragma unroll
            for (int q = 0; q < 32; ++q) y[q] = 0.f;
            RowBuf B0, B1, B2, B3;
#define GLOAD(B, st) gather_load(B, (st), g, j, e_lo, e_hi, g_lo, g_hi, tu, tv, su, sv)
            GLOAD(B0, 0); GLOAD(B1, 1); GLOAD(B2, 2);
#pragma unroll 1
            for (int st = 0; st < 64; st += 4) {
#define SB() __builtin_amdgcn_sched_barrier(0)
                const int s4 = (st + 4 < 64) ? st + 4 : 63, s5 = (st + 5 < 64) ? st + 5 : 63, s6 = (st + 6 < 64) ? st + 6 : 63;
                GLOAD(B3, st + 3); SB(); gather_compute(B0, hp, y); SB();
                GLOAD(B0, s4); SB(); gather_compute(B1, hp, y); SB();
                GLOAD(B1, s5); SB(); gather_compute(B2, hp, y); SB();
                GLOAD(B2, s6); SB(); gather_compute(B3, hp, y); SB();
#undef SB
            }
#undef GLOAD
            float ss = 0.f;
#pragma unroll
            for (int q = 0; q < 32; ++q) { y[q] += __shfl_xor(y[q], 32); ss += y[q] * y[q]; }
            ss += __shfl_xor(ss, 1); ss += __shfl_xor(ss, 2); ss += __shfl_xor(ss, 4); ss += __shfl_xor(ss, 8); ss += __shfl_xor(ss, 16);
            const float rstd = rsqrtf(ss * (1.f / D) + EPS);
            const int k = 32 * j + 16 * g;
            f32x4* op = (f32x4*)(outp + (size_t)m * D + k);
#pragma unroll
            for (int q = 0; q < 4; ++q) { f32x4 xv = op[q]; const f32x4 av = *(const LAS f32x4*)(a2 + k + 4 * q);
#pragma unroll
                for (int t = 0; t < 4; ++t) { const int e = 4 * q + t; const float yy = g ? y[16 + e] : y[e]; xv[t] += av[t] * yy * rstd; }
                op[q] = xv; }
        }
    }
}

typedef GAS unsigned gu32;
#define XB_TMO      128
#define XB_XCNT(j)  (256  + 64 * (j))
#define XB_XSUB(j)  (1280 + 64 * (j))
#define XB_XGEN(j)  (2304 + 64 * (j))
#define XB_TOP      3328
#define XB_TOPGEN   3392
#define XCD_BAR_WORDS 3456
#define XB_SPIN_CAP (1u << 18)

__device__ __forceinline__ unsigned xb_ld(unsigned* p)              { return __hip_atomic_load(p, __ATOMIC_RELAXED, __HIP_MEMORY_SCOPE_AGENT); }
__device__ __forceinline__ unsigned xb_add(unsigned* p, unsigned v) { return __hip_atomic_fetch_add(p, v, __ATOMIC_RELAXED, __HIP_MEMORY_SCOPE_AGENT); }
__device__ __forceinline__ unsigned xb_xcc_id() { return (unsigned)__builtin_amdgcn_s_getreg((3 << 11) | 20) & 0xFu; }
#define XB_SPIN(cond, bar) do { unsigned _sp = 0; while (cond) { __builtin_amdgcn_s_sleep(1); \
    if ((++_sp & 255u) == 0u) { if (xb_ld(&(bar)[XB_TMO])) break; if (_sp > XB_SPIN_CAP) { atomicAdd(&(bar)[XB_TMO], 1u); break; } } } } while (0)

struct XcdBarrier {
    unsigned* bar; unsigned x;
    volatile LAS unsigned* st;
};

__device__ __forceinline__ XcdBarrier xcd_barrier_post(unsigned* bar, volatile LAS unsigned* st) {
    XcdBarrier b; b.bar = bar; b.x = xb_xcc_id(); b.st = st;
    if (threadIdx.x == 0) (void)xb_add(&bar[XB_XCNT(b.x)], 1u);
    return b;
}
__device__ __forceinline__ void xcd_barrier_complete(unsigned* bar, unsigned x, unsigned& nloc, unsigned& nx) {
    const unsigned G = gridDim.x * gridDim.y * gridDim.z;
    unsigned sum, cnt, mine, sp = 0u;
    for (;;) {
        sum = 0u; cnt = 0u; mine = 0u;
#pragma unroll
        for (unsigned j = 0; j < 16; ++j) { const unsigned c = xb_ld(&bar[XB_XCNT(j)]); sum += c; cnt += (c > 0u) ? 1u : 0u; mine = (j == x) ? c : mine; }
        if (sum == G) break;
        __builtin_amdgcn_s_sleep(1);
        if ((++sp & 255u) == 0u) { if (xb_ld(&bar[XB_TMO])) break; if (sp > XB_SPIN_CAP) { atomicAdd(&bar[XB_TMO], 1u); break; } }
    }
    nloc = mine > 0u ? mine : 1u; nx = cnt > 0u ? cnt : 1u;
}

__device__ __forceinline__ void xcd_barrier(const XcdBarrier& b) {
    asm volatile("s_waitcnt vmcnt(0)" ::: "memory");
    __syncthreads();
    if (threadIdx.x == 0) {
        unsigned* bar = b.bar;
        __builtin_amdgcn_s_waitcnt(0);
        unsigned nloc = b.st[0], nx = b.st[1];
        if (nloc == 0u) { xcd_barrier_complete(bar, b.x, nloc, nx); b.st[0] = nloc; b.st[1] = nx; }
        const unsigned old = xb_add(&bar[XB_XSUB(b.x)], 1u);
        const unsigned gen = old / nloc;
        if (old + 1u == (gen + 1u) * nloc) {
            __builtin_amdgcn_fence(__ATOMIC_RELEASE, "agent");
            asm volatile("s_waitcnt vmcnt(0)" ::: "memory");
            const unsigned og = xb_add(&bar[XB_TOP], 1u);
            const unsigned tg = og / nx;
            if (og + 1u == (tg + 1u) * nx) xb_add(&bar[XB_TOPGEN], 1u);
            else XB_SPIN(xb_ld(&bar[XB_TOPGEN]) == tg, bar);
            __builtin_amdgcn_fence(__ATOMIC_ACQUIRE, "agent");
            xb_add(&bar[XB_XGEN(b.x)], 1u);
            asm volatile("s_waitcnt vmcnt(0)" ::: "memory");
        } else {
            XB_SPIN(xb_ld(&bar[XB_XGEN(b.x)]) == gen, bar);
            __builtin_amdgcn_fence(__ATOMIC_ACQUIRE, "agent");
            asm volatile("s_waitcnt vmcnt(0)" ::: "memory");
        }
    }
    __syncthreads();
}

struct Args { const float* in[21]; float* out; unsigned char* ws; };
__global__ void __launch_bounds__(NTHR, 2) fwd_megakernel(Args args) {
    extern __shared__ __attribute__((aligned(16))) unsigned char lds[];
#define MKFRAME() Frame F; { int t_ = threadIdx.x; asm volatile("" : "+v"(t_)); F.lds = (LAS unsigned char*)lds; F.tid = t_; F.lane = t_ & 63; F.wave = __builtin_amdgcn_readfirstlane(t_ >> 6); F.G = gridDim.x; }
#define GRID_SYNC() cg::this_grid().sync()
    volatile LAS unsigned* bst = (volatile LAS unsigned*)((LAS unsigned char*)lds + LDS_BYTES - 64);
    if (threadIdx.x < 16) bst[threadIdx.x] = 0u;
    __syncthreads();
    const XcdBarrier xbar = xcd_barrier_post((unsigned*)(WSP() + WS_CTL) + 1024, bst);
#define XSYNC() xcd_barrier(xbar)
#define WSB(off) ((bf16*)(WSP() + (off)))
#define SEGP(s) segp(WSP(), (s))
    { MKFRAME();
    phase_prologue(F);
    }
    GRID_SYNC();
    { MKFRAME();
    phase_h1(F, (bf16*)OUTP());
    }
    XSYNC();
    { MKFRAME();
    {
        pg8::Gemm g{(const bf16*)OUTP(), WSB(WS_WIN), M, NIN, D}; pg8::StaticOrder S; S.init(M, NIN, F.G, (int)blockIdx.x);
        pg8::EpiBf16<0> E{SEGP(0), 512, nullptr, 512, SEG_ELEMS, 1.f};
        pg8::gemm_phase<pg8::EpiBf16<0>, pg8::StaticOrder, true, true>(F.lds, g, S, E);
    }
    }
    XSYNC();
    { MKFRAME();
    phase_scprep(F);
    { bf16* dW = (bf16*)OUTP(); phase_dnprep(F, dW, dW + (size_t)NITEM * 4096, dW + (size_t)2 * NITEM * 4096, dW + (size_t)3 * NITEM * 4096, WSB(WS_KD)); }
    }
    XSYNC();
    { MKFRAME();
    { const bf16* dW = (const bf16*)OUTP(); phase_scan(F, dW, dW + (size_t)NITEM * 4096, dW + (size_t)2 * NITEM * 4096, dW + (size_t)3 * NITEM * 4096, WSB(WS_KD), SEGP(3), SEGP(6)); }
    }
    XSYNC();
    { MKFRAME();
    {
        pg8::StaticOrder S; S.init(M, D, F.G, (int)blockIdx.x);
        { pg8::Gemm g{SEGP(0), WSB(WS_WSC), M, D, 512}; pg8::EpiGate<false> E{SEGP(4), SEGP(7), SEG_ELEMS};
          pg8::gemm_phase<pg8::EpiGate<false>, pg8::StaticOrder, true, true>(F.lds, g, S, E); }
        { pg8::Gemm g{SEGP(3), WSB(WS_WDN), M, D, 512}; pg8::EpiGate<true> E{SEGP(4), SEGP(9), SEG_ELEMS};
          pg8::gemm_phase<pg8::EpiGate<true>, pg8::StaticOrder, true, true>(F.lds, g, S, E); }
    }
    }
    XSYNC();
    { MKFRAME();
    {
        pg8::Gemm g{SEGP(4), WSB(WS_WMIX), M, D, D}; pg8::StaticOrder S; S.init(M, D, F.G, (int)blockIdx.x);
        pg8::EpiBf16<0> E{SEGP(1), D, nullptr, 0, 0, 1.f};
        pg8::gemm_phase<pg8::EpiBf16<0>, pg8::StaticOrder, true, true>(F.lds, g, S, E);
    }
    }
    XSYNC();
    { MKFRAME();
    phase_x1h2(F, SEGP(1), SEGP(7));
    }
    XSYNC();
    { MKFRAME();
    {
        pg8::Gemm g{SEGP(7), WSB(WS_WQ), M, 2048, D}; pg8::StaticOrder S; S.init(M, 2048, F.G, (int)blockIdx.x);
        pg8::EpiBf16<0> E{SEGP(3), 2048, nullptr, 0, 0, 1.f};
        pg8::gemm_phase<pg8::EpiBf16<0>, pg8::StaticOrder, true, true>(F.lds, g, S, E);
    }
    }
    XSYNC();
    { MKFRAME();
    phase_topk(F, SEGP(3), (int*)SEGP(0), (float*)((unsigned char*)SEGP(0) + 16 * MiB));
    }
    XSYNC();
    { MKFRAME();
    phase_gather(F, SEGP(7), (const int*)SEGP(0), (const float*)((unsigned char*)SEGP(0) + 16 * MiB));
    }
}

extern "C" void kernel_launch(void* const* d_in, const int* in_sizes, int n_in, void* d_out, int out_size, void* d_ws, size_t ws_size, hipStream_t stream) {
    static int grid = 0;
    if (grid == 0) {
        if (n_in != 21 || out_size != M * D || ws_size < WS_END) { fprintf(stderr, "kernel_launch: unexpected problem (n_in %d, out %d, ws %zu)\n", n_in, out_size, ws_size); grid = -1; return; }
        int dev = 0, cus = 0, per_cu = 0;
        hipGetDevice(&dev); hipDeviceGetAttribute(&cus, hipDeviceAttributeMultiprocessorCount, dev);
        hipFuncSetAttribute((const void*)fwd_megakernel, hipFuncAttributeMaxDynamicSharedMemorySize, LDS_BYTES);
        hipOccupancyMaxActiveBlocksPerMultiprocessor(&per_cu, (const void*)fwd_megakernel, NTHR, LDS_BYTES);
        if (per_cu < 1) { fprintf(stderr, "kernel_launch: occupancy query says %d blocks per CU\n", per_cu); per_cu = 1; }
        if (per_cu > 1) per_cu = 1;
        grid = cus * per_cu; if (grid > 256) grid = 256;
        (void)hipGetLastError();
    }
    if (grid < 0) return;
    if (hipMemsetAsync((char*)d_ws + WS_CTL, 0, 65536, stream) != hipSuccess) { fprintf(stderr, "kernel_launch: memset of the barrier words failed\n"); return; }
    Args a{};
    for (int i = 0; i < 21; ++i) a.in[i] = (const float*)d_in[i];
    a.out = (float*)d_out; a.ws = (unsigned char*)d_ws;
    void* kargs[] = {&a};
    hipError_t e = hipLaunchCooperativeKernel((const void*)fwd_megakernel, dim3(grid), dim3(NTHR), kargs, LDS_BYTES, stream);
    if (e != hipSuccess) fprintf(stderr, "cooperative launch failed: %s (grid %d)\n", hipGetErrorString(e), grid);
}
```

```cpp
#include <hip/hip_runtime.h>
#include <hip/hip_cooperative_groups.h>
#include <cstdio>
#include <cstdint>
namespace cg = cooperative_groups;
namespace pg8 {
#define PG8_LAS __attribute__((address_space(3)))
typedef unsigned short bf16_t;
typedef short bf16x8 __attribute__((ext_vector_type(8)));
typedef float f32x4 __attribute__((ext_vector_type(4)));
typedef unsigned u32x4 __attribute__((ext_vector_type(4)));
constexpr int BM = 256, BK = 64, HALF = 128, HTB = HALF * BK * 2  , STAGE_BYTES = 8 * HTB, NXCD = 8, WGM = 8;

__host__ __device__ __forceinline__ int lds_byte(int r, int c) { const int st = (r >> 4) * 2 + (c >> 5), rr = r & 15, cc = c & 31, ob = rr * 64 + cc * 2; return st * 1024 + (ob ^ (((ob >> 9) & 1) << 5)); }
__host__ __device__ __forceinline__ void stage_rc(int b, int& R, int& C) { const int st = b / 1024, sb = b % 1024, swz = sb ^ (((sb >> 9) & 1) << 5); R = (st >> 1) * 16 + swz / 64; C = (st & 1) * 32 + (swz % 64) / 2; }
__host__ __device__ __forceinline__ int perm32(int rho) { const int n = rho >> 4, i = rho & 15; return 8 * (i >> 2) + 4 * n + (i & 3); }

struct Unit { int pm, pn; };
struct Gemm { const bf16_t* A; const bf16_t* Bt; int M, N, K; };

struct StaticOrder {
    int nM, nN, nwg, G, c;
    __host__ __device__ void init(int M, int N, int G_, int c_) { nM = M / BM; nN = N / BM; nwg = nM * nN; G = G_; c = c_; }
    __host__ __device__ bool next(int i, Unit& u) const {
        const long L = (long)i * G + c; if (L >= nwg) return false;
        int wgid = (int)L; { const int q = nwg / NXCD, r = nwg % NXCD, xcd = wgid % NXCD, off = wgid / NXCD; wgid = (xcd < r ? xcd * (q + 1) : r * (q + 1) + (xcd - r) * q) + off; }
        const int nig = WGM * nN, gid = wgid / nig, fm = gid * WGM, gsz = (nM - fm) < WGM ? (nM - fm) : WGM;
        u.pm = fm + ((wgid % nig) % gsz); u.pn = (wgid % nig) / gsz; return true;
    }
    __device__ __forceinline__ void a_ready(const Unit&) const {}
    __device__ __forceinline__ void done(const Unit&) const {}
};

__device__ __forceinline__ unsigned cvt_pk_bf16(float lo, float hi) { unsigned r; asm volatile("v_cvt_pk_bf16_f32 %0, %1, %2" : "=v"(r) : "v"(lo), "v"(hi)); return r; }
typedef float f32x2 __attribute__((ext_vector_type(2)));
__device__ __forceinline__ f32x2 gelu_pk(f32x2 v) {
    const f32x2 av = __builtin_elementwise_abs(v), d = av * 0.2316418882f + 1.0f;
    f32x2 t; t.x = __builtin_amdgcn_rcpf(d.x); t.y = __builtin_amdgcn_rcpf(d.y);
    f32x2 q = t * 0.5307027145f + (-0.7265760135f); q = q * t + 0.7107068705f; q = q * t + (-0.142248368f); q = q * t + 0.127414796f; q = q * t;
    const f32x2 s = (v * v) * (-0.72134752044f);
    f32x2 e; e.x = __builtin_amdgcn_exp2f(s.x); e.y = __builtin_amdgcn_exp2f(s.y);
    const f32x2 m = v * (q * e), r = v - m;
    f32x2 o; o.x = v.x < 0.f ? m.x : r.x; o.y = v.y < 0.f ? m.y : r.y; return o;
}

template <int ACT  > struct EpiBf16 {
    static constexpr bool PERM = true, AFTER_DRAIN = false; static_assert(ACT == 0 || ACT == 1, "EpiBf16: ACT is 0 (none) or 1 (gelu_pk)");
    bf16_t* O; int ldc; const float* bias; int split_cols; size_t split_stride; float scale0;
    __device__ __forceinline__ void operator()(const f32x4 (&acc)[2][2][4][2], const Unit& u, int wr, int wc, int fr, int fq) const {
        const int row0 = u.pm * BM + wr * 64 + fr; int colt = u.pn * BM; bf16_t* base = O;
        float sc = 1.f; if (split_cols) { const int t = colt / split_cols; base += (size_t)t * split_stride; colt -= t * split_cols; if (t == 0) sc = scale0; }
        const int col0 = colt + wc * 32 + 8 * fq, bcol0 = u.pn * BM + wc * 32 + 8 * fq;
        f32x4 bv[2][2];
#pragma unroll
        for (int bj = 0; bj < 2; ++bj)
#pragma unroll
            for (int n = 0; n < 2; ++n) bv[bj][n] = bias ? *(const f32x4*)(bias + bcol0 + bj * HALF + 4 * n) : (f32x4){0.f, 0.f, 0.f, 0.f};
#pragma unroll
        for (int ai = 0; ai < 2; ++ai)
#pragma unroll
            for (int m = 0; m < 4; ++m) { bf16_t* rowp = base + (size_t)(row0 + ai * HALF + m * 16) * ldc + col0;
#pragma unroll
                for (int bj = 0; bj < 2; ++bj) { f32x4 v0 = acc[ai][bj][m][0] + bv[bj][0], v1 = acc[ai][bj][m][1] + bv[bj][1];
                    if (ACT == 1) { f32x2 a = gelu_pk((f32x2){v0[0], v0[1]}), b = gelu_pk((f32x2){v0[2], v0[3]}), c = gelu_pk((f32x2){v1[0], v1[1]}), d = gelu_pk((f32x2){v1[2], v1[3]});
                        v0 = (f32x4){a.x, a.y, b.x, b.y}; v1 = (f32x4){c.x, c.y, d.x, d.y}; }
                    v0 = v0 * sc; v1 = v1 * sc; u32x4 w; w.x = cvt_pk_bf16(v0[0], v0[1]); w.y = cvt_pk_bf16(v0[2], v0[3]); w.z = cvt_pk_bf16(v1[0], v1[1]); w.w = cvt_pk_bf16(v1[2], v1[3]);
                    *(u32x4*)(rowp + bj * HALF) = w; } }
    }
};
__device__ __forceinline__ float bf_lo(unsigned u) { return __uint_as_float(u << 16); }
__device__ __forceinline__ float bf_hi(unsigned u) { return __uint_as_float(u & 0xffff0000u); }
__device__ __forceinline__ float sigm(float x) { return __builtin_amdgcn_rcpf(1.0f + __builtin_amdgcn_exp2f(-1.4426950408889634f * x)); }
template <bool ADD> struct EpiGate {
    static constexpr bool PERM = true, AFTER_DRAIN = false;
    bf16_t* O; const bf16_t* gate; size_t seg_elems;
    __device__ __forceinline__ void operator()(const f32x4 (&acc)[2][2][4][2], const Unit& u, int wr, int wc, int fr, int fq) const {
        const int row0 = u.pm * BM + wr * 64 + fr, col0 = u.pn * BM + wc * 32 + 8 * fq;
#pragma unroll
        for (int ai = 0; ai < 2; ++ai)
#pragma unroll
            for (int m = 0; m < 4; ++m) { const int row = row0 + ai * HALF + m * 16;
#pragma unroll
                for (int bj = 0; bj < 2; ++bj) { const int col = col0 + bj * HALF;
                    const u32x4 gv = *(const u32x4*)(gate + (size_t)(col >> 9) * seg_elems + (size_t)row * 512 + (col & 511));
                    bf16_t* op = O + (size_t)row * 1024 + col;
                    f32x4 v0 = acc[ai][bj][m][0], v1 = acc[ai][bj][m][1];
                    v0[0] *= sigm(bf_lo(gv.x)); v0[1] *= sigm(bf_hi(gv.x)); v0[2] *= sigm(bf_lo(gv.y)); v0[3] *= sigm(bf_hi(gv.y));
                    v1[0] *= sigm(bf_lo(gv.z)); v1[1] *= sigm(bf_hi(gv.z)); v1[2] *= sigm(bf_lo(gv.w)); v1[3] *= sigm(bf_hi(gv.w));
                    if (ADD) { const u32x4 ov = *(const u32x4*)op;
                        v0[0] += bf_lo(ov.x); v0[1] += bf_hi(ov.x); v0[2] += bf_lo(ov.y); v0[3] += bf_hi(ov.y);
                        v1[0] += bf_lo(ov.z); v1[1] += bf_hi(ov.z); v1[2] += bf_lo(ov.w); v1[3] += bf_hi(ov.w); }
                    u32x4 w; w.x = cvt_pk_bf16(v0[0], v0[1]); w.y = cvt_pk_bf16(v0[2], v0[3]); w.z = cvt_pk_bf16(v1[0], v1[1]); w.w = cvt_pk_bf16(v1[2], v1[3]);
                    *(u32x4*)op = w; } }
    }
};
template <class Epi, class Sched, bool ALIGN_EPI = false, bool SP2 = false>
__device__ __forceinline__ void gemm_phase(PG8_LAS unsigned char* lds, const Gemm g, const Sched& S, const Epi& E) {
    int tid_ = threadIdx.x; asm volatile("" : "+v"(tid_));
    const int tid = tid_, wid = __builtin_amdgcn_readfirstlane(tid >> 6), lane = tid & 63, wr = wid >> 2, wc = wid & 3, fr = lane & 15, fq = lane >> 4;
    const int K = g.K, nt = K / BK;
    unsigned voffA[2], voffB[2];
#pragma unroll
    for (int i = 0; i < 2; ++i) { int R, C; stage_rc(tid * 16 + i * 8192, R, C); const int Rb = Epi::PERM ? ((R & ~31) + perm32(R & 31)) : R;
        voffA[i] = (unsigned)(R * K + C) * 2u; voffB[i] = (unsigned)(Rb * K + C) * 2u; }
    const size_t kstep = (size_t)(BK * 2);
    const size_t hstep = (size_t)HALF * K * 2;
    const size_t tstep = 2 * hstep;
    const unsigned ldsw = (unsigned)wid * 1024u;
    const int aoff = lds_byte(wr * 64 + fr, fq * 8), boff = lds_byte(wc * 32 + fr, fq * 8);
#define PG8_SA(b, h) (((b) * 2 + (h)) * HTB)
#define PG8_SB(b, h) ((4 + (b) * 2 + (h)) * HTB)
#define PG8_STAGE(bufoff, gbase, voff) do { _Pragma("unroll") for (int _i = 0; _i < 2; ++_i) \
        __builtin_amdgcn_global_load_lds((const unsigned*)((const char*)(gbase) + (voff)[_i]), (PG8_LAS unsigned*)(lds + (bufoff) + ldsw + _i * 8192), 16, 0, 0); } while (0)
#define PG8_LDA(dst, b, h) do { _Pragma("unroll") for (int m = 0; m < 4; ++m) _Pragma("unroll") for (int k = 0; k < 2; ++k) dst[m][k] = *(const PG8_LAS bf16x8*)(lds + PG8_SA(b, h) + aoff + m * 2048 + k * 1024); } while (0)
#define PG8_LDB(dst, b, h) do { _Pragma("unroll") for (int n = 0; n < 2; ++n) _Pragma("unroll") for (int k = 0; k < 2; ++k) dst[n][k] = *(const PG8_LAS bf16x8*)(lds + PG8_SB(b, h) + boff + n * 2048 + k * 1024); } while (0)
#define PG8_MMA(ai, bj, At, Bt) do { __builtin_amdgcn_s_setprio(1); _Pragma("unroll") for (int m = 0; m < 4; ++m) _Pragma("unroll") for (int n = 0; n < 2; ++n) _Pragma("unroll") for (int k = 0; k < 2; ++k) \
        acc[ai][bj][m][n] = __builtin_amdgcn_mfma_f32_16x16x32_bf16(Bt[n][k], At[m][k], acc[ai][bj][m][n], 0, 0, 0); __builtin_amdgcn_s_setprio(0); } while (0)
#define PG8_WAIT_V(n) asm volatile("s_waitcnt vmcnt(" #n ")" ::: "memory")
#define PG8_WAIT_L(n) asm volatile("s_waitcnt lgkmcnt(" #n ")" ::: "memory")
#define PG8_BAR __builtin_amdgcn_s_barrier()
#define PG8_SCHED __builtin_amdgcn_sched_barrier(0)
    Unit cur, nxt; int ui = 0;
    if (!S.next(0, cur)) return;
    f32x4 acc[2][2][4][2];
#pragma unroll
    for (int a = 0; a < 2; ++a)
#pragma unroll
        for (int b = 0; b < 2; ++b)
#pragma unroll
            for (int m = 0; m < 4; ++m)
#pragma unroll
                for (int n = 0; n < 2; ++n) acc[a][b][m][n] = (f32x4){0.f, 0.f, 0.f, 0.f};
    bf16x8 At[4][2], B0[2][2], B1[2][2];
    const char* cA = (const char*)g.A + (size_t)cur.pm * tstep; const char* cB = (const char*)g.Bt + (size_t)cur.pn * tstep;
    S.a_ready(cur);
    if constexpr (SP2) {
        PG8_STAGE(PG8_SB(0, 0), cB, voffB); PG8_STAGE(PG8_SB(0, 1), cB + hstep, voffB); PG8_STAGE(PG8_SA(0, 0), cA, voffA); PG8_STAGE(PG8_SA(0, 1), cA + hstep, voffA);
        if (wr == 1) PG8_BAR;
        PG8_WAIT_V(2); PG8_BAR;
        PG8_STAGE(PG8_SB(1, 0), cB + kstep, voffB); PG8_STAGE(PG8_SA(1, 0), cA + kstep, voffA); PG8_STAGE(PG8_SB(1, 1), cB + hstep + kstep, voffB);
        PG8_WAIT_V(6); PG8_BAR;
    } else {
        PG8_STAGE(PG8_SB(0, 0), cB, voffB); PG8_STAGE(PG8_SA(0, 0), cA, voffA); PG8_STAGE(PG8_SB(0, 1), cB + hstep, voffB); PG8_STAGE(PG8_SA(0, 1), cA + hstep, voffA);
        if (wr == 1) PG8_BAR;
        PG8_WAIT_V(4); PG8_BAR;
        PG8_STAGE(PG8_SB(1, 0), cB + kstep, voffB); PG8_STAGE(PG8_SA(1, 0), cA + kstep, voffA); PG8_STAGE(PG8_SB(1, 1), cB + hstep + kstep, voffB);
        PG8_WAIT_V(6); PG8_BAR;
    }
    for (;;) {
        const bool has_next = S.next(ui + 1, nxt);
        const char* nA = has_next ? (const char*)g.A + (size_t)nxt.pm * tstep : cA; const char* nB = has_next ? (const char*)g.Bt + (size_t)nxt.pn * tstep : cB;
        for (int t = 0; t < nt; t += 2) {
            const bool last = (t == nt - 2);
            const char* a1 = cA + (size_t)(t + 1) * kstep;
            const char* a2 = last ? nA : cA + (size_t)(t + 2) * kstep; const char* b2 = last ? nB : cB + (size_t)(t + 2) * kstep;
            const char* a3 = a2 + kstep; const char* b3 = b2 + kstep;
            if (last && has_next) S.a_ready(nxt);
            if constexpr (SP2) {
            PG8_LDB(B0, 0, 0); PG8_LDB(B1, 0, 1); PG8_SCHED; PG8_LDA(At, 0, 0); PG8_STAGE(PG8_SA(1, 1), a1 + hstep, voffA);
            PG8_WAIT_V(8); PG8_WAIT_L(0); PG8_BAR; PG8_MMA(0, 0, At, B0); PG8_MMA(0, 1, At, B1); PG8_BAR; PG8_SCHED;
            PG8_LDA(At, 0, 1); PG8_STAGE(PG8_SB(0, 0), b2, voffB); PG8_STAGE(PG8_SB(0, 1), b2 + hstep, voffB); PG8_STAGE(PG8_SA(0, 0), a2, voffA);
            PG8_WAIT_V(8); PG8_WAIT_L(0); PG8_BAR; PG8_MMA(1, 0, At, B0); PG8_MMA(1, 1, At, B1); PG8_BAR; PG8_SCHED;
            PG8_LDB(B0, 1, 0); PG8_LDB(B1, 1, 1); PG8_SCHED; PG8_LDA(At, 1, 0); PG8_STAGE(PG8_SA(0, 1), a2 + hstep, voffA);
            PG8_WAIT_V(8); PG8_WAIT_L(0); PG8_BAR; PG8_MMA(0, 0, At, B0); PG8_MMA(0, 1, At, B1); PG8_BAR; PG8_SCHED;
            PG8_LDA(At, 1, 1); PG8_STAGE(PG8_SB(1, 0), b3, voffB); PG8_STAGE(PG8_SB(1, 1), b3 + hstep, voffB); PG8_STAGE(PG8_SA(1, 0), a3, voffA);
            PG8_WAIT_V(8); PG8_WAIT_L(0); PG8_BAR; PG8_MMA(1, 0, At, B0); PG8_MMA(1, 1, At, B1); PG8_BAR; PG8_SCHED;
            } else {
            PG8_LDB(B0, 0, 0); PG8_SCHED; PG8_LDA(At, 0, 0); PG8_STAGE(PG8_SA(1, 1), a1 + hstep, voffA);
            PG8_WAIT_L(8); PG8_BAR; PG8_WAIT_L(0); PG8_MMA(0, 0, At, B0); PG8_BAR; PG8_SCHED;
            PG8_LDB(B1, 0, 1); PG8_STAGE(PG8_SB(0, 0), b2, voffB);
            PG8_BAR; PG8_WAIT_L(0); PG8_MMA(0, 1, At, B1); PG8_BAR;
            PG8_LDA(At, 0, 1); PG8_STAGE(PG8_SA(0, 0), a2, voffA);
            PG8_BAR; PG8_WAIT_L(0); PG8_MMA(1, 0, At, B0); PG8_BAR; PG8_SCHED;
            PG8_STAGE(PG8_SB(0, 1), b2 + hstep, voffB);
            PG8_WAIT_V(6); PG8_BAR; PG8_MMA(1, 1, At, B1); PG8_BAR;
            PG8_LDB(B0, 1, 0); PG8_SCHED; PG8_LDA(At, 1, 0); PG8_STAGE(PG8_SA(0, 1), a2 + hstep, voffA);
            PG8_WAIT_L(8); PG8_BAR; PG8_WAIT_L(0); PG8_MMA(0, 0, At, B0); PG8_BAR; PG8_SCHED;
            PG8_LDB(B1, 1, 1); PG8_STAGE(PG8_SB(1, 0), b3, voffB);
            PG8_BAR; PG8_WAIT_L(0); PG8_MMA(0, 1, At, B1); PG8_BAR;
            PG8_LDA(At, 1, 1); PG8_STAGE(PG8_SA(1, 0), a3, voffA);
            PG8_BAR; PG8_WAIT_L(0); PG8_MMA(1, 0, At, B0); PG8_BAR; PG8_SCHED;
            PG8_STAGE(PG8_SB(1, 1), b3 + hstep, voffB);
            PG8_WAIT_V(6); PG8_BAR; PG8_MMA(1, 1, At, B1); PG8_BAR;
            }
        }
        if constexpr (ALIGN_EPI) { if (wr == 0) PG8_BAR; }
        if constexpr (!Epi::AFTER_DRAIN) { E(acc, cur, wr, wc, fr, fq); S.done(cur); }
        if (!has_next) break;
#pragma unroll
        for (int a = 0; a < 2; ++a)
#pragma unroll
            for (int b = 0; b < 2; ++b)
#pragma unroll
                for (int m = 0; m < 4; ++m)
#pragma unroll
                    for (int n = 0; n < 2; ++n) acc[a][b][m][n] = (f32x4){0.f, 0.f, 0.f, 0.f};
        cur = nxt; cA = nA; cB = nB; ++ui;
        if constexpr (ALIGN_EPI) { if (wr == 1) PG8_BAR; }
    }
    PG8_WAIT_V(0);
    if constexpr (!ALIGN_EPI) { if (wr == 0) PG8_BAR; }
    PG8_BAR;
    if constexpr (Epi::AFTER_DRAIN) { E.fused(acc, cur, wr, wc, fr, fq, lds, wid, lane); S.done(cur); }
#undef PG8_SA
#undef PG8_SB
#undef PG8_STAGE
#undef PG8_LDA
#undef PG8_LDB
#undef PG8_MMA
#undef PG8_WAIT_V
#undef PG8_WAIT_L
#undef PG8_BAR
#undef PG8_SCHED
}
}
constexpr int NWAVES = 8, NTHR = 512;
constexpr int M = 32768, D = 1024, SEQ = 8192, NBATCH = 4;
constexpr int NIN = 5888;
constexpr int NCHUNK = 128, NITEM = 32 * NCHUNK;
constexpr float EPS = 1e-6f;
constexpr size_t MiB = 1u << 20;
constexpr size_t SEG_ELEMS = (size_t)M * 512;
constexpr size_t WS_CTL = 0, WS_MODP = 1 * MiB, WS_WIN = 2 * MiB, WS_WQ = 14 * MiB, WS_WSC = 18 * MiB, WS_WDN = 19 * MiB, WS_WMIX = 20 * MiB,
                 WS_SK = 22 * MiB, WS_GL = 23 * MiB, WS_SU = 23 * MiB + 65536, WS_SV = 23 * MiB + 131072, WS_TU = 24 * MiB, WS_TV = 56 * MiB, WS_P = 88 * MiB, WS_KD = 472 * MiB, WS_END = 504 * MiB;
constexpr int LDS_BYTES = 147456;

#define GAS __attribute__((address_space(1)))
#define LAS __attribute__((address_space(3)))
typedef unsigned short bf16;
typedef unsigned v4u __attribute__((ext_vector_type(4)));
typedef unsigned v2u __attribute__((ext_vector_type(2)));
typedef float f32x4 __attribute__((ext_vector_type(4)));
typedef float f32x16 __attribute__((ext_vector_type(16)));
typedef short bf16x8 __attribute__((ext_vector_type(8)));

typedef float f32x2_t __attribute__((ext_vector_type(2))); typedef __bf16 bf16x2_t __attribute__((ext_vector_type(2)));
__device__ __forceinline__ unsigned pk2(float lo, float hi) { f32x2_t v = {lo, hi}; bf16x2_t b = __builtin_convertvector(v, bf16x2_t); return __builtin_bit_cast(unsigned, b); }
__device__ __forceinline__ unsigned f2bf(float f) { return pk2(f, 0.f) & 0xffffu; }
__device__ __forceinline__ float bflo(unsigned u) { return __uint_as_float(u << 16); }
__device__ __forceinline__ float bfhi(unsigned u) { return __uint_as_float(u & 0xffff0000u); }
__device__ __forceinline__ float bf2f(bf16 h) { return __uint_as_float((unsigned)h << 16); }
__device__ __forceinline__ float sigmoidf_(float x) { return __builtin_amdgcn_rcpf(1.0f + __builtin_amdgcn_exp2f(-1.4426950408889634f * x)); }
__device__ __forceinline__ float wave_sum(float v) {
#pragma unroll
    for (int o = 1; o < 64; o <<= 1) v += __shfl_xor(v, o);
    return v;
}

struct Frame { LAS unsigned char* lds; int tid, lane, wave, G; };
__device__ __forceinline__ const void* karg(int i) {
    const char __attribute__((address_space(4)))* kp = (const char __attribute__((address_space(4)))*)__builtin_amdgcn_kernarg_segment_ptr();
    asm volatile("" : "+s"(i));
    return *(const void* const __attribute__((address_space(4)))*)(kp + 8 * i);
}
__device__ __forceinline__ const float* IN(int i) { return (const float*)karg(i); }
__device__ __forceinline__ float* OUTP() { return (float*)karg(21); }
__device__ __forceinline__ unsigned char* WSP() { return (unsigned char*)karg(22); }
enum { I_X = 0, I_C, I_WADA, I_BADA, I_NPREMIX, I_NPOSTMIX, I_WIN, I_SCCONV, I_DNCONV, I_ALOG, I_DTBIAS, I_OUTNORM, I_WSC, I_WDN, I_WMIX, I_NPREFFN, I_NPOSTFFN, I_WQ, I_SUBK, I_PU, I_PV };
__device__ __forceinline__ bf16* segp(unsigned char* ws, int s) { return (bf16*)(ws + WS_P) + (size_t)s * SEG_ELEMS; }
__device__ __forceinline__ float modv(const float* b_ada, const float* modp, int b, int j) {
    float s = b_ada[j];
#pragma unroll
    for (int k = 0; k < 8; ++k) s += modp[(size_t)(k * 4 + b) * 6144 + j];
    return s;
}

__device__ __forceinline__ void p0_transpose_item(const float* W, int K, int N, int src_col0, bf16* WT, int dst_row0, int kb, int ncols, LAS float* scr, int lane) {
    const int k0 = 64 * kb;
#pragma unroll 8
    for (int i = 0; i < 32; ++i) { const int kk = 2 * i + (lane >> 5); const int n = lane & 31;
        scr[kk * 33 + n] = (n < ncols) ? W[(size_t)(k0 + kk) * N + src_col0 + n] : 0.f; }
    asm volatile("s_waitcnt lgkmcnt(0)" ::: "memory");
    const int c = lane & 7;
#pragma unroll
    for (int j = 0; j < 4; ++j) { const int n = (lane >> 3) + 8 * j; const LAS float* s = scr + (8 * c) * 33 + n;
        v4u o; o.x = pk2(s[0 * 33], s[1 * 33]); o.y = pk2(s[2 * 33], s[3 * 33]); o.z = pk2(s[4 * 33], s[5 * 33]); o.w = pk2(s[6 * 33], s[7 * 33]);
        *(v4u*)(WT + (size_t)(dst_row0 + n) * K + k0 + 8 * c) = o; }
    asm volatile("s_waitcnt lgkmcnt(0)" ::: "memory");
}
__device__ __forceinline__ void p0_transpose(const float* W, int K, int N, int src_col0, int nblk, bf16* WT, int dst_row0, LAS float* scr, int gw, int NGW, int lane) {
    const int kbs = K / 64;
    for (int it = gw; it < nblk * kbs; it += NGW) { const int nb = it / kbs, kb = it % kbs;
        p0_transpose_item(W, K, N, src_col0 + 32 * nb, WT, dst_row0 + 32 * nb, kb, 32, scr, lane); }
}
__device__ __forceinline__ void p0_convert(const float* src, bf16* dst, size_t nchunks8, size_t gtid, size_t gthreads) {
    for (size_t i = gtid; i < nchunks8; i += gthreads) { const f32x4 a = *(const f32x4*)(src + i * 8), b = *(const f32x4*)(src + i * 8 + 4);
        v4u o; o.x = pk2(a[0], a[1]); o.y = pk2(a[2], a[3]); o.z = pk2(b[0], b[1]); o.w = pk2(b[2], b[3]); *(v4u*)(dst + i * 8) = o; }
}
typedef unsigned u32x6 __attribute__((ext_vector_type(6)));
typedef float f32x32 __attribute__((ext_vector_type(32)));
typedef float f32x16v __attribute__((ext_vector_type(16)));
__device__ __forceinline__ void p0_table_fp6(const float* T, unsigned char* T6, float* SC, LAS float* scr, int gw, int NGW, int lane) {
    const int g = lane >> 5, jl = lane & 31;
    for (int pr = gw; pr < 8192; pr += NGW) {
        const f32x4* src = (const f32x4*)(T + (size_t)(2 * pr) * 1024) + lane;
#pragma unroll
        for (int i = 0; i < 8; ++i) { const f32x4 v = src[64 * i]; const int q = lane + 64 * i, row = q >> 8, kk = (q & 255) * 4;
            *(LAS f32x4*)(scr + (row * 32 + (kk >> 5)) * 36 + (kk & 31)) = v; }
        asm volatile("s_waitcnt lgkmcnt(0)" ::: "memory");
        float x[32]; float am = 0.f;
#pragma unroll
        for (int i = 0; i < 8; ++i) { const f32x4 t = *(const LAS f32x4*)(scr + (g * 32 + jl) * 36 + 4 * i); x[4 * i] = t[0]; x[4 * i + 1] = t[1]; x[4 * i + 2] = t[2]; x[4 * i + 3] = t[3];
            am = fmaxf(am, fmaxf(fmaxf(fabsf(t[0]), fabsf(t[1])), fmaxf(fabsf(t[2]), fabsf(t[3])))); }
#pragma unroll
        for (int o = 1; o < 32; o <<= 1) am = fmaxf(am, __shfl_xor(am, o));
        const float sp = 7.5f / fmaxf(am, 1e-30f), inv = am * (1.0f / 7.5f);
        f32x16v a, b;
#pragma unroll
        for (int i = 0; i < 16; ++i) { a[i] = x[i] * sp; b[i] = x[16 + i] * sp; }
        const u32x6 qv = __builtin_amdgcn_cvt_scalef32_2xpk16_fp6_f32(a, b, 1.0f);
        unsigned char* dst = T6 + (size_t)(2 * pr + g) * 768;
        *(v4u*)(dst + 16 * jl) = (v4u){qv[0], qv[1], qv[2], qv[3]}; *(v2u*)(dst + 512 + 8 * jl) = (v2u){qv[4], qv[5]};
        if (jl == 0) SC[2 * pr + g] = inv;
        asm volatile("s_waitcnt lgkmcnt(0)" ::: "memory");
    }
}
__device__ __forceinline__ void phase_prologue(Frame& F) {
    LAS float* scr = (LAS float*)(F.lds + F.wave * 9216);
    const int gw = blockIdx.x * NWAVES + F.wave, NGW = F.G * NWAVES;
    unsigned char* ws = WSP();
    { const float* w_ada = IN(I_WADA); const float* cc = IN(I_C); float* modp = (float*)(ws + WS_MODP);
    for (int it = gw; it < 768; it += NGW) { const int cgi = it % 96, ks = it / 96, n = cgi * 64 + F.lane, k0 = ks * 128;
        float a0 = 0.f, a1 = 0.f, a2 = 0.f, a3 = 0.f;
#pragma unroll 16
        for (int kk = 0; kk < 128; ++kk) { const int k = k0 + kk; const float w = w_ada[(size_t)k * 6144 + n];
            const float c0 = cc[k], c1 = cc[1024 + k], c2 = cc[2048 + k], c3 = cc[3072 + k];
            a0 += c0 * sigmoidf_(c0) * w; a1 += c1 * sigmoidf_(c1) * w; a2 += c2 * sigmoidf_(c2) * w; a3 += c3 * sigmoidf_(c3) * w; }
        modp[(size_t)(ks * 4 + 0) * 6144 + n] = a0; modp[(size_t)(ks * 4 + 1) * 6144 + n] = a1;
        modp[(size_t)(ks * 4 + 2) * 6144 + n] = a2; modp[(size_t)(ks * 4 + 3) * 6144 + n] = a3; } }
    { const float* w_in = IN(I_WIN); bf16* win_t = (bf16*)(ws + WS_WIN);
    p0_transpose(w_in, 1024, 5648, 0, 112, win_t, 0, scr, gw, NGW, F.lane);
    p0_transpose(w_in, 1024, 5648, 3600, 64, win_t, 3584, scr, gw, NGW, F.lane);
    for (int it = gw; it < 16; it += NGW) p0_transpose_item(w_in, 1024, 5648, 3584, win_t, 5632, it, 16, scr, F.lane);
    { const size_t gtid = (size_t)blockIdx.x * NTHR + F.tid, gth = (size_t)F.G * NTHR;
      for (size_t i = gtid; i < (size_t)224 * 128; i += gth) *(v4u*)(win_t + (size_t)5664 * 1024 + i * 8) = (v4u){0u, 0u, 0u, 0u}; } }
    p0_transpose(IN(I_WQ), 1024, 2048, 0, 64, (bf16*)(ws + WS_WQ), 0, scr, gw, NGW, F.lane);
    p0_transpose(IN(I_WSC), 512, 1024, 0, 32, (bf16*)(ws + WS_WSC), 0, scr, gw, NGW, F.lane);
    p0_transpose(IN(I_WDN), 512, 1024, 0, 32, (bf16*)(ws + WS_WDN), 0, scr, gw, NGW, F.lane);
    p0_transpose(IN(I_WMIX), 1024, 1024, 0, 32, (bf16*)(ws + WS_WMIX), 0, scr, gw, NGW, F.lane);
    { const size_t gtid = (size_t)blockIdx.x * NTHR + F.tid, gth = (size_t)F.G * NTHR;
      p0_convert(IN(I_SUBK), (bf16*)(ws + WS_SK), (size_t)16 * 128 * 128 / 8, gtid, gth);
    }
    { LAS float* scr6 = (LAS float*)(F.lds + F.wave * 9216);
      p0_table_fp6(IN(I_PU), ws + WS_TU, (float*)(ws + WS_SU), scr6, gw, NGW, F.lane);
      p0_table_fp6(IN(I_PV), ws + WS_TV, (float*)(ws + WS_SV), scr6, gw, NGW, F.lane); }
}

__device__ __forceinline__ void phase_h1(Frame& F, bf16* H1) {
    LAS float* gv = (LAS float*)F.lds; LAS float* sv = gv + 1024;
    const float* xin = IN(I_X); const float* npm = IN(I_NPREMIX); const float* b_ada = IN(I_BADA); const float* modp = (const float*)(WSP() + WS_MODP);
    for (int rb = blockIdx.x; rb < M / 128; rb += F.G) {
        const int row0 = rb * 128, b = row0 / SEQ;
        __syncthreads();
        for (int k = F.tid; k < 1024; k += NTHR) { gv[k] = npm[k] * (1.f + modv(b_ada, modp, b, 1024 + k)); sv[k] = modv(b_ada, modp, b, k); }
        __syncthreads();
        for (int r = 0; r < 16; ++r) { const int row = row0 + F.wave * 16 + r;
            const f32x4* xr = (const f32x4*)(xin + (size_t)row * D) + F.lane;
            f32x4 v[4]; float ss = 0.f;
#pragma unroll
            for (int j = 0; j < 4; ++j) { v[j] = xr[64 * j]; ss += (v[j][0] * v[j][0] + v[j][1] * v[j][1]) + (v[j][2] * v[j][2] + v[j][3] * v[j][3]); }
            const float rstd = rsqrtf(wave_sum(ss) * (1.f / D) + EPS);
            v2u* o8 = (v2u*)(H1 + (size_t)row * D) + F.lane;
#pragma unroll
            for (int j = 0; j < 4; ++j) { const int k = 4 * F.lane + 256 * j; const f32x4 g = *(const LAS f32x4*)(gv + k), s = *(const LAS f32x4*)(sv + k);
                v2u o; o.x = pk2(v[j][0] * rstd * g[0] + s[0], v[j][1] * rstd * g[1] + s[1]); o.y = pk2(v[j][2] * rstd * g[2] + s[2], v[j][3] * rstd * g[3] + s[3]); o8[64 * j] = o; }
        }
    }
}

__device__ __forceinline__ void phase_scprep(Frame& F) {
    unsigned char* ws = WSP(); bf16* sb = segp(ws, 0); const bf16* scc = segp(ws, 1); const bf16* scx = segp(ws, 2); const float* scw = IN(I_SCCONV);
    const int gtid = blockIdx.x * NTHR + F.tid, gth = F.G * NTHR;
    for (int it = gtid; it < (M / 16) * 64; it += gth) {
        const int cgp = it & 63, tb = it >> 6, m0 = tb * 16, c0 = cgp * 8;
        float w0[8], w1[8], w2[8], p2[8], p1[8];
#pragma unroll
        for (int e = 0; e < 8; ++e) { w0[e] = scw[c0 + e]; w1[e] = scw[512 + c0 + e]; w2[e] = scw[1024 + c0 + e]; p2[e] = 0.f; p1[e] = 0.f; }
        if ((m0 % SEQ) != 0) {
#pragma unroll
            for (int q = 0; q < 2; ++q) { const size_t off = (size_t)(m0 - 2 + q) * 512 + c0; const v4u cv = *(const v4u*)(scc + off), xv = *(const v4u*)(scx + off);
                float t[8] = {bflo(cv.x) * bflo(xv.x), bfhi(cv.x) * bfhi(xv.x), bflo(cv.y) * bflo(xv.y), bfhi(cv.y) * bfhi(xv.y), bflo(cv.z) * bflo(xv.z), bfhi(cv.z) * bfhi(xv.z), bflo(cv.w) * bflo(xv.w), bfhi(cv.w) * bfhi(xv.w)};
#pragma unroll
                for (int e = 0; e < 8; ++e) { if (q == 0) p2[e] = t[e]; else p1[e] = t[e]; } }
        }
        for (int t = 0; t < 16; ++t) { const size_t off = (size_t)(m0 + t) * 512 + c0;
            const v4u cv = *(const v4u*)(scc + off), xv = *(const v4u*)(scx + off), bv = *(const v4u*)(sb + off);
            float cur[8] = {bflo(cv.x) * bflo(xv.x), bfhi(cv.x) * bfhi(xv.x), bflo(cv.y) * bflo(xv.y), bfhi(cv.y) * bfhi(xv.y), bflo(cv.z) * bflo(xv.z), bfhi(cv.z) * bfhi(xv.z), bflo(cv.w) * bflo(xv.w), bfhi(cv.w) * bfhi(xv.w)};
            float bb[8] = {bflo(bv.x), bfhi(bv.x), bflo(bv.y), bfhi(bv.y), bflo(bv.z), bfhi(bv.z), bflo(bv.w), bfhi(bv.w)};
            float o[8];
#pragma unroll
            for (int e = 0; e < 8; ++e) { o[e] = bb[e] * (w0[e] * p2[e] + w1[e] * p1[e] + w2[e] * cur[e]); p2[e] = p1[e]; p1[e] = cur[e]; }
            v4u ov; ov.x = pk2(o[0], o[1]); ov.y = pk2(o[2], o[3]); ov.z = pk2(o[4], o[5]); ov.w = pk2(o[6], o[7]);
            *(v4u*)(sb + off) = ov; }
    }
}

#define MM4(dst, aptr, X) do { const f32x4 av_ = *(const LAS f32x4*)(aptr); \
    dst = __builtin_amdgcn_mfma_f32_16x16x4f32(av_[0], (X)[0], dst, 0, 0, 0); dst = __builtin_amdgcn_mfma_f32_16x16x4f32(av_[1], (X)[1], dst, 0, 0, 0); \
    dst = __builtin_amdgcn_mfma_f32_16x16x4f32(av_[2], (X)[2], dst, 0, 0, 0); dst = __builtin_amdgcn_mfma_f32_16x16x4f32(av_[3], (X)[3], dst, 0, 0, 0); } while (0)
__device__ __forceinline__ void phase_dnprep(Frame& F, bf16* Wn, bf16* U, bf16* QG, bf16* A, bf16* KD) {
    LAS unsigned char* L = F.lds;
    LAS bf16* raw = (LAS bf16*)L;
    LAS bf16* stg2 = (LAS bf16*)L;
    LAS float* qc = (LAS float*)(L + 32768);
    LAS float* kc = (LAS float*)(L + 32768 + 17408);
    LAS float* vc = (LAS float*)(L + 32768 + 2 * 17408);
    LAS bf16* kh = (LAS bf16*)(L + 84992);
    LAS bf16* qh = (LAS bf16*)(L + 94208);
    LAS float* Ln = (LAS float*)(L + 103424);
    LAS float* Tm = (LAS float*)(L + 120832);
    LAS float* sG = (LAS float*)(L + 124928);
    LAS float* sBeta = sG + 64; LAS float* sEG = sG + 128; LAS float* sEd = sG + 192;
    LAS float* cwl = (LAS float*)(L + 125952);
    LAS bf16* stg = (LAS bf16*)(L + 129024);
    const int tid = F.tid, lane = F.lane, wave = F.wave;
    unsigned char* ws = WSP(); const bf16* segq = segp(ws, 3); const bf16* segab = segp(ws, 11); float* glp = (float*)(ws + WS_GL);
    const float* cw = IN(I_DNCONV); const float* alog = IN(I_ALOG); const float* dtb = IN(I_DTBIAS);
    for (int it = blockIdx.x; it < NITEM; it += F.G) {
        const int bh = it >> 7, n = it & 127, b = bh >> 3, h = bh & 7, m0 = b * SEQ + n * 64;
        __syncthreads();
        for (int ci = tid; ci < 1608; ci += NTHR) { const int s = ci / 536, rem = ci % 536, r = rem >> 3, c8 = rem & 7;
            v4u v = (v4u){0u, 0u, 0u, 0u};
            if (n * 64 - 3 + r >= 0) v = *(const v4u*)(segq + (size_t)s * SEG_ELEMS + (size_t)(m0 - 3 + r) * 512 + h * 64 + c8 * 8);
            *(LAS v4u*)(raw + (s * 67 + r) * 64 + c8 * 8) = v; }
        for (int ci = tid; ci < 768; ci += NTHR) { const int s = ci >> 8, k = (ci >> 6) & 3, c = ci & 63; cwl[ci] = cw[k * 1536 + s * 512 + h * 64 + c]; }
        __syncthreads();
        for (int wu = tid; wu < 3072; wu += NTHR) { const int c4 = wu & 15, t = (wu >> 4) & 63, s = wu >> 10;
            f32x4 acc = (f32x4){0.f, 0.f, 0.f, 0.f};
#pragma unroll
            for (int k = 0; k < 4; ++k) { const f32x4 w = *(const LAS f32x4*)(cwl + (s * 4 + k) * 64 + 4 * c4); const v2u r = *(const LAS v2u*)(raw + (s * 67 + t + k) * 64 + 4 * c4);
                acc[0] += w[0] * bflo(r.x); acc[1] += w[1] * bfhi(r.x); acc[2] += w[2] * bflo(r.y); acc[3] += w[3] * bfhi(r.y); }
#pragma unroll
            for (int e = 0; e < 4; ++e) acc[e] = acc[e] * sigmoidf_(acc[e]);
            *(LAS f32x4*)((s == 0 ? qc : (s == 1 ? kc : vc)) + t * 68 + 4 * c4) = acc; }
        __syncthreads();
        if (wave == 0) {
            const float av = bf2f(segab[(size_t)(m0 + lane) * 512 + h]) + dtb[h], bv = bf2f(segab[(size_t)(m0 + lane) * 512 + 8 + h]);
            const float sp = (av > 20.f) ? av : log1pf(__expf(av));
            float g = -__expf(alog[h]) * sp;
#pragma unroll
            for (int o = 1; o < 64; o <<= 1) { const float t = __shfl_up(g, o); if (lane >= o) g += t; }
            const float g63 = __shfl(g, 63);
            sG[lane] = g; sBeta[lane] = sigmoidf_(bv); sEG[lane] = __expf(g); sEd[lane] = __expf(g63 - g);
            if (lane == 63) glp[it] = __expf(g);
        }
        { const int t = tid >> 3, p = tid & 7;
          f32x4 q0 = *(const LAS f32x4*)(qc + t * 68 + 8 * p), q1 = *(const LAS f32x4*)(qc + t * 68 + 8 * p + 4), k0 = *(const LAS f32x4*)(kc + t * 68 + 8 * p), k1 = *(const LAS f32x4*)(kc + t * 68 + 8 * p + 4);
          float sq = (q0[0] * q0[0] + q0[1] * q0[1]) + (q0[2] * q0[2] + q0[3] * q0[3]) + (q1[0] * q1[0] + q1[1] * q1[1]) + (q1[2] * q1[2] + q1[3] * q1[3]);
          float sk = (k0[0] * k0[0] + k0[1] * k0[1]) + (k0[2] * k0[2] + k0[3] * k0[3]) + (k1[0] * k1[0] + k1[1] * k1[1]) + (k1[2] * k1[2] + k1[3] * k1[3]);
          sq += __shfl_xor(sq, 1); sq += __shfl_xor(sq, 2); sq += __shfl_xor(sq, 4); sk += __shfl_xor(sk, 1); sk += __shfl_xor(sk, 2); sk += __shfl_xor(sk, 4);
          const float rq = rsqrtf(sq + EPS) * 0.125f, rk = rsqrtf(sk + EPS);
          q0 = q0 * rq; q1 = q1 * rq; k0 = k0 * rk; k1 = k1 * rk;
          *(LAS f32x4*)(qc + t * 68 + 8 * p) = q0; *(LAS f32x4*)(qc + t * 68 + 8 * p + 4) = q1; *(LAS f32x4*)(kc + t * 68 + 8 * p) = k0; *(LAS f32x4*)(kc + t * 68 + 8 * p + 4) = k1;
          v4u qb, kb; qb.x = pk2(q0[0], q0[1]); qb.y = pk2(q0[2], q0[3]); qb.z = pk2(q1[0], q1[1]); qb.w = pk2(q1[2], q1[3]);
          kb.x = pk2(k0[0], k0[1]); kb.y = pk2(k0[2], k0[3]); kb.z = pk2(k1[0], k1[1]); kb.w = pk2(k1[2], k1[3]);
          *(LAS v4u*)(qh + t * 72 + 8 * p) = qb; *(LAS v4u*)(kh + t * 72 + 8 * p) = kb; }
        __syncthreads();
        {
            const int fr = lane & 15, g4 = lane >> 4;
#pragma unroll
            for (int x = 0; x < 2; ++x) { const int tile = 2 * wave + x, ti = tile >> 2, tj = tile & 3;
                f32x4 ckk = (f32x4){0.f, 0.f, 0.f, 0.f}, cqk = (f32x4){0.f, 0.f, 0.f, 0.f};
#pragma unroll
                for (int ks = 0; ks < 2; ++ks) {
                    const bf16x8 ak = *(const LAS bf16x8*)(kh + (16 * ti + fr) * 72 + 32 * ks + 8 * g4);
                    const bf16x8 aq = *(const LAS bf16x8*)(qh + (16 * ti + fr) * 72 + 32 * ks + 8 * g4);
                    const bf16x8 bk = *(const LAS bf16x8*)(kh + (16 * tj + fr) * 72 + 32 * ks + 8 * g4);
                    ckk = __builtin_amdgcn_mfma_f32_16x16x32_bf16(ak, bk, ckk, 0, 0, 0);
                    cqk = __builtin_amdgcn_mfma_f32_16x16x32_bf16(aq, bk, cqk, 0, 0, 0); }
                const int j = 16 * tj + fr; const float gj = sG[j];
#pragma unroll
                for (int r = 0; r < 4; ++r) { const int i = 16 * ti + 4 * g4 + r;
                    const float dec = __expf(fminf(sG[i] - gj, 0.f));
                    Ln[i * 68 + j] = (j < i) ? -(sBeta[i] * ckk[r] * dec) : 0.f;
                    stg[i * 64 + j] = (bf16)f2bf((j <= i) ? cqk[r] * dec : 0.f); }
            }
        }
        __syncthreads();
        if (wave == 0) {
            const int bb = lane >> 4, c = lane & 15; float t[16];
#pragma unroll
            for (int i = 0; i < 16; ++i) { float acc = (i == c) ? 1.f : 0.f;
#pragma unroll
                for (int j = 0; j < i; ++j) acc += Ln[(16 * bb + i) * 68 + 16 * bb + j] * t[j];
                t[i] = acc; Tm[(bb * 16 + i) * 16 + c] = acc; }
        } else {
            for (int ct = tid - 64; ct < 1536; ct += NTHR - 64) { const int kind = ct >> 9, idx = ct & 511; const size_t ob = (size_t)it * 4096 + (size_t)idx * 8;
                if (kind == 0) { *(v4u*)(A + ob) = *(const LAS v4u*)(stg + idx * 8); }
                else if (kind == 1) { const int i = idx >> 3, k0 = (idx & 7) * 8; const float e = sEG[i]; const f32x4 a = *(const LAS f32x4*)(qc + i * 68 + k0), c = *(const LAS f32x4*)(qc + i * 68 + k0 + 4);
                    v4u o; o.x = pk2(a[0] * e, a[1] * e); o.y = pk2(a[2] * e, a[3] * e); o.z = pk2(c[0] * e, c[1] * e); o.w = pk2(c[2] * e, c[3] * e); *(v4u*)(QG + ob) = o; }
                else { const int kk = idx >> 3, c0 = (idx & 7) * 8;
                    v4u p; p.x = pk2(kc[(c0 + 0) * 68 + kk] * sEd[c0 + 0], kc[(c0 + 1) * 68 + kk] * sEd[c0 + 1]); p.y = pk2(kc[(c0 + 2) * 68 + kk] * sEd[c0 + 2], kc[(c0 + 3) * 68 + kk] * sEd[c0 + 3]);
                    p.z = pk2(kc[(c0 + 4) * 68 + kk] * sEd[c0 + 4], kc[(c0 + 5) * 68 + kk] * sEd[c0 + 5]); p.w = pk2(kc[(c0 + 6) * 68 + kk] * sEd[c0 + 6], kc[(c0 + 7) * 68 + kk] * sEd[c0 + 7]);
                    *(v4u*)(KD + ob) = p; } }
        }
        __syncthreads();
        {
            const int nn = lane & 15, g4 = lane >> 4; const LAS float* src = (wave < 4) ? vc : kc; const int cc = 16 * (wave & 3) + nn;
            f32x4 R[4];
#pragma unroll
            for (int bb = 0; bb < 4; ++bb)
#pragma unroll
                for (int r = 0; r < 4; ++r) { const int i = 16 * bb + 4 * g4 + r; float v = src[i * 68 + cc] * sBeta[i]; if (wave >= 4) v *= sEG[i]; R[bb][r] = v; }
            const f32x4 Z4 = (f32x4){0.f, 0.f, 0.f, 0.f};
            f32x4 X0 = Z4, X1 = Z4, X2 = Z4, X3 = Z4;
            MM4(X0, Tm + (0 * 16 + nn) * 16 + 4 * g4, R[0]);
            MM4(R[1], Ln + (16 + nn) * 68 + 0 + 4 * g4, X0);
            MM4(X1, Tm + (1 * 16 + nn) * 16 + 4 * g4, R[1]);
            MM4(R[2], Ln + (32 + nn) * 68 + 0 + 4 * g4, X0); MM4(R[2], Ln + (32 + nn) * 68 + 16 + 4 * g4, X1);
            MM4(X2, Tm + (2 * 16 + nn) * 16 + 4 * g4, R[2]);
            MM4(R[3], Ln + (48 + nn) * 68 + 0 + 4 * g4, X0); MM4(R[3], Ln + (48 + nn) * 68 + 16 + 4 * g4, X1); MM4(R[3], Ln + (48 + nn) * 68 + 32 + 4 * g4, X2);
            MM4(X3, Tm + (3 * 16 + nn) * 16 + 4 * g4, R[3]);
            const float sgn = (wave < 4) ? 1.f : -1.f; const int col = 16 * wave + nn;
#pragma unroll
            for (int r = 0; r < 4; ++r) { const int i = 4 * g4 + r;
                stg2[(i) * 128 + col] = (bf16)f2bf(sgn * X0[r]); stg2[(16 + i) * 128 + col] = (bf16)f2bf(sgn * X1[r]);
                stg2[(32 + i) * 128 + col] = (bf16)f2bf(sgn * X2[r]); stg2[(48 + i) * 128 + col] = (bf16)f2bf(sgn * X3[r]); }
        }
        __syncthreads();
        for (int ci = tid; ci < 1024; ci += NTHR) { const int i = ci >> 4, c8 = ci & 15; const v4u v = *(const LAS v4u*)(stg2 + i * 128 + c8 * 8);
            if (c8 < 8) *(v4u*)(U + (size_t)it * 4096 + i * 64 + c8 * 8) = v; else *(v4u*)(Wn + (size_t)it * 4096 + i * 64 + (c8 - 8) * 8) = v; }
    }
}
#undef MM4

__device__ __forceinline__ bf16x8 pack_b(const f32x4& t0, const f32x4& t1) { v4u w; w.x = pk2(t0[0], t0[1]); w.y = pk2(t0[2], t0[3]); w.z = pk2(t1[0], t1[1]); w.w = pk2(t1[2], t1[3]); return __builtin_bit_cast(bf16x8, w); }
__device__ __forceinline__ bf16x8 afrag(const LAS bf16* base, int row, int ks, int g4) {
    const v2u lo = *(const LAS v2u*)(base + row * 72 + 32 * ks + 4 * g4), hi = *(const LAS v2u*)(base + row * 72 + 32 * ks + 16 + 4 * g4);
    v4u w; w.x = lo.x; w.y = lo.y; w.z = hi.x; w.w = hi.y; return __builtin_bit_cast(bf16x8, w); }
#define SCAN_BAR() do { asm volatile("s_waitcnt lgkmcnt(0)" ::: "memory"); __builtin_amdgcn_s_barrier(); asm volatile("" ::: "memory"); } while (0)
__device__ __forceinline__ void phase_scan(Frame& F, const bf16* Wn, const bf16* U, const bf16* QG, const bf16* A, const bf16* KD, bf16* OG, const bf16* Z) {
    if (blockIdx.x >= 32) return;
    LAS unsigned char* L = F.lds; const float* glp = (const float*)(WSP() + WS_GL); const float* onw = IN(I_OUTNORM);
    const int bh = blockIdx.x, b = bh >> 3, h = bh & 7, tid = F.tid, lane = F.lane, wave = F.wave;
    const int nn = lane & 15, g4 = lane >> 4;
#define OPB(buf, mat) ((LAS bf16*)(L + (buf) * 46080 + (mat) * 9216))
#define OST(buf) ((LAS bf16*)(L + 92160 + (buf) * 9216))
    LAS float* gll = (LAS float*)(L + 110592);
    if (tid < NCHUNK) gll[tid] = glp[bh * NCHUNK + tid];
    if (wave >= 4) {
        const int ht = tid - 256;
        const unsigned eo0 = (unsigned)(bh * NCHUNK) * 4096u + (unsigned)ht * 8u;
        const int lo0 = (ht >> 3) * 72 + (ht & 7) * 8, lo1 = lo0 + 32 * 72;
        v4u ra[10], rb[10];
#define HLOAD(R, st) do { const unsigned o_ = eo0 + (unsigned)(st) * 4096u; R[0] = *(const v4u*)(Wn + o_); R[1] = *(const v4u*)(Wn + o_ + 2048); R[2] = *(const v4u*)(U + o_); R[3] = *(const v4u*)(U + o_ + 2048); \
        R[4] = *(const v4u*)(QG + o_); R[5] = *(const v4u*)(QG + o_ + 2048); R[6] = *(const v4u*)(A + o_); R[7] = *(const v4u*)(A + o_ + 2048); R[8] = *(const v4u*)(KD + o_); R[9] = *(const v4u*)(KD + o_ + 2048); } while (0)
#define HSTORE(R, buf) do { _Pragma("unroll") for (int mt_ = 0; mt_ < 5; ++mt_) { *(LAS v4u*)(OPB(buf, mt_) + lo0) = R[2 * mt_]; *(LAS v4u*)(OPB(buf, mt_) + lo1) = R[2 * mt_ + 1]; } } while (0)
        const int ot = ht >> 2, op = ht & 3;
        const unsigned zo0 = (unsigned)(b * SEQ + ot) * 512u + (unsigned)(h * 64 + 16 * op);
        LAS float* onl = (LAS float*)(L + 111104);
        if (ht < 64) onl[ht] = onw[ht];
        v4u zr[2][2];
#define ZLOAD(par, st) do { const unsigned zo_ = zo0 + (unsigned)(st) * 32768u; zr[par][0] = *(const v4u*)(Z + zo_); zr[par][1] = *(const v4u*)(Z + zo_ + 8); } while (0)
#define OUT_STAGE(par, st) do { const v4u o0 = *(const LAS v4u*)(OST(par) + ot * 72 + 16 * op), o1 = *(const LAS v4u*)(OST(par) + ot * 72 + 16 * op + 8); \
        float ov[16] = {bflo(o0.x), bfhi(o0.x), bflo(o0.y), bfhi(o0.y), bflo(o0.z), bfhi(o0.z), bflo(o0.w), bfhi(o0.w), bflo(o1.x), bfhi(o1.x), bflo(o1.y), bfhi(o1.y), bflo(o1.z), bfhi(o1.z), bflo(o1.w), bfhi(o1.w)}; \
        float zv[16] = {bflo(zr[par][0].x), bfhi(zr[par][0].x), bflo(zr[par][0].y), bfhi(zr[par][0].y), bflo(zr[par][0].z), bfhi(zr[par][0].z), bflo(zr[par][0].w), bfhi(zr[par][0].w), \
                        bflo(zr[par][1].x), bfhi(zr[par][1].x), bflo(zr[par][1].y), bfhi(zr[par][1].y), bflo(zr[par][1].z), bfhi(zr[par][1].z), bflo(zr[par][1].w), bfhi(zr[par][1].w)}; \
        float ss_ = 0.f; _Pragma("unroll") for (int e = 0; e < 16; ++e) ss_ += ov[e] * ov[e]; \
        ss_ += __shfl_xor(ss_, 1); ss_ += __shfl_xor(ss_, 2); const float rs_ = rsqrtf(ss_ * (1.f / 64.f) + EPS); float rr[16]; \
        _Pragma("unroll") for (int e = 0; e < 16; ++e) rr[e] = ov[e] * rs_ * onl[16 * op + e] * (zv[e] * sigmoidf_(zv[e])); \
        v4u w0, w1; w0.x = pk2(rr[0], rr[1]); w0.y = pk2(rr[2], rr[3]); w0.z = pk2(rr[4], rr[5]); w0.w = pk2(rr[6], rr[7]); w1.x = pk2(rr[8], rr[9]); w1.y = pk2(rr[10], rr[11]); w1.z = pk2(rr[12], rr[13]); w1.w = pk2(rr[14], rr[15]); \
        { const unsigned oo_ = zo0 + (unsigned)(st) * 32768u; *(v4u*)(OG + oo_) = w0; *(v4u*)(OG + oo_ + 8) = w1; } } while (0)
        HLOAD(ra, 0); HSTORE(ra, 0); HLOAD(ra, 1); HLOAD(rb, 2); ZLOAD(0, 0);
        SCAN_BAR();
        HSTORE(ra, 1); HLOAD(ra, 3); ZLOAD(1, 1);
        SCAN_BAR();
#pragma unroll 1
        for (int n = 1; n < NCHUNK - 1; n += 2) {
            const int l3 = (n + 3 < NCHUNK) ? n + 3 : NCHUNK - 1, l4 = (n + 4 < NCHUNK) ? n + 4 : NCHUNK - 1;
#define SB() __builtin_amdgcn_sched_barrier(0)
            HSTORE(rb, 0); SB(); HLOAD(rb, l3); SB(); OUT_STAGE(0, n - 1); SB(); ZLOAD(0, n + 1); SB();
            SCAN_BAR();
            HSTORE(ra, 1); SB(); HLOAD(ra, l4); SB(); OUT_STAGE(1, n); SB(); ZLOAD(1, n + 2); SB();
            SCAN_BAR();
#undef SB
        }
        OUT_STAGE(0, NCHUNK - 2);
        SCAN_BAR();
        OUT_STAGE(1, NCHUNK - 1);
#undef HLOAD
#undef HSTORE
#undef ZLOAD
#undef OUT_STAGE
    } else {
        const int cs = wave;
        f32x4 S[4];
#pragma unroll
        for (int t = 0; t < 4; ++t) S[t] = (f32x4){0.f, 0.f, 0.f, 0.f};
        SCAN_BAR();
#pragma unroll 1
        for (int n = 0; n < NCHUNK; ++n) {
            const int buf = n & 1; const float glast = gll[n];
            const bf16x8 sb0 = pack_b(S[0], S[1]), sb1 = pack_b(S[2], S[3]);
            f32x4 vn[4], oa[4];
#pragma unroll
            for (int ct = 0; ct < 4; ++ct) {
                f32x4 av;
#pragma unroll
                for (int r = 0; r < 4; ++r) av[r] = bf2f(OPB(buf, 1)[(16 * ct + 4 * g4 + r) * 72 + 16 * cs + nn]);
                f32x4 ao = (f32x4){0.f, 0.f, 0.f, 0.f};
                av = __builtin_amdgcn_mfma_f32_16x16x32_bf16(afrag(OPB(buf, 0), 16 * ct + nn, 0, g4), sb0, av, 0, 0, 0);
                av = __builtin_amdgcn_mfma_f32_16x16x32_bf16(afrag(OPB(buf, 0), 16 * ct + nn, 1, g4), sb1, av, 0, 0, 0);
                ao = __builtin_amdgcn_mfma_f32_16x16x32_bf16(afrag(OPB(buf, 2), 16 * ct + nn, 0, g4), sb0, ao, 0, 0, 0);
                ao = __builtin_amdgcn_mfma_f32_16x16x32_bf16(afrag(OPB(buf, 2), 16 * ct + nn, 1, g4), sb1, ao, 0, 0, 0);
                vn[ct] = av; oa[ct] = ao; }
            const bf16x8 vb0 = pack_b(vn[0], vn[1]), vb1 = pack_b(vn[2], vn[3]);
#pragma unroll
            for (int ct = 0; ct < 4; ++ct) {
                f32x4 ao = oa[ct], as = S[ct] * glast;
                ao = __builtin_amdgcn_mfma_f32_16x16x32_bf16(afrag(OPB(buf, 3), 16 * ct + nn, 0, g4), vb0, ao, 0, 0, 0);
                ao = __builtin_amdgcn_mfma_f32_16x16x32_bf16(afrag(OPB(buf, 3), 16 * ct + nn, 1, g4), vb1, ao, 0, 0, 0);
                as = __builtin_amdgcn_mfma_f32_16x16x32_bf16(afrag(OPB(buf, 4), 16 * ct + nn, 0, g4), vb0, as, 0, 0, 0);
                as = __builtin_amdgcn_mfma_f32_16x16x32_bf16(afrag(OPB(buf, 4), 16 * ct + nn, 1, g4), vb1, as, 0, 0, 0);
                S[ct] = as;
#pragma unroll
                for (int r = 0; r < 4; ++r) OST(buf)[(16 * ct + 4 * g4 + r) * 72 + 16 * cs + nn] = (bf16)f2bf(ao[r]); }
            SCAN_BAR();
        }
    }
#undef OPB
#undef OST
}
#undef SCAN_BAR

__device__ __forceinline__ void phase_x1h2(Frame& F, const bf16* Y, bf16* H2) {
    LAS float* a1 = (LAS float*)F.lds; LAS float* g2 = a1 + 1024; LAS float* s2 = g2 + 1024;
    const float* xin = IN(I_X); const float* npost = IN(I_NPOSTMIX); const float* npre = IN(I_NPREFFN); const float* b_ada = IN(I_BADA); const float* modp = (const float*)(WSP() + WS_MODP); float* outp = OUTP();
    for (int rb = blockIdx.x; rb < M / 128; rb += F.G) {
        const int row0 = rb * 128, b = row0 / SEQ;
        __syncthreads();
        for (int k = F.tid; k < 1024; k += NTHR) { a1[k] = modv(b_ada, modp, b, 2048 + k) * npost[k]; g2[k] = npre[k] * (1.f + modv(b_ada, modp, b, 4096 + k)); s2[k] = modv(b_ada, modp, b, 3072 + k); }
        __syncthreads();
        for (int r = 0; r < 16; ++r) { const int row = row0 + F.wave * 16 + r;
            const v2u* yr = (const v2u*)(Y + (size_t)row * D) + F.lane; const f32x4* xr = (const f32x4*)(xin + (size_t)row * D) + F.lane;
            f32x4 y[4], xv[4]; float ss = 0.f;
#pragma unroll
            for (int j = 0; j < 4; ++j) { const v2u t = yr[64 * j]; y[j] = (f32x4){bflo(t.x), bfhi(t.x), bflo(t.y), bfhi(t.y)}; xv[j] = xr[64 * j];
                ss += (y[j][0] * y[j][0] + y[j][1] * y[j][1]) + (y[j][2] * y[j][2] + y[j][3] * y[j][3]); }
            const float rstd = rsqrtf(wave_sum(ss) * (1.f / D) + EPS); float s1 = 0.f;
            f32x4* orow = (f32x4*)(outp + (size_t)row * D) + F.lane;
#pragma unroll
            for (int j = 0; j < 4; ++j) { const int k = 4 * F.lane + 256 * j; const f32x4 a = *(const LAS f32x4*)(a1 + k);
                xv[j] = xv[j] + a * (y[j] * rstd); orow[64 * j] = xv[j];
                s1 += (xv[j][0] * xv[j][0] + xv[j][1] * xv[j][1]) + (xv[j][2] * xv[j][2] + xv[j][3] * xv[j][3]); }
            const float rstd1 = rsqrtf(wave_sum(s1) * (1.f / D) + EPS);
            v2u* o8 = (v2u*)(H2 + (size_t)row * D) + F.lane;
#pragma unroll
            for (int j = 0; j < 4; ++j) { const int k = 4 * F.lane + 256 * j; const f32x4 g = *(const LAS f32x4*)(g2 + k), s = *(const LAS f32x4*)(s2 + k);
                v2u o; o.x = pk2(xv[j][0] * rstd1 * g[0] + s[0], xv[j][1] * rstd1 * g[1] + s[1]); o.y = pk2(xv[j][2] * rstd1 * g[2] + s[2], xv[j][3] * rstd1 * g[3] + s[3]); o8[64 * j] = o; }
        }
    }
}

__device__ __forceinline__ unsigned mono(float f) { const unsigned u = __float_as_uint(f); return u ^ ((unsigned)((int)u >> 31) | 0x80000000u); }
__device__ __forceinline__ float unmono(unsigned k) { return __uint_as_float((k & 0x80000000u) ? (k ^ 0x80000000u) : ~k); }
#define CE_DESC(a, b) do { const unsigned _mx = max((a), (b)), _mn = min((a), (b)); (a) = _mx; (b) = _mn; } while (0)
__device__ __forceinline__ void top16_of_64(unsigned (&x)[64]) {
#pragma unroll
    for (int g = 0; g < 4; ++g)
#pragma unroll
        for (int k = 2; k <= 16; k <<= 1)
#pragma unroll
            for (int j = k >> 1; j > 0; j >>= 1)
#pragma unroll
                for (int i = 0; i < 16; ++i) { const int l = i ^ j; if (l > i) { if ((i & k) == 0) CE_DESC(x[16 * g + i], x[16 * g + l]); else CE_DESC(x[16 * g + l], x[16 * g + i]); } }
#pragma unroll
    for (int s = 0; s < 3; ++s) { const int a = (s == 1) ? 32 : 0, b2 = (s == 0) ? 16 : (s == 1 ? 48 : 32);
#pragma unroll
        for (int i = 0; i < 16; ++i) x[a + i] = max(x[a + i], x[b2 + 15 - i]);
#pragma unroll
        for (int j = 8; j > 0; j >>= 1)
#pragma unroll
            for (int i = 0; i < 16; ++i) { const int l = i ^ j; if (l > i) CE_DESC(x[a + i], x[a + l]); } }
}
__device__ __forceinline__ void phase_topk(Frame& F, const bf16* Q2, int* EI, float* GA) {
    const int lane = F.lane, wave = F.wave, r = lane & 31, hh = lane >> 5, tsub = wave & 3, hgrp = wave >> 2;
    const bf16* skp = (const bf16*)(WSP() + WS_SK);
    LAS unsigned char* itab = F.lds + wave * 1024;
    for (int tile = blockIdx.x; tile < M / 128; tile += F.G) {
        const int m = tile * 128 + tsub * 32 + r;
#pragma unroll 1
        for (int hd = 0; hd < 4; ++hd) { const int h = hgrp * 4 + hd;
            unsigned k12[2][16];
#pragma unroll
            for (int p = 0; p < 2; ++p) {
                bf16x8 bq[8];
#pragma unroll
                for (int ks = 0; ks < 8; ++ks) bq[ks] = *(const bf16x8*)(Q2 + (size_t)m * 2048 + h * 256 + p * 128 + ks * 16 + hh * 8);
                unsigned keys[64];
#pragma unroll
                for (int kt = 0; kt < 4; ++kt) {
                    f32x16 acc;
#pragma unroll
                    for (int i = 0; i < 16; ++i) acc[i] = 0.f;
                    const bf16* skr = skp + ((size_t)(h * 2 + p) * 128 + kt * 32 + r) * 128 + hh * 8;
#pragma unroll
                    for (int ks = 0; ks < 8; ++ks) { const bf16x8 a = *(const bf16x8*)(skr + ks * 16); acc = __builtin_amdgcn_mfma_f32_32x32x16_bf16(a, bq[ks], acc, 0, 0, 0); }
#pragma unroll
                    for (int i = 0; i < 16; ++i) { const int keyidx = kt * 32 + (i & 3) + 8 * (i >> 2) + 4 * hh; keys[kt * 16 + i] = (mono(acc[i]) & ~127u) | (unsigned)(127 - keyidx); }
                }
                top16_of_64(keys);
                unsigned oth[16];
#pragma unroll
                for (int i = 0; i < 16; ++i) oth[i] = (unsigned)__shfl_xor((int)keys[i], 32);
#pragma unroll
                for (int i = 0; i < 16; ++i) keys[i] = max(keys[i], oth[15 - i]);
#pragma unroll
                for (int j = 8; j > 0; j >>= 1)
#pragma unroll
                    for (int i = 0; i < 16; ++i) { const int l = i ^ j; if (l > i) CE_DESC(keys[i], keys[l]); }
#pragma unroll
                for (int i = 0; i < 16; ++i) k12[p][i] = keys[i];
            }
            float v1[16], v2[16];
#pragma unroll
            for (int i = 0; i < 16; ++i) { v1[i] = unmono(k12[0][i] & ~127u); v2[i] = unmono(k12[1][i] & ~127u); }
            if (hh == 0) {
                v4u w0, w1;
#define PK4(K, b) ((127u - ((K)[b] & 127u)) | ((127u - ((K)[b + 1] & 127u)) << 8) | ((127u - ((K)[b + 2] & 127u)) << 16) | ((127u - ((K)[b + 3] & 127u)) << 24))
                w0.x = PK4(k12[0], 0); w0.y = PK4(k12[0], 4); w0.z = PK4(k12[0], 8); w0.w = PK4(k12[0], 12);
                w1.x = PK4(k12[1], 0); w1.y = PK4(k12[1], 4); w1.z = PK4(k12[1], 8); w1.w = PK4(k12[1], 12);
#undef PK4
                *(LAS v4u*)(itab + r * 32) = w0; *(LAS v4u*)(itab + r * 32 + 16) = w1; }
            unsigned ck[64];
            { int nn = 0;
#pragma unroll
              for (int i = 0; i < 16; ++i)
#pragma unroll
                  for (int j = 0; j < 16; ++j) if ((i + 1) * (j + 1) <= 16) { ck[nn] = (mono(v1[i] + v2[j]) & ~255u) | (unsigned)(255 - (i * 16 + j)); ++nn; }
#pragma unroll
              for (int q = 50; q < 64; ++q) ck[q] = 0u; }
            top16_of_64(ck);
            asm volatile("s_waitcnt lgkmcnt(0)" ::: "memory");
            float ts[16], es[16]; int ei[16]; float sum = 0.f;
#pragma unroll
            for (int q = 0; q < 16; ++q) { ts[q] = unmono(ck[q] & ~255u); const unsigned pos = 255u - (ck[q] & 255u);
                const unsigned e1 = itab[r * 32 + (pos >> 4)], e2 = itab[r * 32 + 16 + (pos & 15u)]; ei[q] = (int)(e1 * 128u + e2); }
#pragma unroll
            for (int q = 0; q < 16; ++q) { es[q] = __expf(ts[q] - ts[0]); sum += es[q]; }
            const float inv = 1.0f / sum;
            int eo[8]; float go[8];
#pragma unroll
            for (int q = 0; q < 8; ++q) { eo[q] = hh ? ei[q + 8] : ei[q]; go[q] = (hh ? es[q + 8] : es[q]) * inv; }
            int* ep = EI + (size_t)m * 128 + h * 16 + hh * 8; float* gp = GA + (size_t)m * 128 + h * 16 + hh * 8;
            *(v4u*)ep = (v4u){(unsigned)eo[0], (unsigned)eo[1], (unsigned)eo[2], (unsigned)eo[3]}; *(v4u*)(ep + 4) = (v4u){(unsigned)eo[4], (unsigned)eo[5], (unsigned)eo[6], (unsigned)eo[7]};
            *(f32x4*)gp = (f32x4){go[0], go[1], go[2], go[3]}; *(f32x4*)(gp + 4) = (f32x4){go[4], go[5], go[6], go[7]};
            asm volatile("s_waitcnt lgkmcnt(0)" ::: "memory");
        }
    }
}

struct RowBuf { v4u ua; v2u ub; v4u va; v2u vb; float su, svg; };
__device__ __forceinline__ void gather_load(RowBuf& B, int step, int g, int j, int e_lo, int e_hi, float g_lo, float g_hi, const unsigned char* tu, const unsigned char* tv, const float* su, const float* sv) {
    const int src = (step * 2 + g) & 63;
    const int eidx = __shfl(step < 32 ? e_lo : e_hi, src); const float gate = __shfl(step < 32 ? g_lo : g_hi, src);
    const unsigned char* ur = tu + (size_t)eidx * 768; const unsigned char* vr = tv + (size_t)eidx * 768;
    B.ua = *(const v4u*)(ur + 16 * j); B.ub = *(const v2u*)(ur + 512 + 8 * j); B.va = *(const v4u*)(vr + 16 * j); B.vb = *(const v2u*)(vr + 512 + 8 * j);
    B.su = su[eidx]; B.svg = gate * sv[eidx];
}
__device__ __forceinline__ void gather_compute(const RowBuf& B, const unsigned (&hp)[16], float (&y)[32]) {
    const f32x32 ru = __builtin_amdgcn_cvt_scalef32_pk32_f32_fp6((u32x6){B.ua.x, B.ua.y, B.ua.z, B.ua.w, B.ub.x, B.ub.y}, 1.0f);
    float d0 = 0.f, d1 = 0.f, d2 = 0.f, d3 = 0.f;
#pragma unroll
    for (int q = 0; q < 8; ++q) { d0 += ru[4 * q] * bflo(hp[2 * q]); d1 += ru[4 * q + 1] * bfhi(hp[2 * q]); d2 += ru[4 * q + 2] * bflo(hp[2 * q + 1]); d3 += ru[4 * q + 3] * bfhi(hp[2 * q + 1]); }
    float d = (d0 + d1) + (d2 + d3);
    d += __shfl_xor(d, 1); d += __shfl_xor(d, 2); d += __shfl_xor(d, 4); d += __shfl_xor(d, 8); d += __shfl_xor(d, 16);
    d *= B.su;
    const float wgt = B.svg * 0.5f * d * (1.0f + erff(d * 0.70710678118654752f));
    __builtin_amdgcn_sched_barrier(0);
    const f32x32 rv = __builtin_amdgcn_cvt_scalef32_pk32_f32_fp6((u32x6){B.va.x, B.va.y, B.va.z, B.va.w, B.vb.x, B.vb.y}, 1.0f);
#pragma unroll
    for (int q = 0; q < 32; ++q) y[q] += wgt * rv[q];
}
__device__ __forceinline__ void phase_gather(Frame& F, const bf16* H2, const int* EI, const float* GA) {
    LAS float* a2 = (LAS float*)F.lds;
    LAS bf16* hrow = (LAS bf16*)(F.lds + 4096 + F.wave * 2048);
    LAS float* yrow = (LAS float*)(F.lds + 4096 + 16384 + F.wave * 4096);
    LAS unsigned* ptab = (LAS unsigned*)(F.lds + 4096 + 16384 + 32768 + F.wave * 128);
    unsigned char* ws = WSP(); const unsigned char* tu = ws + WS_TU; const unsigned char* tv = ws + WS_TV; const float* su = (const float*)(ws + WS_SU); const float* sv = (const float*)(ws + WS_SV); float* outp = OUTP();
    const float* npf = IN(I_NPOSTFFN); const float* b_ada = IN(I_BADA); const float* modp = (const float*)(ws + WS_MODP);
    const int lane = F.lane, g = lane >> 5, j = lane & 31;
    {
        f32x16v pa, pb;
#pragma unroll
        for (int i = 0; i < 16; ++i) { pa[i] = 0.125f * (float)i; pb[i] = (i < 8) ? 2.0f + 0.25f * (float)i : 4.0f + 0.5f * (float)(i - 8); }
        const f32x32 pr = __builtin_amdgcn_cvt_scalef32_pk32_f32_fp6(__builtin_amdgcn_cvt_scalef32_2xpk16_fp6_f32(pa, pb, 1.0f), 1.0f);
#pragma unroll
        for (int q = 0; q < 32; ++q) { const float v = pr[q]; int idx = (v < 2.0f) ? (int)(v * 8.0f + 0.5f) : (v < 4.0f) ? 16 + (int)((v - 2.0f) * 4.0f + 0.5f) : 24 + (int)((v - 4.0f) * 2.0f + 0.5f);
            idx = idx < 0 ? 0 : (idx > 31 ? 31 : idx); if (lane == 0) ptab[q] = (unsigned)idx; }
    }
    for (int rb = blockIdx.x; rb < M / 128; rb += F.G) {
        const int row0 = rb * 128, b = row0 / SEQ;
        __syncthreads();
        for (int k = F.tid; k < 1024; k += NTHR) a2[k] = modv(b_ada, modp, b, 5120 + k) * npf[k];
        __syncthreads();
        for (int ti = 0; ti < 16; ++ti) { const int m = row0 + F.wave * 16 + ti;
            { const v4u h0 = *(const v4u*)(H2 + (size_t)m * D + 16 * lane), h1 = *(const v4u*)(H2 + (size_t)m * D + 16 * lane + 8);
              *(LAS v4u*)(hrow + 16 * lane) = h0; *(LAS v4u*)(hrow + 16 * lane + 8) = h1; }
            const int e_lo = EI[(size_t)m * 128 + lane], e_hi = EI[(size_t)m * 128 + 64 + lane];
            const float g_lo = GA[(size_t)m * 128 + lane], g_hi = GA[(size_t)m * 128 + 64 + lane];
            asm volatile("s_waitcnt lgkmcnt(0)" ::: "memory");
            unsigned hp[16];
#pragma unroll
            for (int q = 0; q < 16; ++q) hp[q] = (unsigned)hrow[32 * j + ptab[2 * q]] | ((unsigned)hrow[32 * j + ptab[2 * q + 1]] << 16);
            float y[32];
#pragma unroll
            for (int q = 0; q < 32; ++q) y[q] = 0.f;
            RowBuf B0, B1, B2, B3;
#define GLOAD(B, st) gather_load(B, (st), g, j, e_lo, e_hi, g_lo, g_hi, tu, tv, su, sv)
#define SB() __builtin_amdgcn_sched_barrier(0)
            GLOAD(B0, 0); GLOAD(B1, 1); GLOAD(B2, 2);
#pragma unroll 1
            for (int st = 0; st < 64; st += 4) {
                const int s4 = (st + 4 < 64) ? st + 4 : 63, s5 = (st + 5 < 64) ? st + 5 : 63, s6 = (st + 6 < 64) ? st + 6 : 63;
                GLOAD(B3, st + 3); SB(); gather_compute(B0, hp, y); SB();
                GLOAD(B0, s4); SB(); gather_compute(B1, hp, y); SB();
                GLOAD(B1, s5); SB(); gather_compute(B2, hp, y); SB();
                GLOAD(B2, s6); SB(); gather_compute(B3, hp, y); SB();
            }
#undef GLOAD
#undef SB
            float ss = 0.f;
#pragma unroll
            for (int q = 0; q < 32; ++q) { y[q] += __shfl_xor(y[q], 32); ss += y[q] * y[q]; }
            ss += __shfl_xor(ss, 1); ss += __shfl_xor(ss, 2); ss += __shfl_xor(ss, 4); ss += __shfl_xor(ss, 8); ss += __shfl_xor(ss, 16);
            const float rstd = rsqrtf(ss * (1.f / D) + EPS);
            if (g == 0) {
#pragma unroll
                for (int q = 0; q < 32; ++q) yrow[32 * j + ptab[q]] = y[q]; }
            asm volatile("s_waitcnt lgkmcnt(0)" ::: "memory");
            const int k = 32 * j + 16 * g;
            f32x4* op = (f32x4*)(outp + (size_t)m * D + k);
#pragma unroll
            for (int q = 0; q < 4; ++q) { f32x4 xv = op[q]; const f32x4 av = *(const LAS f32x4*)(a2 + k + 4 * q), yv = *(const LAS f32x4*)(yrow + k + 4 * q);
                xv = xv + av * yv * rstd; op[q] = xv; }
            asm volatile("s_waitcnt lgkmcnt(0)" ::: "memory");
        }
    }
}

typedef GAS unsigned gu32;
#define XB_TMO      128
#define XB_XCNT(j)  (256  + 64 * (j))
#define XB_XSUB(j)  (1280 + 64 * (j))
#define XB_XGEN(j)  (2304 + 64 * (j))
#define XB_TOP      3328
#define XB_TOPGEN   3392
#define XCD_BAR_WORDS 3456
#define XB_SPIN_CAP (1u << 18)

__device__ __forceinline__ unsigned xb_ld(unsigned* p)              { return __hip_atomic_load(p, __ATOMIC_RELAXED, __HIP_MEMORY_SCOPE_AGENT); }
__device__ __forceinline__ unsigned xb_add(unsigned* p, unsigned v) { return __hip_atomic_fetch_add(p, v, __ATOMIC_RELAXED, __HIP_MEMORY_SCOPE_AGENT); }
__device__ __forceinline__ unsigned xb_xcc_id() { return (unsigned)__builtin_amdgcn_s_getreg((3 << 11) | 20) & 0xFu; }
#define XB_SPIN(cond, bar) do { unsigned _sp = 0; while (cond) { __builtin_amdgcn_s_sleep(1); \
    if ((++_sp & 255u) == 0u) { if (xb_ld(&(bar)[XB_TMO])) break; if (_sp > XB_SPIN_CAP) { atomicAdd(&(bar)[XB_TMO], 1u); break; } } } } while (0)

struct XcdBarrier {
    unsigned* bar; unsigned x;
    volatile LAS unsigned* st;
};

__device__ __forceinline__ XcdBarrier xcd_barrier_post(unsigned* bar, volatile LAS unsigned* st) {
    XcdBarrier b; b.bar = bar; b.x = xb_xcc_id(); b.st = st;
    if (threadIdx.x == 0) (void)xb_add(&bar[XB_XCNT(b.x)], 1u);
    return b;
}
__device__ __forceinline__ void xcd_barrier_complete(unsigned* bar, unsigned x, unsigned& nloc, unsigned& nx) {
    const unsigned G = gridDim.x * gridDim.y * gridDim.z;
    unsigned sum, cnt, mine, sp = 0u;
    for (;;) {
        sum = 0u; cnt = 0u; mine = 0u;
#pragma unroll
        for (unsigned j = 0; j < 16; ++j) { const unsigned c = xb_ld(&bar[XB_XCNT(j)]); sum += c; cnt += (c > 0u) ? 1u : 0u; mine = (j == x) ? c : mine; }
        if (sum == G) break;
        __builtin_amdgcn_s_sleep(1);
        if ((++sp & 255u) == 0u) { if (xb_ld(&bar[XB_TMO])) break; if (sp > XB_SPIN_CAP) { atomicAdd(&bar[XB_TMO], 1u); break; } }
    }
    nloc = mine > 0u ? mine : 1u; nx = cnt > 0u ? cnt : 1u;
}

__device__ __forceinline__ void xcd_barrier(const XcdBarrier& b) {
    asm volatile("s_waitcnt vmcnt(0)" ::: "memory");
    __syncthreads();
    if (threadIdx.x == 0) {
        unsigned* bar = b.bar;
        __builtin_amdgcn_s_waitcnt(0);
        unsigned nloc = b.st[0], nx = b.st[1];
        if (nloc == 0u) { xcd_barrier_complete(bar, b.x, nloc, nx); b.st[0] = nloc; b.st[1] = nx; }
        const unsigned old = xb_add(&bar[XB_XSUB(b.x)], 1u);
        const unsigned gen = old / nloc;
        if (old + 1u == (gen + 1u) * nloc) {
            __builtin_amdgcn_fence(__ATOMIC_RELEASE, "agent");
            asm volatile("s_waitcnt vmcnt(0)" ::: "memory");
            const unsigned og = xb_add(&bar[XB_TOP], 1u);
            const unsigned tg = og / nx;
            if (og + 1u == (tg + 1u) * nx) xb_add(&bar[XB_TOPGEN], 1u);
            else XB_SPIN(xb_ld(&bar[XB_TOPGEN]) == tg, bar);
            __builtin_amdgcn_fence(__ATOMIC_ACQUIRE, "agent");
            xb_add(&bar[XB_XGEN(b.x)], 1u);
            asm volatile("s_waitcnt vmcnt(0)" ::: "memory");
        } else {
            XB_SPIN(xb_ld(&bar[XB_XGEN(b.x)]) == gen, bar);
            __builtin_amdgcn_fence(__ATOMIC_ACQUIRE, "agent");
            asm volatile("s_waitcnt vmcnt(0)" ::: "memory");
        }
    }
    __syncthreads();
}

struct Args { const float* in[21]; float* out; unsigned char* ws; };
__global__ void __launch_bounds__(NTHR, 2) fwd_megakernel(Args args) {
    extern __shared__ __attribute__((aligned(16))) unsigned char lds[];
#define MKFRAME() Frame F; { int t_ = threadIdx.x; asm volatile("" : "+v"(t_)); F.lds = (LAS unsigned char*)lds; F.tid = t_; F.lane = t_ & 63; F.wave = __builtin_amdgcn_readfirstlane(t_ >> 6); F.G = gridDim.x; }
#define GRID_SYNC() cg::this_grid().sync()
    volatile LAS unsigned* bst = (volatile LAS unsigned*)((LAS unsigned char*)lds + LDS_BYTES - 64);
    if (threadIdx.x < 16) bst[threadIdx.x] = 0u;
    __syncthreads();
    const XcdBarrier xbar = xcd_barrier_post((unsigned*)(WSP() + WS_CTL) + 1024, bst);
#define XSYNC() xcd_barrier(xbar)
#define WSB(off) ((bf16*)(WSP() + (off)))
#define SEGP(s) segp(WSP(), (s))
    { MKFRAME();
    phase_prologue(F);
    }
    GRID_SYNC();
    { MKFRAME();
    phase_h1(F, (bf16*)OUTP());
    }
    XSYNC();
    { MKFRAME();
    {
        pg8::Gemm g{(const bf16*)OUTP(), WSB(WS_WIN), M, NIN, D}; pg8::StaticOrder S; S.init(M, NIN, F.G, (int)blockIdx.x);
        pg8::EpiBf16<0> E{SEGP(0), 512, nullptr, 512, SEG_ELEMS, 1.f};
        pg8::gemm_phase<pg8::EpiBf16<0>, pg8::StaticOrder, true, true>(F.lds, g, S, E);
    }
    }
    XSYNC();
    { MKFRAME();
    phase_scprep(F);
    { bf16* dW = (bf16*)OUTP(); phase_dnprep(F, dW, dW + (size_t)NITEM * 4096, dW + (size_t)2 * NITEM * 4096, dW + (size_t)3 * NITEM * 4096, WSB(WS_KD)); }
    }
    XSYNC();
    { MKFRAME();
    { const bf16* dW = (const bf16*)OUTP(); phase_scan(F, dW, dW + (size_t)NITEM * 4096, dW + (size_t)2 * NITEM * 4096, dW + (size_t)3 * NITEM * 4096, WSB(WS_KD), SEGP(3), SEGP(6)); }
    }
    XSYNC();
    { MKFRAME();
    {
        pg8::StaticOrder S; S.init(M, D, F.G, (int)blockIdx.x);
        { pg8::Gemm g{SEGP(0), WSB(WS_WSC), M, D, 512}; pg8::EpiGate<false> E{SEGP(4), SEGP(7), SEG_ELEMS};
          pg8::gemm_phase<pg8::EpiGate<false>, pg8::StaticOrder, true, true>(F.lds, g, S, E); }
        { pg8::Gemm g{SEGP(3), WSB(WS_WDN), M, D, 512}; pg8::EpiGate<true> E{SEGP(4), SEGP(9), SEG_ELEMS};
          pg8::gemm_phase<pg8::EpiGate<true>, pg8::StaticOrder, true, true>(F.lds, g, S, E); }
    }
    }
    XSYNC();
    { MKFRAME();
    {
        pg8::Gemm g{SEGP(4), WSB(WS_WMIX), M, D, D}; pg8::StaticOrder S; S.init(M, D, F.G, (int)blockIdx.x);
        pg8::EpiBf16<0> E{SEGP(1), D, nullptr, 0, 0, 1.f};
        pg8::gemm_phase<pg8::EpiBf16<0>, pg8::StaticOrder, true, true>(F.lds, g, S, E);
    }
    }
    XSYNC();
    { MKFRAME();
    phase_x1h2(F, SEGP(1), SEGP(7));
    }
    XSYNC();
    { MKFRAME();
    {
        pg8::Gemm g{SEGP(7), WSB(WS_WQ), M, 2048, D}; pg8::StaticOrder S; S.init(M, 2048, F.G, (int)blockIdx.x);
        pg8::EpiBf16<0> E{SEGP(3), 2048, nullptr, 0, 0, 1.f};
        pg8::gemm_phase<pg8::EpiBf16<0>, pg8::StaticOrder, true, true>(F.lds, g, S, E);
    }
    }
    XSYNC();
    { MKFRAME();
    phase_topk(F, SEGP(3), (int*)SEGP(0), (float*)((unsigned char*)SEGP(0) + 16 * MiB));
    }
    XSYNC();
    { MKFRAME();
    phase_gather(F, SEGP(7), (const int*)SEGP(0), (const float*)((unsigned char*)SEGP(0) + 16 * MiB));
    }
}

extern "C" void kernel_launch(void* const* d_in, const int* in_sizes, int n_in, void* d_out, int out_size, void* d_ws, size_t ws_size, hipStream_t stream) {
    static int grid = 0;
    if (grid == 0) {
        if (n_in != 21 || out_size != M * D || ws_size < WS_END) { fprintf(stderr, "kernel_launch: unexpected problem (n_in %d, out %d, ws %zu)\n", n_in, out_size, ws_size); grid = -1; return; }
        int dev = 0, cus = 0, per_cu = 0;
        hipGetDevice(&dev); hipDeviceGetAttribute(&cus, hipDeviceAttributeMultiprocessorCount, dev);
        hipFuncSetAttribute((const void*)fwd_megakernel, hipFuncAttributeMaxDynamicSharedMemorySize, LDS_BYTES);
        hipOccupancyMaxActiveBlocksPerMultiprocessor(&per_cu, (const void*)fwd_megakernel, NTHR, LDS_BYTES);
        if (per_cu < 1) { fprintf(stderr, "kernel_launch: occupancy query says %d blocks per CU\n", per_cu); per_cu = 1; }
        if (per_cu > 1) per_cu = 1;
        grid = cus * per_cu; if (grid > 256) grid = 256;
        (void)hipGetLastError();
    }
    if (grid < 0) return;
    if (hipMemsetAsync((char*)d_ws + WS_CTL, 0, 65536, stream) != hipSuccess) { fprintf(stderr, "kernel_launch: memset of the barrier words failed\n"); return; }
    Args a{};
    for (int i = 0; i < 21; ++i) a.in[i] = (const float*)d_in[i];
    a.out = (float*)d_out; a.ws = (unsigned char*)d_ws;
    void* kargs[] = {&a};
    hipError_t e = hipLaunchCooperativeKernel((const void*)fwd_megakernel, dim3(grid), dim3(NTHR), kargs, LDS_BYTES, stream);
    if (e != hipSuccess) fprintf(stderr, "cooperative launch failed: %s (grid %d)\n", hipGetErrorString(e), grid);
}
```

```cpp
#include <hip/hip_runtime.h>
#include <hip/hip_cooperative_groups.h>
#include <cstdio>
#include <cstdint>
namespace cg = cooperative_groups;
namespace pg8 {
#define PG8_LAS __attribute__((address_space(3)))
typedef unsigned short bf16_t;
typedef short bf16x8 __attribute__((ext_vector_type(8)));
typedef float f32x4 __attribute__((ext_vector_type(4)));
typedef unsigned u32x4 __attribute__((ext_vector_type(4)));
constexpr int BM = 256, BK = 64, HALF = 128, HTB = HALF * BK * 2  , STAGE_BYTES = 8 * HTB, NXCD = 8, WGM = 8;

__host__ __device__ __forceinline__ int lds_byte(int r, int c) { const int st = (r >> 4) * 2 + (c >> 5), rr = r & 15, cc = c & 31, ob = rr * 64 + cc * 2; return st * 1024 + (ob ^ (((ob >> 9) & 1) << 5)); }
__host__ __device__ __forceinline__ void stage_rc(int b, int& R, int& C) { const int st = b / 1024, sb = b % 1024, swz = sb ^ (((sb >> 9) & 1) << 5); R = (st >> 1) * 16 + swz / 64; C = (st & 1) * 32 + (swz % 64) / 2; }
__host__ __device__ __forceinline__ int perm32(int rho) { const int n = rho >> 4, i = rho & 15; return 8 * (i >> 2) + 4 * n + (i & 3); }

struct Unit { int pm, pn; };
struct Gemm { const bf16_t* A; const bf16_t* Bt; int M, N, K; };

struct StaticOrder {
    int nM, nN, nwg, G, c;
    __host__ __device__ void init(int M, int N, int G_, int c_) { nM = M / BM; nN = N / BM; nwg = nM * nN; G = G_; c = c_; }
    __host__ __device__ bool next(int i, Unit& u) const {
        const long L = (long)i * G + c; if (L >= nwg) return false;
        int wgid = (int)L; { const int q = nwg / NXCD, r = nwg % NXCD, xcd = wgid % NXCD, off = wgid / NXCD; wgid = (xcd < r ? xcd * (q + 1) : r * (q + 1) + (xcd - r) * q) + off; }
        const int nig = WGM * nN, gid = wgid / nig, fm = gid * WGM, gsz = (nM - fm) < WGM ? (nM - fm) : WGM;
        u.pm = fm + ((wgid % nig) % gsz); u.pn = (wgid % nig) / gsz; return true;
    }
    __device__ __forceinline__ void a_ready(const Unit&) const {}
    __device__ __forceinline__ void done(const Unit&) const {}
};

__device__ __forceinline__ unsigned cvt_pk_bf16(float lo, float hi) { unsigned r; asm volatile("v_cvt_pk_bf16_f32 %0, %1, %2" : "=v"(r) : "v"(lo), "v"(hi)); return r; }
typedef float f32x2 __attribute__((ext_vector_type(2)));
__device__ __forceinline__ f32x2 gelu_pk(f32x2 v) {
    const f32x2 av = __builtin_elementwise_abs(v), d = av * 0.2316418882f + 1.0f;
    f32x2 t; t.x = __builtin_amdgcn_rcpf(d.x); t.y = __builtin_amdgcn_rcpf(d.y);
    f32x2 q = t * 0.5307027145f + (-0.7265760135f); q = q * t + 0.7107068705f; q = q * t + (-0.142248368f); q = q * t + 0.127414796f; q = q * t;
    const f32x2 s = (v * v) * (-0.72134752044f);
    f32x2 e; e.x = __builtin_amdgcn_exp2f(s.x); e.y = __builtin_amdgcn_exp2f(s.y);
    const f32x2 m = v * (q * e), r = v - m;
    f32x2 o; o.x = v.x < 0.f ? m.x : r.x; o.y = v.y < 0.f ? m.y : r.y; return o;
}

template <int ACT  > struct EpiBf16 {
    static constexpr bool PERM = true, AFTER_DRAIN = false; static_assert(ACT == 0 || ACT == 1, "EpiBf16: ACT is 0 (none) or 1 (gelu_pk)");
    bf16_t* O; int ldc; const float* bias; int split_cols; size_t split_stride; float scale0;
    __device__ __forceinline__ void operator()(const f32x4 (&acc)[2][2][4][2], const Unit& u, int wr, int wc, int fr, int fq) const {
        const int row0 = u.pm * BM + wr * 64 + fr; int colt = u.pn * BM; bf16_t* base = O;
        float sc = 1.f; if (split_cols) { const int t = colt / split_cols; base += (size_t)t * split_stride; colt -= t * split_cols; if (t == 0) sc = scale0; }
        const int col0 = colt + wc * 32 + 8 * fq, bcol0 = u.pn * BM + wc * 32 + 8 * fq;
        f32x4 bv[2][2];
#pragma unroll
        for (int bj = 0; bj < 2; ++bj)
#pragma unroll
            for (int n = 0; n < 2; ++n) bv[bj][n] = bias ? *(const f32x4*)(bias + bcol0 + bj * HALF + 4 * n) : (f32x4){0.f, 0.f, 0.f, 0.f};
#pragma unroll
        for (int ai = 0; ai < 2; ++ai)
#pragma unroll
            for (int m = 0; m < 4; ++m) { bf16_t* rowp = base + (size_t)(row0 + ai * HALF + m * 16) * ldc + col0;
#pragma unroll
                for (int bj = 0; bj < 2; ++bj) { f32x4 v0 = acc[ai][bj][m][0] + bv[bj][0], v1 = acc[ai][bj][m][1] + bv[bj][1];
                    if (ACT == 1) { f32x2 a = gelu_pk((f32x2){v0[0], v0[1]}), b = gelu_pk((f32x2){v0[2], v0[3]}), c = gelu_pk((f32x2){v1[0], v1[1]}), d = gelu_pk((f32x2){v1[2], v1[3]});
                        v0 = (f32x4){a.x, a.y, b.x, b.y}; v1 = (f32x4){c.x, c.y, d.x, d.y}; }
                    v0 = v0 * sc; v1 = v1 * sc; u32x4 w; w.x = cvt_pk_bf16(v0[0], v0[1]); w.y = cvt_pk_bf16(v0[2], v0[3]); w.z = cvt_pk_bf16(v1[0], v1[1]); w.w = cvt_pk_bf16(v1[2], v1[3]);
                    *(u32x4*)(rowp + bj * HALF) = w; } }
    }
};
__device__ __forceinline__ float bf_lo(unsigned u) { return __uint_as_float(u << 16); }
__device__ __forceinline__ float bf_hi(unsigned u) { return __uint_as_float(u & 0xffff0000u); }
__device__ __forceinline__ float sigm(float x) { return __builtin_amdgcn_rcpf(1.0f + __builtin_amdgcn_exp2f(-1.4426950408889634f * x)); }
template <bool ADD> struct EpiGate {
    static constexpr bool PERM = true, AFTER_DRAIN = false;
    bf16_t* O; const bf16_t* gate; size_t seg_elems;
    __device__ __forceinline__ void operator()(const f32x4 (&acc)[2][2][4][2], const Unit& u, int wr, int wc, int fr, int fq) const {
        const int row0 = u.pm * BM + wr * 64 + fr, col0 = u.pn * BM + wc * 32 + 8 * fq;
#pragma unroll
        for (int ai = 0; ai < 2; ++ai)
#pragma unroll
            for (int m = 0; m < 4; ++m) { const int row = row0 + ai * HALF + m * 16;
#pragma unroll
                for (int bj = 0; bj < 2; ++bj) { const int col = col0 + bj * HALF;
                    const u32x4 gv = *(const u32x4*)(gate + (size_t)(col >> 9) * seg_elems + (size_t)row * 512 + (col & 511));
                    bf16_t* op = O + (size_t)row * 1024 + col;
                    f32x4 v0 = acc[ai][bj][m][0], v1 = acc[ai][bj][m][1];
                    v0[0] *= sigm(bf_lo(gv.x)); v0[1] *= sigm(bf_hi(gv.x)); v0[2] *= sigm(bf_lo(gv.y)); v0[3] *= sigm(bf_hi(gv.y));
                    v1[0] *= sigm(bf_lo(gv.z)); v1[1] *= sigm(bf_hi(gv.z)); v1[2] *= sigm(bf_lo(gv.w)); v1[3] *= sigm(bf_hi(gv.w));
                    if (ADD) { const u32x4 ov = *(const u32x4*)op;
                        v0[0] += bf_lo(ov.x); v0[1] += bf_hi(ov.x); v0[2] += bf_lo(ov.y); v0[3] += bf_hi(ov.y);
                        v1[0] += bf_lo(ov.z); v1[1] += bf_hi(ov.z); v1[2] += bf_lo(ov.w); v1[3] += bf_hi(ov.w); }
                    u32x4 w; w.x = cvt_pk_bf16(v0[0], v0[1]); w.y = cvt_pk_bf16(v0[2], v0[3]); w.z = cvt_pk_bf16(v1[0], v1[1]); w.w = cvt_pk_bf16(v1[2], v1[3]);
                    *(u32x4*)op = w; } }
    }
};
template <class Epi, class Sched, bool ALIGN_EPI = false, bool SP2 = false>
__device__ __forceinline__ void gemm_phase(PG8_LAS unsigned char* lds, const Gemm g, const Sched& S, const Epi& E) {
    int tid_ = threadIdx.x; asm volatile("" : "+v"(tid_));
    const int tid = tid_, wid = __builtin_amdgcn_readfirstlane(tid >> 6), lane = tid & 63, wr = wid >> 2, wc = wid & 3, fr = lane & 15, fq = lane >> 4;
    const int K = g.K, nt = K / BK;
    unsigned voffA[2], voffB[2];
#pragma unroll
    for (int i = 0; i < 2; ++i) { int R, C; stage_rc(tid * 16 + i * 8192, R, C); const int Rb = Epi::PERM ? ((R & ~31) + perm32(R & 31)) : R;
        voffA[i] = (unsigned)(R * K + C) * 2u; voffB[i] = (unsigned)(Rb * K + C) * 2u; }
    const size_t kstep = (size_t)(BK * 2);
    const size_t hstep = (size_t)HALF * K * 2;
    const size_t tstep = 2 * hstep;
    const unsigned ldsw = (unsigned)wid * 1024u;
    const int aoff = lds_byte(wr * 64 + fr, fq * 8), boff = lds_byte(wc * 32 + fr, fq * 8);
#define PG8_SA(b, h) (((b) * 2 + (h)) * HTB)
#define PG8_SB(b, h) ((4 + (b) * 2 + (h)) * HTB)
#define PG8_STAGE(bufoff, gbase, voff) do { _Pragma("unroll") for (int _i = 0; _i < 2; ++_i) \
        __builtin_amdgcn_global_load_lds((const unsigned*)((const char*)(gbase) + (voff)[_i]), (PG8_LAS unsigned*)(lds + (bufoff) + ldsw + _i * 8192), 16, 0, 0); } while (0)
#define PG8_LDA(dst, b, h) do { _Pragma("unroll") for (int m = 0; m < 4; ++m) _Pragma("unroll") for (int k = 0; k < 2; ++k) dst[m][k] = *(const PG8_LAS bf16x8*)(lds + PG8_SA(b, h) + aoff + m * 2048 + k * 1024); } while (0)
#define PG8_LDB(dst, b, h) do { _Pragma("unroll") for (int n = 0; n < 2; ++n) _Pragma("unroll") for (int k = 0; k < 2; ++k) dst[n][k] = *(const PG8_LAS bf16x8*)(lds + PG8_SB(b, h) + boff + n * 2048 + k * 1024); } while (0)
#define PG8_MMA(ai, bj, At, Bt) do { __builtin_amdgcn_s_setprio(1); _Pragma("unroll") for (int m = 0; m < 4; ++m) _Pragma("unroll") for (int n = 0; n < 2; ++n) _Pragma("unroll") for (int k = 0; k < 2; ++k) \
        acc[ai][bj][m][n] = __builtin_amdgcn_mfma_f32_16x16x32_bf16(Bt[n][k], At[m][k], acc[ai][bj][m][n], 0, 0, 0); __builtin_amdgcn_s_setprio(0); } while (0)
#define PG8_WAIT_V(n) asm volatile("s_waitcnt vmcnt(" #n ")" ::: "memory")
#define PG8_WAIT_L(n) asm volatile("s_waitcnt lgkmcnt(" #n ")" ::: "memory")
#define PG8_BAR __builtin_amdgcn_s_barrier()
#define PG8_SCHED __builtin_amdgcn_sched_barrier(0)
    Unit cur, nxt; int ui = 0;
    if (!S.next(0, cur)) return;
    f32x4 acc[2][2][4][2];
#pragma unroll
    for (int a = 0; a < 2; ++a)
#pragma unroll
        for (int b = 0; b < 2; ++b)
#pragma unroll
            for (int m = 0; m < 4; ++m)
#pragma unroll
                for (int n = 0; n < 2; ++n) acc[a][b][m][n] = (f32x4){0.f, 0.f, 0.f, 0.f};
    bf16x8 At[4][2], B0[2][2], B1[2][2];
    const char* cA = (const char*)g.A + (size_t)cur.pm * tstep; const char* cB = (const char*)g.Bt + (size_t)cur.pn * tstep;
    S.a_ready(cur);
    if constexpr (SP2) {
        PG8_STAGE(PG8_SB(0, 0), cB, voffB); PG8_STAGE(PG8_SB(0, 1), cB + hstep, voffB); PG8_STAGE(PG8_SA(0, 0), cA, voffA); PG8_STAGE(PG8_SA(0, 1), cA + hstep, voffA);
        if (wr == 1) PG8_BAR;
        PG8_WAIT_V(2); PG8_BAR;
        PG8_STAGE(PG8_SB(1, 0), cB + kstep, voffB); PG8_STAGE(PG8_SA(1, 0), cA + kstep, voffA); PG8_STAGE(PG8_SB(1, 1), cB + hstep + kstep, voffB);
        PG8_WAIT_V(6); PG8_BAR;
    } else {
        PG8_STAGE(PG8_SB(0, 0), cB, voffB); PG8_STAGE(PG8_SA(0, 0), cA, voffA); PG8_STAGE(PG8_SB(0, 1), cB + hstep, voffB); PG8_STAGE(PG8_SA(0, 1), cA + hstep, voffA);
        if (wr == 1) PG8_BAR;
        PG8_WAIT_V(4); PG8_BAR;
        PG8_STAGE(PG8_SB(1, 0), cB + kstep, voffB); PG8_STAGE(PG8_SA(1, 0), cA + kstep, voffA); PG8_STAGE(PG8_SB(1, 1), cB + hstep + kstep, voffB);
        PG8_WAIT_V(6); PG8_BAR;
    }
    for (;;) {
        const bool has_next = S.next(ui + 1, nxt);
        const char* nA = has_next ? (const char*)g.A + (size_t)nxt.pm * tstep : cA; const char* nB = has_next ? (const char*)g.Bt + (size_t)nxt.pn * tstep : cB;
        for (int t = 0; t < nt; t += 2) {
            const bool last = (t == nt - 2);
            const char* a1 = cA + (size_t)(t + 1) * kstep;
            const char* a2 = last ? nA : cA + (size_t)(t + 2) * kstep; const char* b2 = last ? nB : cB + (size_t)(t + 2) * kstep;
            const char* a3 = a2 + kstep; const char* b3 = b2 + kstep;
            if (last && has_next) S.a_ready(nxt);
            if constexpr (SP2) {
            PG8_LDB(B0, 0, 0); PG8_LDB(B1, 0, 1); PG8_SCHED; PG8_LDA(At, 0, 0); PG8_STAGE(PG8_SA(1, 1), a1 + hstep, voffA);
            PG8_WAIT_V(8); PG8_WAIT_L(0); PG8_BAR; PG8_MMA(0, 0, At, B0); PG8_MMA(0, 1, At, B1); PG8_BAR; PG8_SCHED;
            PG8_LDA(At, 0, 1); PG8_STAGE(PG8_SB(0, 0), b2, voffB); PG8_STAGE(PG8_SB(0, 1), b2 + hstep, voffB); PG8_STAGE(PG8_SA(0, 0), a2, voffA);
            PG8_WAIT_V(8); PG8_WAIT_L(0); PG8_BAR; PG8_MMA(1, 0, At, B0); PG8_MMA(1, 1, At, B1); PG8_BAR; PG8_SCHED;
            PG8_LDB(B0, 1, 0); PG8_LDB(B1, 1, 1); PG8_SCHED; PG8_LDA(At, 1, 0); PG8_STAGE(PG8_SA(0, 1), a2 + hstep, voffA);
            PG8_WAIT_V(8); PG8_WAIT_L(0); PG8_BAR; PG8_MMA(0, 0, At, B0); PG8_MMA(0, 1, At, B1); PG8_BAR; PG8_SCHED;
            PG8_LDA(At, 1, 1); PG8_STAGE(PG8_SB(1, 0), b3, voffB); PG8_STAGE(PG8_SB(1, 1), b3 + hstep, voffB); PG8_STAGE(PG8_SA(1, 0), a3, voffA);
            PG8_WAIT_V(8); PG8_WAIT_L(0); PG8_BAR; PG8_MMA(1, 0, At, B0); PG8_MMA(1, 1, At, B1); PG8_BAR; PG8_SCHED;
            } else {
            PG8_LDB(B0, 0, 0); PG8_SCHED; PG8_LDA(At, 0, 0); PG8_STAGE(PG8_SA(1, 1), a1 + hstep, voffA);
            PG8_WAIT_L(8); PG8_BAR; PG8_WAIT_L(0); PG8_MMA(0, 0, At, B0); PG8_BAR; PG8_SCHED;
            PG8_LDB(B1, 0, 1); PG8_STAGE(PG8_SB(0, 0), b2, voffB);
            PG8_BAR; PG8_WAIT_L(0); PG8_MMA(0, 1, At, B1); PG8_BAR;
            PG8_LDA(At, 0, 1); PG8_STAGE(PG8_SA(0, 0), a2, voffA);
            PG8_BAR; PG8_WAIT_L(0); PG8_MMA(1, 0, At, B0); PG8_BAR; PG8_SCHED;
            PG8_STAGE(PG8_SB(0, 1), b2 + hstep, voffB);
            PG8_WAIT_V(6); PG8_BAR; PG8_MMA(1, 1, At, B1); PG8_BAR;
            PG8_LDB(B0, 1, 0); PG8_SCHED; PG8_LDA(At, 1, 0); PG8_STAGE(PG8_SA(0, 1), a2 + hstep, voffA);
            PG8_WAIT_L(8); PG8_BAR; PG8_WAIT_L(0); PG8_MMA(0, 0, At, B0); PG8_BAR; PG8_SCHED;
            PG8_LDB(B1, 1, 1); PG8_STAGE(PG8_SB(1, 0), b3, voffB);
            PG8_BAR; PG8_WAIT_L(0); PG8_MMA(0, 1, At, B1); PG8_BAR;
            PG8_LDA(At, 1, 1); PG8_STAGE(PG8_SA(1, 0), a3, voffA);
            PG8_BAR; PG8_WAIT_L(0); PG8_MMA(1, 0, At, B0); PG8_BAR; PG8_SCHED;
            PG8_STAGE(PG8_SB(1, 1), b3 + hstep, voffB);
            PG8_WAIT_V(6); PG8_BAR; PG8_MMA(1, 1, At, B1); PG8_BAR;
            }
        }
        if constexpr (ALIGN_EPI) { if (wr == 0) PG8_BAR; }
        if constexpr (!Epi::AFTER_DRAIN) { E(acc, cur, wr, wc, fr, fq); S.done(cur); }
        if (!has_next) break;
#pragma unroll
        for (int a = 0; a < 2; ++a)
#pragma unroll
            for (int b = 0; b < 2; ++b)
#pragma unroll
                for (int m = 0; m < 4; ++m)
#pragma unroll
                    for (int n = 0; n < 2; ++n) acc[a][b][m][n] = (f32x4){0.f, 0.f, 0.f, 0.f};
        cur = nxt; cA = nA; cB = nB; ++ui;
        if constexpr (ALIGN_EPI) { if (wr == 1) PG8_BAR; }
    }
    PG8_WAIT_V(0);
    if constexpr (!ALIGN_EPI) { if (wr == 0) PG8_BAR; }
    PG8_BAR;
    if constexpr (Epi::AFTER_DRAIN) { E.fused(acc, cur, wr, wc, fr, fq, lds, wid, lane); S.done(cur); }
#undef PG8_SA
#undef PG8_SB
#undef PG8_STAGE
#undef PG8_LDA
#undef PG8_LDB
#undef PG8_MMA
#undef PG8_WAIT_V
#undef PG8_WAIT_L
#undef PG8_BAR
#undef PG8_SCHED
}
}
constexpr int NWAVES = 8, NTHR = 512;
constexpr int M = 32768, D = 1024, SEQ = 8192, NBATCH = 4;
constexpr int NIN = 5888;
constexpr int NCHUNK = 128, NITEM = 32 * NCHUNK;
constexpr float EPS = 1e-6f;
constexpr size_t MiB = 1u << 20;
constexpr size_t SEG_ELEMS = (size_t)M * 512;
constexpr size_t WS_CTL = 0, WS_MODP = 1 * MiB, WS_WIN = 2 * MiB, WS_WQ = 14 * MiB, WS_WSC = 18 * MiB, WS_WDN = 19 * MiB, WS_WMIX = 20 * MiB,
                 WS_SK = 22 * MiB, WS_MODF = 22 * MiB + 768 * 1024, WS_GL = 23 * MiB, WS_SU = 23 * MiB + 65536, WS_SV = 23 * MiB + 131072, WS_TU = 24 * MiB, WS_TV = 56 * MiB, WS_P = 88 * MiB, WS_KD = 472 * MiB, WS_END = 504 * MiB;
constexpr int LDS_BYTES = 147456;

#define GAS __attribute__((address_space(1)))
#define LAS __attribute__((address_space(3)))
typedef unsigned short bf16;
typedef unsigned v4u __attribute__((ext_vector_type(4)));
typedef unsigned v2u __attribute__((ext_vector_type(2)));
typedef float f32x4 __attribute__((ext_vector_type(4)));
typedef float f32x16 __attribute__((ext_vector_type(16)));
typedef short bf16x8 __attribute__((ext_vector_type(8)));

typedef float f32x2_t __attribute__((ext_vector_type(2))); typedef __bf16 bf16x2_t __attribute__((ext_vector_type(2)));
__device__ __forceinline__ unsigned pk2(float lo, float hi) { f32x2_t v = {lo, hi}; bf16x2_t b = __builtin_convertvector(v, bf16x2_t); return __builtin_bit_cast(unsigned, b); }
__device__ __forceinline__ unsigned f2bf(float f) { return pk2(f, 0.f) & 0xffffu; }
__device__ __forceinline__ float bflo(unsigned u) { return __uint_as_float(u << 16); }
__device__ __forceinline__ float bfhi(unsigned u) { return __uint_as_float(u & 0xffff0000u); }
__device__ __forceinline__ float bf2f(bf16 h) { return __uint_as_float((unsigned)h << 16); }
__device__ __forceinline__ float sigmoidf_(float x) { return __builtin_amdgcn_rcpf(1.0f + __builtin_amdgcn_exp2f(-1.4426950408889634f * x)); }
__device__ __forceinline__ float wave_sum(float v) {
#pragma unroll
    for (int o = 1; o < 64; o <<= 1) v += __shfl_xor(v, o);
    return v;
}

struct Frame { LAS unsigned char* lds; int tid, lane, wave, G; };
__device__ __forceinline__ const void* karg(int i) {
    const char __attribute__((address_space(4)))* kp = (const char __attribute__((address_space(4)))*)__builtin_amdgcn_kernarg_segment_ptr();
    asm volatile("" : "+s"(i));
    return *(const void* const __attribute__((address_space(4)))*)(kp + 8 * i);
}
__device__ __forceinline__ const float* IN(int i) { return (const float*)karg(i); }
__device__ __forceinline__ float* OUTP() { return (float*)karg(21); }
__device__ __forceinline__ unsigned char* WSP() { return (unsigned char*)karg(22); }
enum { I_X = 0, I_C, I_WADA, I_BADA, I_NPREMIX, I_NPOSTMIX, I_WIN, I_SCCONV, I_DNCONV, I_ALOG, I_DTBIAS, I_OUTNORM, I_WSC, I_WDN, I_WMIX, I_NPREFFN, I_NPOSTFFN, I_WQ, I_SUBK, I_PU, I_PV };
__device__ __forceinline__ bf16* segp(unsigned char* ws, int s) { return (bf16*)(ws + WS_P) + (size_t)s * SEG_ELEMS; }
__device__ __forceinline__ float modv(const float* b_ada, const float* modp, int b, int j) {
    float s = b_ada[j];
#pragma unroll
    for (int k = 0; k < 8; ++k) s += modp[(size_t)(k * 4 + b) * 6144 + j];
    return s;
}

__device__ __forceinline__ void p0_transpose_item(const float* W, int K, int N, int src_col0, bf16* WT, int dst_row0, int kb, int ncols, LAS float* scr, int lane) {
    const int k0 = 64 * kb;
#pragma unroll 8
    for (int i = 0; i < 32; ++i) { const int kk = 2 * i + (lane >> 5); const int n = lane & 31;
        scr[kk * 33 + n] = (n < ncols) ? W[(size_t)(k0 + kk) * N + src_col0 + n] : 0.f; }
    asm volatile("s_waitcnt lgkmcnt(0)" ::: "memory");
    const int c = lane & 7;
#pragma unroll
    for (int j = 0; j < 4; ++j) { const int n = (lane >> 3) + 8 * j; const LAS float* s = scr + (8 * c) * 33 + n;
        v4u o; o.x = pk2(s[0 * 33], s[1 * 33]); o.y = pk2(s[2 * 33], s[3 * 33]); o.z = pk2(s[4 * 33], s[5 * 33]); o.w = pk2(s[6 * 33], s[7 * 33]);
        *(v4u*)(WT + (size_t)(dst_row0 + n) * K + k0 + 8 * c) = o; }
    asm volatile("s_waitcnt lgkmcnt(0)" ::: "memory");
}
__device__ __forceinline__ void p0_transpose(const float* W, int K, int N, int src_col0, int nblk, bf16* WT, int dst_row0, LAS float* scr, int gw, int NGW, int lane) {
    const int kbs = K / 64;
    for (int it = gw; it < nblk * kbs; it += NGW) { const int nb = it / kbs, kb = it % kbs;
        p0_transpose_item(W, K, N, src_col0 + 32 * nb, WT, dst_row0 + 32 * nb, kb, 32, scr, lane); }
}
__device__ __forceinline__ void p0_convert(const float* src, bf16* dst, size_t nchunks8, size_t gtid, size_t gthreads) {
    for (size_t i = gtid; i < nchunks8; i += gthreads) { const f32x4 a = *(const f32x4*)(src + i * 8), b = *(const f32x4*)(src + i * 8 + 4);
        v4u o; o.x = pk2(a[0], a[1]); o.y = pk2(a[2], a[3]); o.z = pk2(b[0], b[1]); o.w = pk2(b[2], b[3]); *(v4u*)(dst + i * 8) = o; }
}
typedef unsigned u32x6 __attribute__((ext_vector_type(6)));
typedef float f32x32 __attribute__((ext_vector_type(32)));
typedef float f32x16v __attribute__((ext_vector_type(16)));
__device__ __forceinline__ void p0_table_fp6(const float* T, unsigned char* T6, float* SC, LAS float* scr, int gw, int NGW, int lane) {
    const int g = lane >> 5, jl = lane & 31;
    for (int pr = gw; pr < 8192; pr += NGW) {
        const f32x4* src = (const f32x4*)(T + (size_t)(2 * pr) * 1024) + lane;
#pragma unroll
        for (int i = 0; i < 8; ++i) { const f32x4 v = src[64 * i]; const int q = lane + 64 * i, row = q >> 8, kk = (q & 255) * 4;
            *(LAS f32x4*)(scr + (row * 32 + (kk >> 5)) * 36 + (kk & 31)) = v; }
        asm volatile("s_waitcnt lgkmcnt(0)" ::: "memory");
        float x[32]; float am = 0.f;
#pragma unroll
        for (int i = 0; i < 8; ++i) { const f32x4 t = *(const LAS f32x4*)(scr + (g * 32 + jl) * 36 + 4 * i); x[4 * i] = t[0]; x[4 * i + 1] = t[1]; x[4 * i + 2] = t[2]; x[4 * i + 3] = t[3];
            am = fmaxf(am, fmaxf(fmaxf(fabsf(t[0]), fabsf(t[1])), fmaxf(fabsf(t[2]), fabsf(t[3])))); }
#pragma unroll
        for (int o = 1; o < 32; o <<= 1) am = fmaxf(am, __shfl_xor(am, o));
        const float sp = 7.5f / fmaxf(am, 1e-30f), inv = am * (1.0f / 7.5f);
        f32x16v a, b;
#pragma unroll
        for (int i = 0; i < 16; ++i) { a[i] = x[i] * sp; b[i] = x[16 + i] * sp; }
        const u32x6 qv = __builtin_amdgcn_cvt_scalef32_2xpk16_fp6_f32(a, b, 1.0f);
        unsigned char* dst = T6 + (size_t)(2 * pr + g) * 768;
        *(v4u*)(dst + 16 * jl) = (v4u){qv[0], qv[1], qv[2], qv[3]}; *(v2u*)(dst + 512 + 8 * jl) = (v2u){qv[4], qv[5]};
        if (jl == 0) SC[2 * pr + g] = inv;
        asm volatile("s_waitcnt lgkmcnt(0)" ::: "memory");
    }
}
__device__ __forceinline__ void phase_prologue(Frame& F) {
    LAS float* scr = (LAS float*)(F.lds + F.wave * 9216);
    const int gw = blockIdx.x * NWAVES + F.wave, NGW = F.G * NWAVES;
    unsigned char* ws = WSP();
    { const float* w_ada = IN(I_WADA); const float* cc = IN(I_C); float* modp = (float*)(ws + WS_MODP);
    for (int it = gw; it < 768; it += NGW) { const int cgi = it % 96, ks = it / 96, n = cgi * 64 + F.lane, k0 = ks * 128;
        float a0 = 0.f, a1 = 0.f, a2 = 0.f, a3 = 0.f;
#pragma unroll 16
        for (int kk = 0; kk < 128; ++kk) { const int k = k0 + kk; const float w = w_ada[(size_t)k * 6144 + n];
            const float c0 = cc[k], c1 = cc[1024 + k], c2 = cc[2048 + k], c3 = cc[3072 + k];
            a0 += c0 * sigmoidf_(c0) * w; a1 += c1 * sigmoidf_(c1) * w; a2 += c2 * sigmoidf_(c2) * w; a3 += c3 * sigmoidf_(c3) * w; }
        modp[(size_t)(ks * 4 + 0) * 6144 + n] = a0; modp[(size_t)(ks * 4 + 1) * 6144 + n] = a1;
        modp[(size_t)(ks * 4 + 2) * 6144 + n] = a2; modp[(size_t)(ks * 4 + 3) * 6144 + n] = a3; } }
    { const float* w_in = IN(I_WIN); bf16* win_t = (bf16*)(ws + WS_WIN);
    p0_transpose(w_in, 1024, 5648, 0, 112, win_t, 0, scr, gw, NGW, F.lane);
    p0_transpose(w_in, 1024, 5648, 3600, 64, win_t, 3584, scr, gw, NGW, F.lane);
    for (int it = gw; it < 16; it += NGW) p0_transpose_item(w_in, 1024, 5648, 3584, win_t, 5632, it, 16, scr, F.lane);
    { const size_t gtid = (size_t)blockIdx.x * NTHR + F.tid, gth = (size_t)F.G * NTHR;
      for (size_t i = gtid; i < (size_t)224 * 128; i += gth) *(v4u*)(win_t + (size_t)5664 * 1024 + i * 8) = (v4u){0u, 0u, 0u, 0u}; } }
    p0_transpose(IN(I_WQ), 1024, 2048, 0, 64, (bf16*)(ws + WS_WQ), 0, scr, gw, NGW, F.lane);
    p0_transpose(IN(I_WSC), 512, 1024, 0, 32, (bf16*)(ws + WS_WSC), 0, scr, gw, NGW, F.lane);
    p0_transpose(IN(I_WDN), 512, 1024, 0, 32, (bf16*)(ws + WS_WDN), 0, scr, gw, NGW, F.lane);
    p0_transpose(IN(I_WMIX), 1024, 1024, 0, 32, (bf16*)(ws + WS_WMIX), 0, scr, gw, NGW, F.lane);
    { const size_t gtid = (size_t)blockIdx.x * NTHR + F.tid, gth = (size_t)F.G * NTHR;
      p0_convert(IN(I_SUBK), (bf16*)(ws + WS_SK), (size_t)16 * 128 * 128 / 8, gtid, gth);
    }
}

__device__ __forceinline__ void phase_h1(Frame& F, bf16* H1) {
    LAS float* gv = (LAS float*)F.lds; LAS float* sv = gv + 1024;
    const float* xin = IN(I_X); const float* npm = IN(I_NPREMIX); const float* b_ada = IN(I_BADA); const float* modp = (const float*)(WSP() + WS_MODP);
    if (blockIdx.x < 24) { float* modf = (float*)(WSP() + WS_MODF);
        for (int k = F.tid; k < 1024; k += NTHR) { const int idx = blockIdx.x * 1024 + k; modf[idx] = modv(b_ada, modp, idx / 6144, idx % 6144); } }
    for (int rb = blockIdx.x; rb < M / 128; rb += F.G) {
        const int row0 = rb * 128, b = row0 / SEQ;
        __syncthreads();
        for (int k = F.tid; k < 1024; k += NTHR) { gv[k] = npm[k] * (1.f + modv(b_ada, modp, b, 1024 + k)); sv[k] = modv(b_ada, modp, b, k); }
        __syncthreads();
        for (int r = 0; r < 16; ++r) { const int row = row0 + F.wave * 16 + r;
            const f32x4* xr = (const f32x4*)(xin + (size_t)row * D) + F.lane;
            f32x4 v[4]; float ss = 0.f;
#pragma unroll
            for (int j = 0; j < 4; ++j) { v[j] = xr[64 * j]; ss += (v[j][0] * v[j][0] + v[j][1] * v[j][1]) + (v[j][2] * v[j][2] + v[j][3] * v[j][3]); }
            const float rstd = rsqrtf(wave_sum(ss) * (1.f / D) + EPS);
            v2u* o8 = (v2u*)(H1 + (size_t)row * D) + F.lane;
#pragma unroll
            for (int j = 0; j < 4; ++j) { const int k = 4 * F.lane + 256 * j; const f32x4 g = *(const LAS f32x4*)(gv + k), s = *(const LAS f32x4*)(sv + k);
                v2u o; o.x = pk2(v[j][0] * rstd * g[0] + s[0], v[j][1] * rstd * g[1] + s[1]); o.y = pk2(v[j][2] * rstd * g[2] + s[2], v[j][3] * rstd * g[3] + s[3]); o8[64 * j] = o; }
        }
    }
}

__device__ __forceinline__ void phase_scprep(Frame& F) {
    unsigned char* ws = WSP(); bf16* sb = segp(ws, 0); const bf16* scc = segp(ws, 1); const bf16* scx = segp(ws, 2); const float* scw = IN(I_SCCONV);
    const int gtid = blockIdx.x * NTHR + F.tid, gth = F.G * NTHR;
    for (int it = gtid; it < (M / 16) * 64; it += gth) {
        const int cgp = it & 63, tb = it >> 6, m0 = tb * 16, c0 = cgp * 8;
        float w0[8], w1[8], w2[8], p2[8], p1[8];
#pragma unroll
        for (int e = 0; e < 8; ++e) { w0[e] = scw[c0 + e]; w1[e] = scw[512 + c0 + e]; w2[e] = scw[1024 + c0 + e]; p2[e] = 0.f; p1[e] = 0.f; }
        if ((m0 % SEQ) != 0) {
#pragma unroll
            for (int q = 0; q < 2; ++q) { const size_t off = (size_t)(m0 - 2 + q) * 512 + c0; const v4u cv = *(const v4u*)(scc + off), xv = *(const v4u*)(scx + off);
                float t[8] = {bflo(cv.x) * bflo(xv.x), bfhi(cv.x) * bfhi(xv.x), bflo(cv.y) * bflo(xv.y), bfhi(cv.y) * bfhi(xv.y), bflo(cv.z) * bflo(xv.z), bfhi(cv.z) * bfhi(xv.z), bflo(cv.w) * bflo(xv.w), bfhi(cv.w) * bfhi(xv.w)};
#pragma unroll
                for (int e = 0; e < 8; ++e) { if (q == 0) p2[e] = t[e]; else p1[e] = t[e]; } }
        }
        for (int t = 0; t < 16; ++t) { const size_t off = (size_t)(m0 + t) * 512 + c0;
            const v4u cv = *(const v4u*)(scc + off), xv = *(const v4u*)(scx + off), bv = *(const v4u*)(sb + off);
            float cur[8] = {bflo(cv.x) * bflo(xv.x), bfhi(cv.x) * bfhi(xv.x), bflo(cv.y) * bflo(xv.y), bfhi(cv.y) * bfhi(xv.y), bflo(cv.z) * bflo(xv.z), bfhi(cv.z) * bfhi(xv.z), bflo(cv.w) * bflo(xv.w), bfhi(cv.w) * bfhi(xv.w)};
            float bb[8] = {bflo(bv.x), bfhi(bv.x), bflo(bv.y), bfhi(bv.y), bflo(bv.z), bfhi(bv.z), bflo(bv.w), bfhi(bv.w)};
            float o[8];
#pragma unroll
            for (int e = 0; e < 8; ++e) { o[e] = bb[e] * (w0[e] * p2[e] + w1[e] * p1[e] + w2[e] * cur[e]); p2[e] = p1[e]; p1[e] = cur[e]; }
            v4u ov; ov.x = pk2(o[0], o[1]); ov.y = pk2(o[2], o[3]); ov.z = pk2(o[4], o[5]); ov.w = pk2(o[6], o[7]);
            *(v4u*)(sb + off) = ov; }
    }
}

__device__ __forceinline__ int fragoff(int row, int col) { const int jj = col & 31; return ((row >> 4) * 2 + (col >> 5)) * 512 + ((((jj & 15) >> 2) * 16 + (row & 15)) * 8) + (jj & 3) + 4 * (jj >> 4); }
#define MM4(dst, aptr, X) do { const f32x4 av_ = *(const LAS f32x4*)(aptr); \
    dst = __builtin_amdgcn_mfma_f32_16x16x4f32(av_[0], (X)[0], dst, 0, 0, 0); dst = __builtin_amdgcn_mfma_f32_16x16x4f32(av_[1], (X)[1], dst, 0, 0, 0); \
    dst = __builtin_amdgcn_mfma_f32_16x16x4f32(av_[2], (X)[2], dst, 0, 0, 0); dst = __builtin_amdgcn_mfma_f32_16x16x4f32(av_[3], (X)[3], dst, 0, 0, 0); } while (0)
__device__ __forceinline__ void phase_dnprep(Frame& F, bf16* Wn, bf16* U, bf16* QG, bf16* A, bf16* KD) {
    LAS unsigned char* L = F.lds;
    LAS bf16* raw = (LAS bf16*)L;
    LAS bf16* stg2 = (LAS bf16*)L;
    LAS float* qc = (LAS float*)(L + 32768);
    LAS float* kc = (LAS float*)(L + 32768 + 17408);
    LAS float* vc = (LAS float*)(L + 32768 + 2 * 17408);
    LAS bf16* kh = (LAS bf16*)(L + 84992);
    LAS bf16* qh = (LAS bf16*)(L + 94208);
    LAS float* Ln = (LAS float*)(L + 103424);
    LAS float* Tm = (LAS float*)(L + 120832);
    LAS float* sG = (LAS float*)(L + 124928);
    LAS float* sBeta = sG + 64; LAS float* sEG = sG + 128; LAS float* sEd = sG + 192;
    LAS float* cwl = (LAS float*)(L + 125952);
    LAS bf16* stg = (LAS bf16*)(L + 129024);
    const int tid = F.tid, lane = F.lane, wave = F.wave;
    unsigned char* ws = WSP(); const bf16* segq = segp(ws, 3); const bf16* segab = segp(ws, 11); float* glp = (float*)(ws + WS_GL);
    const float* cw = IN(I_DNCONV); const float* alog = IN(I_ALOG); const float* dtb = IN(I_DTBIAS);
    for (int it = blockIdx.x; it < NITEM; it += F.G) {
        const int bh = it >> 7, n = it & 127, b = bh >> 3, h = bh & 7, m0 = b * SEQ + n * 64;
        __syncthreads();
        for (int ci = tid; ci < 1608; ci += NTHR) { const int s = ci / 536, rem = ci % 536, r = rem >> 3, c8 = rem & 7;
            v4u v = (v4u){0u, 0u, 0u, 0u};
            if (n * 64 - 3 + r >= 0) v = *(const v4u*)(segq + (size_t)s * SEG_ELEMS + (size_t)(m0 - 3 + r) * 512 + h * 64 + c8 * 8);
            *(LAS v4u*)(raw + (s * 67 + r) * 64 + c8 * 8) = v; }
        for (int ci = tid; ci < 768; ci += NTHR) { const int s = ci >> 8, k = (ci >> 6) & 3, c = ci & 63; cwl[ci] = cw[k * 1536 + s * 512 + h * 64 + c]; }
        __syncthreads();
        for (int wu = tid; wu < 3072; wu += NTHR) { const int c4 = wu & 15, t = (wu >> 4) & 63, s = wu >> 10;
            f32x4 acc = (f32x4){0.f, 0.f, 0.f, 0.f};
#pragma unroll
            for (int k = 0; k < 4; ++k) { const f32x4 w = *(const LAS f32x4*)(cwl + (s * 4 + k) * 64 + 4 * c4); const v2u r = *(const LAS v2u*)(raw + (s * 67 + t + k) * 64 + 4 * c4);
                acc[0] += w[0] * bflo(r.x); acc[1] += w[1] * bfhi(r.x); acc[2] += w[2] * bflo(r.y); acc[3] += w[3] * bfhi(r.y); }
#pragma unroll
            for (int e = 0; e < 4; ++e) acc[e] = acc[e] * sigmoidf_(acc[e]);
            *(LAS f32x4*)((s == 0 ? qc : (s == 1 ? kc : vc)) + t * 68 + 4 * c4) = acc; }
        __syncthreads();
        if (wave == 0) {
            const float av = bf2f(segab[(size_t)(m0 + lane) * 512 + h]) + dtb[h], bv = bf2f(segab[(size_t)(m0 + lane) * 512 + 8 + h]);
            const float sp = (av > 20.f) ? av : log1pf(__expf(av));
            float g = -__expf(alog[h]) * sp;
#pragma unroll
            for (int o = 1; o < 64; o <<= 1) { const float t = __shfl_up(g, o); if (lane >= o) g += t; }
            const float g63 = __shfl(g, 63);
            sG[lane] = g; sBeta[lane] = sigmoidf_(bv); sEG[lane] = __expf(g); sEd[lane] = __expf(g63 - g);
            if (lane == 63) glp[it] = __expf(g);
        }
        { const int t = tid >> 3, p = tid & 7;
          f32x4 q0 = *(const LAS f32x4*)(qc + t * 68 + 8 * p), q1 = *(const LAS f32x4*)(qc + t * 68 + 8 * p + 4), k0 = *(const LAS f32x4*)(kc + t * 68 + 8 * p), k1 = *(const LAS f32x4*)(kc + t * 68 + 8 * p + 4);
          float sq = (q0[0] * q0[0] + q0[1] * q0[1]) + (q0[2] * q0[2] + q0[3] * q0[3]) + (q1[0] * q1[0] + q1[1] * q1[1]) + (q1[2] * q1[2] + q1[3] * q1[3]);
          float sk = (k0[0] * k0[0] + k0[1] * k0[1]) + (k0[2] * k0[2] + k0[3] * k0[3]) + (k1[0] * k1[0] + k1[1] * k1[1]) + (k1[2] * k1[2] + k1[3] * k1[3]);
          sq += __shfl_xor(sq, 1); sq += __shfl_xor(sq, 2); sq += __shfl_xor(sq, 4); sk += __shfl_xor(sk, 1); sk += __shfl_xor(sk, 2); sk += __shfl_xor(sk, 4);
          const float rq = rsqrtf(sq + EPS) * 0.125f, rk = rsqrtf(sk + EPS);
          q0 = q0 * rq; q1 = q1 * rq; k0 = k0 * rk; k1 = k1 * rk;
          *(LAS f32x4*)(qc + t * 68 + 8 * p) = q0; *(LAS f32x4*)(qc + t * 68 + 8 * p + 4) = q1; *(LAS f32x4*)(kc + t * 68 + 8 * p) = k0; *(LAS f32x4*)(kc + t * 68 + 8 * p + 4) = k1;
          v4u qb, kb; qb.x = pk2(q0[0], q0[1]); qb.y = pk2(q0[2], q0[3]); qb.z = pk2(q1[0], q1[1]); qb.w = pk2(q1[2], q1[3]);
          kb.x = pk2(k0[0], k0[1]); kb.y = pk2(k0[2], k0[3]); kb.z = pk2(k1[0], k1[1]); kb.w = pk2(k1[2], k1[3]);
          *(LAS v4u*)(qh + t * 72 + 8 * p) = qb; *(LAS v4u*)(kh + t * 72 + 8 * p) = kb; }
        __syncthreads();
        {
            const int fr = lane & 15, g4 = lane >> 4;
#pragma unroll
            for (int x = 0; x < 2; ++x) { const int tile = 2 * wave + x, ti = tile >> 2, tj = tile & 3;
                f32x4 ckk = (f32x4){0.f, 0.f, 0.f, 0.f}, cqk = (f32x4){0.f, 0.f, 0.f, 0.f};
#pragma unroll
                for (int ks = 0; ks < 2; ++ks) {
                    const bf16x8 ak = *(const LAS bf16x8*)(kh + (16 * ti + fr) * 72 + 32 * ks + 8 * g4);
                    const bf16x8 aq = *(const LAS bf16x8*)(qh + (16 * ti + fr) * 72 + 32 * ks + 8 * g4);
                    const bf16x8 bk = *(const LAS bf16x8*)(kh + (16 * tj + fr) * 72 + 32 * ks + 8 * g4);
                    ckk = __builtin_amdgcn_mfma_f32_16x16x32_bf16(ak, bk, ckk, 0, 0, 0);
                    cqk = __builtin_amdgcn_mfma_f32_16x16x32_bf16(aq, bk, cqk, 0, 0, 0); }
                const int j = 16 * tj + fr; const float gj = sG[j];
#pragma unroll
                for (int r = 0; r < 4; ++r) { const int i = 16 * ti + 4 * g4 + r;
                    const float dec = __expf(fminf(sG[i] - gj, 0.f));
                    Ln[i * 68 + j] = (j < i) ? -(sBeta[i] * ckk[r] * dec) : 0.f;
                    stg[fragoff(i, j)] = (bf16)f2bf((j <= i) ? cqk[r] * dec : 0.f); }
            }
        }
        __syncthreads();
        if (wave == 0) {
            const int bb = lane >> 4, c = lane & 15; float t[16];
#pragma unroll
            for (int i = 0; i < 16; ++i) { float acc = (i == c) ? 1.f : 0.f;
#pragma unroll
                for (int j = 0; j < i; ++j) acc += Ln[(16 * bb + i) * 68 + 16 * bb + j] * t[j];
                t[i] = acc; Tm[(bb * 16 + i) * 16 + c] = acc; }
        } else {
            for (int ct = tid - 64; ct < 1536; ct += NTHR - 64) { const int kind = ct >> 9, idx = ct & 511; const size_t ob = (size_t)it * 4096 + (size_t)idx * 8;
                if (kind == 0) { *(v4u*)(A + ob) = *(const LAS v4u*)(stg + idx * 8); }
                else if (kind == 1) { const int i = idx >> 3, k0 = (idx & 7) * 8; const float e = sEG[i]; const f32x4 a = *(const LAS f32x4*)(qc + i * 68 + k0), c = *(const LAS f32x4*)(qc + i * 68 + k0 + 4);
                    *(v2u*)(QG + (size_t)it * 4096 + fragoff(i, k0)) = (v2u){pk2(a[0] * e, a[1] * e), pk2(a[2] * e, a[3] * e)};
                    *(v2u*)(QG + (size_t)it * 4096 + fragoff(i, k0 + 4)) = (v2u){pk2(c[0] * e, c[1] * e), pk2(c[2] * e, c[3] * e)}; }
                else { const int kk = idx >> 3, c0 = (idx & 7) * 8;
                    v2u p0, p1; p0.x = pk2(kc[(c0 + 0) * 68 + kk] * sEd[c0 + 0], kc[(c0 + 1) * 68 + kk] * sEd[c0 + 1]); p0.y = pk2(kc[(c0 + 2) * 68 + kk] * sEd[c0 + 2], kc[(c0 + 3) * 68 + kk] * sEd[c0 + 3]);
                    p1.x = pk2(kc[(c0 + 4) * 68 + kk] * sEd[c0 + 4], kc[(c0 + 5) * 68 + kk] * sEd[c0 + 5]); p1.y = pk2(kc[(c0 + 6) * 68 + kk] * sEd[c0 + 6], kc[(c0 + 7) * 68 + kk] * sEd[c0 + 7]);
                    *(v2u*)(KD + (size_t)it * 4096 + fragoff(kk, c0)) = p0; *(v2u*)(KD + (size_t)it * 4096 + fragoff(kk, c0 + 4)) = p1; } }
        }
        __syncthreads();
        {
            const int nn = lane & 15, g4 = lane >> 4; const LAS float* src = (wave < 4) ? vc : kc; const int cc = 16 * (wave & 3) + nn;
            f32x4 R[4];
#pragma unroll
            for (int bb = 0; bb < 4; ++bb)
#pragma unroll
                for (int r = 0; r < 4; ++r) { const int i = 16 * bb + 4 * g4 + r; float v = src[i * 68 + cc] * sBeta[i]; if (wave >= 4) v *= sEG[i]; R[bb][r] = v; }
            const f32x4 Z4 = (f32x4){0.f, 0.f, 0.f, 0.f};
            f32x4 X0 = Z4, X1 = Z4, X2 = Z4, X3 = Z4;
            MM4(X0, Tm + (0 * 16 + nn) * 16 + 4 * g4, R[0]);
            MM4(R[1], Ln + (16 + nn) * 68 + 0 + 4 * g4, X0);
            MM4(X1, Tm + (1 * 16 + nn) * 16 + 4 * g4, R[1]);
            MM4(R[2], Ln + (32 + nn) * 68 + 0 + 4 * g4, X0); MM4(R[2], Ln + (32 + nn) * 68 + 16 + 4 * g4, X1);
            MM4(X2, Tm + (2 * 16 + nn) * 16 + 4 * g4, R[2]);
            MM4(R[3], Ln + (48 + nn) * 68 + 0 + 4 * g4, X0); MM4(R[3], Ln + (48 + nn) * 68 + 16 + 4 * g4, X1); MM4(R[3], Ln + (48 + nn) * 68 + 32 + 4 * g4, X2);
            MM4(X3, Tm + (3 * 16 + nn) * 16 + 4 * g4, R[3]);
            if (wave < 4) {
                LAS bf16* up = stg2 + (wave * 2) * 512 + (g4 * 16 + nn) * 8;
                *(LAS v4u*)(up) = (v4u){pk2(X0[0], X0[1]), pk2(X0[2], X0[3]), pk2(X1[0], X1[1]), pk2(X1[2], X1[3])};
                *(LAS v4u*)(up + 512) = (v4u){pk2(X2[0], X2[1]), pk2(X2[2], X2[3]), pk2(X3[0], X3[1]), pk2(X3[2], X3[3])};
            } else {
                LAS bf16* wp = stg2 + 4096; const int k = 16 * (wave - 4) + nn;
#pragma unroll
                for (int r = 0; r < 4; ++r) { const int i = 4 * g4 + r;
                    wp[fragoff(i, k)] = (bf16)f2bf(-X0[r]); wp[fragoff(16 + i, k)] = (bf16)f2bf(-X1[r]); wp[fragoff(32 + i, k)] = (bf16)f2bf(-X2[r]); wp[fragoff(48 + i, k)] = (bf16)f2bf(-X3[r]); }
            }
        }
        __syncthreads();
        { const v4u vu = *(const LAS v4u*)(stg2 + tid * 8), vw = *(const LAS v4u*)(stg2 + 4096 + tid * 8);
          *(v4u*)(U + (size_t)it * 4096 + tid * 8) = vu; *(v4u*)(Wn + (size_t)it * 4096 + tid * 8) = vw; }
    }
}
#undef MM4

__device__ __forceinline__ bf16x8 pack_b(const f32x4& t0, const f32x4& t1) { v4u w; w.x = pk2(t0[0], t0[1]); w.y = pk2(t0[2], t0[3]); w.z = pk2(t1[0], t1[1]); w.w = pk2(t1[2], t1[3]); return __builtin_bit_cast(bf16x8, w); }
__device__ __forceinline__ bf16x8 afrag(const LAS bf16* base, int row, int ks, int g4) {
    const v2u lo = *(const LAS v2u*)(base + row * 72 + 32 * ks + 4 * g4), hi = *(const LAS v2u*)(base + row * 72 + 32 * ks + 16 + 4 * g4);
    v4u w; w.x = lo.x; w.y = lo.y; w.z = hi.x; w.w = hi.y; return __builtin_bit_cast(bf16x8, w); }
#define SCAN_BAR() do { asm volatile("s_waitcnt lgkmcnt(0)" ::: "memory"); __builtin_amdgcn_s_barrier(); asm volatile("" ::: "memory"); } while (0)
__device__ __forceinline__ void phase_scan(Frame& F, const bf16* Wn, const bf16* U, const bf16* QG, const bf16* A, const bf16* KD, bf16* OT) {
    if (blockIdx.x >= 32) return;
    LAS unsigned char* L = F.lds; const float* glp = (const float*)(WSP() + WS_GL);
    const int bh = blockIdx.x, tid = F.tid, lane = F.lane, wave = F.wave;
    const int nn = lane & 15, g4 = lane >> 4;
#define OPB(buf, mat) ((LAS bf16*)(L + (buf) * 40960 + (mat) * 8192))
#define OST(buf) ((LAS bf16*)(L + 81920 + (buf) * 8192))
#define FRAG(base, ct, ks) (*(const LAS bf16x8*)((base) + ((ct) * 2 + (ks)) * 512 + lane * 8))
    LAS float* gll = (LAS float*)(L + 98304);
    if (tid < NCHUNK) gll[tid] = glp[bh * NCHUNK + tid];
    if (wave >= 4) {
        const int ht = tid - 256;
        const unsigned eo0 = (unsigned)(bh * NCHUNK) * 4096u + (unsigned)ht * 8u;
        const int lo0 = ht * 8, lo1 = lo0 + 2048;
        v4u ra[10], rb[10];
#define HLOAD(R, st) do { const unsigned o_ = eo0 + (unsigned)(st) * 4096u; R[0] = *(const v4u*)(Wn + o_); R[1] = *(const v4u*)(Wn + o_ + 2048); R[2] = *(const v4u*)(U + o_); R[3] = *(const v4u*)(U + o_ + 2048); \
        R[4] = *(const v4u*)(QG + o_); R[5] = *(const v4u*)(QG + o_ + 2048); R[6] = *(const v4u*)(A + o_); R[7] = *(const v4u*)(A + o_ + 2048); R[8] = *(const v4u*)(KD + o_); R[9] = *(const v4u*)(KD + o_ + 2048); } while (0)
#define HSTORE(R, buf) do { _Pragma("unroll") for (int mt_ = 0; mt_ < 5; ++mt_) { *(LAS v4u*)(OPB(buf, mt_) + lo0) = R[2 * mt_]; *(LAS v4u*)(OPB(buf, mt_) + lo1) = R[2 * mt_ + 1]; } } while (0)
#define OUT_STAGE(par, st) do { const v4u o0_ = *(const LAS v4u*)(OST(par) + lo0), o1_ = *(const LAS v4u*)(OST(par) + lo1); const unsigned oo_ = eo0 + (unsigned)(st) * 4096u; \
        *(v4u*)(OT + oo_) = o0_; *(v4u*)(OT + oo_ + 2048) = o1_; } while (0)
#define SB() __builtin_amdgcn_sched_barrier(0)
        HLOAD(ra, 0); HSTORE(ra, 0); HLOAD(ra, 1); HLOAD(rb, 2);
        SCAN_BAR();
        HSTORE(ra, 1); HLOAD(ra, 3);
        SCAN_BAR();
#pragma unroll 1
        for (int n = 1; n < NCHUNK - 1; n += 2) {
            const int l3 = (n + 3 < NCHUNK) ? n + 3 : NCHUNK - 1, l4 = (n + 4 < NCHUNK) ? n + 4 : NCHUNK - 1;
            HSTORE(rb, 0); SB(); HLOAD(rb, l3); SB(); OUT_STAGE(0, n - 1); SB();
            SCAN_BAR();
            HSTORE(ra, 1); SB(); HLOAD(ra, l4); SB(); OUT_STAGE(1, n); SB();
            SCAN_BAR();
        }
        OUT_STAGE(0, NCHUNK - 2);
        SCAN_BAR();
        OUT_STAGE(1, NCHUNK - 1);
#undef HLOAD
#undef HSTORE
#undef OUT_STAGE
#undef SB
    } else {
        const int cs = wave;
        f32x4 S[4];
#pragma unroll
        for (int t = 0; t < 4; ++t) S[t] = (f32x4){0.f, 0.f, 0.f, 0.f};
        SCAN_BAR();
#pragma unroll 1
        for (int n = 0; n < NCHUNK; ++n) {
            const int buf = n & 1; const float glast = gll[n];
            bf16x8 fw[4][2], fq[4][2];
            const v4u u01 = *(const LAS v4u*)(OPB(buf, 1) + (cs * 2 + 0) * 512 + lane * 8), u23 = *(const LAS v4u*)(OPB(buf, 1) + (cs * 2 + 1) * 512 + lane * 8);
#pragma unroll
            for (int ct = 0; ct < 4; ++ct) { fw[ct][0] = FRAG(OPB(buf, 0), ct, 0); fw[ct][1] = FRAG(OPB(buf, 0), ct, 1); fq[ct][0] = FRAG(OPB(buf, 2), ct, 0); fq[ct][1] = FRAG(OPB(buf, 2), ct, 1); }
            const bf16x8 sb0 = pack_b(S[0], S[1]), sb1 = pack_b(S[2], S[3]);
            f32x4 vn[4], oa[4];
            vn[0] = (f32x4){bflo(u01.x), bfhi(u01.x), bflo(u01.y), bfhi(u01.y)}; vn[1] = (f32x4){bflo(u01.z), bfhi(u01.z), bflo(u01.w), bfhi(u01.w)};
            vn[2] = (f32x4){bflo(u23.x), bfhi(u23.x), bflo(u23.y), bfhi(u23.y)}; vn[3] = (f32x4){bflo(u23.z), bfhi(u23.z), bflo(u23.w), bfhi(u23.w)};
#pragma unroll
            for (int ct = 0; ct < 4; ++ct) {
                f32x4 av = vn[ct], ao = (f32x4){0.f, 0.f, 0.f, 0.f};
                av = __builtin_amdgcn_mfma_f32_16x16x32_bf16(fw[ct][0], sb0, av, 0, 0, 0);
                ao = __builtin_amdgcn_mfma_f32_16x16x32_bf16(fq[ct][0], sb0, ao, 0, 0, 0);
                av = __builtin_amdgcn_mfma_f32_16x16x32_bf16(fw[ct][1], sb1, av, 0, 0, 0);
                ao = __builtin_amdgcn_mfma_f32_16x16x32_bf16(fq[ct][1], sb1, ao, 0, 0, 0);
                vn[ct] = av; oa[ct] = ao; }
            bf16x8 fa[4][2], fk[4][2];
#pragma unroll
            for (int ct = 0; ct < 4; ++ct) { fa[ct][0] = FRAG(OPB(buf, 3), ct, 0); fa[ct][1] = FRAG(OPB(buf, 3), ct, 1); fk[ct][0] = FRAG(OPB(buf, 4), ct, 0); fk[ct][1] = FRAG(OPB(buf, 4), ct, 1); }
            const bf16x8 vb0 = pack_b(vn[0], vn[1]), vb1 = pack_b(vn[2], vn[3]);
#pragma unroll
            for (int ct = 0; ct < 4; ++ct) {
                f32x4 ao = oa[ct], as = S[ct] * glast;
                as = __builtin_amdgcn_mfma_f32_16x16x32_bf16(fk[ct][0], vb0, as, 0, 0, 0);
                ao = __builtin_amdgcn_mfma_f32_16x16x32_bf16(fa[ct][0], vb0, ao, 0, 0, 0);
                as = __builtin_amdgcn_mfma_f32_16x16x32_bf16(fk[ct][1], vb1, as, 0, 0, 0);
                ao = __builtin_amdgcn_mfma_f32_16x16x32_bf16(fa[ct][1], vb1, ao, 0, 0, 0);
                S[ct] = as; oa[ct] = ao; }
            *(LAS v4u*)(OST(buf) + (cs * 2 + 0) * 512 + lane * 8) = (v4u){pk2(oa[0][0], oa[0][1]), pk2(oa[0][2], oa[0][3]), pk2(oa[1][0], oa[1][1]), pk2(oa[1][2], oa[1][3])};
            *(LAS v4u*)(OST(buf) + (cs * 2 + 1) * 512 + lane * 8) = (v4u){pk2(oa[2][0], oa[2][1]), pk2(oa[2][2], oa[2][3]), pk2(oa[3][0], oa[3][1]), pk2(oa[3][2], oa[3][3])};
            SCAN_BAR();
        }
    }
#undef OPB
#undef OST
#undef FRAG
}
#undef SCAN_BAR

__device__ __forceinline__ void phase_og(Frame& F, const bf16* OT, const bf16* Z, bf16* OG) {
    const float* onw = IN(I_OUTNORM);
    const int half = F.tid >> 8, ht = F.tid & 255, c = ht >> 2, p = ht & 3;
    LAS bf16* tile = (LAS bf16*)(F.lds + half * 8192);
    for (int it0 = blockIdx.x * 2; it0 < NITEM; it0 += F.G * 2) {
        const int it = it0 + half, bh = it >> 7, n = it & 127, b = bh >> 3, h = bh & 7, m0 = b * SEQ + n * 64;
        __syncthreads();
        { const v4u a0 = *(const v4u*)(OT + (size_t)it * 4096 + ht * 8), a1 = *(const v4u*)(OT + (size_t)it * 4096 + 2048 + ht * 8);
          *(LAS v4u*)(tile + ht * 8) = a0; *(LAS v4u*)(tile + 2048 + ht * 8) = a1; }
        const size_t zo = (size_t)(m0 + c) * 512 + h * 64 + 16 * p;
        const v4u z0 = *(const v4u*)(Z + zo), z1 = *(const v4u*)(Z + zo + 8);
        __syncthreads();
        float ov[16]; float ss = 0.f;
#pragma unroll
        for (int e = 0; e < 16; ++e) { ov[e] = bf2f(tile[fragoff(16 * p + e, c)]); ss += ov[e] * ov[e]; }
        ss += __shfl_xor(ss, 1); ss += __shfl_xor(ss, 2);
        const float rs = rsqrtf(ss * (1.f / 64.f) + EPS);
        const float zv[16] = {bflo(z0.x), bfhi(z0.x), bflo(z0.y), bfhi(z0.y), bflo(z0.z), bfhi(z0.z), bflo(z0.w), bfhi(z0.w), bflo(z1.x), bfhi(z1.x), bflo(z1.y), bfhi(z1.y), bflo(z1.z), bfhi(z1.z), bflo(z1.w), bfhi(z1.w)};
        float rr[16];
#pragma unroll
        for (int e = 0; e < 16; ++e) rr[e] = ov[e] * rs * onw[16 * p + e] * (zv[e] * sigmoidf_(zv[e]));
        v4u w0, w1; w0.x = pk2(rr[0], rr[1]); w0.y = pk2(rr[2], rr[3]); w0.z = pk2(rr[4], rr[5]); w0.w = pk2(rr[6], rr[7]); w1.x = pk2(rr[8], rr[9]); w1.y = pk2(rr[10], rr[11]); w1.z = pk2(rr[12], rr[13]); w1.w = pk2(rr[14], rr[15]);
        *(v4u*)(OG + zo) = w0; *(v4u*)(OG + zo + 8) = w1;
    }
}

__device__ __forceinline__ void phase_x1h2(Frame& F, const bf16* Y, bf16* H2) {
    LAS float* a1 = (LAS float*)F.lds; LAS float* g2 = a1 + 1024; LAS float* s2 = g2 + 1024;
    const float* xin = IN(I_X); const float* npost = IN(I_NPOSTMIX); const float* npre = IN(I_NPREFFN); const float* modf = (const float*)(WSP() + WS_MODF); float* outp = OUTP();
    for (int rb = blockIdx.x; rb < M / 128; rb += F.G) {
        const int row0 = rb * 128, b = row0 / SEQ;
        __syncthreads();
        for (int k = F.tid; k < 1024; k += NTHR) { a1[k] = modf[b * 6144 + 2048 + k] * npost[k]; g2[k] = npre[k] * (1.f + modf[b * 6144 + 4096 + k]); s2[k] = modf[b * 6144 + 3072 + k]; }
        __syncthreads();
        for (int r = 0; r < 16; ++r) { const int row = row0 + F.wave * 16 + r;
            const v2u* yr = (const v2u*)(Y + (size_t)row * D) + F.lane; const f32x4* xr = (const f32x4*)(xin + (size_t)row * D) + F.lane;
            f32x4 y[4], xv[4]; float ss = 0.f;
#pragma unroll
            for (int j = 0; j < 4; ++j) { const v2u t = yr[64 * j]; y[j] = (f32x4){bflo(t.x), bfhi(t.x), bflo(t.y), bfhi(t.y)}; xv[j] = xr[64 * j];
                ss += (y[j][0] * y[j][0] + y[j][1] * y[j][1]) + (y[j][2] * y[j][2] + y[j][3] * y[j][3]); }
            const float rstd = rsqrtf(wave_sum(ss) * (1.f / D) + EPS); float s1 = 0.f;
            f32x4* orow = (f32x4*)(outp + (size_t)row * D) + F.lane;
#pragma unroll
            for (int j = 0; j < 4; ++j) { const int k = 4 * F.lane + 256 * j; const f32x4 a = *(const LAS f32x4*)(a1 + k);
                xv[j] = xv[j] + a * (y[j] * rstd); orow[64 * j] = xv[j];
                s1 += (xv[j][0] * xv[j][0] + xv[j][1] * xv[j][1]) + (xv[j][2] * xv[j][2] + xv[j][3] * xv[j][3]); }
            const float rstd1 = rsqrtf(wave_sum(s1) * (1.f / D) + EPS);
            v2u* o8 = (v2u*)(H2 + (size_t)row * D) + F.lane;
#pragma unroll
            for (int j = 0; j < 4; ++j) { const int k = 4 * F.lane + 256 * j; const f32x4 g = *(const LAS f32x4*)(g2 + k), s = *(const LAS f32x4*)(s2 + k);
                v2u o; o.x = pk2(xv[j][0] * rstd1 * g[0] + s[0], xv[j][1] * rstd1 * g[1] + s[1]); o.y = pk2(xv[j][2] * rstd1 * g[2] + s[2], xv[j][3] * rstd1 * g[3] + s[3]); o8[64 * j] = o; }
        }
    }
}

__device__ __forceinline__ unsigned mono(float f) { const unsigned u = __float_as_uint(f); return u ^ ((unsigned)((int)u >> 31) | 0x80000000u); }
__device__ __forceinline__ float unmono(unsigned k) { return __uint_as_float((k & 0x80000000u) ? (k ^ 0x80000000u) : ~k); }
#define CE_DESC(a, b) do { const unsigned _mx = max((a), (b)), _mn = min((a), (b)); (a) = _mx; (b) = _mn; } while (0)
__device__ __forceinline__ void top16_of_64(unsigned (&x)[64]) {
#pragma unroll
    for (int g = 0; g < 4; ++g)
#pragma unroll
        for (int k = 2; k <= 16; k <<= 1)
#pragma unroll
            for (int j = k >> 1; j > 0; j >>= 1)
#pragma unroll
                for (int i = 0; i < 16; ++i) { const int l = i ^ j; if (l > i) { if ((i & k) == 0) CE_DESC(x[16 * g + i], x[16 * g + l]); else CE_DESC(x[16 * g + l], x[16 * g + i]); } }
#pragma unroll
    for (int s = 0; s < 3; ++s) { const int a = (s == 1) ? 32 : 0, b2 = (s == 0) ? 16 : (s == 1 ? 48 : 32);
#pragma unroll
        for (int i = 0; i < 16; ++i) x[a + i] = max(x[a + i], x[b2 + 15 - i]);
#pragma unroll
        for (int j = 8; j > 0; j >>= 1)
#pragma unroll
            for (int i = 0; i < 16; ++i) { const int l = i ^ j; if (l > i) CE_DESC(x[a + i], x[a + l]); } }
}
__device__ __forceinline__ void phase_topk(Frame& F, const bf16* Q2, int* EI, float* GA) {
    const int lane = F.lane, wave = F.wave, r = lane & 31, hh = lane >> 5, tsub = wave & 3, hgrp = wave >> 2;
    const bf16* skp = (const bf16*)(WSP() + WS_SK);
    LAS unsigned char* itab = F.lds + wave * 1024;
    for (int tile = blockIdx.x; tile < M / 128; tile += F.G) {
        const int m = tile * 128 + tsub * 32 + r;
#pragma unroll 1
        for (int hd = 0; hd < 4; ++hd) { const int h = hgrp * 4 + hd;
            unsigned k12[2][16];
#pragma unroll
            for (int p = 0; p < 2; ++p) {
                bf16x8 bq[8];
#pragma unroll
                for (int ks = 0; ks < 8; ++ks) bq[ks] = *(const bf16x8*)(Q2 + (size_t)m * 2048 + h * 256 + p * 128 + ks * 16 + hh * 8);
                unsigned keys[64];
#pragma unroll
                for (int kt = 0; kt < 4; ++kt) {
                    f32x16 acc;
#pragma unroll
                    for (int i = 0; i < 16; ++i) acc[i] = 0.f;
                    const bf16* skr = skp + ((size_t)(h * 2 + p) * 128 + kt * 32 + r) * 128 + hh * 8;
#pragma unroll
                    for (int ks = 0; ks < 8; ++ks) { const bf16x8 a = *(const bf16x8*)(skr + ks * 16); acc = __builtin_amdgcn_mfma_f32_32x32x16_bf16(a, bq[ks], acc, 0, 0, 0); }
#pragma unroll
                    for (int i = 0; i < 16; ++i) { const int keyidx = kt * 32 + (i & 3) + 8 * (i >> 2) + 4 * hh; keys[kt * 16 + i] = (mono(acc[i]) & ~127u) | (unsigned)(127 - keyidx); }
                }
                top16_of_64(keys);
                unsigned oth[16];
#pragma unroll
                for (int i = 0; i < 16; ++i) oth[i] = (unsigned)__shfl_xor((int)keys[i], 32);
#pragma unroll
                for (int i = 0; i < 16; ++i) keys[i] = max(keys[i], oth[15 - i]);
#pragma unroll
                for (int j = 8; j > 0; j >>= 1)
#pragma unroll
                    for (int i = 0; i < 16; ++i) { const int l = i ^ j; if (l > i) CE_DESC(keys[i], keys[l]); }
#pragma unroll
                for (int i = 0; i < 16; ++i) k12[p][i] = keys[i];
            }
            float v1[16], v2[16];
#pragma unroll
            for (int i = 0; i < 16; ++i) { v1[i] = unmono(k12[0][i] & ~127u); v2[i] = unmono(k12[1][i] & ~127u); }
            if (hh == 0) {
                v4u w0, w1;
#define PK4(K, b) ((127u - ((K)[b] & 127u)) | ((127u - ((K)[b + 1] & 127u)) << 8) | ((127u - ((K)[b + 2] & 127u)) << 16) | ((127u - ((K)[b + 3] & 127u)) << 24))
                w0.x = PK4(k12[0], 0); w0.y = PK4(k12[0], 4); w0.z = PK4(k12[0], 8); w0.w = PK4(k12[0], 12);
                w1.x = PK4(k12[1], 0); w1.y = PK4(k12[1], 4); w1.z = PK4(k12[1], 8); w1.w = PK4(k12[1], 12);
#undef PK4
                *(LAS v4u*)(itab + r * 32) = w0; *(LAS v4u*)(itab + r * 32 + 16) = w1; }
            unsigned ck[64];
            { int nn = 0;
#pragma unroll
              for (int i = 0; i < 16; ++i)
#pragma unroll
                  for (int j = 0; j < 16; ++j) if ((i + 1) * (j + 1) <= 16) { ck[nn] = (mono(v1[i] + v2[j]) & ~255u) | (unsigned)(255 - (i * 16 + j)); ++nn; }
#pragma unroll
              for (int q = 50; q < 64; ++q) ck[q] = 0u; }
            top16_of_64(ck);
            asm volatile("s_waitcnt lgkmcnt(0)" ::: "memory");
            float ts[16], es[16]; int ei[16]; float sum = 0.f;
#pragma unroll
            for (int q = 0; q < 16; ++q) { ts[q] = unmono(ck[q] & ~255u); const unsigned pos = 255u - (ck[q] & 255u);
                const unsigned e1 = itab[r * 32 + (pos >> 4)], e2 = itab[r * 32 + 16 + (pos & 15u)]; ei[q] = (int)(e1 * 128u + e2); }
#pragma unroll
            for (int q = 0; q < 16; ++q) { es[q] = __expf(ts[q] - ts[0]); sum += es[q]; }
            const float inv = 1.0f / sum;
            int eo[8]; float go[8];
#pragma unroll
            for (int q = 0; q < 8; ++q) { eo[q] = hh ? ei[q + 8] : ei[q]; go[q] = (hh ? es[q + 8] : es[q]) * inv; }
            int* ep = EI + (size_t)m * 128 + h * 16 + hh * 8; float* gp = GA + (size_t)m * 128 + h * 16 + hh * 8;
            *(v4u*)ep = (v4u){(unsigned)eo[0], (unsigned)eo[1], (unsigned)eo[2], (unsigned)eo[3]}; *(v4u*)(ep + 4) = (v4u){(unsigned)eo[4], (unsigned)eo[5], (unsigned)eo[6], (unsigned)eo[7]};
            *(f32x4*)gp = (f32x4){go[0], go[1], go[2], go[3]}; *(f32x4*)(gp + 4) = (f32x4){go[4], go[5], go[6], go[7]};
            asm volatile("s_waitcnt lgkmcnt(0)" ::: "memory");
        }
    }
}

struct RowBuf { v4u ua; v2u ub; v4u va; v2u vb; float su, svg; };
__device__ __forceinline__ void gather_load(RowBuf& B, int step, int g, int j, int e_lo, int e_hi, float g_lo, float g_hi, const unsigned char* tu, const unsigned char* tv, const float* su, const float* sv) {
    const int src = (step * 2 + g) & 63;
    const int eidx = __shfl(step < 32 ? e_lo : e_hi, src); const float gate = __shfl(step < 32 ? g_lo : g_hi, src);
    const unsigned char* ur = tu + (size_t)eidx * 768; const unsigned char* vr = tv + (size_t)eidx * 768;
    B.ua = *(const v4u*)(ur + 16 * j); B.ub = *(const v2u*)(ur + 512 + 8 * j); B.va = *(const v4u*)(vr + 16 * j); B.vb = *(const v2u*)(vr + 512 + 8 * j);
    B.su = su[eidx]; B.svg = gate * sv[eidx];
}
__device__ __forceinline__ void gather_compute(const RowBuf& B, const unsigned (&hp)[16], float (&y)[32]) {
    const f32x32 ru = __builtin_amdgcn_cvt_scalef32_pk32_f32_fp6((u32x6){B.ua.x, B.ua.y, B.ua.z, B.ua.w, B.ub.x, B.ub.y}, 1.0f);
    float d0 = 0.f, d1 = 0.f, d2 = 0.f, d3 = 0.f;
#pragma unroll
    for (int q = 0; q < 8; ++q) { d0 += ru[4 * q] * bflo(hp[2 * q]); d1 += ru[4 * q + 1] * bfhi(hp[2 * q]); d2 += ru[4 * q + 2] * bflo(hp[2 * q + 1]); d3 += ru[4 * q + 3] * bfhi(hp[2 * q + 1]); }
    float d = (d0 + d1) + (d2 + d3);
    d += __shfl_xor(d, 1); d += __shfl_xor(d, 2); d += __shfl_xor(d, 4); d += __shfl_xor(d, 8); d += __shfl_xor(d, 16);
    d *= B.su;
    const float wgt = B.svg * 0.5f * d * (1.0f + erff(d * 0.70710678118654752f));
    __builtin_amdgcn_sched_barrier(0);
    const f32x32 rv = __builtin_amdgcn_cvt_scalef32_pk32_f32_fp6((u32x6){B.va.x, B.va.y, B.va.z, B.va.w, B.vb.x, B.vb.y}, 1.0f);
#pragma unroll
    for (int q = 0; q < 32; ++q) y[q] += wgt * rv[q];
}
__device__ __forceinline__ void phase_gather(Frame& F, const bf16* H2, const int* EI, const float* GA) {
    LAS float* a2 = (LAS float*)F.lds;
    LAS bf16* hrow = (LAS bf16*)(F.lds + 16384 + F.wave * 2048);
    LAS float* yrow = (LAS float*)(F.lds + 16384 + 16384 + F.wave * 4096);
    LAS unsigned* ptab = (LAS unsigned*)(F.lds + 16384 + 16384 + 32768 + F.wave * 128);
    unsigned char* ws = WSP(); const unsigned char* tu = ws + WS_TU; const unsigned char* tv = ws + WS_TV; const float* su = (const float*)(ws + WS_SU); const float* sv = (const float*)(ws + WS_SV); float* outp = OUTP();
    const float* npf = IN(I_NPOSTFFN); const float* modf = (const float*)(ws + WS_MODF); unsigned* qctr = (unsigned*)(ws + WS_CTL) + 32;
    const int lane = F.lane, g = lane >> 5, j = lane & 31;
    {
        f32x16v pa, pb;
#pragma unroll
        for (int i = 0; i < 16; ++i) { pa[i] = 0.125f * (float)i; pb[i] = (i < 8) ? 2.0f + 0.25f * (float)i : 4.0f + 0.5f * (float)(i - 8); }
        const f32x32 pr = __builtin_amdgcn_cvt_scalef32_pk32_f32_fp6(__builtin_amdgcn_cvt_scalef32_2xpk16_fp6_f32(pa, pb, 1.0f), 1.0f);
#pragma unroll
        for (int q = 0; q < 32; ++q) { const float v = pr[q]; int idx = (v < 2.0f) ? (int)(v * 8.0f + 0.5f) : (v < 4.0f) ? 16 + (int)((v - 2.0f) * 4.0f + 0.5f) : 24 + (int)((v - 4.0f) * 2.0f + 0.5f);
            idx = idx < 0 ? 0 : (idx > 31 ? 31 : idx); if (lane == 0) ptab[q] = (unsigned)idx; }
    }
    for (int k = F.tid; k < 4096; k += NTHR) a2[k] = modf[(k >> 10) * 6144 + 5120 + (k & 1023)] * npf[k & 1023];
    __syncthreads();
    {
        for (;;) { unsigned tk = 0u; if (lane == 0) tk = __hip_atomic_fetch_add(qctr, 1u, __ATOMIC_RELAXED, __HIP_MEMORY_SCOPE_AGENT);
            const int m = __builtin_amdgcn_readfirstlane((int)tk); if (m >= M) break; const int b = m / SEQ;
            { const v4u h0 = *(const v4u*)(H2 + (size_t)m * D + 16 * lane), h1 = *(const v4u*)(H2 + (size_t)m * D + 16 * lane + 8);
              *(LAS v4u*)(hrow + 16 * lane) = h0; *(LAS v4u*)(hrow + 16 * lane + 8) = h1; }
            const int e_lo = EI[(size_t)m * 128 + lane], e_hi = EI[(size_t)m * 128 + 64 + lane];
            const float g_lo = GA[(size_t)m * 128 + lane], g_hi = GA[(size_t)m * 128 + 64 + lane];
            asm volatile("s_waitcnt lgkmcnt(0)" ::: "memory");
            unsigned hp[16];
#pragma unroll
            for (int q = 0; q < 16; ++q) hp[q] = (unsigned)hrow[32 * j + ptab[2 * q]] | ((unsigned)hrow[32 * j + ptab[2 * q + 1]] << 16);
            float y[32];
#pragma unroll
            for (int q = 0; q < 32; ++q) y[q] = 0.f;
            RowBuf B0, B1, B2, B3;
#define GLOAD(B, st) gather_load(B, (st), g, j, e_lo, e_hi, g_lo, g_hi, tu, tv, su, sv)
#define SB() __builtin_amdgcn_sched_barrier(0)
            GLOAD(B0, 0); GLOAD(B1, 1); GLOAD(B2, 2);
#pragma unroll 1
            for (int st = 0; st < 64; st += 4) {
                const int s4 = (st + 4 < 64) ? st + 4 : 63, s5 = (st + 5 < 64) ? st + 5 : 63, s6 = (st + 6 < 64) ? st + 6 : 63;
                GLOAD(B3, st + 3); SB(); gather_compute(B0, hp, y); SB();
                GLOAD(B0, s4); SB(); gather_compute(B1, hp, y); SB();
                GLOAD(B1, s5); SB(); gather_compute(B2, hp, y); SB();
                GLOAD(B2, s6); SB(); gather_compute(B3, hp, y); SB();
            }
#undef GLOAD
#undef SB
            float ss = 0.f;
#pragma unroll
            for (int q = 0; q < 32; ++q) { y[q] += __shfl_xor(y[q], 32); ss += y[q] * y[q]; }
            ss += __shfl_xor(ss, 1); ss += __shfl_xor(ss, 2); ss += __shfl_xor(ss, 4); ss += __shfl_xor(ss, 8); ss += __shfl_xor(ss, 16);
            const float rstd = rsqrtf(ss * (1.f / D) + EPS);
            if (g == 0) {
#pragma unroll
                for (int q = 0; q < 32; ++q) yrow[32 * j + ptab[q]] = y[q]; }
            asm volatile("s_waitcnt lgkmcnt(0)" ::: "memory");
            const int k = 32 * j + 16 * g;
            f32x4* op = (f32x4*)(outp + (size_t)m * D + k);
#pragma unroll
            for (int q = 0; q < 4; ++q) { f32x4 xv = op[q]; const f32x4 av = *(const LAS f32x4*)(a2 + b * 1024 + k + 4 * q), yv = *(const LAS f32x4*)(yrow + k + 4 * q);
                xv = xv + av * yv * rstd; op[q] = xv; }
            asm volatile("s_waitcnt lgkmcnt(0)" ::: "memory");
        }
    }
}

typedef GAS unsigned gu32;
#define XB_TMO      128
#define XB_XCNT(j)  (256  + 64 * (j))
#define XB_XSUB(j)  (1280 + 64 * (j))
#define XB_XGEN(j)  (2304 + 64 * (j))
#define XB_TOP      3328
#define XB_TOPGEN   3392
#define XCD_BAR_WORDS 3456
#define XB_SPIN_CAP (1u << 18)

__device__ __forceinline__ unsigned xb_ld(unsigned* p)              { return __hip_atomic_load(p, __ATOMIC_RELAXED, __HIP_MEMORY_SCOPE_AGENT); }
__device__ __forceinline__ unsigned xb_add(unsigned* p, unsigned v) { return __hip_atomic_fetch_add(p, v, __ATOMIC_RELAXED, __HIP_MEMORY_SCOPE_AGENT); }
__device__ __forceinline__ unsigned xb_xcc_id() { return (unsigned)__builtin_amdgcn_s_getreg((3 << 11) | 20) & 0xFu; }
#define XB_SPIN(cond, bar) do { unsigned _sp = 0; while (cond) { __builtin_amdgcn_s_sleep(1); \
    if ((++_sp & 255u) == 0u) { if (xb_ld(&(bar)[XB_TMO])) break; if (_sp > XB_SPIN_CAP) { atomicAdd(&(bar)[XB_TMO], 1u); break; } } } } while (0)

struct XcdBarrier {
    unsigned* bar; unsigned x;
    volatile LAS unsigned* st;
};

__device__ __forceinline__ XcdBarrier xcd_barrier_post(unsigned* bar, volatile LAS unsigned* st) {
    XcdBarrier b; b.bar = bar; b.x = xb_xcc_id(); b.st = st;
    if (threadIdx.x == 0) (void)xb_add(&bar[XB_XCNT(b.x)], 1u);
    return b;
}
__device__ __forceinline__ void xcd_barrier_complete(unsigned* bar, unsigned x, unsigned& nloc, unsigned& nx) {
    const unsigned G = gridDim.x * gridDim.y * gridDim.z;
    unsigned sum, cnt, mine, sp = 0u;
    for (;;) {
        sum = 0u; cnt = 0u; mine = 0u;
#pragma unroll
        for (unsigned j = 0; j < 16; ++j) { const unsigned c = xb_ld(&bar[XB_XCNT(j)]); sum += c; cnt += (c > 0u) ? 1u : 0u; mine = (j == x) ? c : mine; }
        if (sum == G) break;
        __builtin_amdgcn_s_sleep(1);
        if ((++sp & 255u) == 0u) { if (xb_ld(&bar[XB_TMO])) break; if (sp > XB_SPIN_CAP) { atomicAdd(&bar[XB_TMO], 1u); break; } }
    }
    nloc = mine > 0u ? mine : 1u; nx = cnt > 0u ? cnt : 1u;
}

__device__ __forceinline__ void xcd_barrier(const XcdBarrier& b) {
    asm volatile("s_waitcnt vmcnt(0)" ::: "memory");
    __syncthreads();
    if (threadIdx.x == 0) {
        unsigned* bar = b.bar;
        __builtin_amdgcn_s_waitcnt(0);
        unsigned nloc = b.st[0], nx = b.st[1];
        if (nloc == 0u) { xcd_barrier_complete(bar, b.x, nloc, nx); b.st[0] = nloc; b.st[1] = nx; }
        const unsigned old = xb_add(&bar[XB_XSUB(b.x)], 1u);
        const unsigned gen = old / nloc;
        if (old + 1u == (gen + 1u) * nloc) {
            __builtin_amdgcn_fence(__ATOMIC_RELEASE, "agent");
            asm volatile("s_waitcnt vmcnt(0)" ::: "memory");
            const unsigned og = xb_add(&bar[XB_TOP], 1u);
            const unsigned tg = og / nx;
            if (og + 1u == (tg + 1u) * nx) xb_add(&bar[XB_TOPGEN], 1u);
            else XB_SPIN(xb_ld(&bar[XB_TOPGEN]) == tg, bar);
            __builtin_amdgcn_fence(__ATOMIC_ACQUIRE, "agent");
            xb_add(&bar[XB_XGEN(b.x)], 1u);
            asm volatile("s_waitcnt vmcnt(0)" ::: "memory");
        } else {
            XB_SPIN(xb_ld(&bar[XB_XGEN(b.x)]) == gen, bar);
            __builtin_amdgcn_fence(__ATOMIC_ACQUIRE, "agent");
            asm volatile("s_waitcnt vmcnt(0)" ::: "memory");
        }
    }
    __syncthreads();
}

struct Args { const float* in[21]; float* out; unsigned char* ws; };
__global__ void __launch_bounds__(NTHR, 2) fwd_megakernel(Args args) {
    extern __shared__ __attribute__((aligned(16))) unsigned char lds[];
#define MKFRAME() Frame F; { int t_ = threadIdx.x; asm volatile("" : "+v"(t_)); F.lds = (LAS unsigned char*)lds; F.tid = t_; F.lane = t_ & 63; F.wave = __builtin_amdgcn_readfirstlane(t_ >> 6); F.G = gridDim.x; }
#define GRID_SYNC() cg::this_grid().sync()
    volatile LAS unsigned* bst = (volatile LAS unsigned*)((LAS unsigned char*)lds + LDS_BYTES - 64);
    if (threadIdx.x < 16) bst[threadIdx.x] = 0u;
    __syncthreads();
    const XcdBarrier xbar = xcd_barrier_post((unsigned*)(WSP() + WS_CTL) + 1024, bst);
#define XSYNC() xcd_barrier(xbar)
#define WSB(off) ((bf16*)(WSP() + (off)))
#define SEGP(s) segp(WSP(), (s))
    { MKFRAME();
    phase_prologue(F);
    }
    GRID_SYNC();
    { MKFRAME();
    phase_h1(F, (bf16*)OUTP());
    }
    XSYNC();
    { MKFRAME();
    {
        pg8::Gemm g{(const bf16*)OUTP(), WSB(WS_WIN), M, NIN, D}; pg8::StaticOrder S; S.init(M, NIN, F.G, (int)blockIdx.x);
        pg8::EpiBf16<0> E{SEGP(0), 512, nullptr, 512, SEG_ELEMS, 1.f};
        pg8::gemm_phase<pg8::EpiBf16<0>, pg8::StaticOrder, true, true>(F.lds, g, S, E);
    }
    }
    XSYNC();
    { MKFRAME();
    phase_scprep(F);
    { bf16* dW = (bf16*)OUTP(); phase_dnprep(F, dW, dW + (size_t)NITEM * 4096, dW + (size_t)2 * NITEM * 4096, dW + (size_t)3 * NITEM * 4096, WSB(WS_KD)); }
    }
    XSYNC();
    { MKFRAME();
    { const bf16* dW = (const bf16*)OUTP(); phase_scan(F, dW, dW + (size_t)NITEM * 4096, dW + (size_t)2 * NITEM * 4096, dW + (size_t)3 * NITEM * 4096, WSB(WS_KD), SEGP(3)); }
    if (blockIdx.x >= 32) {
        { pg8::StaticOrder S; S.init(M, D, F.G - 32, (int)blockIdx.x - 32);
          pg8::Gemm g{SEGP(0), WSB(WS_WSC), M, D, 512}; pg8::EpiGate<false> E{SEGP(4), SEGP(7), SEG_ELEMS};
          pg8::gemm_phase<pg8::EpiGate<false>, pg8::StaticOrder, true, true>(F.lds, g, S, E); }
        __syncthreads();
        unsigned char* ws = WSP(); LAS float* scr6 = (LAS float*)(F.lds + F.wave * 9216);
        const int gw = (blockIdx.x - 32) * NWAVES + F.wave, NGW = (F.G - 32) * NWAVES;
        p0_table_fp6(IN(I_PU), ws + WS_TU, (float*)(ws + WS_SU), scr6, gw, NGW, F.lane);
        p0_table_fp6(IN(I_PV), ws + WS_TV, (float*)(ws + WS_SV), scr6, gw, NGW, F.lane);
    }
    }
    XSYNC();
    { MKFRAME();
    phase_og(F, SEGP(3), SEGP(6), SEGP(11));
    }
    XSYNC();
    { MKFRAME();
    {
        pg8::StaticOrder S; S.init(M, D, F.G, (int)blockIdx.x);
        { pg8::Gemm g{SEGP(11), WSB(WS_WDN), M, D, 512}; pg8::EpiGate<true> E{SEGP(4), SEGP(9), SEG_ELEMS};
          pg8::gemm_phase<pg8::EpiGate<true>, pg8::StaticOrder, true, true>(F.lds, g, S, E); }
    }
    }
    XSYNC();
    { MKFRAME();
    {
        pg8::Gemm g{SEGP(4), WSB(WS_WMIX), M, D, D}; pg8::StaticOrder S; S.init(M, D, F.G, (int)blockIdx.x);
        pg8::EpiBf16<0> E{SEGP(1), D, nullptr, 0, 0, 1.f};
        pg8::gemm_phase<pg8::EpiBf16<0>, pg8::StaticOrder, true, true>(F.lds, g, S, E);
    }
    }
    XSYNC();
    { MKFRAME();
    phase_x1h2(F, SEGP(1), SEGP(7));
    }
    XSYNC();
    { MKFRAME();
    {
        pg8::Gemm g{SEGP(7), WSB(WS_WQ), M, 2048, D}; pg8::StaticOrder S; S.init(M, 2048, F.G, (int)blockIdx.x);
        pg8::EpiBf16<0> E{SEGP(3), 2048, nullptr, 0, 0, 1.f};
        pg8::gemm_phase<pg8::EpiBf16<0>, pg8::StaticOrder, true, true>(F.lds, g, S, E);
    }
    }
    XSYNC();
    { MKFRAME();
    phase_topk(F, SEGP(3), (int*)SEGP(0), (float*)((unsigned char*)SEGP(0) + 16 * MiB));
    }
    XSYNC();
    { MKFRAME();
    phase_gather(F, SEGP(7), (const int*)SEGP(0), (const float*)((unsigned char*)SEGP(0) + 16 * MiB));
    }
}

extern "C" void kernel_launch(void* const* d_in, const int* in_sizes, int n_in, void* d_out, int out_size, void* d_ws, size_t ws_size, hipStream_t stream) {
    static int grid = 0;
    if (grid == 0) {
        if (n_in != 21 || out_size != M * D || ws_size < WS_END) { fprintf(stderr, "kernel_launch: unexpected problem (n_in %d, out %d, ws %zu)\n", n_in, out_size, ws_size); grid = -1; return; }
        int dev = 0, cus = 0, per_cu = 0;
        hipGetDevice(&dev); hipDeviceGetAttribute(&cus, hipDeviceAttributeMultiprocessorCount, dev);
        hipFuncSetAttribute((const void*)fwd_megakernel, hipFuncAttributeMaxDynamicSharedMemorySize, LDS_BYTES);
        hipOccupancyMaxActiveBlocksPerMultiprocessor(&per_cu, (const void*)fwd_megakernel, NTHR, LDS_BYTES);
        if (per_cu < 1) { fprintf(stderr, "kernel_launch: occupancy query says %d blocks per CU\n", per_cu); per_cu = 1; }
        if (per_cu > 1) per_cu = 1;
        grid = cus * per_cu; if (grid > 256) grid = 256;
        (void)hipGetLastError();
    }
    if (grid < 0) return;
    if (hipMemsetAsync((char*)d_ws + WS_CTL, 0, 65536, stream) != hipSuccess) { fprintf(stderr, "kernel_launch: memset of the barrier words failed\n"); return; }
    Args a{};
    for (int i = 0; i < 21; ++i) a.in[i] = (const float*)d_in[i];
    a.out = (float*)d_out; a.ws = (unsigned char*)d_ws;
    void* kargs[] = {&a};
    hipError_t e = hipLaunchCooperativeKernel((const void*)fwd_megakernel, dim3(grid), dim3(NTHR), kargs, LDS_BYTES, stream);
    if (e != hipSuccess) fprintf(stderr, "cooperative launch failed: %s (grid %d)\n", hipGetErrorString(e), grid);
}
```

```cpp
#include <hip/hip_runtime.h>
#include <hip/hip_cooperative_groups.h>
#include <cstdio>
#include <cstdint>
namespace cg = cooperative_groups;
namespace pg8 {
#define PG8_LAS __attribute__((address_space(3)))
typedef unsigned short bf16_t;
typedef short bf16x8 __attribute__((ext_vector_type(8)));
typedef float f32x4 __attribute__((ext_vector_type(4)));
typedef unsigned u32x4 __attribute__((ext_vector_type(4)));
constexpr int BM = 256, BK = 64, HALF = 128, HTB = HALF * BK * 2  , STAGE_BYTES = 8 * HTB, NXCD = 8, WGM = 8;

__host__ __device__ __forceinline__ int lds_byte(int r, int c) { const int st = (r >> 4) * 2 + (c >> 5), rr = r & 15, cc = c & 31, ob = rr * 64 + cc * 2; return st * 1024 + (ob ^ (((ob >> 9) & 1) << 5)); }
__host__ __device__ __forceinline__ void stage_rc(int b, int& R, int& C) { const int st = b / 1024, sb = b % 1024, swz = sb ^ (((sb >> 9) & 1) << 5); R = (st >> 1) * 16 + swz / 64; C = (st & 1) * 32 + (swz % 64) / 2; }
__host__ __device__ __forceinline__ int perm32(int rho) { const int n = rho >> 4, i = rho & 15; return 8 * (i >> 2) + 4 * n + (i & 3); }

struct Unit { int pm, pn; };
struct Gemm { const bf16_t* A; const bf16_t* Bt; int M, N, K; };

struct StaticOrder {
    int nM, nN, nwg, G, c;
    __host__ __device__ void init(int M, int N, int G_, int c_) { nM = M / BM; nN = N / BM; nwg = nM * nN; G = G_; c = c_; }
    __host__ __device__ bool next(int i, Unit& u) const {
        const long L = (long)i * G + c; if (L >= nwg) return false;
        int wgid = (int)L; { const int q = nwg / NXCD, r = nwg % NXCD, xcd = wgid % NXCD, off = wgid / NXCD; wgid = (xcd < r ? xcd * (q + 1) : r * (q + 1) + (xcd - r) * q) + off; }
        const int nig = WGM * nN, gid = wgid / nig, fm = gid * WGM, gsz = (nM - fm) < WGM ? (nM - fm) : WGM;
        u.pm = fm + ((wgid % nig) % gsz); u.pn = (wgid % nig) / gsz; return true;
    }
    __device__ __forceinline__ void a_ready(const Unit&) const {}
    __device__ __forceinline__ void done(const Unit&) const {}
};

__device__ __forceinline__ unsigned cvt_pk_bf16(float lo, float hi) { unsigned r; asm volatile("v_cvt_pk_bf16_f32 %0, %1, %2" : "=v"(r) : "v"(lo), "v"(hi)); return r; }
typedef float f32x2 __attribute__((ext_vector_type(2)));
__device__ __forceinline__ f32x2 gelu_pk(f32x2 v) {
    const f32x2 av = __builtin_elementwise_abs(v), d = av * 0.2316418882f + 1.0f;
    f32x2 t; t.x = __builtin_amdgcn_rcpf(d.x); t.y = __builtin_amdgcn_rcpf(d.y);
    f32x2 q = t * 0.5307027145f + (-0.7265760135f); q = q * t + 0.7107068705f; q = q * t + (-0.142248368f); q = q * t + 0.127414796f; q = q * t;
    const f32x2 s = (v * v) * (-0.72134752044f);
    f32x2 e; e.x = __builtin_amdgcn_exp2f(s.x); e.y = __builtin_amdgcn_exp2f(s.y);
    const f32x2 m = v * (q * e), r = v - m;
    f32x2 o; o.x = v.x < 0.f ? m.x : r.x; o.y = v.y < 0.f ? m.y : r.y; return o;
}

template <int ACT  > struct EpiBf16 {
    static constexpr bool PERM = true, AFTER_DRAIN = false; static_assert(ACT == 0 || ACT == 1, "EpiBf16: ACT is 0 (none) or 1 (gelu_pk)");
    bf16_t* O; int ldc; const float* bias; int split_cols; size_t split_stride; float scale0;
    __device__ __forceinline__ void operator()(const f32x4 (&acc)[2][2][4][2], const Unit& u, int wr, int wc, int fr, int fq) const {
        const int row0 = u.pm * BM + wr * 64 + fr; int colt = u.pn * BM; bf16_t* base = O;
        float sc = 1.f; if (split_cols) { const int t = colt / split_cols; base += (size_t)t * split_stride; colt -= t * split_cols; if (t == 0) sc = scale0; }
        const int col0 = colt + wc * 32 + 8 * fq, bcol0 = u.pn * BM + wc * 32 + 8 * fq;
        f32x4 bv[2][2];
#pragma unroll
        for (int bj = 0; bj < 2; ++bj)
#pragma unroll
            for (int n = 0; n < 2; ++n) bv[bj][n] = bias ? *(const f32x4*)(bias + bcol0 + bj * HALF + 4 * n) : (f32x4){0.f, 0.f, 0.f, 0.f};
#pragma unroll
        for (int ai = 0; ai < 2; ++ai)
#pragma unroll
            for (int m = 0; m < 4; ++m) { bf16_t* rowp = base + (size_t)(row0 + ai * HALF + m * 16) * ldc + col0;
#pragma unroll
                for (int bj = 0; bj < 2; ++bj) { f32x4 v0 = acc[ai][bj][m][0] + bv[bj][0], v1 = acc[ai][bj][m][1] + bv[bj][1];
                    if (ACT == 1) { f32x2 a = gelu_pk((f32x2){v0[0], v0[1]}), b = gelu_pk((f32x2){v0[2], v0[3]}), c = gelu_pk((f32x2){v1[0], v1[1]}), d = gelu_pk((f32x2){v1[2], v1[3]});
                        v0 = (f32x4){a.x, a.y, b.x, b.y}; v1 = (f32x4){c.x, c.y, d.x, d.y}; }
                    v0 = v0 * sc; v1 = v1 * sc; u32x4 w; w.x = cvt_pk_bf16(v0[0], v0[1]); w.y = cvt_pk_bf16(v0[2], v0[3]); w.z = cvt_pk_bf16(v1[0], v1[1]); w.w = cvt_pk_bf16(v1[2], v1[3]);
                    *(u32x4*)(rowp + bj * HALF) = w; } }
    }
};
__device__ __forceinline__ float bf_lo(unsigned u) { return __uint_as_float(u << 16); }
__device__ __forceinline__ float bf_hi(unsigned u) { return __uint_as_float(u & 0xffff0000u); }
__device__ __forceinline__ float sigm(float x) { return __builtin_amdgcn_rcpf(1.0f + __builtin_amdgcn_exp2f(-1.4426950408889634f * x)); }
template <bool ADD> struct EpiGate {
    static constexpr bool PERM = true, AFTER_DRAIN = false;
    bf16_t* O; const bf16_t* gate; size_t seg_elems;
    __device__ __forceinline__ void operator()(const f32x4 (&acc)[2][2][4][2], const Unit& u, int wr, int wc, int fr, int fq) const {
        const int row0 = u.pm * BM + wr * 64 + fr, col0 = u.pn * BM + wc * 32 + 8 * fq;
#pragma unroll
        for (int ai = 0; ai < 2; ++ai)
#pragma unroll
            for (int m = 0; m < 4; ++m) { const int row = row0 + ai * HALF + m * 16;
#pragma unroll
                for (int bj = 0; bj < 2; ++bj) { const int col = col0 + bj * HALF;
                    const u32x4 gv = *(const u32x4*)(gate + (size_t)(col >> 9) * seg_elems + (size_t)row * 512 + (col & 511));
                    bf16_t* op = O + (size_t)row * 1024 + col;
                    f32x4 v0 = acc[ai][bj][m][0], v1 = acc[ai][bj][m][1];
                    v0[0] *= sigm(bf_lo(gv.x)); v0[1] *= sigm(bf_hi(gv.x)); v0[2] *= sigm(bf_lo(gv.y)); v0[3] *= sigm(bf_hi(gv.y));
                    v1[0] *= sigm(bf_lo(gv.z)); v1[1] *= sigm(bf_hi(gv.z)); v1[2] *= sigm(bf_lo(gv.w)); v1[3] *= sigm(bf_hi(gv.w));
                    if (ADD) { const u32x4 ov = *(const u32x4*)op;
                        v0[0] += bf_lo(ov.x); v0[1] += bf_hi(ov.x); v0[2] += bf_lo(ov.y); v0[3] += bf_hi(ov.y);
                        v1[0] += bf_lo(ov.z); v1[1] += bf_hi(ov.z); v1[2] += bf_lo(ov.w); v1[3] += bf_hi(ov.w); }
                    u32x4 w; w.x = cvt_pk_bf16(v0[0], v0[1]); w.y = cvt_pk_bf16(v0[2], v0[3]); w.z = cvt_pk_bf16(v1[0], v1[1]); w.w = cvt_pk_bf16(v1[2], v1[3]);
                    *(u32x4*)op = w; } }
    }
};
template <class Epi, class Sched, bool ALIGN_EPI = false, bool SP2 = false>
__device__ __forceinline__ void gemm_phase(PG8_LAS unsigned char* lds, const Gemm g, const Sched& S, const Epi& E) {
    int tid_ = threadIdx.x; asm volatile("" : "+v"(tid_));
    const int tid = tid_, wid = __builtin_amdgcn_readfirstlane(tid >> 6), lane = tid & 63, wr = wid >> 2, wc = wid & 3, fr = lane & 15, fq = lane >> 4;
    const int K = g.K, nt = K / BK;
    unsigned voffA[2], voffB[2];
#pragma unroll
    for (int i = 0; i < 2; ++i) { int R, C; stage_rc(tid * 16 + i * 8192, R, C); const int Rb = Epi::PERM ? ((R & ~31) + perm32(R & 31)) : R;
        voffA[i] = (unsigned)(R * K + C) * 2u; voffB[i] = (unsigned)(Rb * K + C) * 2u; }
    const size_t kstep = (size_t)(BK * 2);
    const size_t hstep = (size_t)HALF * K * 2;
    const size_t tstep = 2 * hstep;
    const unsigned ldsw = (unsigned)wid * 1024u;
    const int aoff = lds_byte(wr * 64 + fr, fq * 8), boff = lds_byte(wc * 32 + fr, fq * 8);
#define PG8_SA(b, h) (((b) * 2 + (h)) * HTB)
#define PG8_SB(b, h) ((4 + (b) * 2 + (h)) * HTB)
#define PG8_STAGE(bufoff, gbase, voff) do { _Pragma("unroll") for (int _i = 0; _i < 2; ++_i) \
        __builtin_amdgcn_global_load_lds((const unsigned*)((const char*)(gbase) + (voff)[_i]), (PG8_LAS unsigned*)(lds + (bufoff) + ldsw + _i * 8192), 16, 0, 0); } while (0)
#define PG8_LDA(dst, b, h) do { _Pragma("unroll") for (int m = 0; m < 4; ++m) _Pragma("unroll") for (int k = 0; k < 2; ++k) dst[m][k] = *(const PG8_LAS bf16x8*)(lds + PG8_SA(b, h) + aoff + m * 2048 + k * 1024); } while (0)
#define PG8_LDB(dst, b, h) do { _Pragma("unroll") for (int n = 0; n < 2; ++n) _Pragma("unroll") for (int k = 0; k < 2; ++k) dst[n][k] = *(const PG8_LAS bf16x8*)(lds + PG8_SB(b, h) + boff + n * 2048 + k * 1024); } while (0)
#define PG8_MMA(ai, bj, At, Bt) do { __builtin_amdgcn_s_setprio(1); _Pragma("unroll") for (int m = 0; m < 4; ++m) _Pragma("unroll") for (int n = 0; n < 2; ++n) _Pragma("unroll") for (int k = 0; k < 2; ++k) \
        acc[ai][bj][m][n] = __builtin_amdgcn_mfma_f32_16x16x32_bf16(Bt[n][k], At[m][k], acc[ai][bj][m][n], 0, 0, 0); __builtin_amdgcn_s_setprio(0); } while (0)
#define PG8_WAIT_V(n) asm volatile("s_waitcnt vmcnt(" #n ")" ::: "memory")
#define PG8_WAIT_L(n) asm volatile("s_waitcnt lgkmcnt(" #n ")" ::: "memory")
#define PG8_BAR __builtin_amdgcn_s_barrier()
#define PG8_SCHED __builtin_amdgcn_sched_barrier(0)
    Unit cur, nxt; int ui = 0;
    if (!S.next(0, cur)) return;
    f32x4 acc[2][2][4][2];
#pragma unroll
    for (int a = 0; a < 2; ++a)
#pragma unroll
        for (int b = 0; b < 2; ++b)
#pragma unroll
            for (int m = 0; m < 4; ++m)
#pragma unroll
                for (int n = 0; n < 2; ++n) acc[a][b][m][n] = (f32x4){0.f, 0.f, 0.f, 0.f};
    bf16x8 At[4][2], B0[2][2], B1[2][2];
    const char* cA = (const char*)g.A + (size_t)cur.pm * tstep; const char* cB = (const char*)g.Bt + (size_t)cur.pn * tstep;
    S.a_ready(cur);
    if constexpr (SP2) {
        PG8_STAGE(PG8_SB(0, 0), cB, voffB); PG8_STAGE(PG8_SB(0, 1), cB + hstep, voffB); PG8_STAGE(PG8_SA(0, 0), cA, voffA); PG8_STAGE(PG8_SA(0, 1), cA + hstep, voffA);
        if (wr == 1) PG8_BAR;
        PG8_WAIT_V(2); PG8_BAR;
        PG8_STAGE(PG8_SB(1, 0), cB + kstep, voffB); PG8_STAGE(PG8_SA(1, 0), cA + kstep, voffA); PG8_STAGE(PG8_SB(1, 1), cB + hstep + kstep, voffB);
        PG8_WAIT_V(6); PG8_BAR;
    } else {
        PG8_STAGE(PG8_SB(0, 0), cB, voffB); PG8_STAGE(PG8_SA(0, 0), cA, voffA); PG8_STAGE(PG8_SB(0, 1), cB + hstep, voffB); PG8_STAGE(PG8_SA(0, 1), cA + hstep, voffA);
        if (wr == 1) PG8_BAR;
        PG8_WAIT_V(4); PG8_BAR;
        PG8_STAGE(PG8_SB(1, 0), cB + kstep, voffB); PG8_STAGE(PG8_SA(1, 0), cA + kstep, voffA); PG8_STAGE(PG8_SB(1, 1), cB + hstep + kstep, voffB);
        PG8_WAIT_V(6); PG8_BAR;
    }
    for (;;) {
        const bool has_next = S.next(ui + 1, nxt);
        const char* nA = has_next ? (const char*)g.A + (size_t)nxt.pm * tstep : cA; const char* nB = has_next ? (const char*)g.Bt + (size_t)nxt.pn * tstep : cB;
        for (int t = 0; t < nt; t += 2) {
            const bool last = (t == nt - 2);
            const char* a1 = cA + (size_t)(t + 1) * kstep;
            const char* a2 = last ? nA : cA + (size_t)(t + 2) * kstep; const char* b2 = last ? nB : cB + (size_t)(t + 2) * kstep;
            const char* a3 = a2 + kstep; const char* b3 = b2 + kstep;
            if (last && has_next) S.a_ready(nxt);
            if constexpr (SP2) {
            PG8_LDB(B0, 0, 0); PG8_LDB(B1, 0, 1); PG8_SCHED; PG8_LDA(At, 0, 0); PG8_STAGE(PG8_SA(1, 1), a1 + hstep, voffA);
            PG8_WAIT_V(8); PG8_WAIT_L(0); PG8_BAR; PG8_MMA(0, 0, At, B0); PG8_MMA(0, 1, At, B1); PG8_BAR; PG8_SCHED;
            PG8_LDA(At, 0, 1); PG8_STAGE(PG8_SB(0, 0), b2, voffB); PG8_STAGE(PG8_SB(0, 1), b2 + hstep, voffB); PG8_STAGE(PG8_SA(0, 0), a2, voffA);
            PG8_WAIT_V(8); PG8_WAIT_L(0); PG8_BAR; PG8_MMA(1, 0, At, B0); PG8_MMA(1, 1, At, B1); PG8_BAR; PG8_SCHED;
            PG8_LDB(B0, 1, 0); PG8_LDB(B1, 1, 1); PG8_SCHED; PG8_LDA(At, 1, 0); PG8_STAGE(PG8_SA(0, 1), a2 + hstep, voffA);
            PG8_WAIT_V(8); PG8_WAIT_L(0); PG8_BAR; PG8_MMA(0, 0, At, B0); PG8_MMA(0, 1, At, B1); PG8_BAR; PG8_SCHED;
            PG8_LDA(At, 1, 1); PG8_STAGE(PG8_SB(1, 0), b3, voffB); PG8_STAGE(PG8_SB(1, 1), b3 + hstep, voffB); PG8_STAGE(PG8_SA(1, 0), a3, voffA);
            PG8_WAIT_V(8); PG8_WAIT_L(0); PG8_BAR; PG8_MMA(1, 0, At, B0); PG8_MMA(1, 1, At, B1); PG8_BAR; PG8_SCHED;
            } else {
            PG8_LDB(B0, 0, 0); PG8_SCHED; PG8_LDA(At, 0, 0); PG8_STAGE(PG8_SA(1, 1), a1 + hstep, voffA);
            PG8_WAIT_L(8); PG8_BAR; PG8_WAIT_L(0); PG8_MMA(0, 0, At, B0); PG8_BAR; PG8_SCHED;
            PG8_LDB(B1, 0, 1); PG8_STAGE(PG8_SB(0, 0), b2, voffB);
            PG8_BAR; PG8_WAIT_L(0); PG8_MMA(0, 1, At, B1); PG8_BAR;
            PG8_LDA(At, 0, 1); PG8_STAGE(PG8_SA(0, 0), a2, voffA);
            PG8_BAR; PG8_WAIT_L(0); PG8_MMA(1, 0, At, B0); PG8_BAR; PG8_SCHED;
            PG8_STAGE(PG8_SB(0, 1), b2 + hstep, voffB);
            PG8_WAIT_V(6); PG8_BAR; PG8_MMA(1, 1, At, B1); PG8_BAR;
            PG8_LDB(B0, 1, 0); PG8_SCHED; PG8_LDA(At, 1, 0); PG8_STAGE(PG8_SA(0, 1), a2 + hstep, voffA);
            PG8_WAIT_L(8); PG8_BAR; PG8_WAIT_L(0); PG8_MMA(0, 0, At, B0); PG8_BAR; PG8_SCHED;
            PG8_LDB(B1, 1, 1); PG8_STAGE(PG8_SB(1, 0), b3, voffB);
            PG8_BAR; PG8_WAIT_L(0); PG8_MMA(0, 1, At, B1); PG8_BAR;
            PG8_LDA(At, 1, 1); PG8_STAGE(PG8_SA(1, 0), a3, voffA);
            PG8_BAR; PG8_WAIT_L(0); PG8_MMA(1, 0, At, B0); PG8_BAR; PG8_SCHED;
            PG8_STAGE(PG8_SB(1, 1), b3 + hstep, voffB);
            PG8_WAIT_V(6); PG8_BAR; PG8_MMA(1, 1, At, B1); PG8_BAR;
            }
        }
        if constexpr (ALIGN_EPI) { if (wr == 0) PG8_BAR; }
        if constexpr (!Epi::AFTER_DRAIN) { E(acc, cur, wr, wc, fr, fq); S.done(cur); }
        if (!has_next) break;
#pragma unroll
        for (int a = 0; a < 2; ++a)
#pragma unroll
            for (int b = 0; b < 2; ++b)
#pragma unroll
                for (int m = 0; m < 4; ++m)
#pragma unroll
                    for (int n = 0; n < 2; ++n) acc[a][b][m][n] = (f32x4){0.f, 0.f, 0.f, 0.f};
        cur = nxt; cA = nA; cB = nB; ++ui;
        if constexpr (ALIGN_EPI) { if (wr == 1) PG8_BAR; }
    }
    PG8_WAIT_V(0);
    if constexpr (!ALIGN_EPI) { if (wr == 0) PG8_BAR; }
    PG8_BAR;
    if constexpr (Epi::AFTER_DRAIN) { E.fused(acc, cur, wr, wc, fr, fq, lds, wid, lane); S.done(cur); }
#undef PG8_SA
#undef PG8_SB
#undef PG8_STAGE
#undef PG8_LDA
#undef PG8_LDB
#undef PG8_MMA
#undef PG8_WAIT_V
#undef PG8_WAIT_L
#undef PG8_BAR
#undef PG8_SCHED
}
}
constexpr int NWAVES = 8, NTHR = 512;
constexpr int M = 32768, D = 1024, SEQ = 8192, NBATCH = 4;
constexpr int NIN = 5888;
constexpr int NCHUNK = 128, NITEM = 32 * NCHUNK;
constexpr float EPS = 1e-6f;
constexpr size_t MiB = 1u << 20;
constexpr size_t SEG_ELEMS = (size_t)M * 512;
constexpr size_t WS_CTL = 0, WS_MODP = 1 * MiB, WS_WIN = 2 * MiB, WS_WQ = 14 * MiB, WS_WSC = 18 * MiB, WS_WDN = 19 * MiB, WS_WMIX = 20 * MiB,
                 WS_SK = 22 * MiB, WS_MODF = 22 * MiB + 768 * 1024, WS_GL = 23 * MiB, WS_SU = 23 * MiB + 65536, WS_SV = 23 * MiB + 131072, WS_TU = 24 * MiB, WS_TV = 56 * MiB, WS_P = 88 * MiB, WS_KD = 472 * MiB, WS_END = 504 * MiB;
constexpr int LDS_BYTES = 147456;

#define GAS __attribute__((address_space(1)))
#define LAS __attribute__((address_space(3)))
typedef unsigned short bf16;
typedef unsigned v4u __attribute__((ext_vector_type(4)));
typedef unsigned v2u __attribute__((ext_vector_type(2)));
typedef float f32x4 __attribute__((ext_vector_type(4)));
typedef float f32x16 __attribute__((ext_vector_type(16)));
typedef short bf16x8 __attribute__((ext_vector_type(8)));

typedef float f32x2_t __attribute__((ext_vector_type(2))); typedef __bf16 bf16x2_t __attribute__((ext_vector_type(2)));
__device__ __forceinline__ unsigned pk2(float lo, float hi) { f32x2_t v = {lo, hi}; bf16x2_t b = __builtin_convertvector(v, bf16x2_t); return __builtin_bit_cast(unsigned, b); }
__device__ __forceinline__ unsigned f2bf(float f) { return pk2(f, 0.f) & 0xffffu; }
__device__ __forceinline__ float bflo(unsigned u) { return __uint_as_float(u << 16); }
__device__ __forceinline__ float bfhi(unsigned u) { return __uint_as_float(u & 0xffff0000u); }
__device__ __forceinline__ float bf2f(bf16 h) { return __uint_as_float((unsigned)h << 16); }
__device__ __forceinline__ float sigmoidf_(float x) { return __builtin_amdgcn_rcpf(1.0f + __builtin_amdgcn_exp2f(-1.4426950408889634f * x)); }
__device__ __forceinline__ float wave_sum(float v) {
#pragma unroll
    for (int o = 1; o < 64; o <<= 1) v += __shfl_xor(v, o);
    return v;
}

struct Frame { LAS unsigned char* lds; int tid, lane, wave, G; };
__device__ __forceinline__ const void* karg(int i) {
    const char __attribute__((address_space(4)))* kp = (const char __attribute__((address_space(4)))*)__builtin_amdgcn_kernarg_segment_ptr();
    asm volatile("" : "+s"(i));
    return *(const void* const __attribute__((address_space(4)))*)(kp + 8 * i);
}
__device__ __forceinline__ const float* IN(int i) { return (const float*)karg(i); }
__device__ __forceinline__ float* OUTP() { return (float*)karg(21); }
__device__ __forceinline__ unsigned char* WSP() { return (unsigned char*)karg(22); }
enum { I_X = 0, I_C, I_WADA, I_BADA, I_NPREMIX, I_NPOSTMIX, I_WIN, I_SCCONV, I_DNCONV, I_ALOG, I_DTBIAS, I_OUTNORM, I_WSC, I_WDN, I_WMIX, I_NPREFFN, I_NPOSTFFN, I_WQ, I_SUBK, I_PU, I_PV };
__device__ __forceinline__ bf16* segp(unsigned char* ws, int s) { return (bf16*)(ws + WS_P) + (size_t)s * SEG_ELEMS; }
__device__ __forceinline__ float modv(const float* b_ada, const float* modp, int b, int j) {
    float s = b_ada[j];
#pragma unroll
    for (int k = 0; k < 8; ++k) s += modp[(size_t)(k * 4 + b) * 6144 + j];
    return s;
}

__device__ __forceinline__ void p0_transpose_item(const float* W, int K, int N, int src_col0, bf16* WT, int dst_row0, int kb, int ncols, LAS float* scr, int lane) {
    const int k0 = 64 * kb;
#pragma unroll 8
    for (int i = 0; i < 32; ++i) { const int kk = 2 * i + (lane >> 5); const int n = lane & 31;
        scr[kk * 33 + n] = (n < ncols) ? W[(size_t)(k0 + kk) * N + src_col0 + n] : 0.f; }
    asm volatile("s_waitcnt lgkmcnt(0)" ::: "memory");
    const int c = lane & 7;
#pragma unroll
    for (int j = 0; j < 4; ++j) { const int n = (lane >> 3) + 8 * j; const LAS float* s = scr + (8 * c) * 33 + n;
        v4u o; o.x = pk2(s[0 * 33], s[1 * 33]); o.y = pk2(s[2 * 33], s[3 * 33]); o.z = pk2(s[4 * 33], s[5 * 33]); o.w = pk2(s[6 * 33], s[7 * 33]);
        *(v4u*)(WT + (size_t)(dst_row0 + n) * K + k0 + 8 * c) = o; }
    asm volatile("s_waitcnt lgkmcnt(0)" ::: "memory");
}
__device__ __forceinline__ void p0_transpose(const float* W, int K, int N, int src_col0, int nblk, bf16* WT, int dst_row0, LAS float* scr, int gw, int NGW, int lane) {
    const int kbs = K / 64;
    for (int it = gw; it < nblk * kbs; it += NGW) { const int nb = it / kbs, kb = it % kbs;
        p0_transpose_item(W, K, N, src_col0 + 32 * nb, WT, dst_row0 + 32 * nb, kb, 32, scr, lane); }
}
__device__ __forceinline__ void p0_convert(const float* src, bf16* dst, size_t nchunks8, size_t gtid, size_t gthreads) {
    for (size_t i = gtid; i < nchunks8; i += gthreads) { const f32x4 a = *(const f32x4*)(src + i * 8), b = *(const f32x4*)(src + i * 8 + 4);
        v4u o; o.x = pk2(a[0], a[1]); o.y = pk2(a[2], a[3]); o.z = pk2(b[0], b[1]); o.w = pk2(b[2], b[3]); *(v4u*)(dst + i * 8) = o; }
}
typedef unsigned u32x6 __attribute__((ext_vector_type(6)));
typedef float f32x32 __attribute__((ext_vector_type(32)));
typedef float f32x16v __attribute__((ext_vector_type(16)));
__device__ __forceinline__ void p0_table_fp6(const float* T, unsigned char* T6, float* SC, LAS float* scr, int gw, int NGW, int lane) {
    const int g = lane >> 5, jl = lane & 31;
    for (int pr = gw; pr < 8192; pr += NGW) {
        const f32x4* src = (const f32x4*)(T + (size_t)(2 * pr) * 1024) + lane;
#pragma unroll
        for (int i = 0; i < 8; ++i) { const f32x4 v = src[64 * i]; const int q = lane + 64 * i, row = q >> 8, kk = (q & 255) * 4;
            *(LAS f32x4*)(scr + (row * 32 + (kk >> 5)) * 36 + (kk & 31)) = v; }
        asm volatile("s_waitcnt lgkmcnt(0)" ::: "memory");
        float x[32]; float am = 0.f;
#pragma unroll
        for (int i = 0; i < 8; ++i) { const f32x4 t = *(const LAS f32x4*)(scr + (g * 32 + jl) * 36 + 4 * i); x[4 * i] = t[0]; x[4 * i + 1] = t[1]; x[4 * i + 2] = t[2]; x[4 * i + 3] = t[3];
            am = fmaxf(am, fmaxf(fmaxf(fabsf(t[0]), fabsf(t[1])), fmaxf(fabsf(t[2]), fabsf(t[3])))); }
#pragma unroll
        for (int o = 1; o < 32; o <<= 1) am = fmaxf(am, __shfl_xor(am, o));
        const float sp = 7.5f / fmaxf(am, 1e-30f), inv = am * (1.0f / 7.5f);
        f32x16v a, b;
#pragma unroll
        for (int i = 0; i < 16; ++i) { a[i] = x[i] * sp; b[i] = x[16 + i] * sp; }
        const u32x6 qv = __builtin_amdgcn_cvt_scalef32_2xpk16_fp6_f32(a, b, 1.0f);
        unsigned char* dst = T6 + (size_t)(2 * pr + g) * 768;
        *(v4u*)(dst + 16 * jl) = (v4u){qv[0], qv[1], qv[2], qv[3]}; *(v2u*)(dst + 512 + 8 * jl) = (v2u){qv[4], qv[5]};
        if (jl == 0) SC[2 * pr + g] = inv;
        asm volatile("s_waitcnt lgkmcnt(0)" ::: "memory");
    }
}
__device__ __forceinline__ void phase_prologue(Frame& F) {
    LAS float* scr = (LAS float*)(F.lds + F.wave * 9216);
    const int gw = blockIdx.x * NWAVES + F.wave, NGW = F.G * NWAVES;
    unsigned char* ws = WSP();
    { const float* w_ada = IN(I_WADA); const float* cc = IN(I_C); float* modp = (float*)(ws + WS_MODP);
    for (int it = gw; it < 768; it += NGW) { const int cgi = it % 96, ks = it / 96, n = cgi * 64 + F.lane, k0 = ks * 128;
        float a0 = 0.f, a1 = 0.f, a2 = 0.f, a3 = 0.f;
#pragma unroll 16
        for (int kk = 0; kk < 128; ++kk) { const int k = k0 + kk; const float w = w_ada[(size_t)k * 6144 + n];
            const float c0 = cc[k], c1 = cc[1024 + k], c2 = cc[2048 + k], c3 = cc[3072 + k];
            a0 += c0 * sigmoidf_(c0) * w; a1 += c1 * sigmoidf_(c1) * w; a2 += c2 * sigmoidf_(c2) * w; a3 += c3 * sigmoidf_(c3) * w; }
        modp[(size_t)(ks * 4 + 0) * 6144 + n] = a0; modp[(size_t)(ks * 4 + 1) * 6144 + n] = a1;
        modp[(size_t)(ks * 4 + 2) * 6144 + n] = a2; modp[(size_t)(ks * 4 + 3) * 6144 + n] = a3; } }
    { const float* w_in = IN(I_WIN); bf16* win_t = (bf16*)(ws + WS_WIN);
    p0_transpose(w_in, 1024, 5648, 0, 112, win_t, 0, scr, gw, NGW, F.lane);
    p0_transpose(w_in, 1024, 5648, 3600, 64, win_t, 3584, scr, gw, NGW, F.lane);
    for (int it = gw; it < 16; it += NGW) p0_transpose_item(w_in, 1024, 5648, 3584, win_t, 5632, it, 16, scr, F.lane);
    { const size_t gtid = (size_t)blockIdx.x * NTHR + F.tid, gth = (size_t)F.G * NTHR;
      for (size_t i = gtid; i < (size_t)224 * 128; i += gth) *(v4u*)(win_t + (size_t)5664 * 1024 + i * 8) = (v4u){0u, 0u, 0u, 0u}; } }
    p0_transpose(IN(I_WQ), 1024, 2048, 0, 64, (bf16*)(ws + WS_WQ), 0, scr, gw, NGW, F.lane);
    p0_transpose(IN(I_WSC), 512, 1024, 0, 32, (bf16*)(ws + WS_WSC), 0, scr, gw, NGW, F.lane);
    p0_transpose(IN(I_WDN), 512, 1024, 0, 32, (bf16*)(ws + WS_WDN), 0, scr, gw, NGW, F.lane);
    p0_transpose(IN(I_WMIX), 1024, 1024, 0, 32, (bf16*)(ws + WS_WMIX), 0, scr, gw, NGW, F.lane);
    { const size_t gtid = (size_t)blockIdx.x * NTHR + F.tid, gth = (size_t)F.G * NTHR;
      p0_convert(IN(I_SUBK), (bf16*)(ws + WS_SK), (size_t)16 * 128 * 128 / 8, gtid, gth);
    }
}

__device__ __forceinline__ void phase_h1(Frame& F, bf16* H1) {
    LAS float* gv = (LAS float*)F.lds; LAS float* sv = gv + 1024;
    const float* xin = IN(I_X); const float* npm = IN(I_NPREMIX); const float* b_ada = IN(I_BADA); const float* modp = (const float*)(WSP() + WS_MODP);
    if (blockIdx.x < 24) { float* modf = (float*)(WSP() + WS_MODF);
        for (int k = F.tid; k < 1024; k += NTHR) { const int idx = blockIdx.x * 1024 + k; modf[idx] = modv(b_ada, modp, idx / 6144, idx % 6144); } }
    for (int rb = blockIdx.x; rb < M / 128; rb += F.G) {
        const int row0 = rb * 128, b = row0 / SEQ;
        __syncthreads();
        for (int k = F.tid; k < 1024; k += NTHR) { gv[k] = npm[k] * (1.f + modv(b_ada, modp, b, 1024 + k)); sv[k] = modv(b_ada, modp, b, k); }
        __syncthreads();
        for (int r = 0; r < 16; ++r) { const int row = row0 + F.wave * 16 + r;
            const f32x4* xr = (const f32x4*)(xin + (size_t)row * D) + F.lane;
            f32x4 v[4]; float ss = 0.f;
#pragma unroll
            for (int j = 0; j < 4; ++j) { v[j] = xr[64 * j]; ss += (v[j][0] * v[j][0] + v[j][1] * v[j][1]) + (v[j][2] * v[j][2] + v[j][3] * v[j][3]); }
            const float rstd = rsqrtf(wave_sum(ss) * (1.f / D) + EPS);
            v2u* o8 = (v2u*)(H1 + (size_t)row * D) + F.lane;
#pragma unroll
            for (int j = 0; j < 4; ++j) { const int k = 4 * F.lane + 256 * j; const f32x4 g = *(const LAS f32x4*)(gv + k), s = *(const LAS f32x4*)(sv + k);
                v2u o; o.x = pk2(v[j][0] * rstd * g[0] + s[0], v[j][1] * rstd * g[1] + s[1]); o.y = pk2(v[j][2] * rstd * g[2] + s[2], v[j][3] * rstd * g[3] + s[3]); o8[64 * j] = o; }
        }
    }
}

__device__ __forceinline__ void phase_scprep(Frame& F) {
    unsigned char* ws = WSP(); bf16* sb = segp(ws, 0); const bf16* scc = segp(ws, 1); const bf16* scx = segp(ws, 2); const float* scw = IN(I_SCCONV);
    const int gtid = blockIdx.x * NTHR + F.tid, gth = F.G * NTHR;
    for (int it = gtid; it < (M / 16) * 64; it += gth) {
        const int cgp = it & 63, tb = it >> 6, m0 = tb * 16, c0 = cgp * 8;
        float w0[8], w1[8], w2[8], p2[8], p1[8];
#pragma unroll
        for (int e = 0; e < 8; ++e) { w0[e] = scw[c0 + e]; w1[e] = scw[512 + c0 + e]; w2[e] = scw[1024 + c0 + e]; p2[e] = 0.f; p1[e] = 0.f; }
        if ((m0 % SEQ) != 0) {
#pragma unroll
            for (int q = 0; q < 2; ++q) { const size_t off = (size_t)(m0 - 2 + q) * 512 + c0; const v4u cv = *(const v4u*)(scc + off), xv = *(const v4u*)(scx + off);
                float t[8] = {bflo(cv.x) * bflo(xv.x), bfhi(cv.x) * bfhi(xv.x), bflo(cv.y) * bflo(xv.y), bfhi(cv.y) * bfhi(xv.y), bflo(cv.z) * bflo(xv.z), bfhi(cv.z) * bfhi(xv.z), bflo(cv.w) * bflo(xv.w), bfhi(cv.w) * bfhi(xv.w)};
#pragma unroll
                for (int e = 0; e < 8; ++e) { if (q == 0) p2[e] = t[e]; else p1[e] = t[e]; } }
        }
        for (int t = 0; t < 16; ++t) { const size_t off = (size_t)(m0 + t) * 512 + c0;
            const v4u cv = *(const v4u*)(scc + off), xv = *(const v4u*)(scx + off), bv = *(const v4u*)(sb + off);
            float cur[8] = {bflo(cv.x) * bflo(xv.x), bfhi(cv.x) * bfhi(xv.x), bflo(cv.y) * bflo(xv.y), bfhi(cv.y) * bfhi(xv.y), bflo(cv.z) * bflo(xv.z), bfhi(cv.z) * bfhi(xv.z), bflo(cv.w) * bflo(xv.w), bfhi(cv.w) * bfhi(xv.w)};
            float bb[8] = {bflo(bv.x), bfhi(bv.x), bflo(bv.y), bfhi(bv.y), bflo(bv.z), bfhi(bv.z), bflo(bv.w), bfhi(bv.w)};
            float o[8];
#pragma unroll
            for (int e = 0; e < 8; ++e) { o[e] = bb[e] * (w0[e] * p2[e] + w1[e] * p1[e] + w2[e] * cur[e]); p2[e] = p1[e]; p1[e] = cur[e]; }
            v4u ov; ov.x = pk2(o[0], o[1]); ov.y = pk2(o[2], o[3]); ov.z = pk2(o[4], o[5]); ov.w = pk2(o[6], o[7]);
            *(v4u*)(sb + off) = ov; }
    }
}

__device__ __forceinline__ bf16x8 pack_b(const f32x4& t0, const f32x4& t1) { v4u w; w.x = pk2(t0[0], t0[1]); w.y = pk2(t0[2], t0[3]); w.z = pk2(t1[0], t1[1]); w.w = pk2(t1[2], t1[3]); return __builtin_bit_cast(bf16x8, w); }
__device__ __forceinline__ int fragoff(int row, int col) { const int jj = col & 31; return ((row >> 4) * 2 + (col >> 5)) * 512 + ((((jj & 15) >> 2) * 16 + (row & 15)) * 8) + (jj & 3) + 4 * (jj >> 4); }
#define MM4(dst, aptr, X) do { const f32x4 av_ = *(const LAS f32x4*)(aptr); \
    dst = __builtin_amdgcn_mfma_f32_16x16x4f32(av_[0], (X)[0], dst, 0, 0, 0); dst = __builtin_amdgcn_mfma_f32_16x16x4f32(av_[1], (X)[1], dst, 0, 0, 0); \
    dst = __builtin_amdgcn_mfma_f32_16x16x4f32(av_[2], (X)[2], dst, 0, 0, 0); dst = __builtin_amdgcn_mfma_f32_16x16x4f32(av_[3], (X)[3], dst, 0, 0, 0); } while (0)
#define LBAR() do { asm volatile("s_waitcnt lgkmcnt(0)" ::: "memory"); __builtin_amdgcn_s_barrier(); asm volatile("" ::: "memory"); } while (0)
#define MMB(dst, rb, c0, use1, c1, Xa, Xb) do { const f32x4 l0_ = *(const LAS f32x4*)(Ln + (16 * (rb) + nn) * 68 + 16 * (c0) + 4 * g4); \
    const f32x4 l1_ = (use1) ? *(const LAS f32x4*)(Ln + (16 * (rb) + nn) * 68 + 16 * (c1) + 4 * g4) : (f32x4){0.f, 0.f, 0.f, 0.f}; \
    dst = __builtin_amdgcn_mfma_f32_16x16x32_bf16(pack_b(l0_, l1_), pack_b(Xa, Xb), dst, 0, 0, 0); } while (0)
__device__ __forceinline__ void phase_dnprep(Frame& F, bf16* Wn, bf16* U, bf16* QG, bf16* A, bf16* KD) {
    LAS unsigned char* L = F.lds;
    LAS bf16* raw = (LAS bf16*)L;
    LAS bf16* stg2 = (LAS bf16*)L;
    LAS float* qc = (LAS float*)(L + 32768);
    LAS float* kc = (LAS float*)(L + 32768 + 17408);
    LAS float* vc = (LAS float*)(L + 32768 + 2 * 17408);
    LAS bf16* kh = (LAS bf16*)(L + 84992);
    LAS bf16* qh = (LAS bf16*)(L + 94208);
    LAS float* Ln = (LAS float*)(L + 103424);
    LAS float* Tm = (LAS float*)(L + 120832);
    LAS float* sG = (LAS float*)(L + 124928);
    LAS float* sBeta = sG + 64; LAS float* sEG = sG + 128; LAS float* sEd = sG + 192;
    LAS float* cwl = (LAS float*)(L + 125952);
    LAS bf16* stg = (LAS bf16*)(L + 129024);
    const int tid = F.tid, lane = F.lane, wave = F.wave;
    unsigned char* ws = WSP(); const bf16* segq = segp(ws, 3); const bf16* segab = segp(ws, 11); float* glp = (float*)(ws + WS_GL);
    const float* cw = IN(I_DNCONV); const float* alog = IN(I_ALOG); const float* dtb = IN(I_DTBIAS);
    v4u pr[4]; float pcw[2]; float pa = 0.f, pb = 0.f, pal = 0.f;
#define PREFETCH(itn) do { const int bh_ = (itn) >> 7, n_ = (itn) & 127, b_ = bh_ >> 3, h_ = bh_ & 7, m0_ = b_ * SEQ + n_ * 64; \
        _Pragma("unroll") for (int q_ = 0; q_ < 4; ++q_) { const int ci_ = tid + q_ * NTHR; pr[q_] = (v4u){0u, 0u, 0u, 0u}; \
            if (ci_ < 1608) { const int s_ = ci_ / 536, rem_ = ci_ % 536, r_ = rem_ >> 3, c8_ = rem_ & 7; \
                if (n_ * 64 - 3 + r_ >= 0) pr[q_] = *(const v4u*)(segq + (size_t)s_ * SEG_ELEMS + (size_t)(m0_ - 3 + r_) * 512 + h_ * 64 + c8_ * 8); } } \
        _Pragma("unroll") for (int q_ = 0; q_ < 2; ++q_) { const int ci_ = tid + q_ * NTHR; pcw[q_] = 0.f; if (ci_ < 768) pcw[q_] = cw[((ci_ >> 6) & 3) * 1536 + (ci_ >> 8) * 512 + h_ * 64 + (ci_ & 63)]; } \
        if (wave == 0) { pa = bf2f(segab[(size_t)(m0_ + lane) * 512 + h_]) + dtb[h_]; pb = bf2f(segab[(size_t)(m0_ + lane) * 512 + 8 + h_]); pal = alog[h_]; } } while (0)
    if ((int)blockIdx.x < NITEM) PREFETCH((int)blockIdx.x);
    for (int it = blockIdx.x; it < NITEM; it += F.G) {
        const int bh = it >> 7, h = bh & 7;
        LBAR();
#pragma unroll
        for (int q = 0; q < 4; ++q) { const int ci = tid + q * NTHR; if (ci < 1608) { const int s_ = ci / 536, rem = ci % 536, r = rem >> 3, c8 = rem & 7; *(LAS v4u*)(raw + (s_ * 67 + r) * 64 + c8 * 8) = pr[q]; } }
#pragma unroll
        for (int q = 0; q < 2; ++q) { const int ci = tid + q * NTHR; if (ci < 768) cwl[ci] = pcw[q]; }
        const float av_cur = pa, bv_cur = pb, al_cur = pal;
        LBAR();
        { const int itn = it + F.G; if (itn < NITEM) PREFETCH(itn); }
        for (int wu = tid; wu < 3072; wu += NTHR) { const int c4 = wu & 15, t = (wu >> 4) & 63, s_ = wu >> 10;
            f32x4 acc = (f32x4){0.f, 0.f, 0.f, 0.f};
#pragma unroll
            for (int k = 0; k < 4; ++k) { const f32x4 w = *(const LAS f32x4*)(cwl + (s_ * 4 + k) * 64 + 4 * c4); const v2u r = *(const LAS v2u*)(raw + (s_ * 67 + t + k) * 64 + 4 * c4);
                acc[0] += w[0] * bflo(r.x); acc[1] += w[1] * bfhi(r.x); acc[2] += w[2] * bflo(r.y); acc[3] += w[3] * bfhi(r.y); }
#pragma unroll
            for (int e = 0; e < 4; ++e) acc[e] = acc[e] * sigmoidf_(acc[e]);
            *(LAS f32x4*)((s_ == 0 ? qc : (s_ == 1 ? kc : vc)) + t * 68 + 4 * c4) = acc; }
        if (wave == 0) {
            const float sp = (av_cur > 20.f) ? av_cur : __logf(1.0f + __expf(av_cur));
            float g = -__expf(al_cur) * sp;
#pragma unroll
            for (int o = 1; o < 64; o <<= 1) { const float t = __shfl_up(g, o); if (lane >= o) g += t; }
            const float g63 = __shfl(g, 63);
            sG[lane] = g; sBeta[lane] = sigmoidf_(bv_cur); sEG[lane] = __expf(g); sEd[lane] = __expf(g63 - g);
            if (lane == 63) glp[it] = __expf(g);
        }
        LBAR();
        { const int t = tid >> 3, p = tid & 7;
          f32x4 q0 = *(const LAS f32x4*)(qc + t * 68 + 8 * p), q1 = *(const LAS f32x4*)(qc + t * 68 + 8 * p + 4), k0 = *(const LAS f32x4*)(kc + t * 68 + 8 * p), k1 = *(const LAS f32x4*)(kc + t * 68 + 8 * p + 4);
          float sq = (q0[0] * q0[0] + q0[1] * q0[1]) + (q0[2] * q0[2] + q0[3] * q0[3]) + (q1[0] * q1[0] + q1[1] * q1[1]) + (q1[2] * q1[2] + q1[3] * q1[3]);
          float sk = (k0[0] * k0[0] + k0[1] * k0[1]) + (k0[2] * k0[2] + k0[3] * k0[3]) + (k1[0] * k1[0] + k1[1] * k1[1]) + (k1[2] * k1[2] + k1[3] * k1[3]);
          sq += __shfl_xor(sq, 1); sq += __shfl_xor(sq, 2); sq += __shfl_xor(sq, 4); sk += __shfl_xor(sk, 1); sk += __shfl_xor(sk, 2); sk += __shfl_xor(sk, 4);
          const float rq = rsqrtf(sq + EPS) * 0.125f, rk = rsqrtf(sk + EPS);
          q0 = q0 * rq; q1 = q1 * rq; k0 = k0 * rk; k1 = k1 * rk;
          *(LAS f32x4*)(qc + t * 68 + 8 * p) = q0; *(LAS f32x4*)(qc + t * 68 + 8 * p + 4) = q1; *(LAS f32x4*)(kc + t * 68 + 8 * p) = k0; *(LAS f32x4*)(kc + t * 68 + 8 * p + 4) = k1;
          v4u qb, kb; qb.x = pk2(q0[0], q0[1]); qb.y = pk2(q0[2], q0[3]); qb.z = pk2(q1[0], q1[1]); qb.w = pk2(q1[2], q1[3]);
          kb.x = pk2(k0[0], k0[1]); kb.y = pk2(k0[2], k0[3]); kb.z = pk2(k1[0], k1[1]); kb.w = pk2(k1[2], k1[3]);
          *(LAS v4u*)(qh + t * 72 + 8 * p) = qb; *(LAS v4u*)(kh + t * 72 + 8 * p) = kb; }
        LBAR();
        {
            const int fr = lane & 15, g4 = lane >> 4;
#pragma unroll
            for (int x = 0; x < 2; ++x) { const int tile = 2 * wave + x, ti = tile >> 2, tj = tile & 3;
                f32x4 ckk = (f32x4){0.f, 0.f, 0.f, 0.f}, cqk = (f32x4){0.f, 0.f, 0.f, 0.f};
#pragma unroll
                for (int ks = 0; ks < 2; ++ks) {
                    const bf16x8 ak = *(const LAS bf16x8*)(kh + (16 * ti + fr) * 72 + 32 * ks + 8 * g4);
                    const bf16x8 aq = *(const LAS bf16x8*)(qh + (16 * ti + fr) * 72 + 32 * ks + 8 * g4);
                    const bf16x8 bk = *(const LAS bf16x8*)(kh + (16 * tj + fr) * 72 + 32 * ks + 8 * g4);
                    ckk = __builtin_amdgcn_mfma_f32_16x16x32_bf16(ak, bk, ckk, 0, 0, 0);
                    cqk = __builtin_amdgcn_mfma_f32_16x16x32_bf16(aq, bk, cqk, 0, 0, 0); }
                const int j = 16 * tj + fr; const float gj = sG[j];
#pragma unroll
                for (int r = 0; r < 4; ++r) { const int i = 16 * ti + 4 * g4 + r;
                    const float dec = __expf(fminf(sG[i] - gj, 0.f));
                    Ln[i * 68 + j] = (j < i) ? -(sBeta[i] * ckk[r] * dec) : 0.f;
                    stg[fragoff(i, j)] = (bf16)f2bf((j <= i) ? cqk[r] * dec : 0.f); }
            }
        }
        LBAR();
        if (wave == 0) {
            const int bb = lane >> 4, c = lane & 15; float t[16];
#pragma unroll
            for (int i = 0; i < 16; ++i) { float acc = (i == c) ? 1.f : 0.f;
#pragma unroll
                for (int j = 0; j < i; ++j) acc += Ln[(16 * bb + i) * 68 + 16 * bb + j] * t[j];
                t[i] = acc; Tm[(bb * 16 + i) * 16 + c] = acc; }
        } else {
            for (int ct = tid - 64; ct < 1536; ct += NTHR - 64) { const int kind = ct >> 9, idx = ct & 511; const size_t ob = (size_t)it * 4096 + (size_t)idx * 8;
                if (kind == 0) { *(v4u*)(A + ob) = *(const LAS v4u*)(stg + idx * 8); }
                else if (kind == 1) { const int i = idx >> 3, k0 = (idx & 7) * 8; const float e = sEG[i]; const f32x4 a = *(const LAS f32x4*)(qc + i * 68 + k0), c = *(const LAS f32x4*)(qc + i * 68 + k0 + 4);
                    *(v2u*)(QG + (size_t)it * 4096 + fragoff(i, k0)) = (v2u){pk2(a[0] * e, a[1] * e), pk2(a[2] * e, a[3] * e)};
                    *(v2u*)(QG + (size_t)it * 4096 + fragoff(i, k0 + 4)) = (v2u){pk2(c[0] * e, c[1] * e), pk2(c[2] * e, c[3] * e)}; }
                else { const int kk = idx >> 3, c0 = (idx & 7) * 8;
                    v2u p0, p1; p0.x = pk2(kc[(c0 + 0) * 68 + kk] * sEd[c0 + 0], kc[(c0 + 1) * 68 + kk] * sEd[c0 + 1]); p0.y = pk2(kc[(c0 + 2) * 68 + kk] * sEd[c0 + 2], kc[(c0 + 3) * 68 + kk] * sEd[c0 + 3]);
                    p1.x = pk2(kc[(c0 + 4) * 68 + kk] * sEd[c0 + 4], kc[(c0 + 5) * 68 + kk] * sEd[c0 + 5]); p1.y = pk2(kc[(c0 + 6) * 68 + kk] * sEd[c0 + 6], kc[(c0 + 7) * 68 + kk] * sEd[c0 + 7]);
                    *(v2u*)(KD + (size_t)it * 4096 + fragoff(kk, c0)) = p0; *(v2u*)(KD + (size_t)it * 4096 + fragoff(kk, c0 + 4)) = p1; } }
        }
        LBAR();
        {
            const int nn = lane & 15, g4 = lane >> 4; const LAS float* src = (wave < 4) ? vc : kc; const int cc = 16 * (wave & 3) + nn;
            f32x4 R[4];
#pragma unroll
            for (int bb = 0; bb < 4; ++bb)
#pragma unroll
                for (int r = 0; r < 4; ++r) { const int i = 16 * bb + 4 * g4 + r; float v = src[i * 68 + cc] * sBeta[i]; if (wave >= 4) v *= sEG[i]; R[bb][r] = v; }
            const f32x4 Z4 = (f32x4){0.f, 0.f, 0.f, 0.f};
            f32x4 X0 = Z4, X1 = Z4, X2 = Z4, X3 = Z4;
            MM4(X0, Tm + (0 * 16 + nn) * 16 + 4 * g4, R[0]);
            MMB(R[1], 1, 0, false, 0, X0, Z4);
            MM4(X1, Tm + (1 * 16 + nn) * 16 + 4 * g4, R[1]);
            MMB(R[2], 2, 0, true, 1, X0, X1);
            MM4(X2, Tm + (2 * 16 + nn) * 16 + 4 * g4, R[2]);
            MMB(R[3], 3, 0, true, 1, X0, X1); MMB(R[3], 3, 2, false, 0, X2, Z4);
            MM4(X3, Tm + (3 * 16 + nn) * 16 + 4 * g4, R[3]);
            if (wave < 4) {
                LAS bf16* up = stg2 + (wave * 2) * 512 + (g4 * 16 + nn) * 8;
                *(LAS v4u*)(up) = (v4u){pk2(X0[0], X0[1]), pk2(X0[2], X0[3]), pk2(X1[0], X1[1]), pk2(X1[2], X1[3])};
                *(LAS v4u*)(up + 512) = (v4u){pk2(X2[0], X2[1]), pk2(X2[2], X2[3]), pk2(X3[0], X3[1]), pk2(X3[2], X3[3])};
            } else {
                LAS bf16* wp = stg2 + 4096; const int k = 16 * (wave - 4) + nn;
#pragma unroll
                for (int r = 0; r < 4; ++r) { const int i = 4 * g4 + r;
                    wp[fragoff(i, k)] = (bf16)f2bf(-X0[r]); wp[fragoff(16 + i, k)] = (bf16)f2bf(-X1[r]); wp[fragoff(32 + i, k)] = (bf16)f2bf(-X2[r]); wp[fragoff(48 + i, k)] = (bf16)f2bf(-X3[r]); }
            }
        }
        LBAR();
        { const v4u vu = *(const LAS v4u*)(stg2 + tid * 8), vw = *(const LAS v4u*)(stg2 + 4096 + tid * 8);
          *(v4u*)(U + (size_t)it * 4096 + tid * 8) = vu; *(v4u*)(Wn + (size_t)it * 4096 + tid * 8) = vw; }
    }
#undef PREFETCH
}
#undef LBAR
#undef MMB
#undef MM4

__device__ __forceinline__ bf16x8 afrag(const LAS bf16* base, int row, int ks, int g4) {
    const v2u lo = *(const LAS v2u*)(base + row * 72 + 32 * ks + 4 * g4), hi = *(const LAS v2u*)(base + row * 72 + 32 * ks + 16 + 4 * g4);
    v4u w; w.x = lo.x; w.y = lo.y; w.z = hi.x; w.w = hi.y; return __builtin_bit_cast(bf16x8, w); }
#define SCAN_BAR() do { asm volatile("s_waitcnt lgkmcnt(0)" ::: "memory"); __builtin_amdgcn_s_barrier(); asm volatile("" ::: "memory"); } while (0)
__device__ __forceinline__ void phase_scan(Frame& F, const bf16* Wn, const bf16* U, const bf16* QG, const bf16* A, const bf16* KD, bf16* OT) {
    if (blockIdx.x >= 32) return;
    LAS unsigned char* L = F.lds; const float* glp = (const float*)(WSP() + WS_GL);
    const int bh = blockIdx.x, tid = F.tid, lane = F.lane, wave = F.wave;
    const int nn = lane & 15, g4 = lane >> 4;
#define OPB(buf, mat) ((LAS bf16*)(L + (buf) * 40960 + (mat) * 8192))
#define OST(buf) ((LAS bf16*)(L + 81920 + (buf) * 8192))
#define FRAG(base, ct, ks) (*(const LAS bf16x8*)((base) + ((ct) * 2 + (ks)) * 512 + lane * 8))
    LAS float* gll = (LAS float*)(L + 98304);
    if (tid < NCHUNK) gll[tid] = glp[bh * NCHUNK + tid];
    if (wave >= 4) {
        const int ht = tid - 256;
        const unsigned eo0 = (unsigned)(bh * NCHUNK) * 4096u + (unsigned)ht * 8u;
        const int lo0 = ht * 8, lo1 = lo0 + 2048;
        v4u ra[10], rb[10];
#define HLOAD(R, st) do { const unsigned o_ = eo0 + (unsigned)(st) * 4096u; R[0] = *(const v4u*)(Wn + o_); R[1] = *(const v4u*)(Wn + o_ + 2048); R[2] = *(const v4u*)(U + o_); R[3] = *(const v4u*)(U + o_ + 2048); \
        R[4] = *(const v4u*)(QG + o_); R[5] = *(const v4u*)(QG + o_ + 2048); R[6] = *(const v4u*)(A + o_); R[7] = *(const v4u*)(A + o_ + 2048); R[8] = *(const v4u*)(KD + o_); R[9] = *(const v4u*)(KD + o_ + 2048); } while (0)
#define HSTORE(R, buf) do { _Pragma("unroll") for (int mt_ = 0; mt_ < 5; ++mt_) { *(LAS v4u*)(OPB(buf, mt_) + lo0) = R[2 * mt_]; *(LAS v4u*)(OPB(buf, mt_) + lo1) = R[2 * mt_ + 1]; } } while (0)
#define OUT_STAGE(par, st) do { const v4u o0_ = *(const LAS v4u*)(OST(par) + lo0), o1_ = *(const LAS v4u*)(OST(par) + lo1); const unsigned oo_ = eo0 + (unsigned)(st) * 4096u; \
        *(v4u*)(OT + oo_) = o0_; *(v4u*)(OT + oo_ + 2048) = o1_; } while (0)
#define SB() __builtin_amdgcn_sched_barrier(0)
        HLOAD(ra, 0); HSTORE(ra, 0); HLOAD(ra, 1); HLOAD(rb, 2);
        SCAN_BAR();
        HSTORE(ra, 1); HLOAD(ra, 3);
        SCAN_BAR();
#pragma unroll 1
        for (int n = 1; n < NCHUNK - 1; n += 2) {
            const int l3 = (n + 3 < NCHUNK) ? n + 3 : NCHUNK - 1, l4 = (n + 4 < NCHUNK) ? n + 4 : NCHUNK - 1;
            HSTORE(rb, 0); SB(); HLOAD(rb, l3); SB(); OUT_STAGE(0, n - 1); SB();
            SCAN_BAR();
            HSTORE(ra, 1); SB(); HLOAD(ra, l4); SB(); OUT_STAGE(1, n); SB();
            SCAN_BAR();
        }
        OUT_STAGE(0, NCHUNK - 2);
        SCAN_BAR();
        OUT_STAGE(1, NCHUNK - 1);
#undef HLOAD
#undef HSTORE
#undef OUT_STAGE
#undef SB
    } else {
        const int cs = wave;
        f32x4 S[4];
#pragma unroll
        for (int t = 0; t < 4; ++t) S[t] = (f32x4){0.f, 0.f, 0.f, 0.f};
        SCAN_BAR();
#pragma unroll 1
        for (int n = 0; n < NCHUNK; ++n) {
            const int buf = n & 1; const float glast = gll[n];
            bf16x8 fw[4][2], fq[4][2];
            const v4u u01 = *(const LAS v4u*)(OPB(buf, 1) + (cs * 2 + 0) * 512 + lane * 8), u23 = *(const LAS v4u*)(OPB(buf, 1) + (cs * 2 + 1) * 512 + lane * 8);
#pragma unroll
            for (int ct = 0; ct < 4; ++ct) { fw[ct][0] = FRAG(OPB(buf, 0), ct, 0); fw[ct][1] = FRAG(OPB(buf, 0), ct, 1); fq[ct][0] = FRAG(OPB(buf, 2), ct, 0); fq[ct][1] = FRAG(OPB(buf, 2), ct, 1); }
            const bf16x8 sb0 = pack_b(S[0], S[1]), sb1 = pack_b(S[2], S[3]);
            f32x4 vn[4], oa[4];
            vn[0] = (f32x4){bflo(u01.x), bfhi(u01.x), bflo(u01.y), bfhi(u01.y)}; vn[1] = (f32x4){bflo(u01.z), bfhi(u01.z), bflo(u01.w), bfhi(u01.w)};
            vn[2] = (f32x4){bflo(u23.x), bfhi(u23.x), bflo(u23.y), bfhi(u23.y)}; vn[3] = (f32x4){bflo(u23.z), bfhi(u23.z), bflo(u23.w), bfhi(u23.w)};
#pragma unroll
            for (int ct = 0; ct < 4; ++ct) {
                f32x4 av = vn[ct], ao = (f32x4){0.f, 0.f, 0.f, 0.f};
                av = __builtin_amdgcn_mfma_f32_16x16x32_bf16(fw[ct][0], sb0, av, 0, 0, 0);
                ao = __builtin_amdgcn_mfma_f32_16x16x32_bf16(fq[ct][0], sb0, ao, 0, 0, 0);
                av = __builtin_amdgcn_mfma_f32_16x16x32_bf16(fw[ct][1], sb1, av, 0, 0, 0);
                ao = __builtin_amdgcn_mfma_f32_16x16x32_bf16(fq[ct][1], sb1, ao, 0, 0, 0);
                vn[ct] = av; oa[ct] = ao; }
            bf16x8 fa[4][2], fk[4][2];
#pragma unroll
            for (int ct = 0; ct < 4; ++ct) { fa[ct][0] = FRAG(OPB(buf, 3), ct, 0); fa[ct][1] = FRAG(OPB(buf, 3), ct, 1); fk[ct][0] = FRAG(OPB(buf, 4), ct, 0); fk[ct][1] = FRAG(OPB(buf, 4), ct, 1); }
            const bf16x8 vb0 = pack_b(vn[0], vn[1]), vb1 = pack_b(vn[2], vn[3]);
#pragma unroll
            for (int ct = 0; ct < 4; ++ct) {
                f32x4 ao = oa[ct], as = S[ct] * glast;
                as = __builtin_amdgcn_mfma_f32_16x16x32_bf16(fk[ct][0], vb0, as, 0, 0, 0);
                ao = __builtin_amdgcn_mfma_f32_16x16x32_bf16(fa[ct][0], vb0, ao, 0, 0, 0);
                as = __builtin_amdgcn_mfma_f32_16x16x32_bf16(fk[ct][1], vb1, as, 0, 0, 0);
                ao = __builtin_amdgcn_mfma_f32_16x16x32_bf16(fa[ct][1], vb1, ao, 0, 0, 0);
                S[ct] = as; oa[ct] = ao; }
            *(LAS v4u*)(OST(buf) + (cs * 2 + 0) * 512 + lane * 8) = (v4u){pk2(oa[0][0], oa[0][1]), pk2(oa[0][2], oa[0][3]), pk2(oa[1][0], oa[1][1]), pk2(oa[1][2], oa[1][3])};
            *(LAS v4u*)(OST(buf) + (cs * 2 + 1) * 512 + lane * 8) = (v4u){pk2(oa[2][0], oa[2][1]), pk2(oa[2][2], oa[2][3]), pk2(oa[3][0], oa[3][1]), pk2(oa[3][2], oa[3][3])};
            SCAN_BAR();
        }
    }
#undef OPB
#undef OST
#undef FRAG
}
#undef SCAN_BAR

__device__ __forceinline__ void phase_og(Frame& F, const bf16* OT, const bf16* Z, bf16* OG) {
    const float* onw = IN(I_OUTNORM);
    const int half = F.tid >> 8, ht = F.tid & 255, c = ht >> 2, p = ht & 3;
    LAS bf16* tile = (LAS bf16*)(F.lds + half * 8192);
    for (int it0 = blockIdx.x * 2; it0 < NITEM; it0 += F.G * 2) {
        const int it = it0 + half, bh = it >> 7, n = it & 127, b = bh >> 3, h = bh & 7, m0 = b * SEQ + n * 64;
        __syncthreads();
        { const v4u a0 = *(const v4u*)(OT + (size_t)it * 4096 + ht * 8), a1 = *(const v4u*)(OT + (size_t)it * 4096 + 2048 + ht * 8);
          *(LAS v4u*)(tile + ht * 8) = a0; *(LAS v4u*)(tile + 2048 + ht * 8) = a1; }
        const size_t zo = (size_t)(m0 + c) * 512 + h * 64 + 16 * p;
        const v4u z0 = *(const v4u*)(Z + zo), z1 = *(const v4u*)(Z + zo + 8);
        __syncthreads();
        float ov[16]; float ss = 0.f;
#pragma unroll
        for (int e = 0; e < 16; ++e) { ov[e] = bf2f(tile[fragoff(16 * p + e, c)]); ss += ov[e] * ov[e]; }
        ss += __shfl_xor(ss, 1); ss += __shfl_xor(ss, 2);
        const float rs = rsqrtf(ss * (1.f / 64.f) + EPS);
        const float zv[16] = {bflo(z0.x), bfhi(z0.x), bflo(z0.y), bfhi(z0.y), bflo(z0.z), bfhi(z0.z), bflo(z0.w), bfhi(z0.w), bflo(z1.x), bfhi(z1.x), bflo(z1.y), bfhi(z1.y), bflo(z1.z), bfhi(z1.z), bflo(z1.w), bfhi(z1.w)};
        float rr[16];
#pragma unroll
        for (int e = 0; e < 16; ++e) rr[e] = ov[e] * rs * onw[16 * p + e] * (zv[e] * sigmoidf_(zv[e]));
        v4u w0, w1; w0.x = pk2(rr[0], rr[1]); w0.y = pk2(rr[2], rr[3]); w0.z = pk2(rr[4], rr[5]); w0.w = pk2(rr[6], rr[7]); w1.x = pk2(rr[8], rr[9]); w1.y = pk2(rr[10], rr[11]); w1.z = pk2(rr[12], rr[13]); w1.w = pk2(rr[14], rr[15]);
        *(v4u*)(OG + zo) = w0; *(v4u*)(OG + zo + 8) = w1;
    }
}

__device__ __forceinline__ void phase_x1h2(Frame& F, const bf16* Y, bf16* H2) {
    LAS float* a1 = (LAS float*)F.lds; LAS float* g2 = a1 + 1024; LAS float* s2 = g2 + 1024;
    const float* xin = IN(I_X); const float* npost = IN(I_NPOSTMIX); const float* npre = IN(I_NPREFFN); const float* modf = (const float*)(WSP() + WS_MODF); float* outp = OUTP();
    for (int rb = blockIdx.x; rb < M / 128; rb += F.G) {
        const int row0 = rb * 128, b = row0 / SEQ;
        __syncthreads();
        for (int k = F.tid; k < 1024; k += NTHR) { a1[k] = modf[b * 6144 + 2048 + k] * npost[k]; g2[k] = npre[k] * (1.f + modf[b * 6144 + 4096 + k]); s2[k] = modf[b * 6144 + 3072 + k]; }
        __syncthreads();
        for (int r = 0; r < 16; ++r) { const int row = row0 + F.wave * 16 + r;
            const v2u* yr = (const v2u*)(Y + (size_t)row * D) + F.lane; const f32x4* xr = (const f32x4*)(xin + (size_t)row * D) + F.lane;
            f32x4 y[4], xv[4]; float ss = 0.f;
#pragma unroll
            for (int j = 0; j < 4; ++j) { const v2u t = yr[64 * j]; y[j] = (f32x4){bflo(t.x), bfhi(t.x), bflo(t.y), bfhi(t.y)}; xv[j] = xr[64 * j];
                ss += (y[j][0] * y[j][0] + y[j][1] * y[j][1]) + (y[j][2] * y[j][2] + y[j][3] * y[j][3]); }
            const float rstd = rsqrtf(wave_sum(ss) * (1.f / D) + EPS); float s1 = 0.f;
            f32x4* orow = (f32x4*)(outp + (size_t)row * D) + F.lane;
#pragma unroll
            for (int j = 0; j < 4; ++j) { const int k = 4 * F.lane + 256 * j; const f32x4 a = *(const LAS f32x4*)(a1 + k);
                xv[j] = xv[j] + a * (y[j] * rstd); orow[64 * j] = xv[j];
                s1 += (xv[j][0] * xv[j][0] + xv[j][1] * xv[j][1]) + (xv[j][2] * xv[j][2] + xv[j][3] * xv[j][3]); }
            const float rstd1 = rsqrtf(wave_sum(s1) * (1.f / D) + EPS);
            v2u* o8 = (v2u*)(H2 + (size_t)row * D) + F.lane;
#pragma unroll
            for (int j = 0; j < 4; ++j) { const int k = 4 * F.lane + 256 * j; const f32x4 g = *(const LAS f32x4*)(g2 + k), s = *(const LAS f32x4*)(s2 + k);
                v2u o; o.x = pk2(xv[j][0] * rstd1 * g[0] + s[0], xv[j][1] * rstd1 * g[1] + s[1]); o.y = pk2(xv[j][2] * rstd1 * g[2] + s[2], xv[j][3] * rstd1 * g[3] + s[3]); o8[64 * j] = o; }
        }
    }
}

__device__ __forceinline__ unsigned mono(float f) { const unsigned u = __float_as_uint(f); return u ^ ((unsigned)((int)u >> 31) | 0x80000000u); }
__device__ __forceinline__ float unmono(unsigned k) { return __uint_as_float((k & 0x80000000u) ? (k ^ 0x80000000u) : ~k); }
#define CE_DESC(a, b) do { const unsigned _mx = max((a), (b)), _mn = min((a), (b)); (a) = _mx; (b) = _mn; } while (0)
__device__ __forceinline__ void top16_of_64(unsigned (&x)[64]) {
#pragma unroll
    for (int g = 0; g < 4; ++g)
#pragma unroll
        for (int k = 2; k <= 16; k <<= 1)
#pragma unroll
            for (int j = k >> 1; j > 0; j >>= 1)
#pragma unroll
                for (int i = 0; i < 16; ++i) { const int l = i ^ j; if (l > i) { if ((i & k) == 0) CE_DESC(x[16 * g + i], x[16 * g + l]); else CE_DESC(x[16 * g + l], x[16 * g + i]); } }
#pragma unroll
    for (int s = 0; s < 3; ++s) { const int a = (s == 1) ? 32 : 0, b2 = (s == 0) ? 16 : (s == 1 ? 48 : 32);
#pragma unroll
        for (int i = 0; i < 16; ++i) x[a + i] = max(x[a + i], x[b2 + 15 - i]);
#pragma unroll
        for (int j = 8; j > 0; j >>= 1)
#pragma unroll
            for (int i = 0; i < 16; ++i) { const int l = i ^ j; if (l > i) CE_DESC(x[a + i], x[a + l]); } }
}
__device__ __forceinline__ void phase_topk(Frame& F, const bf16* Q2, int* EI, float* GA) {
    const int lane = F.lane, wave = F.wave, r = lane & 31, hh = lane >> 5, tsub = wave & 3, hgrp = wave >> 2;
    const bf16* skp = (const bf16*)(WSP() + WS_SK);
    LAS unsigned char* itab = F.lds + wave * 1024;
    for (int tile = blockIdx.x; tile < M / 128; tile += F.G) {
        const int m = tile * 128 + tsub * 32 + r;
#pragma unroll 1
        for (int hd = 0; hd < 4; ++hd) { const int h = hgrp * 4 + hd;
            unsigned k12[2][16];
#pragma unroll
            for (int p = 0; p < 2; ++p) {
                bf16x8 bq[8];
#pragma unroll
                for (int ks = 0; ks < 8; ++ks) bq[ks] = *(const bf16x8*)(Q2 + (size_t)m * 2048 + h * 256 + p * 128 + ks * 16 + hh * 8);
                unsigned keys[64];
#pragma unroll
                for (int kt = 0; kt < 4; ++kt) {
                    f32x16 acc;
#pragma unroll
                    for (int i = 0; i < 16; ++i) acc[i] = 0.f;
                    const bf16* skr = skp + ((size_t)(h * 2 + p) * 128 + kt * 32 + r) * 128 + hh * 8;
#pragma unroll
                    for (int ks = 0; ks < 8; ++ks) { const bf16x8 a = *(const bf16x8*)(skr + ks * 16); acc = __builtin_amdgcn_mfma_f32_32x32x16_bf16(a, bq[ks], acc, 0, 0, 0); }
#pragma unroll
                    for (int i = 0; i < 16; ++i) { const int keyidx = kt * 32 + (i & 3) + 8 * (i >> 2) + 4 * hh; keys[kt * 16 + i] = (mono(acc[i]) & ~127u) | (unsigned)(127 - keyidx); }
                }
                top16_of_64(keys);
                unsigned oth[16];
#pragma unroll
                for (int i = 0; i < 16; ++i) oth[i] = (unsigned)__shfl_xor((int)keys[i], 32);
#pragma unroll
                for (int i = 0; i < 16; ++i) keys[i] = max(keys[i], oth[15 - i]);
#pragma unroll
                for (int j = 8; j > 0; j >>= 1)
#pragma unroll
                    for (int i = 0; i < 16; ++i) { const int l = i ^ j; if (l > i) CE_DESC(keys[i], keys[l]); }
#pragma unroll
                for (int i = 0; i < 16; ++i) k12[p][i] = keys[i];
            }
            float v1[16], v2[16];
#pragma unroll
            for (int i = 0; i < 16; ++i) { v1[i] = unmono(k12[0][i] & ~127u); v2[i] = unmono(k12[1][i] & ~127u); }
            if (hh == 0) {
                v4u w0, w1;
#define PK4(K, b) ((127u - ((K)[b] & 127u)) | ((127u - ((K)[b + 1] & 127u)) << 8) | ((127u - ((K)[b + 2] & 127u)) << 16) | ((127u - ((K)[b + 3] & 127u)) << 24))
                w0.x = PK4(k12[0], 0); w0.y = PK4(k12[0], 4); w0.z = PK4(k12[0], 8); w0.w = PK4(k12[0], 12);
                w1.x = PK4(k12[1], 0); w1.y = PK4(k12[1], 4); w1.z = PK4(k12[1], 8); w1.w = PK4(k12[1], 12);
#undef PK4
                *(LAS v4u*)(itab + r * 32) = w0; *(LAS v4u*)(itab + r * 32 + 16) = w1; }
            unsigned ck[64];
            { int nn = 0;
#pragma unroll
              for (int i = 0; i < 16; ++i)
#pragma unroll
                  for (int j = 0; j < 16; ++j) if ((i + 1) * (j + 1) <= 16) { ck[nn] = (mono(v1[i] + v2[j]) & ~255u) | (unsigned)(255 - (i * 16 + j)); ++nn; }
#pragma unroll
              for (int q = 50; q < 64; ++q) ck[q] = 0u; }
            top16_of_64(ck);
            asm volatile("s_waitcnt lgkmcnt(0)" ::: "memory");
            float ts[16], es[16]; int ei[16]; float sum = 0.f;
#pragma unroll
            for (int q = 0; q < 16; ++q) { ts[q] = unmono(ck[q] & ~255u); const unsigned pos = 255u - (ck[q] & 255u);
                const unsigned e1 = itab[r * 32 + (pos >> 4)], e2 = itab[r * 32 + 16 + (pos & 15u)]; ei[q] = (int)(e1 * 128u + e2); }
#pragma unroll
            for (int q = 0; q < 16; ++q) { es[q] = __expf(ts[q] - ts[0]); sum += es[q]; }
            const float inv = 1.0f / sum;
            int eo[8]; float go[8];
#pragma unroll
            for (int q = 0; q < 8; ++q) { eo[q] = hh ? ei[q + 8] : ei[q]; go[q] = (hh ? es[q + 8] : es[q]) * inv; }
            int* ep = EI + (size_t)m * 128 + h * 16 + hh * 8; float* gp = GA + (size_t)m * 128 + h * 16 + hh * 8;
            *(v4u*)ep = (v4u){(unsigned)eo[0], (unsigned)eo[1], (unsigned)eo[2], (unsigned)eo[3]}; *(v4u*)(ep + 4) = (v4u){(unsigned)eo[4], (unsigned)eo[5], (unsigned)eo[6], (unsigned)eo[7]};
            *(f32x4*)gp = (f32x4){go[0], go[1], go[2], go[3]}; *(f32x4*)(gp + 4) = (f32x4){go[4], go[5], go[6], go[7]};
            asm volatile("s_waitcnt lgkmcnt(0)" ::: "memory");
        }
    }
}

struct RowBuf { v4u ua; v2u ub; v4u va; v2u vb; float su, svg; };
__device__ __forceinline__ void gather_load(RowBuf& B, int step, int g, int j, int e_lo, int e_hi, float g_lo, float g_hi, const unsigned char* tu, const unsigned char* tv, const float* su, const float* sv) {
    const int src = (step * 2 + g) & 63;
    const int eidx = __shfl(step < 32 ? e_lo : e_hi, src); const float gate = __shfl(step < 32 ? g_lo : g_hi, src);
    const unsigned char* ur = tu + (size_t)eidx * 768; const unsigned char* vr = tv + (size_t)eidx * 768;
    B.ua = *(const v4u*)(ur + 16 * j); B.ub = *(const v2u*)(ur + 512 + 8 * j); B.va = *(const v4u*)(vr + 16 * j); B.vb = *(const v2u*)(vr + 512 + 8 * j);
    B.su = su[eidx]; B.svg = gate * sv[eidx];
}
__device__ __forceinline__ void gather_compute(const RowBuf& B, const unsigned (&hp)[16], float (&y)[32]) {
    const f32x32 ru = __builtin_amdgcn_cvt_scalef32_pk32_f32_fp6((u32x6){B.ua.x, B.ua.y, B.ua.z, B.ua.w, B.ub.x, B.ub.y}, 1.0f);
    float d0 = 0.f, d1 = 0.f, d2 = 0.f, d3 = 0.f;
#pragma unroll
    for (int q = 0; q < 8; ++q) { d0 += ru[4 * q] * bflo(hp[2 * q]); d1 += ru[4 * q + 1] * bfhi(hp[2 * q]); d2 += ru[4 * q + 2] * bflo(hp[2 * q + 1]); d3 += ru[4 * q + 3] * bfhi(hp[2 * q + 1]); }
    float d = (d0 + d1) + (d2 + d3);
    d += __shfl_xor(d, 1); d += __shfl_xor(d, 2); d += __shfl_xor(d, 4); d += __shfl_xor(d, 8); d += __shfl_xor(d, 16);
    d *= B.su;
    const float wgt = B.svg * 0.5f * d * (1.0f + erff(d * 0.70710678118654752f));
    __builtin_amdgcn_sched_barrier(0);
    const f32x32 rv = __builtin_amdgcn_cvt_scalef32_pk32_f32_fp6((u32x6){B.va.x, B.va.y, B.va.z, B.va.w, B.vb.x, B.vb.y}, 1.0f);
#pragma unroll
    for (int q = 0; q < 32; ++q) y[q] += wgt * rv[q];
}
__device__ __forceinline__ void phase_gather(Frame& F, const bf16* H2, const int* EI, const float* GA) {
    LAS float* a2 = (LAS float*)F.lds;
    LAS bf16* hrow = (LAS bf16*)(F.lds + 16384 + F.wave * 2048);
    LAS float* yrow = (LAS float*)(F.lds + 16384 + 16384 + F.wave * 4096);
    LAS unsigned* ptab = (LAS unsigned*)(F.lds + 16384 + 16384 + 32768 + F.wave * 128);
    unsigned char* ws = WSP(); const unsigned char* tu = ws + WS_TU; const unsigned char* tv = ws + WS_TV; const float* su = (const float*)(ws + WS_SU); const float* sv = (const float*)(ws + WS_SV); float* outp = OUTP();
    const float* npf = IN(I_NPOSTFFN); const float* modf = (const float*)(ws + WS_MODF); unsigned* qctr = (unsigned*)(ws + WS_CTL) + 32;
    const int lane = F.lane, g = lane >> 5, j = lane & 31;
    {
        f32x16v pa, pb;
#pragma unroll
        for (int i = 0; i < 16; ++i) { pa[i] = 0.125f * (float)i; pb[i] = (i < 8) ? 2.0f + 0.25f * (float)i : 4.0f + 0.5f * (float)(i - 8); }
        const f32x32 pr = __builtin_amdgcn_cvt_scalef32_pk32_f32_fp6(__builtin_amdgcn_cvt_scalef32_2xpk16_fp6_f32(pa, pb, 1.0f), 1.0f);
#pragma unroll
        for (int q = 0; q < 32; ++q) { const float v = pr[q]; int idx = (v < 2.0f) ? (int)(v * 8.0f + 0.5f) : (v < 4.0f) ? 16 + (int)((v - 2.0f) * 4.0f + 0.5f) : 24 + (int)((v - 4.0f) * 2.0f + 0.5f);
            idx = idx < 0 ? 0 : (idx > 31 ? 31 : idx); if (lane == 0) ptab[q] = (unsigned)idx; }
    }
    for (int k = F.tid; k < 4096; k += NTHR) a2[k] = modf[(k >> 10) * 6144 + 5120 + (k & 1023)] * npf[k & 1023];
    __syncthreads();
    {
        for (;;) { unsigned tk = 0u; if (lane == 0) tk = __hip_atomic_fetch_add(qctr, 1u, __ATOMIC_RELAXED, __HIP_MEMORY_SCOPE_AGENT);
            const int m = __builtin_amdgcn_readfirstlane((int)tk); if (m >= M) break; const int b = m / SEQ;
            { const v4u h0 = *(const v4u*)(H2 + (size_t)m * D + 16 * lane), h1 = *(const v4u*)(H2 + (size_t)m * D + 16 * lane + 8);
              *(LAS v4u*)(hrow + 16 * lane) = h0; *(LAS v4u*)(hrow + 16 * lane + 8) = h1; }
            const int e_lo = EI[(size_t)m * 128 + lane], e_hi = EI[(size_t)m * 128 + 64 + lane];
            const float g_lo = GA[(size_t)m * 128 + lane], g_hi = GA[(size_t)m * 128 + 64 + lane];
            asm volatile("s_waitcnt lgkmcnt(0)" ::: "memory");
            unsigned hp[16];
#pragma unroll
            for (int q = 0; q < 16; ++q) hp[q] = (unsigned)hrow[32 * j + ptab[2 * q]] | ((unsigned)hrow[32 * j + ptab[2 * q + 1]] << 16);
            float y[32];
#pragma unroll
            for (int q = 0; q < 32; ++q) y[q] = 0.f;
            RowBuf B0, B1, B2, B3;
#define GLOAD(B, st) gather_load(B, (st), g, j, e_lo, e_hi, g_lo, g_hi, tu, tv, su, sv)
#define SB() __builtin_amdgcn_sched_barrier(0)
            GLOAD(B0, 0); GLOAD(B1, 1); GLOAD(B2, 2);
#pragma unroll 1
            for (int st = 0; st < 64; st += 4) {
                const int s4 = (st + 4 < 64) ? st + 4 : 63, s5 = (st + 5 < 64) ? st + 5 : 63, s6 = (st + 6 < 64) ? st + 6 : 63;
                GLOAD(B3, st + 3); SB(); gather_compute(B0, hp, y); SB();
                GLOAD(B0, s4); SB(); gather_compute(B1, hp, y); SB();
                GLOAD(B1, s5); SB(); gather_compute(B2, hp, y); SB();
                GLOAD(B2, s6); SB(); gather_compute(B3, hp, y); SB();
            }
#undef GLOAD
#undef SB
            float ss = 0.f;
#pragma unroll
            for (int q = 0; q < 32; ++q) { y[q] += __shfl_xor(y[q], 32); ss += y[q] * y[q]; }
            ss += __shfl_xor(ss, 1); ss += __shfl_xor(ss, 2); ss += __shfl_xor(ss, 4); ss += __shfl_xor(ss, 8); ss += __shfl_xor(ss, 16);
            const float rstd = rsqrtf(ss * (1.f / D) + EPS);
            if (g == 0) {
#pragma unroll
                for (int q = 0; q < 32; ++q) yrow[32 * j + ptab[q]] = y[q]; }
            asm volatile("s_waitcnt lgkmcnt(0)" ::: "memory");
            const int k = 32 * j + 16 * g;
            f32x4* op = (f32x4*)(outp + (size_t)m * D + k);
#pragma unroll
            for (int q = 0; q < 4; ++q) { f32x4 xv = op[q]; const f32x4 av = *(const LAS f32x4*)(a2 + b * 1024 + k + 4 * q), yv = *(const LAS f32x4*)(yrow + k + 4 * q);
                xv = xv + av * yv * rstd; op[q] = xv; }
            asm volatile("s_waitcnt lgkmcnt(0)" ::: "memory");
        }
    }
}

typedef GAS unsigned gu32;
#define XB_TMO      128
#define XB_XCNT(j)  (256  + 64 * (j))
#define XB_XSUB(j)  (1280 + 64 * (j))
#define XB_XGEN(j)  (2304 + 64 * (j))
#define XB_TOP      3328
#define XB_TOPGEN   3392
#define XCD_BAR_WORDS 3456
#define XB_SPIN_CAP (1u << 18)

__device__ __forceinline__ unsigned xb_ld(unsigned* p)              { return __hip_atomic_load(p, __ATOMIC_RELAXED, __HIP_MEMORY_SCOPE_AGENT); }
__device__ __forceinline__ unsigned xb_add(unsigned* p, unsigned v) { return __hip_atomic_fetch_add(p, v, __ATOMIC_RELAXED, __HIP_MEMORY_SCOPE_AGENT); }
__device__ __forceinline__ unsigned xb_xcc_id() { return (unsigned)__builtin_amdgcn_s_getreg((3 << 11) | 20) & 0xFu; }
#define XB_SPIN(cond, bar) do { unsigned _sp = 0; while (cond) { __builtin_amdgcn_s_sleep(1); \
    if ((++_sp & 255u) == 0u) { if (xb_ld(&(bar)[XB_TMO])) break; if (_sp > XB_SPIN_CAP) { atomicAdd(&(bar)[XB_TMO], 1u); break; } } } } while (0)

struct XcdBarrier {
    unsigned* bar; unsigned x;
    volatile LAS unsigned* st;
};

__device__ __forceinline__ XcdBarrier xcd_barrier_post(unsigned* bar, volatile LAS unsigned* st) {
    XcdBarrier b; b.bar = bar; b.x = xb_xcc_id(); b.st = st;
    if (threadIdx.x == 0) (void)xb_add(&bar[XB_XCNT(b.x)], 1u);
    return b;
}
__device__ __forceinline__ void xcd_barrier_complete(unsigned* bar, unsigned x, unsigned& nloc, unsigned& nx) {
    const unsigned G = gridDim.x * gridDim.y * gridDim.z;
    unsigned sum, cnt, mine, sp = 0u;
    for (;;) {
        sum = 0u; cnt = 0u; mine = 0u;
#pragma unroll
        for (unsigned j = 0; j < 16; ++j) { const unsigned c = xb_ld(&bar[XB_XCNT(j)]); sum += c; cnt += (c > 0u) ? 1u : 0u; mine = (j == x) ? c : mine; }
        if (sum == G) break;
        __builtin_amdgcn_s_sleep(1);
        if ((++sp & 255u) == 0u) { if (xb_ld(&bar[XB_TMO])) break; if (sp > XB_SPIN_CAP) { atomicAdd(&bar[XB_TMO], 1u); break; } }
    }
    nloc = mine > 0u ? mine : 1u; nx = cnt > 0u ? cnt : 1u;
}

__device__ __forceinline__ void xcd_barrier(const XcdBarrier& b) {
    asm volatile("s_waitcnt vmcnt(0)" ::: "memory");
    __syncthreads();
    if (threadIdx.x == 0) {
        unsigned* bar = b.bar;
        __builtin_amdgcn_s_waitcnt(0);
        unsigned nloc = b.st[0], nx = b.st[1];
        if (nloc == 0u) { xcd_barrier_complete(bar, b.x, nloc, nx); b.st[0] = nloc; b.st[1] = nx; }
        const unsigned old = xb_add(&bar[XB_XSUB(b.x)], 1u);
        const unsigned gen = old / nloc;
        if (old + 1u == (gen + 1u) * nloc) {
            __builtin_amdgcn_fence(__ATOMIC_RELEASE, "agent");
            asm volatile("s_waitcnt vmcnt(0)" ::: "memory");
            const unsigned og = xb_add(&bar[XB_TOP], 1u);
            const unsigned tg = og / nx;
            if (og + 1u == (tg + 1u) * nx) xb_add(&bar[XB_TOPGEN], 1u);
            else XB_SPIN(xb_ld(&bar[XB_TOPGEN]) == tg, bar);
            __builtin_amdgcn_fence(__ATOMIC_ACQUIRE, "agent");
            xb_add(&bar[XB_XGEN(b.x)], 1u);
            asm volatile("s_waitcnt vmcnt(0)" ::: "memory");
        } else {
            XB_SPIN(xb_ld(&bar[XB_XGEN(b.x)]) == gen, bar);
            __builtin_amdgcn_fence(__ATOMIC_ACQUIRE, "agent");
            asm volatile("s_waitcnt vmcnt(0)" ::: "memory");
        }
    }
    __syncthreads();
}

struct Args { const float* in[21]; float* out; unsigned char* ws; };
__global__ void __launch_bounds__(NTHR, 2) fwd_megakernel(Args args) {
    extern __shared__ __attribute__((aligned(16))) unsigned char lds[];
#define MKFRAME() Frame F; { int t_ = threadIdx.x; asm volatile("" : "+v"(t_)); F.lds = (LAS unsigned char*)lds; F.tid = t_; F.lane = t_ & 63; F.wave = __builtin_amdgcn_readfirstlane(t_ >> 6); F.G = gridDim.x; }
#define GRID_SYNC() cg::this_grid().sync()
    volatile LAS unsigned* bst = (volatile LAS unsigned*)((LAS unsigned char*)lds + LDS_BYTES - 64);
    if (threadIdx.x < 16) bst[threadIdx.x] = 0u;
    __syncthreads();
    const XcdBarrier xbar = xcd_barrier_post((unsigned*)(WSP() + WS_CTL) + 1024, bst);
#define XSYNC() xcd_barrier(xbar)
#define WSB(off) ((bf16*)(WSP() + (off)))
#define SEGP(s) segp(WSP(), (s))
    { MKFRAME();
    phase_prologue(F);
    }
    GRID_SYNC();
    { MKFRAME();
    phase_h1(F, (bf16*)OUTP());
    }
    XSYNC();
    { MKFRAME();
    {
        pg8::Gemm g{(const bf16*)OUTP(), WSB(WS_WIN), M, NIN, D}; pg8::StaticOrder S; S.init(M, NIN, F.G, (int)blockIdx.x);
        pg8::EpiBf16<0> E{SEGP(0), 512, nullptr, 512, SEG_ELEMS, 1.f};
        pg8::gemm_phase<pg8::EpiBf16<0>, pg8::StaticOrder, true, true>(F.lds, g, S, E);
    }
    }
    XSYNC();
    { MKFRAME();
    phase_scprep(F);
    { bf16* dW = (bf16*)OUTP(); phase_dnprep(F, dW, dW + (size_t)NITEM * 4096, dW + (size_t)2 * NITEM * 4096, dW + (size_t)3 * NITEM * 4096, WSB(WS_KD)); }
    }
    XSYNC();
    { MKFRAME();
    { const bf16* dW = (const bf16*)OUTP(); phase_scan(F, dW, dW + (size_t)NITEM * 4096, dW + (size_t)2 * NITEM * 4096, dW + (size_t)3 * NITEM * 4096, WSB(WS_KD), SEGP(3)); }
    if (blockIdx.x >= 32) {
        { pg8::StaticOrder S; S.init(M, D, F.G - 32, (int)blockIdx.x - 32);
          pg8::Gemm g{SEGP(0), WSB(WS_WSC), M, D, 512}; pg8::EpiGate<false> E{SEGP(4), SEGP(7), SEG_ELEMS};
          pg8::gemm_phase<pg8::EpiGate<false>, pg8::StaticOrder, true, true>(F.lds, g, S, E); }
        __syncthreads();
        unsigned char* ws = WSP(); LAS float* scr6 = (LAS float*)(F.lds + F.wave * 9216);
        const int gw = (blockIdx.x - 32) * NWAVES + F.wave, NGW = (F.G - 32) * NWAVES;
        p0_table_fp6(IN(I_PU), ws + WS_TU, (float*)(ws + WS_SU), scr6, gw, NGW, F.lane);
        p0_table_fp6(IN(I_PV), ws + WS_TV, (float*)(ws + WS_SV), scr6, gw, NGW, F.lane);
    }
    }
    XSYNC();
    { MKFRAME();
    phase_og(F, SEGP(3), SEGP(6), SEGP(11));
    }
    XSYNC();
    { MKFRAME();
    {
        pg8::StaticOrder S; S.init(M, D, F.G, (int)blockIdx.x);
        { pg8::Gemm g{SEGP(11), WSB(WS_WDN), M, D, 512}; pg8::EpiGate<true> E{SEGP(4), SEGP(9), SEG_ELEMS};
          pg8::gemm_phase<pg8::EpiGate<true>, pg8::StaticOrder, true, true>(F.lds, g, S, E); }
    }
    }
    XSYNC();
    { MKFRAME();
    {
        pg8::Gemm g{SEGP(4), WSB(WS_WMIX), M, D, D}; pg8::StaticOrder S; S.init(M, D, F.G, (int)blockIdx.x);
        pg8::EpiBf16<0> E{SEGP(1), D, nullptr, 0, 0, 1.f};
        pg8::gemm_phase<pg8::EpiBf16<0>, pg8::StaticOrder, true, true>(F.lds, g, S, E);
    }
    }
    XSYNC();
    { MKFRAME();
    phase_x1h2(F, SEGP(1), SEGP(7));
    }
    XSYNC();
    { MKFRAME();
    {
        pg8::Gemm g{SEGP(7), WSB(WS_WQ), M, 2048, D}; pg8::StaticOrder S; S.init(M, 2048, F.G, (int)blockIdx.x);
        pg8::EpiBf16<0> E{SEGP(3), 2048, nullptr, 0, 0, 1.f};
        pg8::gemm_phase<pg8::EpiBf16<0>, pg8::StaticOrder, true, true>(F.lds, g, S, E);
    }
    }
    XSYNC();
    { MKFRAME();
    phase_topk(F, SEGP(3), (int*)SEGP(0), (float*)((unsigned char*)SEGP(0) + 16 * MiB));
    }
    XSYNC();
    { MKFRAME();
    phase_gather(F, SEGP(7), (const int*)SEGP(0), (const float*)((unsigned char*)SEGP(0) + 16 * MiB));
    }
}

extern "C" void kernel_launch(void* const* d_in, const int* in_sizes, int n_in, void* d_out, int out_size, void* d_ws, size_t ws_size, hipStream_t stream) {
    static int grid = 0;
    if (grid == 0) {
        if (n_in != 21 || out_size != M * D || ws_size < WS_END) { fprintf(stderr, "kernel_launch: unexpected problem (n_in %d, out %d, ws %zu)\n", n_in, out_size, ws_size); grid = -1; return; }
        int dev = 0, cus = 0, per_cu = 0;
        hipGetDevice(&dev); hipDeviceGetAttribute(&cus, hipDeviceAttributeMultiprocessorCount, dev);
        hipFuncSetAttribute((const void*)fwd_megakernel, hipFuncAttributeMaxDynamicSharedMemorySize, LDS_BYTES);
        hipOccupancyMaxActiveBlocksPerMultiprocessor(&per_cu, (const void*)fwd_megakernel, NTHR, LDS_BYTES);
        if (per_cu < 1) { fprintf(stderr, "kernel_launch: occupancy query says %d blocks per CU\n", per_cu); per_cu = 1; }
        if (per_cu > 1) per_cu = 1;
        grid = cus * per_cu; if (grid > 256) grid = 256;
        (void)hipGetLastError();
    }
    if (grid < 0) return;
    if (hipMemsetAsync((char*)d_ws + WS_CTL, 0, 65536, stream) != hipSuccess) { fprintf(stderr, "kernel_launch: memset of the barrier words failed\n"); return; }
    Args a{};
    for (int i = 0; i < 21; ++i) a.in[i] = (const float*)d_in[i];
    a.out = (float*)d_out; a.ws = (unsigned char*)d_ws;
    void* kargs[] = {&a};
    hipError_t e = hipLaunchCooperativeKernel((const void*)fwd_megakernel, dim3(grid), dim3(NTHR), kargs, LDS_BYTES, stream);
    if (e != hipSuccess) fprintf(stderr, "cooperative launch failed: %s (grid %d)\n", hipGetErrorString(e), grid);
}
```

```cpp
#include <hip/hip_runtime.h>
#include <hip/hip_cooperative_groups.h>
#include <cstdio>
#include <cstdint>
namespace cg = cooperative_groups;
namespace pg8 {
#define PG8_LAS __attribute__((address_space(3)))
typedef unsigned short bf16_t;
typedef short bf16x8 __attribute__((ext_vector_type(8)));
typedef float f32x4 __attribute__((ext_vector_type(4)));
typedef unsigned u32x4 __attribute__((ext_vector_type(4)));
constexpr int BM = 256, BK = 64, HALF = 128, HTB = HALF * BK * 2  , STAGE_BYTES = 8 * HTB, NXCD = 8, WGM = 8;

__host__ __device__ __forceinline__ int lds_byte(int r, int c) { const int st = (r >> 4) * 2 + (c >> 5), rr = r & 15, cc = c & 31, ob = rr * 64 + cc * 2; return st * 1024 + (ob ^ (((ob >> 9) & 1) << 5)); }
__host__ __device__ __forceinline__ void stage_rc(int b, int& R, int& C) { const int st = b / 1024, sb = b % 1024, swz = sb ^ (((sb >> 9) & 1) << 5); R = (st >> 1) * 16 + swz / 64; C = (st & 1) * 32 + (swz % 64) / 2; }
__host__ __device__ __forceinline__ int perm32(int rho) { const int n = rho >> 4, i = rho & 15; return 8 * (i >> 2) + 4 * n + (i & 3); }

struct Unit { int pm, pn; };
struct Gemm { const bf16_t* A; const bf16_t* Bt; int M, N, K; };

struct StaticOrder {
    int nM, nN, nwg, G, c;
    __host__ __device__ void init(int M, int N, int G_, int c_) { nM = M / BM; nN = N / BM; nwg = nM * nN; G = G_; c = c_; }
    __host__ __device__ bool next(int i, Unit& u) const {
        const long L = (long)i * G + c; if (L >= nwg) return false;
        int wgid = (int)L; { const int q = nwg / NXCD, r = nwg % NXCD, xcd = wgid % NXCD, off = wgid / NXCD; wgid = (xcd < r ? xcd * (q + 1) : r * (q + 1) + (xcd - r) * q) + off; }
        const int nig = WGM * nN, gid = wgid / nig, fm = gid * WGM, gsz = (nM - fm) < WGM ? (nM - fm) : WGM;
        u.pm = fm + ((wgid % nig) % gsz); u.pn = (wgid % nig) / gsz; return true;
    }
    __device__ __forceinline__ void a_ready(const Unit&) const {}
    __device__ __forceinline__ void done(const Unit&) const {}
};

__device__ __forceinline__ unsigned cvt_pk_bf16(float lo, float hi) { unsigned r; asm volatile("v_cvt_pk_bf16_f32 %0, %1, %2" : "=v"(r) : "v"(lo), "v"(hi)); return r; }
typedef float f32x2 __attribute__((ext_vector_type(2)));
__device__ __forceinline__ f32x2 gelu_pk(f32x2 v) {
    const f32x2 av = __builtin_elementwise_abs(v), d = av * 0.2316418882f + 1.0f;
    f32x2 t; t.x = __builtin_amdgcn_rcpf(d.x); t.y = __builtin_amdgcn_rcpf(d.y);
    f32x2 q = t * 0.5307027145f + (-0.7265760135f); q = q * t + 0.7107068705f; q = q * t + (-0.142248368f); q = q * t + 0.127414796f; q = q * t;
    const f32x2 s = (v * v) * (-0.72134752044f);
    f32x2 e; e.x = __builtin_amdgcn_exp2f(s.x); e.y = __builtin_amdgcn_exp2f(s.y);
    const f32x2 m = v * (q * e), r = v - m;
    f32x2 o; o.x = v.x < 0.f ? m.x : r.x; o.y = v.y < 0.f ? m.y : r.y; return o;
}

template <int ACT  > struct EpiBf16 {
    static constexpr bool PERM = true, AFTER_DRAIN = false; static_assert(ACT == 0 || ACT == 1, "EpiBf16: ACT is 0 (none) or 1 (gelu_pk)");
    bf16_t* O; int ldc; const float* bias; int split_cols; size_t split_stride; float scale0;
    __device__ __forceinline__ void operator()(const f32x4 (&acc)[2][2][4][2], const Unit& u, int wr, int wc, int fr, int fq) const {
        const int row0 = u.pm * BM + wr * 64 + fr; int colt = u.pn * BM; bf16_t* base = O;
        float sc = 1.f; if (split_cols) { const int t = colt / split_cols; base += (size_t)t * split_stride; colt -= t * split_cols; if (t == 0) sc = scale0; }
        const int col0 = colt + wc * 32 + 8 * fq, bcol0 = u.pn * BM + wc * 32 + 8 * fq;
        f32x4 bv[2][2];
#pragma unroll
        for (int bj = 0; bj < 2; ++bj)
#pragma unroll
            for (int n = 0; n < 2; ++n) bv[bj][n] = bias ? *(const f32x4*)(bias + bcol0 + bj * HALF + 4 * n) : (f32x4){0.f, 0.f, 0.f, 0.f};
#pragma unroll
        for (int ai = 0; ai < 2; ++ai)
#pragma unroll
            for (int m = 0; m < 4; ++m) { bf16_t* rowp = base + (size_t)(row0 + ai * HALF + m * 16) * ldc + col0;
#pragma unroll
                for (int bj = 0; bj < 2; ++bj) { f32x4 v0 = acc[ai][bj][m][0] + bv[bj][0], v1 = acc[ai][bj][m][1] + bv[bj][1];
                    if (ACT == 1) { f32x2 a = gelu_pk((f32x2){v0[0], v0[1]}), b = gelu_pk((f32x2){v0[2], v0[3]}), c = gelu_pk((f32x2){v1[0], v1[1]}), d = gelu_pk((f32x2){v1[2], v1[3]});
                        v0 = (f32x4){a.x, a.y, b.x, b.y}; v1 = (f32x4){c.x, c.y, d.x, d.y}; }
                    v0 = v0 * sc; v1 = v1 * sc; u32x4 w; w.x = cvt_pk_bf16(v0[0], v0[1]); w.y = cvt_pk_bf16(v0[2], v0[3]); w.z = cvt_pk_bf16(v1[0], v1[1]); w.w = cvt_pk_bf16(v1[2], v1[3]);
                    *(u32x4*)(rowp + bj * HALF) = w; } }
    }
};
__device__ __forceinline__ float bf_lo(unsigned u) { return __uint_as_float(u << 16); }
__device__ __forceinline__ float bf_hi(unsigned u) { return __uint_as_float(u & 0xffff0000u); }
__device__ __forceinline__ float sigm(float x) { return __builtin_amdgcn_rcpf(1.0f + __builtin_amdgcn_exp2f(-1.4426950408889634f * x)); }
template <bool ADD> struct EpiGate {
    static constexpr bool PERM = true, AFTER_DRAIN = false;
    bf16_t* O; const bf16_t* gate; size_t seg_elems;
    __device__ __forceinline__ void operator()(const f32x4 (&acc)[2][2][4][2], const Unit& u, int wr, int wc, int fr, int fq) const {
        const int row0 = u.pm * BM + wr * 64 + fr, col0 = u.pn * BM + wc * 32 + 8 * fq;
#pragma unroll
        for (int ai = 0; ai < 2; ++ai)
#pragma unroll
            for (int m = 0; m < 4; ++m) { const int row = row0 + ai * HALF + m * 16;
#pragma unroll
                for (int bj = 0; bj < 2; ++bj) { const int col = col0 + bj * HALF;
                    const u32x4 gv = *(const u32x4*)(gate + (size_t)(col >> 9) * seg_elems + (size_t)row * 512 + (col & 511));
                    bf16_t* op = O + (size_t)row * 1024 + col;
                    f32x4 v0 = acc[ai][bj][m][0], v1 = acc[ai][bj][m][1];
                    v0[0] *= sigm(bf_lo(gv.x)); v0[1] *= sigm(bf_hi(gv.x)); v0[2] *= sigm(bf_lo(gv.y)); v0[3] *= sigm(bf_hi(gv.y));
                    v1[0] *= sigm(bf_lo(gv.z)); v1[1] *= sigm(bf_hi(gv.z)); v1[2] *= sigm(bf_lo(gv.w)); v1[3] *= sigm(bf_hi(gv.w));
                    if (ADD) { const u32x4 ov = *(const u32x4*)op;
                        v0[0] += bf_lo(ov.x); v0[1] += bf_hi(ov.x); v0[2] += bf_lo(ov.y); v0[3] += bf_hi(ov.y);
                        v1[0] += bf_lo(ov.z); v1[1] += bf_hi(ov.z); v1[2] += bf_lo(ov.w); v1[3] += bf_hi(ov.w); }
                    u32x4 w; w.x = cvt_pk_bf16(v0[0], v0[1]); w.y = cvt_pk_bf16(v0[2], v0[3]); w.z = cvt_pk_bf16(v1[0], v1[1]); w.w = cvt_pk_bf16(v1[2], v1[3]);
                    *(u32x4*)op = w; } }
    }
};
struct EpiQF {
    static constexpr bool PERM = true, AFTER_DRAIN = false;
    bf16_t* O;
    __device__ __forceinline__ void operator()(const f32x4 (&acc)[2][2][4][2], const Unit& u, int wr, int wc, int fr, int fq) const {
        const int row0 = u.pm * BM + wr * 64 + fr, col0 = u.pn * BM + wc * 32 + 8 * fq;
#pragma unroll
        for (int ai = 0; ai < 2; ++ai)
#pragma unroll
            for (int m = 0; m < 4; ++m) { const int row = row0 + ai * HALF + m * 16;
#pragma unroll
                for (int bj = 0; bj < 2; ++bj) { const int col = col0 + bj * HALF;
                    const f32x4 v0 = acc[ai][bj][m][0], v1 = acc[ai][bj][m][1];
                    u32x4 w; w.x = cvt_pk_bf16(v0[0], v0[1]); w.y = cvt_pk_bf16(v0[2], v0[3]); w.z = cvt_pk_bf16(v1[0], v1[1]); w.w = cvt_pk_bf16(v1[2], v1[3]);
                    *(u32x4*)(O + ((size_t)((row >> 5) * 128 + (col >> 4)) * 512 + (size_t)((((col >> 3) & 1) * 32 + (row & 31)) * 8))) = w; } }
    }
};
template <class Epi, class Sched, bool ALIGN_EPI = false, bool SP2 = false>
__device__ __forceinline__ void gemm_phase(PG8_LAS unsigned char* lds, const Gemm g, const Sched& S, const Epi& E) {
    int tid_ = threadIdx.x; asm volatile("" : "+v"(tid_));
    const int tid = tid_, wid = __builtin_amdgcn_readfirstlane(tid >> 6), lane = tid & 63, wr = wid >> 2, wc = wid & 3, fr = lane & 15, fq = lane >> 4;
    const int K = g.K, nt = K / BK;
    unsigned voffA[2], voffB[2];
#pragma unroll
    for (int i = 0; i < 2; ++i) { int R, C; stage_rc(tid * 16 + i * 8192, R, C); const int Rb = Epi::PERM ? ((R & ~31) + perm32(R & 31)) : R;
        voffA[i] = (unsigned)(R * K + C) * 2u; voffB[i] = (unsigned)(Rb * K + C) * 2u; }
    const size_t kstep = (size_t)(BK * 2);
    const size_t hstep = (size_t)HALF * K * 2;
    const size_t tstep = 2 * hstep;
    const unsigned ldsw = (unsigned)wid * 1024u;
    const int aoff = lds_byte(wr * 64 + fr, fq * 8), boff = lds_byte(wc * 32 + fr, fq * 8);
#define PG8_SA(b, h) (((b) * 2 + (h)) * HTB)
#define PG8_SB(b, h) ((4 + (b) * 2 + (h)) * HTB)
#define PG8_STAGE(bufoff, gbase, voff) do { _Pragma("unroll") for (int _i = 0; _i < 2; ++_i) \
        __builtin_amdgcn_global_load_lds((const unsigned*)((const char*)(gbase) + (voff)[_i]), (PG8_LAS unsigned*)(lds + (bufoff) + ldsw + _i * 8192), 16, 0, 0); } while (0)
#define PG8_LDA(dst, b, h) do { _Pragma("unroll") for (int m = 0; m < 4; ++m) _Pragma("unroll") for (int k = 0; k < 2; ++k) dst[m][k] = *(const PG8_LAS bf16x8*)(lds + PG8_SA(b, h) + aoff + m * 2048 + k * 1024); } while (0)
#define PG8_LDB(dst, b, h) do { _Pragma("unroll") for (int n = 0; n < 2; ++n) _Pragma("unroll") for (int k = 0; k < 2; ++k) dst[n][k] = *(const PG8_LAS bf16x8*)(lds + PG8_SB(b, h) + boff + n * 2048 + k * 1024); } while (0)
#define PG8_MMA(ai, bj, At, Bt) do { __builtin_amdgcn_s_setprio(1); _Pragma("unroll") for (int m = 0; m < 4; ++m) _Pragma("unroll") for (int n = 0; n < 2; ++n) _Pragma("unroll") for (int k = 0; k < 2; ++k) \
        acc[ai][bj][m][n] = __builtin_amdgcn_mfma_f32_16x16x32_bf16(Bt[n][k], At[m][k], acc[ai][bj][m][n], 0, 0, 0); __builtin_amdgcn_s_setprio(0); } while (0)
#define PG8_WAIT_V(n) asm volatile("s_waitcnt vmcnt(" #n ")" ::: "memory")
#define PG8_WAIT_L(n) asm volatile("s_waitcnt lgkmcnt(" #n ")" ::: "memory")
#define PG8_BAR __builtin_amdgcn_s_barrier()
#define PG8_SCHED __builtin_amdgcn_sched_barrier(0)
    Unit cur, nxt; int ui = 0;
    if (!S.next(0, cur)) return;
    f32x4 acc[2][2][4][2];
#pragma unroll
    for (int a = 0; a < 2; ++a)
#pragma unroll
        for (int b = 0; b < 2; ++b)
#pragma unroll
            for (int m = 0; m < 4; ++m)
#pragma unroll
                for (int n = 0; n < 2; ++n) acc[a][b][m][n] = (f32x4){0.f, 0.f, 0.f, 0.f};
    bf16x8 At[4][2], B0[2][2], B1[2][2];
    const char* cA = (const char*)g.A + (size_t)cur.pm * tstep; const char* cB = (const char*)g.Bt + (size_t)cur.pn * tstep;
    S.a_ready(cur);
    if constexpr (SP2) {
        PG8_STAGE(PG8_SB(0, 0), cB, voffB); PG8_STAGE(PG8_SB(0, 1), cB + hstep, voffB); PG8_STAGE(PG8_SA(0, 0), cA, voffA); PG8_STAGE(PG8_SA(0, 1), cA + hstep, voffA);
        if (wr == 1) PG8_BAR;
        PG8_WAIT_V(2); PG8_BAR;
        PG8_STAGE(PG8_SB(1, 0), cB + kstep, voffB); PG8_STAGE(PG8_SA(1, 0), cA + kstep, voffA); PG8_STAGE(PG8_SB(1, 1), cB + hstep + kstep, voffB);
        PG8_WAIT_V(6); PG8_BAR;
    } else {
        PG8_STAGE(PG8_SB(0, 0), cB, voffB); PG8_STAGE(PG8_SA(0, 0), cA, voffA); PG8_STAGE(PG8_SB(0, 1), cB + hstep, voffB); PG8_STAGE(PG8_SA(0, 1), cA + hstep, voffA);
        if (wr == 1) PG8_BAR;
        PG8_WAIT_V(4); PG8_BAR;
        PG8_STAGE(PG8_SB(1, 0), cB + kstep, voffB); PG8_STAGE(PG8_SA(1, 0), cA + kstep, voffA); PG8_STAGE(PG8_SB(1, 1), cB + hstep + kstep, voffB);
        PG8_WAIT_V(6); PG8_BAR;
    }
    for (;;) {
        const bool has_next = S.next(ui + 1, nxt);
        const char* nA = has_next ? (const char*)g.A + (size_t)nxt.pm * tstep : cA; const char* nB = has_next ? (const char*)g.Bt + (size_t)nxt.pn * tstep : cB;
        for (int t = 0; t < nt; t += 2) {
            const bool last = (t == nt - 2);
            const char* a1 = cA + (size_t)(t + 1) * kstep;
            const char* a2 = last ? nA : cA + (size_t)(t + 2) * kstep; const char* b2 = last ? nB : cB + (size_t)(t + 2) * kstep;
            const char* a3 = a2 + kstep; const char* b3 = b2 + kstep;
            if (last && has_next) S.a_ready(nxt);
            if constexpr (SP2) {
            PG8_LDB(B0, 0, 0); PG8_LDB(B1, 0, 1); PG8_SCHED; PG8_LDA(At, 0, 0); PG8_STAGE(PG8_SA(1, 1), a1 + hstep, voffA);
            PG8_WAIT_V(8); PG8_WAIT_L(0); PG8_BAR; PG8_MMA(0, 0, At, B0); PG8_MMA(0, 1, At, B1); PG8_BAR; PG8_SCHED;
            PG8_LDA(At, 0, 1); PG8_STAGE(PG8_SB(0, 0), b2, voffB); PG8_STAGE(PG8_SB(0, 1), b2 + hstep, voffB); PG8_STAGE(PG8_SA(0, 0), a2, voffA);
            PG8_WAIT_V(8); PG8_WAIT_L(0); PG8_BAR; PG8_MMA(1, 0, At, B0); PG8_MMA(1, 1, At, B1); PG8_BAR; PG8_SCHED;
            PG8_LDB(B0, 1, 0); PG8_LDB(B1, 1, 1); PG8_SCHED; PG8_LDA(At, 1, 0); PG8_STAGE(PG8_SA(0, 1), a2 + hstep, voffA);
            PG8_WAIT_V(8); PG8_WAIT_L(0); PG8_BAR; PG8_MMA(0, 0, At, B0); PG8_MMA(0, 1, At, B1); PG8_BAR; PG8_SCHED;
            PG8_LDA(At, 1, 1); PG8_STAGE(PG8_SB(1, 0), b3, voffB); PG8_STAGE(PG8_SB(1, 1), b3 + hstep, voffB); PG8_STAGE(PG8_SA(1, 0), a3, voffA);
            PG8_WAIT_V(8); PG8_WAIT_L(0); PG8_BAR; PG8_MMA(1, 0, At, B0); PG8_MMA(1, 1, At, B1); PG8_BAR; PG8_SCHED;
            } else {
            PG8_LDB(B0, 0, 0); PG8_SCHED; PG8_LDA(At, 0, 0); PG8_STAGE(PG8_SA(1, 1), a1 + hstep, voffA);
            PG8_WAIT_L(8); PG8_BAR; PG8_WAIT_L(0); PG8_MMA(0, 0, At, B0); PG8_BAR; PG8_SCHED;
            PG8_LDB(B1, 0, 1); PG8_STAGE(PG8_SB(0, 0), b2, voffB);
            PG8_BAR; PG8_WAIT_L(0); PG8_MMA(0, 1, At, B1); PG8_BAR;
            PG8_LDA(At, 0, 1); PG8_STAGE(PG8_SA(0, 0), a2, voffA);
            PG8_BAR; PG8_WAIT_L(0); PG8_MMA(1, 0, At, B0); PG8_BAR; PG8_SCHED;
            PG8_STAGE(PG8_SB(0, 1), b2 + hstep, voffB);
            PG8_WAIT_V(6); PG8_BAR; PG8_MMA(1, 1, At, B1); PG8_BAR;
            PG8_LDB(B0, 1, 0); PG8_SCHED; PG8_LDA(At, 1, 0); PG8_STAGE(PG8_SA(0, 1), a2 + hstep, voffA);
            PG8_WAIT_L(8); PG8_BAR; PG8_WAIT_L(0); PG8_MMA(0, 0, At, B0); PG8_BAR; PG8_SCHED;
            PG8_LDB(B1, 1, 1); PG8_STAGE(PG8_SB(1, 0), b3, voffB);
            PG8_BAR; PG8_WAIT_L(0); PG8_MMA(0, 1, At, B1); PG8_BAR;
            PG8_LDA(At, 1, 1); PG8_STAGE(PG8_SA(1, 0), a3, voffA);
            PG8_BAR; PG8_WAIT_L(0); PG8_MMA(1, 0, At, B0); PG8_BAR; PG8_SCHED;
            PG8_STAGE(PG8_SB(1, 1), b3 + hstep, voffB);
            PG8_WAIT_V(6); PG8_BAR; PG8_MMA(1, 1, At, B1); PG8_BAR;
            }
        }
        if constexpr (ALIGN_EPI) { if (wr == 0) PG8_BAR; }
        if constexpr (!Epi::AFTER_DRAIN) { E(acc, cur, wr, wc, fr, fq); S.done(cur); }
        if (!has_next) break;
#pragma unroll
        for (int a = 0; a < 2; ++a)
#pragma unroll
            for (int b = 0; b < 2; ++b)
#pragma unroll
                for (int m = 0; m < 4; ++m)
#pragma unroll
                    for (int n = 0; n < 2; ++n) acc[a][b][m][n] = (f32x4){0.f, 0.f, 0.f, 0.f};
        cur = nxt; cA = nA; cB = nB; ++ui;
        if constexpr (ALIGN_EPI) { if (wr == 1) PG8_BAR; }
    }
    PG8_WAIT_V(0);
    if constexpr (!ALIGN_EPI) { if (wr == 0) PG8_BAR; }
    PG8_BAR;
    if constexpr (Epi::AFTER_DRAIN) { E.fused(acc, cur, wr, wc, fr, fq, lds, wid, lane); S.done(cur); }
#undef PG8_SA
#undef PG8_SB
#undef PG8_STAGE
#undef PG8_LDA
#undef PG8_LDB
#undef PG8_MMA
#undef PG8_WAIT_V
#undef PG8_WAIT_L
#undef PG8_BAR
#undef PG8_SCHED
}
}
constexpr int NWAVES = 8, NTHR = 512;
constexpr int M = 32768, D = 1024, SEQ = 8192, NBATCH = 4;
constexpr int NIN = 5888;
constexpr int NCHUNK = 128, NITEM = 32 * NCHUNK;
constexpr float EPS = 1e-6f;
constexpr size_t MiB = 1u << 20;
constexpr size_t SEG_ELEMS = (size_t)M * 512;
constexpr size_t WS_CTL = 0, WS_MODP = 1 * MiB, WS_WIN = 2 * MiB, WS_WQ = 14 * MiB, WS_WSC = 18 * MiB, WS_WDN = 19 * MiB, WS_WMIX = 20 * MiB,
                 WS_SK = 22 * MiB, WS_MODF = 22 * MiB + 768 * 1024, WS_GL = 23 * MiB, WS_SU = 23 * MiB + 65536, WS_SV = 23 * MiB + 131072, WS_TU = 24 * MiB, WS_TV = 56 * MiB, WS_P = 88 * MiB, WS_KD = 472 * MiB, WS_END = 504 * MiB;
constexpr int LDS_BYTES = 147456;

#define GAS __attribute__((address_space(1)))
#define LAS __attribute__((address_space(3)))
typedef unsigned short bf16;
typedef unsigned v4u __attribute__((ext_vector_type(4)));
typedef unsigned v2u __attribute__((ext_vector_type(2)));
typedef float f32x4 __attribute__((ext_vector_type(4)));
typedef float f32x16 __attribute__((ext_vector_type(16)));
typedef short bf16x8 __attribute__((ext_vector_type(8)));

typedef float f32x2_t __attribute__((ext_vector_type(2))); typedef __bf16 bf16x2_t __attribute__((ext_vector_type(2)));
__device__ __forceinline__ unsigned pk2(float lo, float hi) { f32x2_t v = {lo, hi}; bf16x2_t b = __builtin_convertvector(v, bf16x2_t); return __builtin_bit_cast(unsigned, b); }
__device__ __forceinline__ unsigned f2bf(float f) { return pk2(f, 0.f) & 0xffffu; }
__device__ __forceinline__ float bflo(unsigned u) { return __uint_as_float(u << 16); }
__device__ __forceinline__ float bfhi(unsigned u) { return __uint_as_float(u & 0xffff0000u); }
__device__ __forceinline__ float bf2f(bf16 h) { return __uint_as_float((unsigned)h << 16); }
__device__ __forceinline__ float sigmoidf_(float x) { return __builtin_amdgcn_rcpf(1.0f + __builtin_amdgcn_exp2f(-1.4426950408889634f * x)); }
__device__ __forceinline__ float wave_sum(float v) {
#pragma unroll
    for (int o = 1; o < 64; o <<= 1) v += __shfl_xor(v, o);
    return v;
}

struct Frame { LAS unsigned char* lds; int tid, lane, wave, G; };
__device__ __forceinline__ const void* karg(int i) {
    const char __attribute__((address_space(4)))* kp = (const char __attribute__((address_space(4)))*)__builtin_amdgcn_kernarg_segment_ptr();
    asm volatile("" : "+s"(i));
    return *(const void* const __attribute__((address_space(4)))*)(kp + 8 * i);
}
__device__ __forceinline__ const float* IN(int i) { return (const float*)karg(i); }
__device__ __forceinline__ float* OUTP() { return (float*)karg(21); }
__device__ __forceinline__ unsigned char* WSP() { return (unsigned char*)karg(22); }
enum { I_X = 0, I_C, I_WADA, I_BADA, I_NPREMIX, I_NPOSTMIX, I_WIN, I_SCCONV, I_DNCONV, I_ALOG, I_DTBIAS, I_OUTNORM, I_WSC, I_WDN, I_WMIX, I_NPREFFN, I_NPOSTFFN, I_WQ, I_SUBK, I_PU, I_PV };
__device__ __forceinline__ bf16* segp(unsigned char* ws, int s) { return (bf16*)(ws + WS_P) + (size_t)s * SEG_ELEMS; }
__device__ __forceinline__ float modv(const float* b_ada, const float* modp, int b, int j) {
    float s = b_ada[j];
#pragma unroll
    for (int k = 0; k < 8; ++k) s += modp[(size_t)(k * 4 + b) * 6144 + j];
    return s;
}

__device__ __forceinline__ void p0_transpose_item(const float* W, int K, int N, int src_col0, bf16* WT, int dst_row0, int kb, int ncols, LAS float* scr, int lane) {
    const int k0 = 64 * kb;
#pragma unroll 8
    for (int i = 0; i < 32; ++i) { const int kk = 2 * i + (lane >> 5); const int n = lane & 31;
        scr[kk * 33 + n] = (n < ncols) ? W[(size_t)(k0 + kk) * N + src_col0 + n] : 0.f; }
    asm volatile("s_waitcnt lgkmcnt(0)" ::: "memory");
    const int c = lane & 7;
#pragma unroll
    for (int j = 0; j < 4; ++j) { const int n = (lane >> 3) + 8 * j; const LAS float* s = scr + (8 * c) * 33 + n;
        v4u o; o.x = pk2(s[0 * 33], s[1 * 33]); o.y = pk2(s[2 * 33], s[3 * 33]); o.z = pk2(s[4 * 33], s[5 * 33]); o.w = pk2(s[6 * 33], s[7 * 33]);
        *(v4u*)(WT + (size_t)(dst_row0 + n) * K + k0 + 8 * c) = o; }
    asm volatile("s_waitcnt lgkmcnt(0)" ::: "memory");
}
__device__ __forceinline__ void p0_transpose(const float* W, int K, int N, int src_col0, int nblk, bf16* WT, int dst_row0, LAS float* scr, int gw, int NGW, int lane) {
    const int kbs = K / 64;
    for (int it = gw; it < nblk * kbs; it += NGW) { const int nb = it / kbs, kb = it % kbs;
        p0_transpose_item(W, K, N, src_col0 + 32 * nb, WT, dst_row0 + 32 * nb, kb, 32, scr, lane); }
}
__device__ __forceinline__ void p0_convert(const float* src, bf16* dst, size_t nchunks8, size_t gtid, size_t gthreads) {
    for (size_t i = gtid; i < nchunks8; i += gthreads) { const f32x4 a = *(const f32x4*)(src + i * 8), b = *(const f32x4*)(src + i * 8 + 4);
        v4u o; o.x = pk2(a[0], a[1]); o.y = pk2(a[2], a[3]); o.z = pk2(b[0], b[1]); o.w = pk2(b[2], b[3]); *(v4u*)(dst + i * 8) = o; }
}
typedef unsigned u32x6 __attribute__((ext_vector_type(6)));
typedef float f32x32 __attribute__((ext_vector_type(32)));
typedef float f32x16v __attribute__((ext_vector_type(16)));
__device__ __forceinline__ void p0_table_fp6(const float* T, unsigned char* T6, float* SC, LAS float* scr, int gw, int NGW, int lane) {
    const int g = lane >> 5, jl = lane & 31;
    for (int pr = gw; pr < 8192; pr += NGW) {
        const f32x4* src = (const f32x4*)(T + (size_t)(2 * pr) * 1024) + lane;
#pragma unroll
        for (int i = 0; i < 8; ++i) { const f32x4 v = src[64 * i]; const int q = lane + 64 * i, row = q >> 8, kk = (q & 255) * 4;
            *(LAS f32x4*)(scr + (row * 32 + (kk >> 5)) * 36 + (kk & 31)) = v; }
        asm volatile("s_waitcnt lgkmcnt(0)" ::: "memory");
        float x[32]; float am = 0.f;
#pragma unroll
        for (int i = 0; i < 8; ++i) { const f32x4 t = *(const LAS f32x4*)(scr + (g * 32 + jl) * 36 + 4 * i); x[4 * i] = t[0]; x[4 * i + 1] = t[1]; x[4 * i + 2] = t[2]; x[4 * i + 3] = t[3];
            am = fmaxf(am, fmaxf(fmaxf(fabsf(t[0]), fabsf(t[1])), fmaxf(fabsf(t[2]), fabsf(t[3])))); }
#pragma unroll
        for (int o = 1; o < 32; o <<= 1) am = fmaxf(am, __shfl_xor(am, o));
        const float sp = 7.5f / fmaxf(am, 1e-30f), inv = am * (1.0f / 7.5f);
        f32x16v a, b;
#pragma unroll
        for (int i = 0; i < 16; ++i) { a[i] = x[i] * sp; b[i] = x[16 + i] * sp; }
        const u32x6 qv = __builtin_amdgcn_cvt_scalef32_2xpk16_fp6_f32(a, b, 1.0f);
        unsigned char* dst = T6 + (size_t)(2 * pr + g) * 768;
        *(v4u*)(dst + 16 * jl) = (v4u){qv[0], qv[1], qv[2], qv[3]}; *(v2u*)(dst + 512 + 8 * jl) = (v2u){qv[4], qv[5]};
        if (jl == 0) SC[2 * pr + g] = inv;
        asm volatile("s_waitcnt lgkmcnt(0)" ::: "memory");
    }
}
__device__ __forceinline__ void phase_prologue(Frame& F) {
    LAS float* scr = (LAS float*)(F.lds + F.wave * 9216);
    const int gw = blockIdx.x * NWAVES + F.wave, NGW = F.G * NWAVES;
    unsigned char* ws = WSP();
    { const float* w_ada = IN(I_WADA); const float* cc = IN(I_C); float* modp = (float*)(ws + WS_MODP);
    for (int it = gw; it < 768; it += NGW) { const int cgi = it % 96, ks = it / 96, n = cgi * 64 + F.lane, k0 = ks * 128;
        float a0 = 0.f, a1 = 0.f, a2 = 0.f, a3 = 0.f;
#pragma unroll 16
        for (int kk = 0; kk < 128; ++kk) { const int k = k0 + kk; const float w = w_ada[(size_t)k * 6144 + n];
            const float c0 = cc[k], c1 = cc[1024 + k], c2 = cc[2048 + k], c3 = cc[3072 + k];
            a0 += c0 * sigmoidf_(c0) * w; a1 += c1 * sigmoidf_(c1) * w; a2 += c2 * sigmoidf_(c2) * w; a3 += c3 * sigmoidf_(c3) * w; }
        modp[(size_t)(ks * 4 + 0) * 6144 + n] = a0; modp[(size_t)(ks * 4 + 1) * 6144 + n] = a1;
        modp[(size_t)(ks * 4 + 2) * 6144 + n] = a2; modp[(size_t)(ks * 4 + 3) * 6144 + n] = a3; } }
    { const float* w_in = IN(I_WIN); bf16* win_t = (bf16*)(ws + WS_WIN);
    p0_transpose(w_in, 1024, 5648, 0, 112, win_t, 0, scr, gw, NGW, F.lane);
    p0_transpose(w_in, 1024, 5648, 3600, 64, win_t, 3584, scr, gw, NGW, F.lane);
    for (int it = gw; it < 16; it += NGW) p0_transpose_item(w_in, 1024, 5648, 3584, win_t, 5632, it, 16, scr, F.lane);
    { const size_t gtid = (size_t)blockIdx.x * NTHR + F.tid, gth = (size_t)F.G * NTHR;
      for (size_t i = gtid; i < (size_t)224 * 128; i += gth) *(v4u*)(win_t + (size_t)5664 * 1024 + i * 8) = (v4u){0u, 0u, 0u, 0u}; } }
    p0_transpose(IN(I_WQ), 1024, 2048, 0, 64, (bf16*)(ws + WS_WQ), 0, scr, gw, NGW, F.lane);
    p0_transpose(IN(I_WSC), 512, 1024, 0, 32, (bf16*)(ws + WS_WSC), 0, scr, gw, NGW, F.lane);
    p0_transpose(IN(I_WDN), 512, 1024, 0, 32, (bf16*)(ws + WS_WDN), 0, scr, gw, NGW, F.lane);
    p0_transpose(IN(I_WMIX), 1024, 1024, 0, 32, (bf16*)(ws + WS_WMIX), 0, scr, gw, NGW, F.lane);
    { const size_t gtid = (size_t)blockIdx.x * NTHR + F.tid, gth = (size_t)F.G * NTHR;
      { const float* skf = IN(I_SUBK); bf16* skb = (bf16*)(ws + WS_SK);
        for (size_t c = gtid; c < (size_t)16 * 128 * 128 / 8; c += gth) { const int hp = (int)(c >> 11), nkey = (int)(c >> 4) & 127, d8 = (int)c & 15;
            const f32x4 a = *(const f32x4*)(skf + c * 8), b = *(const f32x4*)(skf + c * 8 + 4);
            v4u o; o.x = pk2(a[0], a[1]); o.y = pk2(a[2], a[3]); o.z = pk2(b[0], b[1]); o.w = pk2(b[2], b[3]);
            const size_t dc = (size_t)hp * 2048 + (size_t)(((nkey >> 5) * 8 + (d8 >> 1)) * 64 + (d8 & 1) * 32 + (nkey & 31));
            *(v4u*)(skb + dc * 8) = o; } }
    }
}

__device__ __forceinline__ void phase_h1(Frame& F, bf16* H1) {
    LAS float* gv = (LAS float*)F.lds; LAS float* sv = gv + 1024;
    const float* xin = IN(I_X); const float* npm = IN(I_NPREMIX); const float* b_ada = IN(I_BADA); const float* modp = (const float*)(WSP() + WS_MODP);
    if (blockIdx.x < 24) { float* modf = (float*)(WSP() + WS_MODF);
        for (int k = F.tid; k < 1024; k += NTHR) { const int idx = blockIdx.x * 1024 + k; modf[idx] = modv(b_ada, modp, idx / 6144, idx % 6144); } }
    for (int rb = blockIdx.x; rb < M / 128; rb += F.G) {
        const int row0 = rb * 128, b = row0 / SEQ;
        __syncthreads();
        for (int k = F.tid; k < 1024; k += NTHR) { gv[k] = npm[k] * (1.f + modv(b_ada, modp, b, 1024 + k)); sv[k] = modv(b_ada, modp, b, k); }
        __syncthreads();
        for (int r = 0; r < 16; ++r) { const int row = row0 + F.wave * 16 + r;
            const f32x4* xr = (const f32x4*)(xin + (size_t)row * D) + F.lane;
            f32x4 v[4]; float ss = 0.f;
#pragma unroll
            for (int j = 0; j < 4; ++j) { v[j] = xr[64 * j]; ss += (v[j][0] * v[j][0] + v[j][1] * v[j][1]) + (v[j][2] * v[j][2] + v[j][3] * v[j][3]); }
            const float rstd = rsqrtf(wave_sum(ss) * (1.f / D) + EPS);
            v2u* o8 = (v2u*)(H1 + (size_t)row * D) + F.lane;
#pragma unroll
            for (int j = 0; j < 4; ++j) { const int k = 4 * F.lane + 256 * j; const f32x4 g = *(const LAS f32x4*)(gv + k), s = *(const LAS f32x4*)(sv + k);
                v2u o; o.x = pk2(v[j][0] * rstd * g[0] + s[0], v[j][1] * rstd * g[1] + s[1]); o.y = pk2(v[j][2] * rstd * g[2] + s[2], v[j][3] * rstd * g[3] + s[3]); o8[64 * j] = o; }
        }
    }
}

__device__ __forceinline__ void phase_scprep(Frame& F) {
    unsigned char* ws = WSP(); bf16* sb = segp(ws, 0); const bf16* scc = segp(ws, 1); const bf16* scx = segp(ws, 2); const float* scw = IN(I_SCCONV);
    const int gtid = blockIdx.x * NTHR + F.tid, gth = F.G * NTHR;
    for (int it = gtid; it < (M / 16) * 64; it += gth) {
        const int cgp = it & 63, tb = it >> 6, m0 = tb * 16, c0 = cgp * 8;
        float w0[8], w1[8], w2[8], p2[8], p1[8];
#pragma unroll
        for (int e = 0; e < 8; ++e) { w0[e] = scw[c0 + e]; w1[e] = scw[512 + c0 + e]; w2[e] = scw[1024 + c0 + e]; p2[e] = 0.f; p1[e] = 0.f; }
        if ((m0 % SEQ) != 0) {
#pragma unroll
            for (int q = 0; q < 2; ++q) { const size_t off = (size_t)(m0 - 2 + q) * 512 + c0; const v4u cv = *(const v4u*)(scc + off), xv = *(const v4u*)(scx + off);
                float t[8] = {bflo(cv.x) * bflo(xv.x), bfhi(cv.x) * bfhi(xv.x), bflo(cv.y) * bflo(xv.y), bfhi(cv.y) * bfhi(xv.y), bflo(cv.z) * bflo(xv.z), bfhi(cv.z) * bfhi(xv.z), bflo(cv.w) * bflo(xv.w), bfhi(cv.w) * bfhi(xv.w)};
#pragma unroll
                for (int e = 0; e < 8; ++e) { if (q == 0) p2[e] = t[e]; else p1[e] = t[e]; } }
        }
        for (int t = 0; t < 16; ++t) { const size_t off = (size_t)(m0 + t) * 512 + c0;
            const v4u cv = *(const v4u*)(scc + off), xv = *(const v4u*)(scx + off), bv = *(const v4u*)(sb + off);
            float cur[8] = {bflo(cv.x) * bflo(xv.x), bfhi(cv.x) * bfhi(xv.x), bflo(cv.y) * bflo(xv.y), bfhi(cv.y) * bfhi(xv.y), bflo(cv.z) * bflo(xv.z), bfhi(cv.z) * bfhi(xv.z), bflo(cv.w) * bflo(xv.w), bfhi(cv.w) * bfhi(xv.w)};
            float bb[8] = {bflo(bv.x), bfhi(bv.x), bflo(bv.y), bfhi(bv.y), bflo(bv.z), bfhi(bv.z), bflo(bv.w), bfhi(bv.w)};
            float o[8];
#pragma unroll
            for (int e = 0; e < 8; ++e) { o[e] = bb[e] * (w0[e] * p2[e] + w1[e] * p1[e] + w2[e] * cur[e]); p2[e] = p1[e]; p1[e] = cur[e]; }
            v4u ov; ov.x = pk2(o[0], o[1]); ov.y = pk2(o[2], o[3]); ov.z = pk2(o[4], o[5]); ov.w = pk2(o[6], o[7]);
            *(v4u*)(sb + off) = ov; }
    }
}

__device__ __forceinline__ bf16x8 pack_b(const f32x4& t0, const f32x4& t1) { v4u w; w.x = pk2(t0[0], t0[1]); w.y = pk2(t0[2], t0[3]); w.z = pk2(t1[0], t1[1]); w.w = pk2(t1[2], t1[3]); return __builtin_bit_cast(bf16x8, w); }
__device__ __forceinline__ int fragoff(int row, int col) { const int jj = col & 31; return ((row >> 4) * 2 + (col >> 5)) * 512 + ((((jj & 15) >> 2) * 16 + (row & 15)) * 8) + (jj & 3) + 4 * (jj >> 4); }
#define MM4(dst, aptr, X) do { const f32x4 av_ = *(const LAS f32x4*)(aptr); \
    dst = __builtin_amdgcn_mfma_f32_16x16x4f32(av_[0], (X)[0], dst, 0, 0, 0); dst = __builtin_amdgcn_mfma_f32_16x16x4f32(av_[1], (X)[1], dst, 0, 0, 0); \
    dst = __builtin_amdgcn_mfma_f32_16x16x4f32(av_[2], (X)[2], dst, 0, 0, 0); dst = __builtin_amdgcn_mfma_f32_16x16x4f32(av_[3], (X)[3], dst, 0, 0, 0); } while (0)
#define LBAR() do { asm volatile("s_waitcnt lgkmcnt(0)" ::: "memory"); __builtin_amdgcn_s_barrier(); asm volatile("" ::: "memory"); } while (0)
#define MMB(dst, rb, c0, use1, c1, Xa, Xb) do { const f32x4 l0_ = *(const LAS f32x4*)(Ln + (16 * (rb) + nn) * 68 + 16 * (c0) + 4 * g4); \
    const f32x4 l1_ = (use1) ? *(const LAS f32x4*)(Ln + (16 * (rb) + nn) * 68 + 16 * (c1) + 4 * g4) : (f32x4){0.f, 0.f, 0.f, 0.f}; \
    dst = __builtin_amdgcn_mfma_f32_16x16x32_bf16(pack_b(l0_, l1_), pack_b(Xa, Xb), dst, 0, 0, 0); } while (0)
__device__ __forceinline__ void phase_dnprep(Frame& F, bf16* Wn, bf16* U, bf16* QG, bf16* A, bf16* KD) {
    LAS unsigned char* L = F.lds;
    LAS bf16* raw = (LAS bf16*)L;
    LAS bf16* stg2 = (LAS bf16*)L;
    LAS float* qc = (LAS float*)(L + 32768);
    LAS float* kc = (LAS float*)(L + 32768 + 17408);
    LAS float* vc = (LAS float*)(L + 32768 + 2 * 17408);
    LAS bf16* kh = (LAS bf16*)(L + 84992);
    LAS bf16* qh = (LAS bf16*)(L + 94208);
    LAS float* Ln = (LAS float*)(L + 103424);
    LAS float* Tm = (LAS float*)(L + 120832);
    LAS float* sG = (LAS float*)(L + 124928);
    LAS float* sBeta = sG + 64; LAS float* sEG = sG + 128; LAS float* sEd = sG + 192;
    LAS float* cwl = (LAS float*)(L + 125952);
    LAS bf16* stg = (LAS bf16*)(L + 129024);
    const int tid = F.tid, lane = F.lane, wave = F.wave;
    unsigned char* ws = WSP(); const bf16* segq = segp(ws, 3); const bf16* segab = segp(ws, 11); float* glp = (float*)(ws + WS_GL);
    const float* cw = IN(I_DNCONV); const float* alog = IN(I_ALOG); const float* dtb = IN(I_DTBIAS);
    v4u pr[4]; float pcw[2]; float pa = 0.f, pb = 0.f, pal = 0.f;
#define PREFETCH(itn) do { const int bh_ = (itn) >> 7, n_ = (itn) & 127, b_ = bh_ >> 3, h_ = bh_ & 7, m0_ = b_ * SEQ + n_ * 64; \
        _Pragma("unroll") for (int q_ = 0; q_ < 4; ++q_) { const int ci_ = tid + q_ * NTHR; pr[q_] = (v4u){0u, 0u, 0u, 0u}; \
            if (ci_ < 1608) { const int s_ = ci_ / 536, rem_ = ci_ % 536, r_ = rem_ >> 3, c8_ = rem_ & 7; \
                if (n_ * 64 - 3 + r_ >= 0) pr[q_] = *(const v4u*)(segq + (size_t)s_ * SEG_ELEMS + (size_t)(m0_ - 3 + r_) * 512 + h_ * 64 + c8_ * 8); } } \
        _Pragma("unroll") for (int q_ = 0; q_ < 2; ++q_) { const int ci_ = tid + q_ * NTHR; pcw[q_] = 0.f; if (ci_ < 768) pcw[q_] = cw[((ci_ >> 6) & 3) * 1536 + (ci_ >> 8) * 512 + h_ * 64 + (ci_ & 63)]; } \
        if (wave == 0) { pa = bf2f(segab[(size_t)(m0_ + lane) * 512 + h_]) + dtb[h_]; pb = bf2f(segab[(size_t)(m0_ + lane) * 512 + 8 + h_]); pal = alog[h_]; } } while (0)
    if ((int)blockIdx.x < NITEM) PREFETCH((int)blockIdx.x);
    for (int it = blockIdx.x; it < NITEM; it += F.G) {
        const int bh = it >> 7, h = bh & 7;
        LBAR();
#pragma unroll
        for (int q = 0; q < 4; ++q) { const int ci = tid + q * NTHR; if (ci < 1608) { const int s_ = ci / 536, rem = ci % 536, r = rem >> 3, c8 = rem & 7; *(LAS v4u*)(raw + (s_ * 67 + r) * 64 + c8 * 8) = pr[q]; } }
#pragma unroll
        for (int q = 0; q < 2; ++q) { const int ci = tid + q * NTHR; if (ci < 768) cwl[ci] = pcw[q]; }
        const float av_cur = pa, bv_cur = pb, al_cur = pal;
        LBAR();
        { const int itn = it + F.G; if (itn < NITEM) PREFETCH(itn); }
        for (int wu = tid; wu < 3072; wu += NTHR) { const int c4 = wu & 15, t = (wu >> 4) & 63, s_ = wu >> 10;
            f32x4 acc = (f32x4){0.f, 0.f, 0.f, 0.f};
#pragma unroll
            for (int k = 0; k < 4; ++k) { const f32x4 w = *(const LAS f32x4*)(cwl + (s_ * 4 + k) * 64 + 4 * c4); const v2u r = *(const LAS v2u*)(raw + (s_ * 67 + t + k) * 64 + 4 * c4);
                acc[0] += w[0] * bflo(r.x); acc[1] += w[1] * bfhi(r.x); acc[2] += w[2] * bflo(r.y); acc[3] += w[3] * bfhi(r.y); }
#pragma unroll
            for (int e = 0; e < 4; ++e) acc[e] = acc[e] * sigmoidf_(acc[e]);
            *(LAS f32x4*)((s_ == 0 ? qc : (s_ == 1 ? kc : vc)) + t * 68 + 4 * c4) = acc; }
        if (wave == 0) {
            const float sp = (av_cur > 20.f) ? av_cur : __logf(1.0f + __expf(av_cur));
            float g = -__expf(al_cur) * sp;
#pragma unroll
            for (int o = 1; o < 64; o <<= 1) { const float t = __shfl_up(g, o); if (lane >= o) g += t; }
            const float g63 = __shfl(g, 63);
            sG[lane] = g; sBeta[lane] = sigmoidf_(bv_cur); sEG[lane] = __expf(g); sEd[lane] = __expf(g63 - g);
            if (lane == 63) glp[it] = __expf(g);
        }
        LBAR();
        { const int t = tid >> 3, p = tid & 7;
          f32x4 q0 = *(const LAS f32x4*)(qc + t * 68 + 8 * p), q1 = *(const LAS f32x4*)(qc + t * 68 + 8 * p + 4), k0 = *(const LAS f32x4*)(kc + t * 68 + 8 * p), k1 = *(const LAS f32x4*)(kc + t * 68 + 8 * p + 4);
          float sq = (q0[0] * q0[0] + q0[1] * q0[1]) + (q0[2] * q0[2] + q0[3] * q0[3]) + (q1[0] * q1[0] + q1[1] * q1[1]) + (q1[2] * q1[2] + q1[3] * q1[3]);
          float sk = (k0[0] * k0[0] + k0[1] * k0[1]) + (k0[2] * k0[2] + k0[3] * k0[3]) + (k1[0] * k1[0] + k1[1] * k1[1]) + (k1[2] * k1[2] + k1[3] * k1[3]);
          sq += __shfl_xor(sq, 1); sq += __shfl_xor(sq, 2); sq += __shfl_xor(sq, 4); sk += __shfl_xor(sk, 1); sk += __shfl_xor(sk, 2); sk += __shfl_xor(sk, 4);
          const float rq = rsqrtf(sq + EPS) * 0.125f, rk = rsqrtf(sk + EPS);
          q0 = q0 * rq; q1 = q1 * rq; k0 = k0 * rk; k1 = k1 * rk;
          *(LAS f32x4*)(qc + t * 68 + 8 * p) = q0; *(LAS f32x4*)(qc + t * 68 + 8 * p + 4) = q1; *(LAS f32x4*)(kc + t * 68 + 8 * p) = k0; *(LAS f32x4*)(kc + t * 68 + 8 * p + 4) = k1;
          v4u qb, kb; qb.x = pk2(q0[0], q0[1]); qb.y = pk2(q0[2], q0[3]); qb.z = pk2(q1[0], q1[1]); qb.w = pk2(q1[2], q1[3]);
          kb.x = pk2(k0[0], k0[1]); kb.y = pk2(k0[2], k0[3]); kb.z = pk2(k1[0], k1[1]); kb.w = pk2(k1[2], k1[3]);
          *(LAS v4u*)(qh + t * 72 + 8 * p) = qb; *(LAS v4u*)(kh + t * 72 + 8 * p) = kb; }
        LBAR();
        {
            const int fr = lane & 15, g4 = lane >> 4;
#pragma unroll
            for (int x = 0; x < 2; ++x) { const int tile = 2 * wave + x, ti = tile >> 2, tj = tile & 3;
                f32x4 ckk = (f32x4){0.f, 0.f, 0.f, 0.f}, cqk = (f32x4){0.f, 0.f, 0.f, 0.f};
#pragma unroll
                for (int ks = 0; ks < 2; ++ks) {
                    const bf16x8 ak = *(const LAS bf16x8*)(kh + (16 * ti + fr) * 72 + 32 * ks + 8 * g4);
                    const bf16x8 aq = *(const LAS bf16x8*)(qh + (16 * ti + fr) * 72 + 32 * ks + 8 * g4);
                    const bf16x8 bk = *(const LAS bf16x8*)(kh + (16 * tj + fr) * 72 + 32 * ks + 8 * g4);
                    ckk = __builtin_amdgcn_mfma_f32_16x16x32_bf16(ak, bk, ckk, 0, 0, 0);
                    cqk = __builtin_amdgcn_mfma_f32_16x16x32_bf16(aq, bk, cqk, 0, 0, 0); }
                const int j = 16 * tj + fr; const float gj = sG[j];
#pragma unroll
                for (int r = 0; r < 4; ++r) { const int i = 16 * ti + 4 * g4 + r;
                    const float dec = __expf(fminf(sG[i] - gj, 0.f));
                    Ln[i * 68 + j] = (j < i) ? -(sBeta[i] * ckk[r] * dec) : 0.f;
                    stg[fragoff(i, j)] = (bf16)f2bf((j <= i) ? cqk[r] * dec : 0.f); }
            }
        }
        LBAR();
        if (wave == 0) {
            const int bb = lane >> 4, c = lane & 15; float t[16];
#pragma unroll
            for (int i = 0; i < 16; ++i) { float acc = (i == c) ? 1.f : 0.f;
#pragma unroll
                for (int j = 0; j < i; ++j) acc += Ln[(16 * bb + i) * 68 + 16 * bb + j] * t[j];
                t[i] = acc; Tm[(bb * 16 + i) * 16 + c] = acc; }
        } else {
            for (int ct = tid - 64; ct < 1536; ct += NTHR - 64) { const int kind = ct >> 9, idx = ct & 511; const size_t ob = (size_t)it * 4096 + (size_t)idx * 8;
                if (kind == 0) { *(v4u*)(A + ob) = *(const LAS v4u*)(stg + idx * 8); }
                else if (kind == 1) { const int i = idx >> 3, k0 = (idx & 7) * 8; const float e = sEG[i]; const f32x4 a = *(const LAS f32x4*)(qc + i * 68 + k0), c = *(const LAS f32x4*)(qc + i * 68 + k0 + 4);
                    *(v2u*)(QG + (size_t)it * 4096 + fragoff(i, k0)) = (v2u){pk2(a[0] * e, a[1] * e), pk2(a[2] * e, a[3] * e)};
                    *(v2u*)(QG + (size_t)it * 4096 + fragoff(i, k0 + 4)) = (v2u){pk2(c[0] * e, c[1] * e), pk2(c[2] * e, c[3] * e)}; }
                else { const int kk = idx >> 3, c0 = (idx & 7) * 8;
                    v2u p0, p1; p0.x = pk2(kc[(c0 + 0) * 68 + kk] * sEd[c0 + 0], kc[(c0 + 1) * 68 + kk] * sEd[c0 + 1]); p0.y = pk2(kc[(c0 + 2) * 68 + kk] * sEd[c0 + 2], kc[(c0 + 3) * 68 + kk] * sEd[c0 + 3]);
                    p1.x = pk2(kc[(c0 + 4) * 68 + kk] * sEd[c0 + 4], kc[(c0 + 5) * 68 + kk] * sEd[c0 + 5]); p1.y = pk2(kc[(c0 + 6) * 68 + kk] * sEd[c0 + 6], kc[(c0 + 7) * 68 + kk] * sEd[c0 + 7]);
                    *(v2u*)(KD + (size_t)it * 4096 + fragoff(kk, c0)) = p0; *(v2u*)(KD + (size_t)it * 4096 + fragoff(kk, c0 + 4)) = p1; } }
        }
        LBAR();
        {
            const int nn = lane & 15, g4 = lane >> 4; const LAS float* src = (wave < 4) ? vc : kc; const int cc = 16 * (wave & 3) + nn;
            f32x4 R[4];
#pragma unroll
            for (int bb = 0; bb < 4; ++bb)
#pragma unroll
                for (int r = 0; r < 4; ++r) { const int i = 16 * bb + 4 * g4 + r; float v = src[i * 68 + cc] * sBeta[i]; if (wave >= 4) v *= sEG[i]; R[bb][r] = v; }
            const f32x4 Z4 = (f32x4){0.f, 0.f, 0.f, 0.f};
            f32x4 X0 = Z4, X1 = Z4, X2 = Z4, X3 = Z4;
            MM4(X0, Tm + (0 * 16 + nn) * 16 + 4 * g4, R[0]);
            MMB(R[1], 1, 0, false, 0, X0, Z4);
            MM4(X1, Tm + (1 * 16 + nn) * 16 + 4 * g4, R[1]);
            MMB(R[2], 2, 0, true, 1, X0, X1);
            MM4(X2, Tm + (2 * 16 + nn) * 16 + 4 * g4, R[2]);
            MMB(R[3], 3, 0, true, 1, X0, X1); MMB(R[3], 3, 2, false, 0, X2, Z4);
            MM4(X3, Tm + (3 * 16 + nn) * 16 + 4 * g4, R[3]);
            if (wave < 4) {
                LAS bf16* up = stg2 + (wave * 2) * 512 + (g4 * 16 + nn) * 8;
                *(LAS v4u*)(up) = (v4u){pk2(X0[0], X0[1]), pk2(X0[2], X0[3]), pk2(X1[0], X1[1]), pk2(X1[2], X1[3])};
                *(LAS v4u*)(up + 512) = (v4u){pk2(X2[0], X2[1]), pk2(X2[2], X2[3]), pk2(X3[0], X3[1]), pk2(X3[2], X3[3])};
            } else {
                LAS bf16* wp = stg2 + 4096; const int k = 16 * (wave - 4) + nn;
#pragma unroll
                for (int r = 0; r < 4; ++r) { const int i = 4 * g4 + r;
                    wp[fragoff(i, k)] = (bf16)f2bf(-X0[r]); wp[fragoff(16 + i, k)] = (bf16)f2bf(-X1[r]); wp[fragoff(32 + i, k)] = (bf16)f2bf(-X2[r]); wp[fragoff(48 + i, k)] = (bf16)f2bf(-X3[r]); }
            }
        }
        LBAR();
        { const v4u vu = *(const LAS v4u*)(stg2 + tid * 8), vw = *(const LAS v4u*)(stg2 + 4096 + tid * 8);
          *(v4u*)(U + (size_t)it * 4096 + tid * 8) = vu; *(v4u*)(Wn + (size_t)it * 4096 + tid * 8) = vw; }
    }
#undef PREFETCH
}
#undef LBAR
#undef MMB
#undef MM4

__device__ __forceinline__ bf16x8 afrag(const LAS bf16* base, int row, int ks, int g4) {
    const v2u lo = *(const LAS v2u*)(base + row * 72 + 32 * ks + 4 * g4), hi = *(const LAS v2u*)(base + row * 72 + 32 * ks + 16 + 4 * g4);
    v4u w; w.x = lo.x; w.y = lo.y; w.z = hi.x; w.w = hi.y; return __builtin_bit_cast(bf16x8, w); }
#define SCAN_BAR() do { asm volatile("s_waitcnt lgkmcnt(0)" ::: "memory"); __builtin_amdgcn_s_barrier(); asm volatile("" ::: "memory"); } while (0)
__device__ __forceinline__ void phase_scan(Frame& F, const bf16* Wn, const bf16* U, const bf16* QG, const bf16* A, const bf16* KD, bf16* OT) {
    if (blockIdx.x >= 32) return;
    LAS unsigned char* L = F.lds; const float* glp = (const float*)(WSP() + WS_GL);
    const int bh = blockIdx.x, tid = F.tid, lane = F.lane, wave = F.wave;
    const int nn = lane & 15, g4 = lane >> 4;
#define OPB(buf, mat) ((LAS bf16*)(L + (buf) * 40960 + (mat) * 8192))
#define OST(buf) ((LAS bf16*)(L + 81920 + (buf) * 8192))
#define FRAG(base, ct, ks) (*(const LAS bf16x8*)((base) + ((ct) * 2 + (ks)) * 512 + lane * 8))
    LAS float* gll = (LAS float*)(L + 98304);
    if (tid < NCHUNK) gll[tid] = glp[bh * NCHUNK + tid];
    if (wave >= 4) {
        const int ht = tid - 256;
        const unsigned eo0 = (unsigned)(bh * NCHUNK) * 4096u + (unsigned)ht * 8u;
        const int lo0 = ht * 8, lo1 = lo0 + 2048;
        v4u ra[10], rb[10];
#define HLOAD(R, st) do { const unsigned o_ = eo0 + (unsigned)(st) * 4096u; R[0] = *(const v4u*)(Wn + o_); R[1] = *(const v4u*)(Wn + o_ + 2048); R[2] = *(const v4u*)(U + o_); R[3] = *(const v4u*)(U + o_ + 2048); \
        R[4] = *(const v4u*)(QG + o_); R[5] = *(const v4u*)(QG + o_ + 2048); R[6] = *(const v4u*)(A + o_); R[7] = *(const v4u*)(A + o_ + 2048); R[8] = *(const v4u*)(KD + o_); R[9] = *(const v4u*)(KD + o_ + 2048); } while (0)
#define HSTORE(R, buf) do { _Pragma("unroll") for (int mt_ = 0; mt_ < 5; ++mt_) { *(LAS v4u*)(OPB(buf, mt_) + lo0) = R[2 * mt_]; *(LAS v4u*)(OPB(buf, mt_) + lo1) = R[2 * mt_ + 1]; } } while (0)
#define OUT_STAGE(par, st) do { const v4u o0_ = *(const LAS v4u*)(OST(par) + lo0), o1_ = *(const LAS v4u*)(OST(par) + lo1); const unsigned oo_ = eo0 + (unsigned)(st) * 4096u; \
        *(v4u*)(OT + oo_) = o0_; *(v4u*)(OT + oo_ + 2048) = o1_; } while (0)
#define SB() __builtin_amdgcn_sched_barrier(0)
        HLOAD(ra, 0); HSTORE(ra, 0); HLOAD(ra, 1); HLOAD(rb, 2);
        SCAN_BAR();
        HSTORE(ra, 1); HLOAD(ra, 3);
        SCAN_BAR();
#pragma unroll 1
        for (int n = 1; n < NCHUNK - 1; n += 2) {
            const int l3 = (n + 3 < NCHUNK) ? n + 3 : NCHUNK - 1, l4 = (n + 4 < NCHUNK) ? n + 4 : NCHUNK - 1;
            HSTORE(rb, 0); SB(); HLOAD(rb, l3); SB(); OUT_STAGE(0, n - 1); SB();
            SCAN_BAR();
            HSTORE(ra, 1); SB(); HLOAD(ra, l4); SB(); OUT_STAGE(1, n); SB();
            SCAN_BAR();
        }
        OUT_STAGE(0, NCHUNK - 2);
        SCAN_BAR();
        OUT_STAGE(1, NCHUNK - 1);
#undef HLOAD
#undef HSTORE
#undef OUT_STAGE
#undef SB
    } else {
        const int cs = wave;
        f32x4 S[4];
#pragma unroll
        for (int t = 0; t < 4; ++t) S[t] = (f32x4){0.f, 0.f, 0.f, 0.f};
        SCAN_BAR();
#pragma unroll 1
        for (int n = 0; n < NCHUNK; ++n) {
            const int buf = n & 1; const float glast = gll[n];
            bf16x8 fw[4][2], fq[4][2];
            const v4u u01 = *(const LAS v4u*)(OPB(buf, 1) + (cs * 2 + 0) * 512 + lane * 8), u23 = *(const LAS v4u*)(OPB(buf, 1) + (cs * 2 + 1) * 512 + lane * 8);
#pragma unroll
            for (int ct = 0; ct < 4; ++ct) { fw[ct][0] = FRAG(OPB(buf, 0), ct, 0); fw[ct][1] = FRAG(OPB(buf, 0), ct, 1); fq[ct][0] = FRAG(OPB(buf, 2), ct, 0); fq[ct][1] = FRAG(OPB(buf, 2), ct, 1); }
            const bf16x8 sb0 = pack_b(S[0], S[1]), sb1 = pack_b(S[2], S[3]);
            f32x4 vn[4], oa[4];
            vn[0] = (f32x4){bflo(u01.x), bfhi(u01.x), bflo(u01.y), bfhi(u01.y)}; vn[1] = (f32x4){bflo(u01.z), bfhi(u01.z), bflo(u01.w), bfhi(u01.w)};
            vn[2] = (f32x4){bflo(u23.x), bfhi(u23.x), bflo(u23.y), bfhi(u23.y)}; vn[3] = (f32x4){bflo(u23.z), bfhi(u23.z), bflo(u23.w), bfhi(u23.w)};
#pragma unroll
            for (int ct = 0; ct < 4; ++ct) {
                f32x4 av = vn[ct], ao = (f32x4){0.f, 0.f, 0.f, 0.f};
                av = __builtin_amdgcn_mfma_f32_16x16x32_bf16(fw[ct][0], sb0, av, 0, 0, 0);
                ao = __builtin_amdgcn_mfma_f32_16x16x32_bf16(fq[ct][0], sb0, ao, 0, 0, 0);
                av = __builtin_amdgcn_mfma_f32_16x16x32_bf16(fw[ct][1], sb1, av, 0, 0, 0);
                ao = __builtin_amdgcn_mfma_f32_16x16x32_bf16(fq[ct][1], sb1, ao, 0, 0, 0);
                vn[ct] = av; oa[ct] = ao; }
            bf16x8 fa[4][2], fk[4][2];
#pragma unroll
            for (int ct = 0; ct < 4; ++ct) { fa[ct][0] = FRAG(OPB(buf, 3), ct, 0); fa[ct][1] = FRAG(OPB(buf, 3), ct, 1); fk[ct][0] = FRAG(OPB(buf, 4), ct, 0); fk[ct][1] = FRAG(OPB(buf, 4), ct, 1); }
            const bf16x8 vb0 = pack_b(vn[0], vn[1]), vb1 = pack_b(vn[2], vn[3]);
#pragma unroll
            for (int ct = 0; ct < 4; ++ct) {
                f32x4 ao = oa[ct], as = S[ct] * glast;
                as = __builtin_amdgcn_mfma_f32_16x16x32_bf16(fk[ct][0], vb0, as, 0, 0, 0);
                ao = __builtin_amdgcn_mfma_f32_16x16x32_bf16(fa[ct][0], vb0, ao, 0, 0, 0);
                as = __builtin_amdgcn_mfma_f32_16x16x32_bf16(fk[ct][1], vb1, as, 0, 0, 0);
                ao = __builtin_amdgcn_mfma_f32_16x16x32_bf16(fa[ct][1], vb1, ao, 0, 0, 0);
                S[ct] = as; oa[ct] = ao; }
            *(LAS v4u*)(OST(buf) + (cs * 2 + 0) * 512 + lane * 8) = (v4u){pk2(oa[0][0], oa[0][1]), pk2(oa[0][2], oa[0][3]), pk2(oa[1][0], oa[1][1]), pk2(oa[1][2], oa[1][3])};
            *(LAS v4u*)(OST(buf) + (cs * 2 + 1) * 512 + lane * 8) = (v4u){pk2(oa[2][0], oa[2][1]), pk2(oa[2][2], oa[2][3]), pk2(oa[3][0], oa[3][1]), pk2(oa[3][2], oa[3][3])};
            SCAN_BAR();
        }
    }
#undef OPB
#undef OST
#undef FRAG
}
#undef SCAN_BAR

__device__ __forceinline__ void phase_og(Frame& F, const bf16* OT, const bf16* Z, bf16* OG) {
    const float* onw = IN(I_OUTNORM);
    const int half = F.tid >> 8, ht = F.tid & 255, c = ht >> 2, p = ht & 3;
    LAS bf16* tile = (LAS bf16*)(F.lds + half * 8192);
    for (int it0 = blockIdx.x * 2; it0 < NITEM; it0 += F.G * 2) {
        const int it = it0 + half, bh = it >> 7, n = it & 127, b = bh >> 3, h = bh & 7, m0 = b * SEQ + n * 64;
        __syncthreads();
        { const v4u a0 = *(const v4u*)(OT + (size_t)it * 4096 + ht * 8), a1 = *(const v4u*)(OT + (size_t)it * 4096 + 2048 + ht * 8);
          *(LAS v4u*)(tile + ht * 8) = a0; *(LAS v4u*)(tile + 2048 + ht * 8) = a1; }
        const size_t zo = (size_t)(m0 + c) * 512 + h * 64 + 16 * p;
        const v4u z0 = *(const v4u*)(Z + zo), z1 = *(const v4u*)(Z + zo + 8);
        __syncthreads();
        float ov[16]; float ss = 0.f;
#pragma unroll
        for (int e = 0; e < 16; ++e) { ov[e] = bf2f(tile[fragoff(16 * p + e, c)]); ss += ov[e] * ov[e]; }
        ss += __shfl_xor(ss, 1); ss += __shfl_xor(ss, 2);
        const float rs = rsqrtf(ss * (1.f / 64.f) + EPS);
        const float zv[16] = {bflo(z0.x), bfhi(z0.x), bflo(z0.y), bfhi(z0.y), bflo(z0.z), bfhi(z0.z), bflo(z0.w), bfhi(z0.w), bflo(z1.x), bfhi(z1.x), bflo(z1.y), bfhi(z1.y), bflo(z1.z), bfhi(z1.z), bflo(z1.w), bfhi(z1.w)};
        float rr[16];
#pragma unroll
        for (int e = 0; e < 16; ++e) rr[e] = ov[e] * rs * onw[16 * p + e] * (zv[e] * sigmoidf_(zv[e]));
        v4u w0, w1; w0.x = pk2(rr[0], rr[1]); w0.y = pk2(rr[2], rr[3]); w0.z = pk2(rr[4], rr[5]); w0.w = pk2(rr[6], rr[7]); w1.x = pk2(rr[8], rr[9]); w1.y = pk2(rr[10], rr[11]); w1.z = pk2(rr[12], rr[13]); w1.w = pk2(rr[14], rr[15]);
        *(v4u*)(OG + zo) = w0; *(v4u*)(OG + zo + 8) = w1;
    }
}

__device__ __forceinline__ void phase_x1h2(Frame& F, const bf16* Y, bf16* H2) {
    LAS float* a1 = (LAS float*)F.lds; LAS float* g2 = a1 + 1024; LAS float* s2 = g2 + 1024;
    const float* xin = IN(I_X); const float* npost = IN(I_NPOSTMIX); const float* npre = IN(I_NPREFFN); const float* modf = (const float*)(WSP() + WS_MODF); float* outp = OUTP();
    for (int rb = blockIdx.x; rb < M / 128; rb += F.G) {
        const int row0 = rb * 128, b = row0 / SEQ;
        __syncthreads();
        for (int k = F.tid; k < 1024; k += NTHR) { a1[k] = modf[b * 6144 + 2048 + k] * npost[k]; g2[k] = npre[k] * (1.f + modf[b * 6144 + 4096 + k]); s2[k] = modf[b * 6144 + 3072 + k]; }
        __syncthreads();
        for (int r = 0; r < 16; ++r) { const int row = row0 + F.wave * 16 + r;
            const v2u* yr = (const v2u*)(Y + (size_t)row * D) + F.lane; const f32x4* xr = (const f32x4*)(xin + (size_t)row * D) + F.lane;
            f32x4 y[4], xv[4]; float ss = 0.f;
#pragma unroll
            for (int j = 0; j < 4; ++j) { const v2u t = yr[64 * j]; y[j] = (f32x4){bflo(t.x), bfhi(t.x), bflo(t.y), bfhi(t.y)}; xv[j] = xr[64 * j];
                ss += (y[j][0] * y[j][0] + y[j][1] * y[j][1]) + (y[j][2] * y[j][2] + y[j][3] * y[j][3]); }
            const float rstd = rsqrtf(wave_sum(ss) * (1.f / D) + EPS); float s1 = 0.f;
            f32x4* orow = (f32x4*)(outp + (size_t)row * D) + F.lane;
#pragma unroll
            for (int j = 0; j < 4; ++j) { const int k = 4 * F.lane + 256 * j; const f32x4 a = *(const LAS f32x4*)(a1 + k);
                xv[j] = xv[j] + a * (y[j] * rstd); orow[64 * j] = xv[j];
                s1 += (xv[j][0] * xv[j][0] + xv[j][1] * xv[j][1]) + (xv[j][2] * xv[j][2] + xv[j][3] * xv[j][3]); }
            const float rstd1 = rsqrtf(wave_sum(s1) * (1.f / D) + EPS);
            v2u* o8 = (v2u*)(H2 + (size_t)row * D) + F.lane;
#pragma unroll
            for (int j = 0; j < 4; ++j) { const int k = 4 * F.lane + 256 * j; const f32x4 g = *(const LAS f32x4*)(g2 + k), s = *(const LAS f32x4*)(s2 + k);
                v2u o; o.x = pk2(xv[j][0] * rstd1 * g[0] + s[0], xv[j][1] * rstd1 * g[1] + s[1]); o.y = pk2(xv[j][2] * rstd1 * g[2] + s[2], xv[j][3] * rstd1 * g[3] + s[3]); o8[64 * j] = o; }
        }
    }
}

__device__ __forceinline__ unsigned mono(float f) { const unsigned u = __float_as_uint(f); return u ^ ((unsigned)((int)u >> 31) | 0x80000000u); }
__device__ __forceinline__ float unmono(unsigned k) { return __uint_as_float((k & 0x80000000u) ? (k ^ 0x80000000u) : ~k); }
#define CE_DESC(a, b) do { const unsigned _mx = max((a), (b)), _mn = min((a), (b)); (a) = _mx; (b) = _mn; } while (0)
__device__ __forceinline__ void top16_of_64(unsigned (&x)[64]) {
#pragma unroll
    for (int g = 0; g < 4; ++g)
#pragma unroll
        for (int k = 2; k <= 16; k <<= 1)
#pragma unroll
            for (int j = k >> 1; j > 0; j >>= 1)
#pragma unroll
                for (int i = 0; i < 16; ++i) { const int l = i ^ j; if (l > i) { if ((i & k) == 0) CE_DESC(x[16 * g + i], x[16 * g + l]); else CE_DESC(x[16 * g + l], x[16 * g + i]); } }
#pragma unroll
    for (int s = 0; s < 3; ++s) { const int a = (s == 1) ? 32 : 0, b2 = (s == 0) ? 16 : (s == 1 ? 48 : 32);
#pragma unroll
        for (int i = 0; i < 16; ++i) x[a + i] = max(x[a + i], x[b2 + 15 - i]);
#pragma unroll
        for (int j = 8; j > 0; j >>= 1)
#pragma unroll
            for (int i = 0; i < 16; ++i) { const int l = i ^ j; if (l > i) CE_DESC(x[a + i], x[a + l]); } }
}
__device__ __forceinline__ void phase_topk(Frame& F, const bf16* Q2, int* EI, float* GA) {
    const int tid = F.tid, lane = F.lane, wave = F.wave, r = lane & 31, hh = lane >> 5;
    const bf16* skp = (const bf16*)(WSP() + WS_SK);
    LAS unsigned char* itab = F.lds + wave * 1024;
    LAS bf16* skl = (LAS bf16*)(F.lds + 8192);
    for (int item = blockIdx.x; item < (M / 256) * 2; item += F.G) {
        const int tile = item >> 1, hgrp = item & 1, m = tile * 256 + wave * 32 + r;
        __syncthreads();
        { const bf16* src = skp + (size_t)(hgrp * 4 * 2) * 16384;
#pragma unroll
          for (int q = 0; q < 4; ++q) *(LAS v4u*)(skl + (tid + q * NTHR) * 8) = *(const v4u*)(src + (size_t)(tid + q * NTHR) * 8); }
        __syncthreads();
        unsigned k12[2][16];
#pragma unroll 1
        for (int it8 = 0; it8 < 8; ++it8) { const int hd = it8 >> 1, p = it8 & 1, h = hgrp * 4 + hd;
            v4u nx[4]; { const int nit = (it8 < 7) ? it8 + 1 : it8; const bf16* src = skp + (size_t)((hgrp * 4 + (nit >> 1)) * 2 + (nit & 1)) * 16384;
#pragma unroll
              for (int q = 0; q < 4; ++q) nx[q] = *(const v4u*)(src + (size_t)(tid + q * NTHR) * 8); }
            const LAS bf16* skb = skl + (it8 & 1) * 16384;
            {
                bf16x8 bq[8];
#pragma unroll
                for (int ks = 0; ks < 8; ++ks) bq[ks] = *(const bf16x8*)(Q2 + ((size_t)((tile * 8 + wave) * 128 + h * 16 + p * 8 + ks) * 512 + lane * 8));
                unsigned keys[64];
#pragma unroll
                for (int kt = 0; kt < 4; ++kt) {
                    f32x16 acc;
#pragma unroll
                    for (int i = 0; i < 16; ++i) acc[i] = 0.f;
#pragma unroll
                    for (int ks = 0; ks < 8; ++ks) { const bf16x8 a = *(const LAS bf16x8*)(skb + (kt * 8 + ks) * 512 + lane * 8); acc = __builtin_amdgcn_mfma_f32_32x32x16_bf16(a, bq[ks], acc, 0, 0, 0); }
#pragma unroll
                    for (int i = 0; i < 16; ++i) { const int keyidx = kt * 32 + (i & 3) + 8 * (i >> 2) + 4 * hh; keys[kt * 16 + i] = (mono(acc[i]) & ~127u) | (unsigned)(127 - keyidx); }
                }
#pragma unroll
                for (int q = 0; q < 4; ++q) *(LAS v4u*)(skl + ((it8 + 1) & 1) * 16384 + (tid + q * NTHR) * 8) = nx[q];
                top16_of_64(keys);
                unsigned oth[16];
#pragma unroll
                for (int i = 0; i < 16; ++i) oth[i] = (unsigned)__shfl_xor((int)keys[i], 32);
#pragma unroll
                for (int i = 0; i < 16; ++i) keys[i] = max(keys[i], oth[15 - i]);
#pragma unroll
                for (int j = 8; j > 0; j >>= 1)
#pragma unroll
                    for (int i = 0; i < 16; ++i) { const int l = i ^ j; if (l > i) CE_DESC(keys[i], keys[l]); }
                if (p == 0) {
#pragma unroll
                    for (int i = 0; i < 16; ++i) k12[0][i] = keys[i];
                } else {
#pragma unroll
                    for (int i = 0; i < 16; ++i) k12[1][i] = keys[i];
                }
            }
            __syncthreads();
            if (p == 0) continue;
            float v1[16], v2[16];
#pragma unroll
            for (int i = 0; i < 16; ++i) { v1[i] = unmono(k12[0][i] & ~127u); v2[i] = unmono(k12[1][i] & ~127u); }
            if (hh == 0) {
                v4u w0, w1;
#define PK4(K, b) ((127u - ((K)[b] & 127u)) | ((127u - ((K)[b + 1] & 127u)) << 8) | ((127u - ((K)[b + 2] & 127u)) << 16) | ((127u - ((K)[b + 3] & 127u)) << 24))
                w0.x = PK4(k12[0], 0); w0.y = PK4(k12[0], 4); w0.z = PK4(k12[0], 8); w0.w = PK4(k12[0], 12);
                w1.x = PK4(k12[1], 0); w1.y = PK4(k12[1], 4); w1.z = PK4(k12[1], 8); w1.w = PK4(k12[1], 12);
#undef PK4
                *(LAS v4u*)(itab + r * 32) = w0; *(LAS v4u*)(itab + r * 32 + 16) = w1; }
            unsigned ck[64];
            { int nn = 0;
#pragma unroll
              for (int i = 0; i < 16; ++i)
#pragma unroll
                  for (int j = 0; j < 16; ++j) if ((i + 1) * (j + 1) <= 16) { ck[nn] = (mono(v1[i] + v2[j]) & ~255u) | (unsigned)(255 - (i * 16 + j)); ++nn; }
#pragma unroll
              for (int q = 50; q < 64; ++q) ck[q] = 0u; }
            top16_of_64(ck);
            asm volatile("s_waitcnt lgkmcnt(0)" ::: "memory");
            float ts[16], es[16]; int ei[16]; float sum = 0.f;
#pragma unroll
            for (int q = 0; q < 16; ++q) { ts[q] = unmono(ck[q] & ~255u); const unsigned pos = 255u - (ck[q] & 255u);
                const unsigned e1 = itab[r * 32 + (pos >> 4)], e2 = itab[r * 32 + 16 + (pos & 15u)]; ei[q] = (int)(e1 * 128u + e2); }
#pragma unroll
            for (int q = 0; q < 16; ++q) { es[q] = __expf(ts[q] - ts[0]); sum += es[q]; }
            const float inv = 1.0f / sum;
            int eo[8]; float go[8];
#pragma unroll
            for (int q = 0; q < 8; ++q) { eo[q] = hh ? ei[q + 8] : ei[q]; go[q] = (hh ? es[q + 8] : es[q]) * inv; }
            int* ep = EI + (size_t)m * 128 + h * 16 + hh * 8; float* gp = GA + (size_t)m * 128 + h * 16 + hh * 8;
            *(v4u*)ep = (v4u){(unsigned)eo[0], (unsigned)eo[1], (unsigned)eo[2], (unsigned)eo[3]}; *(v4u*)(ep + 4) = (v4u){(unsigned)eo[4], (unsigned)eo[5], (unsigned)eo[6], (unsigned)eo[7]};
            *(f32x4*)gp = (f32x4){go[0], go[1], go[2], go[3]}; *(f32x4*)(gp + 4) = (f32x4){go[4], go[5], go[6], go[7]};
            asm volatile("s_waitcnt lgkmcnt(0)" ::: "memory");
        }
    }
}

struct RowBuf { v4u ua; v2u ub; v4u va; v2u vb; float su, svg; };
__device__ __forceinline__ void gather_load(RowBuf& B, int step, int g, int j, int e_lo, int e_hi, float g_lo, float g_hi, const unsigned char* tu, const unsigned char* tv, const float* su, const float* sv) {
    const int src = (step * 2 + g) & 63;
    const int eidx = __shfl(step < 32 ? e_lo : e_hi, src); const float gate = __shfl(step < 32 ? g_lo : g_hi, src);
    const unsigned char* ur = tu + (size_t)eidx * 768; const unsigned char* vr = tv + (size_t)eidx * 768;
    B.ua = *(const v4u*)(ur + 16 * j); B.ub = *(const v2u*)(ur + 512 + 8 * j); B.va = *(const v4u*)(vr + 16 * j); B.vb = *(const v2u*)(vr + 512 + 8 * j);
    B.su = su[eidx]; B.svg = gate * sv[eidx];
}
__device__ __forceinline__ void gather_compute(const RowBuf& B, const unsigned (&hp)[16], float (&y)[32]) {
    const f32x32 ru = __builtin_amdgcn_cvt_scalef32_pk32_f32_fp6((u32x6){B.ua.x, B.ua.y, B.ua.z, B.ua.w, B.ub.x, B.ub.y}, 1.0f);
    float d0 = 0.f, d1 = 0.f, d2 = 0.f, d3 = 0.f;
#pragma unroll
    for (int q = 0; q < 8; ++q) { d0 += ru[4 * q] * bflo(hp[2 * q]); d1 += ru[4 * q + 1] * bfhi(hp[2 * q]); d2 += ru[4 * q + 2] * bflo(hp[2 * q + 1]); d3 += ru[4 * q + 3] * bfhi(hp[2 * q + 1]); }
    float d = (d0 + d1) + (d2 + d3);
    d += __shfl_xor(d, 1); d += __shfl_xor(d, 2); d += __shfl_xor(d, 4); d += __shfl_xor(d, 8); d += __shfl_xor(d, 16);
    d *= B.su;
    const float wgt = B.svg * 0.5f * d * (1.0f + erff(d * 0.70710678118654752f));
    __builtin_amdgcn_sched_barrier(0);
    const f32x32 rv = __builtin_amdgcn_cvt_scalef32_pk32_f32_fp6((u32x6){B.va.x, B.va.y, B.va.z, B.va.w, B.vb.x, B.vb.y}, 1.0f);
#pragma unroll
    for (int q = 0; q < 32; ++q) y[q] += wgt * rv[q];
}
__device__ __forceinline__ void phase_gather(Frame& F, const bf16* H2, const int* EI, const float* GA) {
    LAS float* a2 = (LAS float*)F.lds;
    LAS bf16* hrow = (LAS bf16*)(F.lds + 16384 + F.wave * 2048);
    LAS float* yrow = (LAS float*)(F.lds + 16384 + 16384 + F.wave * 4096);
    LAS unsigned* ptab = (LAS unsigned*)(F.lds + 16384 + 16384 + 32768 + F.wave * 128);
    unsigned char* ws = WSP(); const unsigned char* tu = ws + WS_TU; const unsigned char* tv = ws + WS_TV; const float* su = (const float*)(ws + WS_SU); const float* sv = (const float*)(ws + WS_SV); float* outp = OUTP();
    const float* npf = IN(I_NPOSTFFN); const float* modf = (const float*)(ws + WS_MODF); unsigned* qctr = (unsigned*)(ws + WS_CTL) + 32;
    const int lane = F.lane, g = lane >> 5, j = lane & 31;
    {
        f32x16v pa, pb;
#pragma unroll
        for (int i = 0; i < 16; ++i) { pa[i] = 0.125f * (float)i; pb[i] = (i < 8) ? 2.0f + 0.25f * (float)i : 4.0f + 0.5f * (float)(i - 8); }
        const f32x32 pr = __builtin_amdgcn_cvt_scalef32_pk32_f32_fp6(__builtin_amdgcn_cvt_scalef32_2xpk16_fp6_f32(pa, pb, 1.0f), 1.0f);
#pragma unroll
        for (int q = 0; q < 32; ++q) { const float v = pr[q]; int idx = (v < 2.0f) ? (int)(v * 8.0f + 0.5f) : (v < 4.0f) ? 16 + (int)((v - 2.0f) * 4.0f + 0.5f) : 24 + (int)((v - 4.0f) * 2.0f + 0.5f);
            idx = idx < 0 ? 0 : (idx > 31 ? 31 : idx); if (lane == 0) ptab[q] = (unsigned)idx; }
    }
    for (int k = F.tid; k < 4096; k += NTHR) a2[k] = modf[(k >> 10) * 6144 + 5120 + (k & 1023)] * npf[k & 1023];
    __syncthreads();
    {
        for (;;) { unsigned tk = 0u; if (lane == 0) tk = __hip_atomic_fetch_add(qctr, 1u, __ATOMIC_RELAXED, __HIP_MEMORY_SCOPE_AGENT);
            const int m = __builtin_amdgcn_readfirstlane((int)tk); if (m >= M) break; const int b = m / SEQ;
            { const v4u h0 = *(const v4u*)(H2 + (size_t)m * D + 16 * lane), h1 = *(const v4u*)(H2 + (size_t)m * D + 16 * lane + 8);
              *(LAS v4u*)(hrow + 16 * lane) = h0; *(LAS v4u*)(hrow + 16 * lane + 8) = h1; }
            const int e_lo = EI[(size_t)m * 128 + lane], e_hi = EI[(size_t)m * 128 + 64 + lane];
            const float g_lo = GA[(size_t)m * 128 + lane], g_hi = GA[(size_t)m * 128 + 64 + lane];
            asm volatile("s_waitcnt lgkmcnt(0)" ::: "memory");
            unsigned hp[16];
#pragma unroll
            for (int q = 0; q < 16; ++q) hp[q] = (unsigned)hrow[32 * j + ptab[2 * q]] | ((unsigned)hrow[32 * j + ptab[2 * q + 1]] << 16);
            float y[32];
#pragma unroll
            for (int q = 0; q < 32; ++q) y[q] = 0.f;
            RowBuf B0, B1, B2, B3;
#define GLOAD(B, st) gather_load(B, (st), g, j, e_lo, e_hi, g_lo, g_hi, tu, tv, su, sv)
#define SB() __builtin_amdgcn_sched_barrier(0)
            GLOAD(B0, 0); GLOAD(B1, 1); GLOAD(B2, 2);
#pragma unroll 1
            for (int st = 0; st < 64; st += 4) {
                const int s4 = (st + 4 < 64) ? st + 4 : 63, s5 = (st + 5 < 64) ? st + 5 : 63, s6 = (st + 6 < 64) ? st + 6 : 63;
                GLOAD(B3, st + 3); SB(); gather_compute(B0, hp, y); SB();
                GLOAD(B0, s4); SB(); gather_compute(B1, hp, y); SB();
                GLOAD(B1, s5); SB(); gather_compute(B2, hp, y); SB();
                GLOAD(B2, s6); SB(); gather_compute(B3, hp, y); SB();
            }
#undef GLOAD
#undef SB
            float ss = 0.f;
#pragma unroll
            for (int q = 0; q < 32; ++q) { y[q] += __shfl_xor(y[q], 32); ss += y[q] * y[q]; }
            ss += __shfl_xor(ss, 1); ss += __shfl_xor(ss, 2); ss += __shfl_xor(ss, 4); ss += __shfl_xor(ss, 8); ss += __shfl_xor(ss, 16);
            const float rstd = rsqrtf(ss * (1.f / D) + EPS);
            if (g == 0) {
#pragma unroll
                for (int q = 0; q < 32; ++q) yrow[32 * j + ptab[q]] = y[q]; }
            asm volatile("s_waitcnt lgkmcnt(0)" ::: "memory");
            const int k = 32 * j + 16 * g;
            f32x4* op = (f32x4*)(outp + (size_t)m * D + k);
#pragma unroll
            for (int q = 0; q < 4; ++q) { f32x4 xv = op[q]; const f32x4 av = *(const LAS f32x4*)(a2 + b * 1024 + k + 4 * q), yv = *(const LAS f32x4*)(yrow + k + 4 * q);
                xv = xv + av * yv * rstd; op[q] = xv; }
            asm volatile("s_waitcnt lgkmcnt(0)" ::: "memory");
        }
    }
}

typedef GAS unsigned gu32;
#define XB_TMO      128
#define XB_XCNT(j)  (256  + 64 * (j))
#define XB_XSUB(j)  (1280 + 64 * (j))
#define XB_XGEN(j)  (2304 + 64 * (j))
#define XB_TOP      3328
#define XB_TOPGEN   3392
#define XCD_BAR_WORDS 3456
#define XB_SPIN_CAP (1u << 18)

__device__ __forceinline__ unsigned xb_ld(unsigned* p)              { return __hip_atomic_load(p, __ATOMIC_RELAXED, __HIP_MEMORY_SCOPE_AGENT); }
__device__ __forceinline__ unsigned xb_add(unsigned* p, unsigned v) { return __hip_atomic_fetch_add(p, v, __ATOMIC_RELAXED, __HIP_MEMORY_SCOPE_AGENT); }
__device__ __forceinline__ unsigned xb_xcc_id() { return (unsigned)__builtin_amdgcn_s_getreg((3 << 11) | 20) & 0xFu; }
#define XB_SPIN(cond, bar) do { unsigned _sp = 0; while (cond) { __builtin_amdgcn_s_sleep(1); \
    if ((++_sp & 255u) == 0u) { if (xb_ld(&(bar)[XB_TMO])) break; if (_sp > XB_SPIN_CAP) { atomicAdd(&(bar)[XB_TMO], 1u); break; } } } } while (0)

struct XcdBarrier {
    unsigned* bar; unsigned x;
    volatile LAS unsigned* st;
};

__device__ __forceinline__ XcdBarrier xcd_barrier_post(unsigned* bar, volatile LAS unsigned* st) {
    XcdBarrier b; b.bar = bar; b.x = xb_xcc_id(); b.st = st;
    if (threadIdx.x == 0) (void)xb_add(&bar[XB_XCNT(b.x)], 1u);
    return b;
}
__device__ __forceinline__ void xcd_barrier_complete(unsigned* bar, unsigned x, unsigned& nloc, unsigned& nx) {
    const unsigned G = gridDim.x * gridDim.y * gridDim.z;
    unsigned sum, cnt, mine, sp = 0u;
    for (;;) {
        sum = 0u; cnt = 0u; mine = 0u;
#pragma unroll
        for (unsigned j = 0; j < 16; ++j) { const unsigned c = xb_ld(&bar[XB_XCNT(j)]); sum += c; cnt += (c > 0u) ? 1u : 0u; mine = (j == x) ? c : mine; }
        if (sum == G) break;
        __builtin_amdgcn_s_sleep(1);
        if ((++sp & 255u) == 0u) { if (xb_ld(&bar[XB_TMO])) break; if (sp > XB_SPIN_CAP) { atomicAdd(&bar[XB_TMO], 1u); break; } }
    }
    nloc = mine > 0u ? mine : 1u; nx = cnt > 0u ? cnt : 1u;
}

__device__ __forceinline__ void xcd_barrier(const XcdBarrier& b) {
    asm volatile("s_waitcnt vmcnt(0)" ::: "memory");
    __syncthreads();
    if (threadIdx.x == 0) {
        unsigned* bar = b.bar;
        __builtin_amdgcn_s_waitcnt(0);
        unsigned nloc = b.st[0], nx = b.st[1];
        if (nloc == 0u) { xcd_barrier_complete(bar, b.x, nloc, nx); b.st[0] = nloc; b.st[1] = nx; }
        const unsigned old = xb_add(&bar[XB_XSUB(b.x)], 1u);
        const unsigned gen = old / nloc;
        if (old + 1u == (gen + 1u) * nloc) {
            __builtin_amdgcn_fence(__ATOMIC_RELEASE, "agent");
            asm volatile("s_waitcnt vmcnt(0)" ::: "memory");
            const unsigned og = xb_add(&bar[XB_TOP], 1u);
            const unsigned tg = og / nx;
            if (og + 1u == (tg + 1u) * nx) xb_add(&bar[XB_TOPGEN], 1u);
            else XB_SPIN(xb_ld(&bar[XB_TOPGEN]) == tg, bar);
            __builtin_amdgcn_fence(__ATOMIC_ACQUIRE, "agent");
            xb_add(&bar[XB_XGEN(b.x)], 1u);
            asm volatile("s_waitcnt vmcnt(0)" ::: "memory");
        } else {
            XB_SPIN(xb_ld(&bar[XB_XGEN(b.x)]) == gen, bar);
            __builtin_amdgcn_fence(__ATOMIC_ACQUIRE, "agent");
            asm volatile("s_waitcnt vmcnt(0)" ::: "memory");
        }
    }
    __syncthreads();
}

struct Args { const float* in[21]; float* out; unsigned char* ws; };
__global__ void __launch_bounds__(NTHR, 2) fwd_megakernel(Args args) {
    extern __shared__ __attribute__((aligned(16))) unsigned char lds[];
#define MKFRAME() Frame F; { int t_ = threadIdx.x; asm volatile("" : "+v"(t_)); F.lds = (LAS unsigned char*)lds; F.tid = t_; F.lane = t_ & 63; F.wave = __builtin_amdgcn_readfirstlane(t_ >> 6); F.G = gridDim.x; }
#define GRID_SYNC() cg::this_grid().sync()
    volatile LAS unsigned* bst = (volatile LAS unsigned*)((LAS unsigned char*)lds + LDS_BYTES - 64);
    if (threadIdx.x < 16) bst[threadIdx.x] = 0u;
    __syncthreads();
    const XcdBarrier xbar = xcd_barrier_post((unsigned*)(WSP() + WS_CTL) + 1024, bst);
#define XSYNC() xcd_barrier(xbar)
#define WSB(off) ((bf16*)(WSP() + (off)))
#define SEGP(s) segp(WSP(), (s))
    { MKFRAME();
    phase_prologue(F);
    }
    GRID_SYNC();
    { MKFRAME();
    phase_h1(F, (bf16*)OUTP());
    }
    XSYNC();
    { MKFRAME();
    {
        pg8::Gemm g{(const bf16*)OUTP(), WSB(WS_WIN), M, NIN, D}; pg8::StaticOrder S; S.init(M, NIN, F.G, (int)blockIdx.x);
        pg8::EpiBf16<0> E{SEGP(0), 512, nullptr, 512, SEG_ELEMS, 1.f};
        pg8::gemm_phase<pg8::EpiBf16<0>, pg8::StaticOrder, true, true>(F.lds, g, S, E);
    }
    }
    XSYNC();
    { MKFRAME();
    phase_scprep(F);
    { bf16* dW = (bf16*)OUTP(); phase_dnprep(F, dW, dW + (size_t)NITEM * 4096, dW + (size_t)2 * NITEM * 4096, dW + (size_t)3 * NITEM * 4096, WSB(WS_KD)); }
    }
    XSYNC();
    { MKFRAME();
    { const bf16* dW = (const bf16*)OUTP(); phase_scan(F, dW, dW + (size_t)NITEM * 4096, dW + (size_t)2 * NITEM * 4096, dW + (size_t)3 * NITEM * 4096, WSB(WS_KD), SEGP(3)); }
    if (blockIdx.x >= 32) {
        { pg8::StaticOrder S; S.init(M, D, F.G - 32, (int)blockIdx.x - 32);
          pg8::Gemm g{SEGP(0), WSB(WS_WSC), M, D, 512}; pg8::EpiGate<false> E{SEGP(4), SEGP(7), SEG_ELEMS};
          pg8::gemm_phase<pg8::EpiGate<false>, pg8::StaticOrder, true, true>(F.lds, g, S, E); }
        __syncthreads();
        unsigned char* ws = WSP(); LAS float* scr6 = (LAS float*)(F.lds + F.wave * 9216);
        const int gw = (blockIdx.x - 32) * NWAVES + F.wave, NGW = (F.G - 32) * NWAVES;
        p0_table_fp6(IN(I_PU), ws + WS_TU, (float*)(ws + WS_SU), scr6, gw, NGW, F.lane);
        p0_table_fp6(IN(I_PV), ws + WS_TV, (float*)(ws + WS_SV), scr6, gw, NGW, F.lane);
    }
    }
    XSYNC();
    { MKFRAME();
    phase_og(F, SEGP(3), SEGP(6), SEGP(11));
    }
    XSYNC();
    { MKFRAME();
    {
        pg8::StaticOrder S; S.init(M, D, F.G, (int)blockIdx.x);
        { pg8::Gemm g{SEGP(11), WSB(WS_WDN), M, D, 512}; pg8::EpiGate<true> E{SEGP(4), SEGP(9), SEG_ELEMS};
          pg8::gemm_phase<pg8::EpiGate<true>, pg8::StaticOrder, true, true>(F.lds, g, S, E); }
    }
    }
    XSYNC();
    { MKFRAME();
    {
        pg8::Gemm g{SEGP(4), WSB(WS_WMIX), M, D, D}; pg8::StaticOrder S; S.init(M, D, F.G, (int)blockIdx.x);
        pg8::EpiBf16<0> E{SEGP(1), D, nullptr, 0, 0, 1.f};
        pg8::gemm_phase<pg8::EpiBf16<0>, pg8::StaticOrder, true, true>(F.lds, g, S, E);
    }
    }
    XSYNC();
    { MKFRAME();
    phase_x1h2(F, SEGP(1), SEGP(7));
    }
    XSYNC();
    { MKFRAME();
    {
        pg8::Gemm g{SEGP(7), WSB(WS_WQ), M, 2048, D}; pg8::StaticOrder S; S.init(M, 2048, F.G, (int)blockIdx.x);
        pg8::EpiQF E{SEGP(3)};
        pg8::gemm_phase<pg8::EpiQF, pg8::StaticOrder, true, true>(F.lds, g, S, E);
    }
    }
    XSYNC();
    { MKFRAME();
    phase_topk(F, SEGP(3), (int*)SEGP(0), (float*)((unsigned char*)SEGP(0) + 16 * MiB));
    }
    XSYNC();
    { MKFRAME();
    phase_gather(F, SEGP(7), (const int*)SEGP(0), (const float*)((unsigned char*)SEGP(0) + 16 * MiB));
    }
}

extern "C" void kernel_launch(void* const* d_in, const int* in_sizes, int n_in, void* d_out, int out_size, void* d_ws, size_t ws_size, hipStream_t stream) {
    static int grid = 0;
    if (grid == 0) {
        if (n_in != 21 || out_size != M * D || ws_size < WS_END) { fprintf(stderr, "kernel_launch: unexpected problem (n_in %d, out %d, ws %zu)\n", n_in, out_size, ws_size); grid = -1; return; }
        int dev = 0, cus = 0, per_cu = 0;
        hipGetDevice(&dev); hipDeviceGetAttribute(&cus, hipDeviceAttributeMultiprocessorCount, dev);
        hipFuncSetAttribute((const void*)fwd_megakernel, hipFuncAttributeMaxDynamicSharedMemorySize, LDS_BYTES);
        hipOccupancyMaxActiveBlocksPerMultiprocessor(&per_cu, (const void*)fwd_megakernel, NTHR, LDS_BYTES);
        if (per_cu < 1) { fprintf(stderr, "kernel_launch: occupancy query says %d blocks per CU\n", per_cu); per_cu = 1; }
        if (per_cu > 1) per_cu = 1;
        grid = cus * per_cu; if (grid > 256) grid = 256;
        (void)hipGetLastError();
    }
    if (grid < 0) return;
    if (hipMemsetAsync((char*)d_ws + WS_CTL, 0, 65536, stream) != hipSuccess) { fprintf(stderr, "kernel_launch: memset of the barrier words failed\n"); return; }
    Args a{};
    for (int i = 0; i < 21; ++i) a.in[i] = (const float*)d_in[i];
    a.out = (float*)d_out; a.ws = (unsigned char*)d_ws;
    void* kargs[] = {&a};
    hipError_t e = hipLaunchCooperativeKernel((const void*)fwd_megakernel, dim3(grid), dim3(NTHR), kargs, LDS_BYTES, stream);
    if (e != hipSuccess) fprintf(stderr, "cooperative launch failed: %s (grid %d)\n", hipGetErrorString(e), grid);
}
```
